# Optimizing an MI355X kernel written in HIP

```python
import math
import jax, jax.numpy as jnp
from jax import lax
import numpy as np


D_MODEL = 2048
BATCH = 2
SEQ = 16384
DEPTH = 2
DEC_BATCH = 16
DEC_SEQ = 32
PAST_LEN = 2048

CHUNK = 64
N_A_LAYERS = DEPTH // 2
N_B_LAYERS = DEPTH - N_A_LAYERS
SSM_GROUP = 16
N_GROUPS = D_MODEL // SSM_GROUP
SSM_STATE = 64
SCAN_BLOCK = CHUNK
N_HEADS = 8
HEAD_DIM = D_MODEL // (2 * N_HEADS)
V_DIM = 2 * HEAD_DIM
ROT_DIM = HEAD_DIM // 4
ROPE_THETA = 500000.0
Q_BLOCK = 128
D_FF = 5632
CONV_W = 3
PLE_DIM = 256
EPS = 1e-6
SUBLN_EPS = 1e-5

kernel_name = 'yoco_s5_diffattn_stream_step'


def _rmsnorm(x, g, eps=EPS):
    xf = x.astype(jnp.float32)
    y = xf * lax.rsqrt(jnp.mean(xf * xf, axis=-1, keepdims=True) + eps)
    return (y * g.astype(jnp.float32)).astype(x.dtype)


def _rope_partial(x, pos):
    half = ROT_DIM // 2
    inv = ROPE_THETA ** (-jnp.arange(half, dtype=jnp.float32) * 2.0 / ROT_DIM)
    ang = pos.astype(jnp.float32)[:, None] * inv[None, :]
    cos = jnp.cos(ang)[None, :, None, None, :]
    sin = jnp.sin(ang)[None, :, None, None, :]
    xf = x.astype(jnp.float32)
    x1 = xf[..., :half]
    x2 = xf[..., half:ROT_DIM]
    out = jnp.concatenate([x1 * cos - x2 * sin, x2 * cos + x1 * sin, xf[..., ROT_DIM:]], axis=-1)
    return out.astype(x.dtype)


def _s5_scan(u, s_re, s_im, a_re, a_im, log_dt, b_re, b_im, c_re, c_im, d_skip):
    f32 = jnp.float32
    bt, L, _ = u.shape
    uf = u.astype(f32).reshape(bt, L, N_GROUPS, SSM_GROUP)
    a_re = a_re.astype(f32)
    a_im = a_im.astype(f32)
    dt = jnp.exp(log_dt.astype(f32))[:, None]
    mag = jnp.exp(a_re * dt)
    lb_re = mag * jnp.cos(a_im * dt)
    lb_im = mag * jnp.sin(a_im * dt)
    den = a_re * a_re + a_im * a_im
    n_re = lb_re - 1.0
    k_re = (n_re * a_re + lb_im * a_im) / den
    k_im = (lb_im * a_re - n_re * a_im) / den
    b_re = b_re.astype(f32)
    b_im = b_im.astype(f32)
    bb_re = k_re[..., None] * b_re - k_im[..., None] * b_im
    bb_im = k_re[..., None] * b_im + k_im[..., None] * b_re
    c_re = c_re.astype(f32)
    c_im = c_im.astype(f32)
    blk = SCAN_BLOCK if L % SCAN_BLOCK == 0 else L
    nb = L // blk
    ub = uf.reshape(bt, nb, blk, N_GROUPS, SSM_GROUP).swapaxes(0, 1)
    a_blk_re = jnp.broadcast_to(lb_re, (bt, blk, N_GROUPS, SSM_STATE))
    a_blk_im = jnp.broadcast_to(lb_im, (bt, blk, N_GROUPS, SSM_STATE))

    def combine(e1, e2):
        a1r, a1i, b1r, b1i = e1
        a2r, a2i, b2r, b2i = e2
        return (a2r * a1r - a2i * a1i,
                a2r * a1i + a2i * a1r,
                a2r * b1r - a2i * b1i + b2r,
                a2r * b1i + a2i * b1r + b2i)

    def step(carry, ut):
        xr0, xi0 = carry
        bu_re = jnp.einsum('blgc,gpc->blgp', ut, bb_re)
        bu_im = jnp.einsum('blgc,gpc->blgp', ut, bb_im)
        pr, pi, sr, si = lax.associative_scan(combine, (a_blk_re, a_blk_im, bu_re, bu_im), axis=1)
        xr = sr + pr * xr0[:, None] - pi * xi0[:, None]
        xi = si + pr * xi0[:, None] + pi * xr0[:, None]
        y = jnp.einsum('blgp,gcp->blgc', xr, c_re) - jnp.einsum('blgp,gcp->blgc', xi, c_im)
        return (xr[:, -1], xi[:, -1]), y

    (fr, fi), ys = lax.scan(step, (s_re.astype(f32), s_im.astype(f32)), ub)
    y = ys.swapaxes(0, 1).reshape(bt, L, D_MODEL) + uf.reshape(bt, L, D_MODEL) * d_skip.astype(f32)
    return y.astype(u.dtype), fr, fi


def _glu(y, w_glu):
    g = jax.nn.gelu(y)
    z = g @ w_glu
    return z[..., :D_MODEL] * jax.nn.sigmoid(z[..., D_MODEL:])


def _conv_ffn(h, conv0, g, w_up, conv_w, conv_b, w_down):
    L = h.shape[1]
    z = _rmsnorm(h, g) @ w_up
    zp = jnp.concatenate([conv0.astype(z.dtype), z], axis=1)
    c = conv_b
    for k in range(CONV_W):
        c = c + conv_w[k] * zp[:, k:k + L]
    out = (jax.nn.silu(c[..., D_FF:]) * c[..., :D_FF]) @ w_down
    return out, zp[:, -(CONV_W - 1):]


def _ple(h, p_i, g, w_gate, w_proj):
    return h + (p_i @ w_proj) * jax.nn.sigmoid(_rmsnorm(h, g) @ w_gate)


def _shared_kv(h, pos, g, w_k, w_v):
    bt, L, _ = h.shape
    n = _rmsnorm(h, g)
    k = _rope_partial((n @ w_k).reshape(bt, L, N_HEADS, 2, HEAD_DIM), pos)
    v = (n @ w_v).reshape(bt, L, N_HEADS, V_DIM)
    return k, v


def _diff_attend(q, k, v, q_cid, k_cid, lam):
    f32 = jnp.float32
    scale = HEAD_DIM ** -0.5
    kf = k.astype(f32)
    vf = v.astype(f32)

    def block(args):
        qb, cb = args
        s = jnp.einsum('bqhcd,bkhcd->bhcqk', qb.astype(f32), kf) * scale
        mask = k_cid[None, :] <= cb[:, None]
        s = jnp.where(mask, s, -jnp.inf)
        pr = jax.nn.softmax(s, axis=-1)
        a = pr[:, :, 0] - lam * pr[:, :, 1]
        return jnp.einsum('bhqk,bkhv->bqhv', a, vf)

    bq, sq = q.shape[:2]
    if sq > Q_BLOCK and sq % Q_BLOCK == 0:
        nb = sq // Q_BLOCK
        qb = q.reshape(bq, nb, Q_BLOCK, N_HEADS, 2, HEAD_DIM).swapaxes(0, 1)
        cb = q_cid.reshape(nb, Q_BLOCK)
        o = lax.map(block, (qb, cb))
        return o.swapaxes(0, 1).reshape(bq, sq, N_HEADS, V_DIM)
    return block((q, q_cid))


def _diff_attn(u, pos, k_all, v_all, layer_idx, w_q, lq1, lk1, lq2, lk2, g_sub, w_o):
    bt, L, _ = u.shape
    f32 = jnp.float32
    q = _rope_partial((u @ w_q).reshape(bt, L, N_HEADS, 2, HEAD_DIM), pos)
    lam_init = 0.8 - 0.6 * math.exp(-0.3 * layer_idx)
    lam = (jnp.exp(jnp.sum(lq1.astype(f32) * lk1.astype(f32)))
           - jnp.exp(jnp.sum(lq2.astype(f32) * lk2.astype(f32))) + lam_init)
    k_cid = jnp.arange(k_all.shape[1], dtype=jnp.int32) // CHUNK
    o = _diff_attend(q, k_all, v_all, pos // CHUNK, k_cid, lam)
    o = _rmsnorm(o, g_sub, SUBLN_EPS) * (1.0 - lam_init)
    return o.reshape(bt, L, N_HEADS * V_DIM).astype(u.dtype) @ w_o


def _run_group(x, p, pos0, ssm_re0, ssm_im0, conv0, k_cache, v_cache, W):
    bt, L, _ = x.shape
    pos = pos0 + jnp.arange(L, dtype=jnp.int32)
    h = x
    ssm_re, ssm_im, conv_new = [], [], []
    k_rows = v_rows = k_all = v_all = None
    for i in range(DEPTH):
        u = _rmsnorm(h, W['norm_mix'][i])
        if i < N_A_LAYERS:
            y, sr, si = _s5_scan(u, ssm_re0[i], ssm_im0[i], W['ssm_a_re'][i], W['ssm_a_im'][i],
                                 W['ssm_log_dt'][i], W['ssm_b_re'][i], W['ssm_b_im'][i],
                                 W['ssm_c_re'][i], W['ssm_c_im'][i], W['ssm_d'][i])
            ssm_re.append(sr)
            ssm_im.append(si)
            h = h + _glu(y, W['w_glu'][i])
        else:
            if i == N_A_LAYERS:
                k_rows, v_rows = _shared_kv(h, pos, W['norm_kv'], W['w_k'], W['w_v'])
                if k_cache is None:
                    k_all, v_all = k_rows, v_rows
                else:
                    kc = k_cache.reshape(bt, k_cache.shape[1], N_HEADS, 2, HEAD_DIM).astype(k_rows.dtype)
                    k_all = jnp.concatenate([kc, k_rows], axis=1)
                    v_all = jnp.concatenate([v_cache.astype(v_rows.dtype), v_rows], axis=1)
            j = i - N_A_LAYERS
            h = h + _diff_attn(u, pos, k_all, v_all, i, W['w_q'][j], W['lambda_q1'][j],
                               W['lambda_k1'][j], W['lambda_q2'][j], W['lambda_k2'][j],
                               W['norm_sub'][j], W['w_o'][j])
        f, cs = _conv_ffn(h, conv0[i], W['norm_ffn'][i], W['w_up'][i], W['conv_w'][i],
                          W['conv_b'][i], W['w_down'][i])
        conv_new.append(cs)
        h = h + f
        h = _ple(h, p[i], W['norm_ple'][i], W['w_ple_gate'][i], W['w_ple_proj'][i])
    y = _rmsnorm(h, W['norm_final'])
    k_out = k_rows.reshape(bt, L, N_HEADS, 2 * HEAD_DIM)
    return y, jnp.stack(ssm_re), jnp.stack(ssm_im), jnp.stack(conv_new), k_out, v_rows


def setup_inputs(seed: int = 0) -> dict:
    key = jax.random.key(seed)
    ks = iter(jax.random.split(key, 48))
    f32 = jnp.float32

    def nrm(shape, scale=1.0):
        return jax.random.normal(next(ks), shape, f32) * scale

    def gain(shape):
        return 1.0 + nrm(shape, 0.02)

    qk = N_HEADS * 2 * HEAD_DIM
    vd = N_HEADS * V_DIM
    n_idx = jnp.arange(SSM_STATE, dtype=f32)
    return {
        'x_prompt': nrm((BATCH, SEQ, D_MODEL)),
        'x_sample': nrm((DEC_BATCH, DEC_SEQ, D_MODEL)),
        'state_ssm_re': nrm((N_A_LAYERS, DEC_BATCH, N_GROUPS, SSM_STATE), 0.5),
        'state_ssm_im': nrm((N_A_LAYERS, DEC_BATCH, N_GROUPS, SSM_STATE), 0.5),
        'state_conv': nrm((DEPTH, DEC_BATCH, CONV_W - 1, 2 * D_FF)),
        'cache_k': nrm((DEC_BATCH, PAST_LEN, N_HEADS, 2 * HEAD_DIM)),
        'cache_v': nrm((DEC_BATCH, PAST_LEN, N_HEADS, V_DIM)),
        'p_prompt': nrm((DEPTH, BATCH, SEQ, PLE_DIM)),
        'p_sample': nrm((DEPTH, DEC_BATCH, DEC_SEQ, PLE_DIM)),
        'norm_mix': gain((DEPTH, D_MODEL)),
        'ssm_a_re': -0.5 * jnp.exp(nrm((N_A_LAYERS, N_GROUPS, SSM_STATE), 0.02)),
        'ssm_a_im': math.pi * n_idx + nrm((N_A_LAYERS, N_GROUPS, SSM_STATE), 0.01),
        'ssm_log_dt': jax.random.uniform(next(ks), (N_A_LAYERS, N_GROUPS), f32,
                                         math.log(1e-3), math.log(1e-1)),
        'ssm_b_re': nrm((N_A_LAYERS, N_GROUPS, SSM_STATE, SSM_GROUP), (2 * SSM_GROUP) ** -0.5),
        'ssm_b_im': nrm((N_A_LAYERS, N_GROUPS, SSM_STATE, SSM_GROUP), (2 * SSM_GROUP) ** -0.5),
        'ssm_c_re': nrm((N_A_LAYERS, N_GROUPS, SSM_GROUP, SSM_STATE), SSM_STATE ** -0.5),
        'ssm_c_im': nrm((N_A_LAYERS, N_GROUPS, SSM_GROUP, SSM_STATE), SSM_STATE ** -0.5),
        'ssm_d': nrm((N_A_LAYERS, D_MODEL)),
        'w_glu': nrm((N_A_LAYERS, D_MODEL, 2 * D_MODEL), D_MODEL ** -0.5),
        'norm_kv': gain((D_MODEL,)),
        'w_k': nrm((D_MODEL, qk), D_MODEL ** -0.5),
        'w_v': nrm((D_MODEL, vd), D_MODEL ** -0.5),
        'w_q': nrm((N_B_LAYERS, D_MODEL, qk), D_MODEL ** -0.5),
        'lambda_q1': nrm((N_B_LAYERS, HEAD_DIM), 0.1),
        'lambda_k1': nrm((N_B_LAYERS, HEAD_DIM), 0.1),
        'lambda_q2': nrm((N_B_LAYERS, HEAD_DIM), 0.1),
        'lambda_k2': nrm((N_B_LAYERS, HEAD_DIM), 0.1),
        'norm_sub': gain((N_B_LAYERS, V_DIM)),
        'w_o': nrm((N_B_LAYERS, vd, D_MODEL), vd ** -0.5),
        'norm_ffn': gain((DEPTH, D_MODEL)),
        'w_up': nrm((DEPTH, D_MODEL, 2 * D_FF), D_MODEL ** -0.5),
        'conv_w': nrm((DEPTH, CONV_W, 2 * D_FF), CONV_W ** -0.5),
        'conv_b': nrm((DEPTH, 2 * D_FF), 0.01),
        'w_down': nrm((DEPTH, D_FF, D_MODEL), D_FF ** -0.5),
        'norm_ple': gain((DEPTH, D_MODEL)),
        'w_ple_gate': nrm((DEPTH, D_MODEL, D_MODEL), D_MODEL ** -0.5),
        'w_ple_proj': nrm((DEPTH, PLE_DIM, D_MODEL), PLE_DIM ** -0.5),
        'norm_final': gain((D_MODEL,)),
    }


def reference(x_prompt, x_sample, state_ssm_re, state_ssm_im, state_conv, cache_k, cache_v,
              p_prompt, p_sample, norm_mix, ssm_a_re, ssm_a_im, ssm_log_dt, ssm_b_re, ssm_b_im,
              ssm_c_re, ssm_c_im, ssm_d, w_glu, norm_kv, w_k, w_v, w_q, lambda_q1, lambda_k1,
              lambda_q2, lambda_k2, norm_sub, w_o, norm_ffn, w_up, conv_w, conv_b, w_down,
              norm_ple, w_ple_gate, w_ple_proj, norm_final):
    W = {
        'norm_mix': norm_mix, 'ssm_a_re': ssm_a_re, 'ssm_a_im': ssm_a_im,
        'ssm_log_dt': ssm_log_dt, 'ssm_b_re': ssm_b_re, 'ssm_b_im': ssm_b_im,
        'ssm_c_re': ssm_c_re, 'ssm_c_im': ssm_c_im, 'ssm_d': ssm_d, 'w_glu': w_glu,
        'norm_kv': norm_kv, 'w_k': w_k, 'w_v': w_v, 'w_q': w_q,
        'lambda_q1': lambda_q1, 'lambda_k1': lambda_k1, 'lambda_q2': lambda_q2,
        'lambda_k2': lambda_k2, 'norm_sub': norm_sub, 'w_o': w_o,
        'norm_ffn': norm_ffn, 'w_up': w_up, 'conv_w': conv_w, 'conv_b': conv_b,
        'w_down': w_down, 'norm_ple': norm_ple, 'w_ple_gate': w_ple_gate,
        'w_ple_proj': w_ple_proj, 'norm_final': norm_final,
    }
    bp = x_prompt.shape[0]
    z_ssm = jnp.zeros((N_A_LAYERS, bp, N_GROUPS, SSM_STATE), jnp.float32)
    z_conv = jnp.zeros((DEPTH, bp, CONV_W - 1, 2 * D_FF), x_prompt.dtype)
    y_p, sre_p, sim_p, conv_p, k_p, v_p = _run_group(
        x_prompt, p_prompt, 0, z_ssm, z_ssm, z_conv, None, None, W)
    y_s, sre_s, sim_s, conv_s, k_s, v_s = _run_group(
        x_sample, p_sample, cache_k.shape[1], state_ssm_re, state_ssm_im, state_conv,
        cache_k, cache_v, W)
    return (y_p, y_s, sre_p, sim_p, conv_p, k_p, v_p, sre_s, sim_s, conv_s, k_s, v_s)
```

```cpp
#include <hip/hip_runtime.h>
#include <cstdio>
#include <cstdint>

#ifndef MK_N_LAUNCHES
#define MK_N_LAUNCHES 1
#endif

#ifndef PROBE_ATT2
#define PROBE_ATT2 0
#endif
#ifndef PROBE_UP2
#define PROBE_UP2 0
#endif
#ifndef PROBE_G2
#define PROBE_G2 0
#endif
#ifndef PROBE_SSM2
#define PROBE_SSM2 0
#endif
#ifndef PROBE_MFMA
#define PROBE_MFMA 0
#endif
#ifndef PROBE_FF2
#define PROBE_FF2 0
#endif
#ifndef PROBE_PO2
#define PROBE_PO2 0
#endif
#ifndef PROBE_DOWN2
#define PROBE_DOWN2 0
#endif
#ifndef PROBE_P2
#define PROBE_P2 0
#endif
#ifndef PROBE_S2
#define PROBE_S2 0
#endif
#define LAS __attribute__((address_space(3)))
typedef unsigned short bf16_t;
typedef short bf16x8 __attribute__((ext_vector_type(8)));
typedef short s16x4 __attribute__((ext_vector_type(4)));
typedef float f32x4 __attribute__((ext_vector_type(4)));
typedef float f32x2 __attribute__((ext_vector_type(2)));
typedef float f32x16 __attribute__((ext_vector_type(16)));
typedef unsigned u32x4 __attribute__((ext_vector_type(4)));
typedef unsigned u32x2 __attribute__((ext_vector_type(2)));

constexpr int DM = 2048, SEQ = 16384, NBAT = 2, MP = NBAT * SEQ, DB = 16, DSEQ = 32, MS = DB * DSEQ, MT = MP + MS;
constexpr int NTILE = MT / 256;
constexpr int DFF = 5632, DFF2 = 2 * DFF, PLE = 256, PAST = 2048;
constexpr int NG = 128, NST = 64, NH = 8, HD = 128, VD = 256;
constexpr float EPS = 1e-6f, SUBLN_EPS = 1e-5f;
constexpr int NWAVES = 8, NTHR = 512;

constexpr size_t O_Y = 0, O_YS = 67108864, O_SRE_P = 68157440, O_SIM_P = 68173824, O_CONV_P = 68190208, O_K_P = 68280320, O_V_P = 135389184,
                 O_SRE_S = 202498048, O_SIM_S = 202629120, O_CONV_S = 202760192, O_K_S = 203481088, O_V_S = 204529664, O_END = 205578240;

constexpr size_t MiB = 1u << 20;
constexpr size_t WS_CTL = 0, CTL_ZERO_BYTES = 1 * MiB;
constexpr size_t WS_WGLU = 1 * MiB;
constexpr size_t WS_WUP = 17 * MiB;
constexpr size_t WS_WDOWN = 105 * MiB;
constexpr size_t WS_WGATE = 149 * MiB;
constexpr size_t WS_WPROJ = 165 * MiB;
constexpr size_t WS_WQKV = 167 * MiB;
constexpr size_t WS_WO = 191 * MiB;
constexpr size_t WS_ROPE = 199 * MiB;
constexpr size_t WS_L16 = 202 * MiB;
constexpr size_t WS_CONVP = 202 * MiB + 131072;
constexpr size_t WS_QS = 203 * MiB;
constexpr size_t WS_PB = 209 * MiB;
constexpr size_t WS_PART0 = 226 * MiB, WS_PART1 = 235 * MiB;
constexpr size_t WS_HB = 244 * MiB;
constexpr size_t WS_UB = 374 * MiB;
constexpr size_t WS_PP = 504 * MiB;
constexpr size_t WS_BIG = 634 * MiB;
constexpr size_t WS_KB = 894 * MiB;
constexpr size_t WS_VB = 1022 * MiB;
constexpr size_t WS_END = 1150 * MiB;
constexpr size_t WS_SSM = WS_KB;
constexpr size_t SSM_G_BYTES = 262144;
constexpr size_t WS_ZSIDE = WS_VB;

constexpr int CW_BAR = 4096;

constexpr int RING_BYTES = 131072, LDSCTL_OFF = RING_BYTES, LDS_BYTES = 147456;

__device__ __forceinline__ unsigned cvt_pk_bf16(float lo, float hi) { unsigned r; asm volatile("v_cvt_pk_bf16_f32 %0, %1, %2" : "=v"(r) : "v"(lo), "v"(hi)); return r; }
__device__ __forceinline__ float bf2f(unsigned short b) { return __uint_as_float(((unsigned)b) << 16); }
__device__ __forceinline__ float fsigmoid(float x) { return __builtin_amdgcn_rcpf(1.f + __expf(-x)); }
__device__ __forceinline__ float gelu_tanh(float x) { const float t = 1.5957691216f * (x + 0.044715f * x * x * x); return x * fsigmoid(t); }
__device__ __forceinline__ float wave_sum(float v) {
#pragma unroll
    for (int o = 1; o < 64; o <<= 1) v += __shfl_xor(v, o);
    return v;
}
template <class T> __device__ __forceinline__ T* at32(T* base, unsigned elem) { return (T*)((char*)base + elem * (unsigned)sizeof(T)); }
template <class T> __device__ __forceinline__ const T* at32(const T* base, unsigned elem) { return (const T*)((const char*)base + elem * (unsigned)sizeof(T)); }
template <int CTRL> __device__ __forceinline__ float dppf(float v) { return __int_as_float(__builtin_amdgcn_mov_dpp(__float_as_int(v), CTRL, 0xf, 0xf, false)); }
#define DPP_ROR1 0x121
#define DPP_ROR2 0x122

namespace pg8 {
constexpr int BM = 256, BK = 64, HALF = 128, HTB = HALF * BK * 2, STAGE_BYTES = 8 * HTB, NXCD = 8, WGM = 4;
__host__ __device__ __forceinline__ int lds_byte(int r, int c) { const int st = (r >> 4) * 2 + (c >> 5), rr = r & 15, cc = c & 31, ob = rr * 64 + cc * 2; return st * 1024 + (ob ^ (((ob >> 9) & 1) << 5)); }
__host__ __device__ __forceinline__ void stage_rc(int b, int& R, int& C) { const int st = b / 1024, sb = b % 1024, swz = sb ^ (((sb >> 9) & 1) << 5); R = (st >> 1) * 16 + swz / 64; C = (st & 1) * 32 + (swz % 64) / 2; }
__host__ __device__ __forceinline__ int perm32(int rho) { const int n = rho >> 4, i = rho & 15; return 8 * (i >> 2) + 4 * n + (i & 3); }

struct Unit { int pm, pn, rb, aih; };
struct Gemm { const bf16_t* A; const bf16_t* Bt; int M, N, K; };

struct StaticOrder {
    int nM, nN, nwg, G, c;
    __host__ __device__ void init(int M, int N, int G_, int c_) { nM = M / BM; nN = N / BM; nwg = nM * nN; G = G_; c = c_; }
    __host__ __device__ bool next(int i, Unit& u) const {
        const long L = (long)i * G + c; if (L >= nwg) return false;
        int wgid = (int)L; { const int q = nwg / NXCD, r = nwg % NXCD, xcd = wgid % NXCD, off = wgid / NXCD; wgid = (xcd < r ? xcd * (q + 1) : r * (q + 1) + (xcd - r) * q) + off; }
        const int nig = WGM * nN, gid = wgid / nig, fm = gid * WGM, gsz = (nM - fm) < WGM ? (nM - fm) : WGM;
        u.pm = fm + ((wgid % nig) % gsz); u.pn = (wgid % nig) / gsz; u.rb = u.pm * BM; u.aih = 0; return true;
    }
    __device__ __forceinline__ void a_ready(const Unit&) const {}
    __device__ __forceinline__ void done(const Unit&) const {}
};
struct HalfOrder {
    int nN, nwg, G, c, pm0;
    __host__ __device__ void init(int pm0_, int N, int G_, int c_) { pm0 = pm0_; nN = N / BM; nwg = 4 * nN; G = G_; c = c_; }
    __host__ __device__ bool next(int i, Unit& u) const {
        const long L = (long)i * G + c; if (L >= nwg) return false;
        const int idx = (int)L, sub = idx & 3; u.pn = idx >> 2; u.pm = pm0 + (sub >> 1); u.aih = sub & 1; u.rb = u.pm * BM + 64 * u.aih; return true;
    }
    __device__ __forceinline__ void a_ready(const Unit&) const {}
    __device__ __forceinline__ void done(const Unit&) const {}
};

#ifndef PG8_SP2
#define PG8_SP2 true
#endif
#ifndef PG8_ALIGN
#define PG8_ALIGN true
#endif
template <class Epi, class Sched, bool HALFM = false, bool ALIGN_EPI = PG8_ALIGN, bool SP2 = PG8_SP2>
__device__ __forceinline__ void gemm_phase(LAS unsigned char* lds, const Gemm g, const Sched& S, const Epi& E, const int wid  ) {
    int lane_ = __builtin_amdgcn_mbcnt_hi(~0u, __builtin_amdgcn_mbcnt_lo(~0u, 0u)); asm volatile("" : "+v"(lane_));
    const int lane = lane_, tid = wid * 64 + lane, wr = wid >> 2, wc = wid & 3, fr = lane & 15, fq = lane >> 4;
    const int K = g.K, nt = K / BK;
    unsigned voffA[2], voffB[2];
#pragma unroll
    for (int i = 0; i < 2; ++i) { int R, C; stage_rc(tid * 16 + i * 8192, R, C); const int Rb = Epi::PERM ? ((R & ~31) + perm32(R & 31)) : R;
        const int Ra = (R >> 6) * 128 + (R & 63);
        voffA[i] = (unsigned)(Ra * K + C) * 2u; voffB[i] = (unsigned)(Rb * K + C) * 2u; }
    const __amdgpu_buffer_rsrc_t rsA_ = __builtin_amdgcn_make_buffer_rsrc((void*)g.A, 0, 0x7ffffff0, 0x00020000), rsB_ = __builtin_amdgcn_make_buffer_rsrc((void*)g.Bt, 0, 0x7ffffff0, 0x00020000);
    const size_t kstep = (size_t)(BK * 2);
    const size_t hstepB = (size_t)HALF * K * 2, hstepA = (size_t)64 * K * 2;
    const size_t tstep = (size_t)BM * K * 2;
    const unsigned ldsw = (unsigned)wid * 1024u;
    const int aoff = lds_byte(wr * 64 + fr, fq * 8), boff = lds_byte(wc * 32 + fr, fq * 8);
#define PG8_SA(b, h) (((b) * 2 + (h)) * HTB)
#define PG8_SB(b, h) ((4 + (b) * 2 + (h)) * HTB)
#define PG8_STAGE(bufoff, gbase, voff) do { const int so_ = (int)(unsigned)((const char*)(gbase) - PG8_BASE_##voff); _Pragma("unroll") for (int _i = 0; _i < 2; ++_i) \
        __builtin_amdgcn_raw_ptr_buffer_load_lds(PG8_RS_##voff, (LAS unsigned*)(lds + (bufoff) + ldsw + _i * 8192), 16, (int)(voff)[_i], so_, 0, 0); } while (0)
#define PG8_BASE_voffA ((const char*)g.A)
#define PG8_BASE_voffB ((const char*)g.Bt)
#define PG8_RS_voffA rsA_
#define PG8_RS_voffB rsB_
#define PG8_LDA(dst, b, h) do { _Pragma("unroll") for (int m = 0; m < 4; ++m) _Pragma("unroll") for (int k = 0; k < 2; ++k) dst[m][k] = *(const LAS bf16x8*)(lds + PG8_SA(b, h) + aoff + m * 2048 + k * 1024); } while (0)
#define PG8_LDB(dst, b, h) do { _Pragma("unroll") for (int n = 0; n < 2; ++n) _Pragma("unroll") for (int k = 0; k < 2; ++k) dst[n][k] = *(const LAS bf16x8*)(lds + PG8_SB(b, h) + boff + n * 2048 + k * 1024); } while (0)
#define PG8_MMA(ai, bj, At, Bt) do { __builtin_amdgcn_s_setprio(1); _Pragma("unroll") for (int m = 0; m < 4; ++m) _Pragma("unroll") for (int n = 0; n < 2; ++n) _Pragma("unroll") for (int k = 0; k < 2; ++k) \
        acc[ai][bj][m][n] = __builtin_amdgcn_mfma_f32_16x16x32_bf16(Bt[n][k], At[m][k], acc[ai][bj][m][n], 0, 0, 0); __builtin_amdgcn_s_setprio(0); } while (0)
#define PG8_WAIT_V(n) asm volatile("s_waitcnt vmcnt(" #n ")" ::: "memory")
#define PG8_WAIT_L(n) asm volatile("s_waitcnt lgkmcnt(" #n ")" ::: "memory")
#define PG8_BAR __builtin_amdgcn_s_barrier()
#define PG8_SCHED __builtin_amdgcn_sched_barrier(0)
    Unit cur, nxt; int ui = 0;
    if (!S.next(0, cur)) return;
    f32x4 acc[2][2][4][2];
#pragma unroll
    for (int a = 0; a < 2; ++a)
#pragma unroll
        for (int b = 0; b < 2; ++b)
#pragma unroll
            for (int m = 0; m < 4; ++m)
#pragma unroll
                for (int n = 0; n < 2; ++n) acc[a][b][m][n] = (f32x4){0.f, 0.f, 0.f, 0.f};
    bf16x8 At[4][2], B0[2][2], B1[2][2];
    static_assert(SP2 || !HALFM, "half-M units: SP2 loop only");
    const char* cA = (const char*)g.A + (size_t)cur.pm * tstep + (size_t)cur.aih * hstepA; const char* cB = (const char*)g.Bt + (size_t)cur.pn * tstep;
    S.a_ready(cur);
    if constexpr (SP2) {
        PG8_STAGE(PG8_SB(0, 0), cB, voffB); PG8_STAGE(PG8_SB(0, 1), cB + hstepB, voffB); PG8_STAGE(PG8_SA(0, 0), cA, voffA); if constexpr (!HALFM) PG8_STAGE(PG8_SA(0, 1), cA + hstepA, voffA);
        if (wr == 1) PG8_BAR;
        if constexpr (HALFM) PG8_WAIT_V(0); else PG8_WAIT_V(2);
        PG8_BAR;
        PG8_STAGE(PG8_SB(1, 0), cB + kstep, voffB); PG8_STAGE(PG8_SA(1, 0), cA + kstep, voffA); PG8_STAGE(PG8_SB(1, 1), cB + hstepB + kstep, voffB);
        PG8_WAIT_V(6); PG8_BAR;
    } else {
    PG8_STAGE(PG8_SB(0, 0), cB, voffB); PG8_STAGE(PG8_SA(0, 0), cA, voffA); PG8_STAGE(PG8_SB(0, 1), cB + hstepB, voffB); PG8_STAGE(PG8_SA(0, 1), cA + hstepA, voffA);
    if (wr == 1) PG8_BAR;
    PG8_WAIT_V(4); PG8_BAR;
    PG8_STAGE(PG8_SB(1, 0), cB + kstep, voffB); PG8_STAGE(PG8_SA(1, 0), cA + kstep, voffA); PG8_STAGE(PG8_SB(1, 1), cB + hstepB + kstep, voffB);
    PG8_WAIT_V(6); PG8_BAR;
    }
    for (;;) {
        const bool has_next = S.next(ui + 1, nxt);
        const char* nA = has_next ? (const char*)g.A + (size_t)nxt.pm * tstep + (size_t)nxt.aih * hstepA : cA; const char* nB = has_next ? (const char*)g.Bt + (size_t)nxt.pn * tstep : cB;
        for (int t = 0; t < nt; t += 2) {
            const bool last = (t == nt - 2);
            const char* a1 = cA + (size_t)(t + 1) * kstep;
            const char* a2 = last ? nA : cA + (size_t)(t + 2) * kstep; const char* b2 = last ? nB : cB + (size_t)(t + 2) * kstep;
            const char* a3 = a2 + kstep; const char* b3 = b2 + kstep;
            if (last && has_next) S.a_ready(nxt);
            if constexpr (SP2) {
#define PG8_WAIT_VH() do { if constexpr (HALFM) PG8_WAIT_V(6); else PG8_WAIT_V(8); } while (0)
            PG8_LDB(B0, 0, 0); PG8_LDB(B1, 0, 1); PG8_SCHED; PG8_LDA(At, 0, 0); if constexpr (!HALFM) PG8_STAGE(PG8_SA(1, 1), a1 + hstepA, voffA);
            PG8_WAIT_VH(); PG8_WAIT_L(0); PG8_BAR; PG8_MMA(0, 0, At, B0); PG8_MMA(0, 1, At, B1); PG8_BAR; PG8_SCHED;
            if constexpr (!HALFM) PG8_LDA(At, 0, 1); PG8_STAGE(PG8_SB(0, 0), b2, voffB); PG8_STAGE(PG8_SB(0, 1), b2 + hstepB, voffB); PG8_STAGE(PG8_SA(0, 0), a2, voffA);
            PG8_WAIT_VH(); PG8_WAIT_L(0); PG8_BAR; if constexpr (!HALFM) { PG8_MMA(1, 0, At, B0); PG8_MMA(1, 1, At, B1); } PG8_BAR; PG8_SCHED;
            PG8_LDB(B0, 1, 0); PG8_LDB(B1, 1, 1); PG8_SCHED; PG8_LDA(At, 1, 0); if constexpr (!HALFM) PG8_STAGE(PG8_SA(0, 1), a2 + hstepA, voffA);
            PG8_WAIT_VH(); PG8_WAIT_L(0); PG8_BAR; PG8_MMA(0, 0, At, B0); PG8_MMA(0, 1, At, B1); PG8_BAR; PG8_SCHED;
            if constexpr (!HALFM) PG8_LDA(At, 1, 1); PG8_STAGE(PG8_SB(1, 0), b3, voffB); PG8_STAGE(PG8_SB(1, 1), b3 + hstepB, voffB); PG8_STAGE(PG8_SA(1, 0), a3, voffA);
            PG8_WAIT_VH(); PG8_WAIT_L(0); PG8_BAR; if constexpr (!HALFM) { PG8_MMA(1, 0, At, B0); PG8_MMA(1, 1, At, B1); } PG8_BAR; PG8_SCHED;
#undef PG8_WAIT_VH
            } else {
            PG8_LDB(B0, 0, 0); PG8_SCHED; PG8_LDA(At, 0, 0); PG8_STAGE(PG8_SA(1, 1), a1 + hstepA, voffA);
            PG8_WAIT_L(8); PG8_BAR; PG8_WAIT_L(0); PG8_MMA(0, 0, At, B0); PG8_BAR; PG8_SCHED;
            PG8_LDB(B1, 0, 1); PG8_STAGE(PG8_SB(0, 0), b2, voffB);
            PG8_BAR; PG8_WAIT_L(0); PG8_MMA(0, 1, At, B1); PG8_BAR;
            PG8_LDA(At, 0, 1); PG8_STAGE(PG8_SA(0, 0), a2, voffA);
            PG8_BAR; PG8_WAIT_L(0); PG8_MMA(1, 0, At, B0); PG8_BAR; PG8_SCHED;
            PG8_STAGE(PG8_SB(0, 1), b2 + hstepB, voffB);
            PG8_WAIT_V(6); PG8_BAR; PG8_MMA(1, 1, At, B1); PG8_BAR;
            PG8_LDB(B0, 1, 0); PG8_SCHED; PG8_LDA(At, 1, 0); PG8_STAGE(PG8_SA(0, 1), a2 + hstepA, voffA);
            PG8_WAIT_L(8); PG8_BAR; PG8_WAIT_L(0); PG8_MMA(0, 0, At, B0); PG8_BAR; PG8_SCHED;
            PG8_LDB(B1, 1, 1); PG8_STAGE(PG8_SB(1, 0), b3, voffB);
            PG8_BAR; PG8_WAIT_L(0); PG8_MMA(0, 1, At, B1); PG8_BAR;
            PG8_LDA(At, 1, 1); PG8_STAGE(PG8_SA(1, 0), a3, voffA);
            PG8_BAR; PG8_WAIT_L(0); PG8_MMA(1, 0, At, B0); PG8_BAR; PG8_SCHED;
            PG8_STAGE(PG8_SB(1, 1), b3 + hstepB, voffB);
            PG8_WAIT_V(6); PG8_BAR; PG8_MMA(1, 1, At, B1); PG8_BAR;
            }
        }
        if constexpr (ALIGN_EPI) { if (wr == 0) PG8_BAR; }
        E.template run<HALFM ? 1 : 2>(acc, cur, wr, wc, fr, fq); S.done(cur);
        if (!has_next) break;
#pragma unroll
        for (int a = 0; a < 2; ++a)
#pragma unroll
            for (int b = 0; b < 2; ++b)
#pragma unroll
                for (int m = 0; m < 4; ++m)
#pragma unroll
                    for (int n = 0; n < 2; ++n) acc[a][b][m][n] = (f32x4){0.f, 0.f, 0.f, 0.f};
        cur = nxt; cA = nA; cB = nB; ++ui;
        if constexpr (ALIGN_EPI) { if (wr == 1) PG8_BAR; }
    }
    PG8_WAIT_V(0);
    if constexpr (!ALIGN_EPI) { if (wr == 0) PG8_BAR; }
    PG8_BAR;
#undef PG8_SA
#undef PG8_SB
#undef PG8_STAGE
#undef PG8_BASE_voffA
#undef PG8_BASE_voffB
#undef PG8_RS_voffA
#undef PG8_RS_voffB
#undef PG8_LDA
#undef PG8_LDB
#undef PG8_MMA
#undef PG8_WAIT_V
#undef PG8_WAIT_L
#undef PG8_BAR
#undef PG8_SCHED
}
}
using pg8::Unit;

typedef f32x4 Acc[2][2][4][2];

__device__ __forceinline__ unsigned part_idx(int ph, int slot, int fr) { return (unsigned)(((ph * 64 + slot) * 16 + fr) * 8); }
constexpr int RSTD_LDS = RING_BYTES;
template <int NP, int NAI> __device__ __forceinline__ void load_rstd(const float* part, int rowbase, int fr, int fq, float (&rs)[2][4], LAS unsigned char* lds, int wid, int key) {
    LAS float* rc = (LAS float*)(lds + RSTD_LDS) + wid * 128; LAS int* tagp = (LAS int*)(lds + LDS_BYTES - 256) + 32 + wid;
    const int want = key | rowbase;
    if (__builtin_amdgcn_readfirstlane(*tagp) == want) {
#pragma unroll
        for (int ai = 0; ai < NAI; ++ai)
#pragma unroll
            for (int m = 0; m < 4; ++m) rs[ai][m] = rc[64 * ai + 16 * m + fr];
        return;
    }
    { const int ph = rowbase >> 7, q0 = (rowbase >> 4) & 7;
      f32x4 sacc[2] = {{0.f, 0.f, 0.f, 0.f}, {0.f, 0.f, 0.f, 0.f}};
#pragma unroll
      for (int i = 0; i < NP / 4; ++i) { const unsigned o_ = part_idx(ph, fq * (NP / 4) + i, fr) + q0;
#pragma unroll
          for (int ai = 0; ai < NAI; ++ai) sacc[ai] += *(const f32x4*)at32(part, o_ + 4 * ai);
          if ((i & 3) == 3) asm volatile("" : "+v"(sacc[0]), "+v"(sacc[1]));     }
#pragma unroll
      for (int ai = 0; ai < NAI; ++ai)
#pragma unroll
        for (int m = 0; m < 4; ++m) { float sv = sacc[ai][m]; sv += __shfl_xor(sv, 16); sv += __shfl_xor(sv, 32);
            rs[ai][m] = rsqrtf(sv * (1.0f / DM) + EPS);
            if (NAI == 2 && fq == 0) rc[64 * ai + 16 * m + fr] = rs[ai][m]; } }
    if (NAI == 2) { if (fr == 0 && fq == 0) *tagp = want; }
    asm volatile("s_waitcnt lgkmcnt(0)" ::: "memory");
}

template <int NAI> __device__ __forceinline__ void store_part4(float* part, const Unit& u, int wr, int slot, int fr, int fq, int ai, const f32x4 v) {
    if (fq == 0) *(f32x4*)at32(part, part_idx(u.pm * 2 + wr, slot, fr) + 4u * (unsigned)(NAI == 1 ? u.aih : ai)) = v;
}
struct EpiGlu {
    static constexpr bool PERM = true;
    const float* xp; const float* xs; bf16_t* hb; float* part;
    template <int NAI> __device__ __forceinline__ void run(Acc& acc, const Unit& u, int wr, int wc, int fr, int fq) const {
        asm volatile("" : "+v"(fr), "+v"(fq));
        const int rowbase = u.rb + wr * 128 + fr, col0 = u.pn * 128 + wc * 32 + 8 * fq;
        const bool smp = u.pm >= MP / 256; const float* xb = smp ? xs : xp; const int rsub = smp ? MP : 0;
#pragma unroll
        for (int ai = 0; ai < NAI; ++ai) {
            f32x4 xv[4][2]; f32x4 ssv;
#pragma unroll
            for (int m = 0; m < 4; ++m)
#pragma unroll
                for (int n = 0; n < 2; ++n) xv[m][n] = *(const f32x4*)at32(xb, (unsigned)((rowbase + 64 * ai + 16 * m - rsub) * DM + col0 + 4 * n));
#pragma unroll
            for (int m = 0; m < 4; ++m) {
                const int r = rowbase + 64 * ai + 16 * m; float ss = 0.f; u32x4 w;
#pragma unroll
                for (int n = 0; n < 2; ++n) {
                    const f32x4 a = acc[ai][0][m][n], b = acc[ai][1][m][n]; f32x4 o;
#pragma unroll
                    for (int j = 0; j < 4; ++j) { o[j] = xv[m][n][j] + a[j] * fsigmoid(b[j]); ss += o[j] * o[j]; }
                    w[2 * n] = cvt_pk_bf16(o[0], o[1]); w[2 * n + 1] = cvt_pk_bf16(o[2], o[3]);
                }
                *(u32x4*)at32(hb, (unsigned)(r * DM + col0)) = w;
                ss += __shfl_xor(ss, 16); ss += __shfl_xor(ss, 32);
                ssv[m] = ss;
            }
            store_part4<NAI>(part, u, wr, u.pn * 4 + wc, fr, fq, ai, ssv);
        }
    }
};

struct EpiResid {
    static constexpr bool PERM = true;
    bf16_t* hb; float* part;
    template <int NAI> __device__ __forceinline__ void run(Acc& acc, const Unit& u, int wr, int wc, int fr, int fq) const {
        asm volatile("" : "+v"(fr), "+v"(fq));
        const int rowbase = u.rb + wr * 128 + fr, col0 = u.pn * 256 + wc * 32 + 8 * fq;
#pragma unroll
        for (int ai = 0; ai < NAI; ++ai) {
            u32x4 hv[4][2]; f32x4 ssv;
#pragma unroll
            for (int m = 0; m < 4; ++m)
#pragma unroll
                for (int bj = 0; bj < 2; ++bj) hv[m][bj] = *(const u32x4*)at32((const bf16_t*)hb, (unsigned)((rowbase + 64 * ai + 16 * m) * DM + col0 + 128 * bj));
#pragma unroll
            for (int m = 0; m < 4; ++m) {
                const int r = rowbase + 64 * ai + 16 * m; float ss = 0.f;
#pragma unroll
                for (int bj = 0; bj < 2; ++bj) { u32x4 w;
#pragma unroll
                    for (int n = 0; n < 2; ++n) {
                        const unsigned h0 = hv[m][bj][2 * n], h1 = hv[m][bj][2 * n + 1]; const f32x4 a = acc[ai][bj][m][n];
                        const f32x4 o = {__uint_as_float(h0 << 16) + a[0], __uint_as_float(h0 & 0xffff0000u) + a[1], __uint_as_float(h1 << 16) + a[2], __uint_as_float(h1 & 0xffff0000u) + a[3]};
                        ss += (o[0] * o[0] + o[1] * o[1]) + (o[2] * o[2] + o[3] * o[3]);
                        w[2 * n] = cvt_pk_bf16(o[0], o[1]); w[2 * n + 1] = cvt_pk_bf16(o[2], o[3]);
                    }
                    *(u32x4*)at32(hb, (unsigned)(r * DM + col0 + 128 * bj)) = w; }
                ss += __shfl_xor(ss, 16); ss += __shfl_xor(ss, 32);
                ssv[m] = ss;
            }
            store_part4<NAI>(part, u, wr, u.pn * 4 + wc, fr, fq, ai, ssv);
        }
    }
};

struct EpiBf16 {
    static constexpr bool PERM = true;
    bf16_t* O; int ldc;
    template <int NAI> __device__ __forceinline__ void run(Acc& acc, const Unit& u, int wr, int wc, int fr, int fq) const {
        asm volatile("" : "+v"(fr), "+v"(fq));
        const int rowbase = u.rb + wr * 128 + fr, col0 = u.pn * 256 + wc * 32 + 8 * fq;
#pragma unroll
        for (int ai = 0; ai < NAI; ++ai)
#pragma unroll
            for (int m = 0; m < 4; ++m) { const unsigned ro = (unsigned)((rowbase + 64 * ai + 16 * m) * ldc + col0);
#pragma unroll
                for (int bj = 0; bj < 2; ++bj) { const f32x4 v0 = acc[ai][bj][m][0], v1 = acc[ai][bj][m][1];
                    u32x4 w = {cvt_pk_bf16(v0[0], v0[1]), cvt_pk_bf16(v0[2], v0[3]), cvt_pk_bf16(v1[0], v1[1]), cvt_pk_bf16(v1[2], v1[3])}; *(u32x4*)at32(O, ro + (unsigned)(bj * 128)) = w; } }
    }
};

struct EpiPle {
    static constexpr bool PERM = true;
    const float* partin; const bf16_t* hsrc; bf16_t* ppio; float* part; LAS unsigned char* lds; int key;
    template <int NAI> __device__ __forceinline__ void run(Acc& acc, const Unit& u, int wr, int wc, int fr, int fq) const {
        asm volatile("" : "+v"(fr), "+v"(fq));
        const int rowbase = u.rb + wr * 128 + fr, col0 = u.pn * 256 + wc * 32 + 8 * fq;
        float rs[2][4]; load_rstd<32, NAI>(partin, u.rb + wr * 128, fr, fq, rs, lds, wr * 4 + wc, key); f32x4 ssv = {0.f, 0.f, 0.f, 0.f};
#pragma unroll
        for (int q2 = 0; q2 < 2 * NAI; ++q2) {
            const int ai = q2 >> 1, m0 = (q2 & 1) * 2;
            u32x4 hv[2][2], pv[2][2];
#pragma unroll
            for (int mm = 0; mm < 2; ++mm)
#pragma unroll
                for (int bj = 0; bj < 2; ++bj) { const unsigned o_ = (unsigned)((rowbase + 64 * ai + 16 * (m0 + mm)) * DM + col0 + 128 * bj);
                    hv[mm][bj] = *(const u32x4*)at32(hsrc, o_); pv[mm][bj] = *(const u32x4*)at32((const bf16_t*)ppio, o_); }
#pragma unroll
            for (int mm = 0; mm < 2; ++mm) {
                const int m = m0 + mm, r = rowbase + 64 * ai + 16 * m; float ss = 0.f;
#pragma unroll
                for (int bj = 0; bj < 2; ++bj) { u32x4 w;
#pragma unroll
                    for (int n = 0; n < 2; ++n) {
                        const unsigned pw0 = pv[mm][bj][2 * n], pw1 = pv[mm][bj][2 * n + 1], h0 = hv[mm][bj][2 * n], h1 = hv[mm][bj][2 * n + 1];
                        const f32x4 a = acc[ai][bj][m][n] * rs[ai][m]; f32x4 o;
                        o[0] = __uint_as_float(h0 << 16) + __uint_as_float(pw0 << 16) * fsigmoid(a[0]); o[1] = __uint_as_float(h0 & 0xffff0000u) + __uint_as_float(pw0 & 0xffff0000u) * fsigmoid(a[1]);
                        o[2] = __uint_as_float(h1 << 16) + __uint_as_float(pw1 << 16) * fsigmoid(a[2]); o[3] = __uint_as_float(h1 & 0xffff0000u) + __uint_as_float(pw1 & 0xffff0000u) * fsigmoid(a[3]);
                        ss += (o[0] * o[0] + o[1] * o[1]) + (o[2] * o[2] + o[3] * o[3]);
                        w[2 * n] = cvt_pk_bf16(o[0], o[1]); w[2 * n + 1] = cvt_pk_bf16(o[2], o[3]);
                    }
                    *(u32x4*)at32(ppio, (unsigned)(r * DM + col0 + 128 * bj)) = w; }
                ss += __shfl_xor(ss, 16); ss += __shfl_xor(ss, 32);
                ssv[m] = ss;
            }
            if (q2 & 1) store_part4<NAI>(part, u, wr, u.pn * 4 + wc, fr, fq, ai, ssv);
        }
    }
};

template <int NP> struct EpiUp {
    static constexpr bool PERM = true;
    const float* partin; bf16_t* act; const float* cw; const float* cb; const float* state; float* zside; float* conv_p; float* conv_s; LAS unsigned char* lds; int key;
    template <int NAI> __device__ __forceinline__ void run(Acc& acc, const Unit& u, int wr, int wc, int fr, int fq) const {
        asm volatile("" : "+v"(fr), "+v"(fq));
        const bool sample = u.pm >= MP / 256;
        const int rowhalf = u.rb + wr * 128;
        { float rs[2][4]; load_rstd<NP, NAI>(partin, rowhalf, fr, fq, rs, lds, wr * 4 + wc, key);
#pragma unroll
          for (int ai = 0; ai < NAI; ++ai)
#pragma unroll
            for (int bj = 0; bj < 2; ++bj)
#pragma unroll
                for (int m = 0; m < 4; ++m)
#pragma unroll
                    for (int n = 0; n < 2; ++n) acc[ai][bj][m][n] = acc[ai][bj][m][n] * rs[ai][m]; }
        const int ht = u.pm * 2 + wr;
        const bool seqstart = (!sample) && ((ht & 127) == 0);
        const bool seqend = (!sample) && ((ht & 127) == 127);
        const int sb2 = ((rowhalf - MP) >> 5) * 2;
        const int c8 = u.pn * 128 + wc * 32 + 8 * fq;
#pragma unroll
        for (int n = 0; n < 2; ++n) {
            const int c0 = c8 + 4 * n;
            if (NAI == 2 && !sample) {
                if (fr < 2) { const unsigned o = (unsigned)((ht * 4 + fr) * DFF2 + c0); *(f32x4*)at32(zside, o) = acc[0][0][0][n]; *(f32x4*)at32(zside, o + DFF) = acc[0][1][0][n]; }
                if (fr >= 14) { const unsigned o = (unsigned)((ht * 4 + 2 + (fr - 14)) * DFF2 + c0); *(f32x4*)at32(zside, o) = acc[NAI - 1][0][3][n]; *(f32x4*)at32(zside, o + DFF) = acc[NAI - 1][1][3][n];
                    if (seqend) { const unsigned o2 = (unsigned)(((ht >> 7) * 2 + (fr - 14)) * DFF2 + c0); *(f32x4*)at32(conv_p, o2) = acc[NAI - 1][0][3][n]; *(f32x4*)at32(conv_p, o2 + DFF) = acc[NAI - 1][1][3][n]; } }
            } else if (sample && fr >= 14) {
#pragma unroll
                for (int qq = 1; qq < 4 * NAI; qq += 2) { const unsigned o2 = (unsigned)((sb2 + (qq >> 1) * 2 + (fr - 14)) * DFF2 + c0);
                    *(f32x4*)at32(conv_s, o2) = acc[qq >> 2][0][qq & 3][n]; *(f32x4*)at32(conv_s, o2 + DFF) = acc[qq >> 2][1][qq & 3][n]; }
            }
        }
        unsigned outp[4 * NAI][4];
        f32x4 nr0 = *(const f32x4*)at32(cw, (unsigned)(c8 * 8)), nr1 = *(const f32x4*)at32(cw, (unsigned)(c8 * 8 + 4)), nr2 = *(const f32x4*)at32(cw, (unsigned)(c8 * 8 + 8)), nr3 = *(const f32x4*)at32(cw, (unsigned)(c8 * 8 + 12));
#pragma unroll
        for (int n = 0; n < 2; ++n)
#pragma unroll
            for (int jp = 0; jp < 2; ++jp) {
                const int c0 = c8 + 4 * n + 2 * jp;
                const f32x4 ra = nr0, rb_ = nr1, rc_ = nr2, rd_ = nr3;
                asm volatile("" ::: "memory");
                if (n * 2 + jp < 3) { const unsigned o = (unsigned)((c0 + 2) * 8); nr0 = *(const f32x4*)at32(cw, o); nr1 = *(const f32x4*)at32(cw, o + 4); nr2 = *(const f32x4*)at32(cw, o + 8); nr3 = *(const f32x4*)at32(cw, o + 12); }
                const f32x2 w0v = {ra[0], ra[1]}, w1v = {ra[2], ra[3]}, w2v = {rb_[0], rb_[1]}, bv = {rb_[2], rb_[3]};
                const f32x2 w0g = {rc_[0], rc_[1]}, w1g = {rc_[2], rc_[3]}, w2g = {rd_[0], rd_[1]}, bg = {rd_[2], rd_[3]};
                f32x2 p1v = {0.f, 0.f}, p2v = p1v, p1g = p1v, p2g = p1v;
#pragma unroll
                for (int q = 0; q < 4 * NAI; ++q) {
                    const int ai = q >> 2, m = q & 3;
                    const f32x2 zv = {acc[ai][0][m][n][2 * jp], acc[ai][0][m][n][2 * jp + 1]}, zg = {acc[ai][1][m][n][2 * jp], acc[ai][1][m][n][2 * jp + 1]};
                    if (sample && !(q & 1)) {
                        f32x2 hv = {0.f, 0.f}, hg = hv;
                        if (fr >= 14) { const unsigned so = (unsigned)((sb2 + (q >> 1) * 2 + (fr - 14)) * DFF2 + c0); hv = *(const f32x2*)at32(state, so); hg = *(const f32x2*)at32(state, so + DFF); }
#pragma unroll
                        for (int j = 0; j < 2; ++j) { p1v[j] = dppf<DPP_ROR1>(hv[j]); p2v[j] = dppf<DPP_ROR2>(hv[j]); p1g[j] = dppf<DPP_ROR1>(hg[j]); p2g[j] = dppf<DPP_ROR2>(hg[j]); }
                    }
                    f32x2 r1v, r2v, r1g, r2g, P1v, P2v, P1g, P2g;
#pragma unroll
                    for (int j = 0; j < 2; ++j) {
                        r1v[j] = dppf<DPP_ROR1>(zv[j]); r2v[j] = dppf<DPP_ROR2>(zv[j]); r1g[j] = dppf<DPP_ROR1>(zg[j]); r2g[j] = dppf<DPP_ROR2>(zg[j]);
                        P1v[j] = fr >= 1 ? r1v[j] : p1v[j]; P2v[j] = fr >= 2 ? r2v[j] : p2v[j]; P1g[j] = fr >= 1 ? r1g[j] : p1g[j]; P2g[j] = fr >= 2 ? r2g[j] : p2g[j];
                    }
                    const f32x2 cv = __builtin_elementwise_fma(w0v, P2v, __builtin_elementwise_fma(w1v, P1v, __builtin_elementwise_fma(w2v, zv, bv)));
                    const f32x2 cg = __builtin_elementwise_fma(w0g, P2g, __builtin_elementwise_fma(w1g, P1g, __builtin_elementwise_fma(w2g, zg, bg)));
                    const f32x2 tt = cg * (f32x2){-1.4426950408889634f, -1.4426950408889634f};
                    f32x2 ee = {__builtin_amdgcn_exp2f(tt[0]), __builtin_amdgcn_exp2f(tt[1])}; ee = ee + (f32x2){1.f, 1.f};
                    const f32x2 sg = {__builtin_amdgcn_rcpf(ee[0]), __builtin_amdgcn_rcpf(ee[1])};
                    const f32x2 o = cv * cg * sg;
                    p1v = r1v; p2v = r2v; p1g = r1g; p2g = r2g;
                    outp[q][2 * n + jp] = cvt_pk_bf16(o[0], o[1]);
                }
            }
#pragma unroll
        for (int q = 0; q < 4 * NAI; ++q) {
            const bool deferred = (!sample) && q == 0 && fr < 2 && !seqstart;
            if (!deferred) { u32x4 w = {outp[q][0], outp[q][1], outp[q][2], outp[q][3]}; *(u32x4*)at32(act, (unsigned)((rowhalf + 16 * q + fr) * DFF + c8)) = w; }
        }
    }
};

struct EpiQkv {
    static constexpr bool PERM = false;
    const float* partin; const float* rope; bf16_t* qb; float* qs; bf16_t* kb; bf16_t* vb; float* out; LAS unsigned char* lds; int key;
    template <int NAI> __device__ __forceinline__ void run(Acc& acc, const Unit& u, int wr, int wc, int fr, int fq) const {
        asm volatile("" : "+v"(fr), "+v"(fq));
        const int rowhalf = u.rb + wr * 128;
        float rs[2][4]; load_rstd<32, NAI>(partin, rowhalf, fr, fq, rs, lds, wr * 4 + wc, key);
        const int which = u.pn >> 3, head = u.pn & 7;
#pragma unroll
        for (int ai = 0; ai < NAI; ++ai)
#pragma unroll
            for (int m = 0; m < 4; ++m) {
                const int r = rowhalf + 64 * ai + 16 * m + fr; const bool smp = r >= MP;
                const int pos = smp ? PAST + ((r - MP) & 31) : (r & (SEQ - 1));
                f32x4 cs = {1.f, 1.f, 1.f, 1.f}, sn = {0.f, 0.f, 0.f, 0.f};
                if (which < 2 && wc == 0) { cs = *(const f32x4*)at32(rope, (unsigned)(pos * 32 + 4 * fq)); sn = *(const f32x4*)at32(rope, (unsigned)(pos * 32 + 16 + 4 * fq)); }
#pragma unroll
                for (int bj = 0; bj < 2; ++bj) {
                    f32x4 v0 = acc[ai][bj][m][0] * rs[ai][m], v1 = acc[ai][bj][m][1] * rs[ai][m];
                    if (which < 2 && wc == 0) { const f32x4 a = v0, b = v1; v0 = a * cs - b * sn; v1 = b * cs + a * sn; }
                    const int c = head * 256 + bj * 128 + wc * 32 + 4 * fq;
                    u32x2 w0, w1; w0.x = cvt_pk_bf16(v0[0], v0[1]); w0.y = cvt_pk_bf16(v0[2], v0[3]); w1.x = cvt_pk_bf16(v1[0], v1[1]); w1.y = cvt_pk_bf16(v1[2], v1[3]);
                    if (which == 0) {
                        *(u32x2*)at32(qb, (unsigned)(r * DM + c)) = w0; *(u32x2*)at32(qb, (unsigned)(r * DM + c + 16)) = w1;
                        if (smp) { *(f32x4*)at32(qs, (unsigned)((r - MP) * DM + c)) = v0; *(f32x4*)at32(qs, (unsigned)((r - MP) * DM + c + 16)) = v1; }
                    } else {
                        float* ob = out + (smp ? (which == 1 ? O_K_S : O_V_S) : (which == 1 ? O_K_P : O_V_P)); const unsigned oo = (unsigned)((smp ? r - MP : r) * DM + c);
                        *(f32x4*)at32(ob, oo) = v0; *(f32x4*)at32(ob, oo + 16u) = v1;
                        if (!smp) { bf16_t* bp = (which == 1 ? kb : vb); *(u32x2*)at32(bp, (unsigned)(r * DM + c)) = w0; *(u32x2*)at32(bp, (unsigned)(r * DM + c + 16)) = w1; }
                    }
                }
            }
    }
};

#define XB_TMO      128
#define XB_XCNT(j)  (256  + 64 * (j))
#define XB_XSUB(j)  (1280 + 64 * (j))
#define XB_XGEN(j)  (2304 + 64 * (j))
#define XB_TOP      3328
#define XB_TOPGEN   3392
#define XCD_BAR_WORDS 3456
#define XB_SPIN_CAP (1u << 22)

__device__ __forceinline__ unsigned xb_ld(unsigned* p)              { return __hip_atomic_load(p, __ATOMIC_RELAXED, __HIP_MEMORY_SCOPE_AGENT); }
__device__ __forceinline__ unsigned xb_add(unsigned* p, unsigned v) { return __hip_atomic_fetch_add(p, v, __ATOMIC_RELAXED, __HIP_MEMORY_SCOPE_AGENT); }
__device__ __forceinline__ unsigned xb_xcc_id() { return (unsigned)__builtin_amdgcn_s_getreg((3 << 11) | 20) & 0xFu; }
#define XB_SPIN(cond, bar) do { unsigned _sp = 0; while (cond) { __builtin_amdgcn_s_sleep(1); \
    if ((++_sp & 255u) == 0u) { if (xb_ld(&(bar)[XB_TMO])) break; if (_sp > XB_SPIN_CAP) { atomicAdd(&(bar)[XB_TMO], 1u); break; } } } } while (0)

struct XcdBarrier { unsigned* bar; unsigned x; volatile LAS unsigned* st; };

__device__ __forceinline__ XcdBarrier xcd_barrier_post(unsigned* bar, volatile LAS unsigned* st) {
    XcdBarrier b; b.bar = bar; b.x = xb_xcc_id(); b.st = st;
    if (threadIdx.x == 0) (void)xb_add(&bar[XB_XCNT(b.x)], 1u);
    return b;
}
__device__ __forceinline__ void xcd_barrier_complete(unsigned* bar, unsigned x, unsigned& nloc, unsigned& nx) {
    const unsigned G = gridDim.x * gridDim.y * gridDim.z;
    unsigned sum, cnt, mine, sp = 0u;
    for (;;) {
        sum = 0u; cnt = 0u; mine = 0u;
#pragma unroll
        for (unsigned j = 0; j < 16; ++j) { const unsigned c = xb_ld(&bar[XB_XCNT(j)]); sum += c; cnt += (c > 0u) ? 1u : 0u; mine = (j == x) ? c : mine; }
        if (sum == G) break;
        __builtin_amdgcn_s_sleep(1);
        if ((++sp & 255u) == 0u) { if (xb_ld(&bar[XB_TMO])) break; if (sp > XB_SPIN_CAP) { atomicAdd(&bar[XB_TMO], 1u); break; } }
    }
    nloc = mine > 0u ? mine : 1u; nx = cnt > 0u ? cnt : 1u;
}
__device__ __forceinline__ void xcd_barrier(const XcdBarrier& b) {
    asm volatile("s_waitcnt vmcnt(0)" ::: "memory");
    __syncthreads();
    if (threadIdx.x == 0) {
        unsigned* bar = b.bar;
        __builtin_amdgcn_s_waitcnt(0);
        unsigned nloc = b.st[0], nx = b.st[1];
        if (nloc == 0u) { xcd_barrier_complete(bar, b.x, nloc, nx); b.st[0] = nloc; b.st[1] = nx; }
        const unsigned old = xb_add(&bar[XB_XSUB(b.x)], 1u);
        const unsigned gen = old / nloc;
        if (old + 1u == (gen + 1u) * nloc) {
            __builtin_amdgcn_fence(__ATOMIC_RELEASE, "agent");
            asm volatile("s_waitcnt vmcnt(0)" ::: "memory");
            const unsigned og = xb_add(&bar[XB_TOP], 1u);
            const unsigned tg = og / nx;
            if (og + 1u == (tg + 1u) * nx) xb_add(&bar[XB_TOPGEN], 1u);
            else XB_SPIN(xb_ld(&bar[XB_TOPGEN]) == tg, bar);
            __builtin_amdgcn_fence(__ATOMIC_ACQUIRE, "agent");
            xb_add(&bar[XB_XGEN(b.x)], 1u);
            asm volatile("s_waitcnt vmcnt(0)" ::: "memory");
        } else {
            XB_SPIN(xb_ld(&bar[XB_XGEN(b.x)]) == gen, bar);
            __builtin_amdgcn_fence(__ATOMIC_ACQUIRE, "agent");
            asm volatile("s_waitcnt vmcnt(0)" ::: "memory");
        }
    }
    __syncthreads();
}

namespace att {
constexpr float SCALE = 0.08838834764831845f, THR = 8.f;
constexpr int NW = 8, QBLK = 32, KVBLK = 64, QB = NW * QBLK, D = 128;
constexpr int SHM_V = KVBLK * D * 2, SHM_K = KVBLK * D * 2;
constexpr int LDS_ATT = 2 * SHM_V + 2 * SHM_K + NW * 64 * 4;
constexpr int QS = DM, KS = DM, OS = 2 * DM;
template <class A, class Bt> struct same_t { static constexpr bool v = false; };
template <class A> struct same_t<A, A> { static constexpr bool v = true; };
#define KSWZ(row, colB) ((row) * 256 + ((colB) ^ (((row) & 7) << 4)))
#define SBAR() __builtin_amdgcn_sched_barrier(0)
__device__ __forceinline__ int v_st(int k, int c) { const int kk = (k & ~0xC) | ((k & 4) << 1) | ((k & 8) >> 1); return ((kk >> 3) * 4 + (c >> 5)) * 512 + ((kk & 7) * 32 + (c & 31)) * 2; }
__device__ __forceinline__ int v_rd_base(int lane) { return ((lane & 3) << 3) | (((lane >> 2) & 3) << 6) | (((lane >> 4) & 1) << 5) | (((lane >> 5) & 1) << 8); }
constexpr int v_rd_off(int d0, int ks, int half) { return d0 * 512 + ks * 4096 + half * 2048; }
__device__ __forceinline__ int crow(int r, int hi) { return (r & 3) + 8 * (r >> 2) + 4 * hi; }
__device__ __forceinline__ unsigned cvtpk(float lo, float hi) { unsigned r; asm volatile("v_cvt_pk_bf16_f32 %0, %1, %2" : "=v"(r) : "v"(lo), "v"(hi)); return r; }
__device__ __forceinline__ bf16x8 pack8(f32x4 a, f32x4 b) { u32x4 w = {cvtpk(a[0], a[1]), cvtpk(a[2], a[3]), cvtpk(b[0], b[1]), cvtpk(b[2], b[3])}; return *reinterpret_cast<bf16x8*>(&w); }
template <class T> __device__ __forceinline__ bf16x8 load8(const T* p) {
    if constexpr (same_t<T, float>::v) { return pack8(*(const f32x4*)p, *(const f32x4*)(p + 4)); }
    else { return *reinterpret_cast<const bf16x8*>(p); }
}
__device__ __forceinline__ void partialSM(f32x16& p0, f32x16& p1, float& m_reg, float& mn, float& alpha) {
    float pmax;
    asm("v_max3_f32 %0, %1, %2, %3" : "=v"(pmax) : "v"(p0[0]), "v"(p0[1]), "v"(p0[2]));
#pragma unroll
    for (int r = 3; r < 15; r += 2) asm("v_max3_f32 %0, %0, %1, %2" : "+v"(pmax) : "v"(p0[r]), "v"(p0[r + 1]));
    asm("v_max3_f32 %0, %0, %1, %2" : "+v"(pmax) : "v"(p0[15]), "v"(p1[0]));
#pragma unroll
    for (int r = 1; r < 15; r += 2) asm("v_max3_f32 %0, %0, %1, %2" : "+v"(pmax) : "v"(p1[r]), "v"(p1[r + 1]));
    asm("v_max_f32 %0, %0, %1" : "+v"(pmax) : "v"(p1[15]));
    { auto rr = __builtin_amdgcn_permlane32_swap(__float_as_uint(pmax), __float_as_uint(pmax), false, false);
      asm("v_max_f32 %0, %1, %2" : "=v"(pmax) : "v"(__uint_as_float(rr[0])), "v"(__uint_as_float(rr[1]))); }
    constexpr float C2 = 1.4426950408889634f * SCALE;
    if (__builtin_expect(__all((pmax - m_reg) * SCALE <= THR), 1)) { mn = m_reg; alpha = 1.f; }
    else { mn = fmaxf(m_reg, pmax); alpha = __builtin_amdgcn_exp2f((m_reg - mn) * C2); m_reg = mn; }
    const float mnL = -mn * C2;
    for (int r = 0; r < 16; ++r) p0[r] = fmaf(p0[r], C2, mnL); for (int r = 0; r < 16; ++r) p1[r] = fmaf(p1[r], C2, mnL);
    for (int r = 0; r < 16; ++r) p0[r] = __builtin_amdgcn_exp2f(p0[r]);
}
__device__ __forceinline__ void partialSM2(f32x16& p0, f32x16& p1, float& mnL, float& mthr, float& alpha) {
    float pmax;
    asm("v_max3_f32 %0, %1, %2, %3" : "=v"(pmax) : "v"(p0[0]), "v"(p0[1]), "v"(p0[2]));
#pragma unroll
    for (int r = 3; r < 15; r += 2) asm("v_max3_f32 %0, %0, %1, %2" : "+v"(pmax) : "v"(p0[r]), "v"(p0[r + 1]));
    asm("v_max3_f32 %0, %0, %1, %2" : "+v"(pmax) : "v"(p0[15]), "v"(p1[0]));
#pragma unroll
    for (int r = 1; r < 15; r += 2) asm("v_max3_f32 %0, %0, %1, %2" : "+v"(pmax) : "v"(p1[r]), "v"(p1[r + 1]));
    asm("v_max_f32 %0, %0, %1" : "+v"(pmax) : "v"(p1[15]));
    { auto rr = __builtin_amdgcn_permlane32_swap(__float_as_uint(pmax), __float_as_uint(pmax), false, false);
      asm("v_max_f32 %0, %1, %2" : "=v"(pmax) : "v"(__uint_as_float(rr[0])), "v"(__uint_as_float(rr[1]))); }
    constexpr float C2 = 1.4426950408889634f * SCALE;
    if (__builtin_expect(__all(pmax <= mthr), 1)) { alpha = 1.f; }
    else { const float m_old = mnL * (-1.f / C2), mn = fmaxf(m_old, pmax); alpha = __builtin_amdgcn_exp2f((m_old - mn) * C2); mnL = -mn * C2; mthr = mn + THR / SCALE; }
    for (int r = 0; r < 16; ++r) p0[r] = fmaf(p0[r], C2, mnL); for (int r = 0; r < 16; ++r) p1[r] = fmaf(p1[r], C2, mnL);
    for (int r = 0; r < 16; ++r) p0[r] = __builtin_amdgcn_exp2f(p0[r]);
}
__device__ __forceinline__ void finishSM(f32x16& p0, f32x16& p1, float alpha, float& l_reg, bf16x8& pa0, bf16x8& pa1, bf16x8& pa2, bf16x8& pa3) {
    for (int r = 0; r < 16; ++r) p1[r] = __builtin_amdgcn_exp2f(p1[r]);
    float ps = 0; for (int r = 0; r < 16; ++r) ps += p0[r]; for (int r = 0; r < 16; ++r) ps += p1[r];
    { auto rr = __builtin_amdgcn_permlane32_swap(__float_as_uint(ps), __float_as_uint(ps), false, false);
      ps = __uint_as_float(rr[0]) + __uint_as_float(rr[1]); }
    l_reg = l_reg * alpha + ps;
#define PK4(P, B_, OUT) do { unsigned a0 = cvtpk(P[B_+0], P[B_+1]), a1 = cvtpk(P[B_+2], P[B_+3]);                          \
        unsigned b0 = cvtpk(P[B_+4], P[B_+5]), b1 = cvtpk(P[B_+6], P[B_+7]);                                             \
        auto r0 = __builtin_amdgcn_permlane32_swap(a0, b0, false, false); auto r1 = __builtin_amdgcn_permlane32_swap(a1, b1, false, false); \
        u32x4 w = {r0[0], r1[0], r0[1], r1[1]}; OUT = *reinterpret_cast<bf16x8*>(&w); } while (0)
    PK4(p0, 0, pa0); PK4(p0, 8, pa1); PK4(p1, 0, pa2); PK4(p1, 8, pa3);
#undef PK4
}
template <int KB>
__device__ __forceinline__ void qkt(f32x16& p0, f32x16& p1, const char* K_lds, int r32, int hi, const bf16x8* qr) {
    p0 = f32x16{}; p1 = f32x16{};
    const char* kb[4];
#pragma unroll
    for (int dd = 0; dd < 4; ++dd) kb[dd] = K_lds + KB * SHM_K + KSWZ(r32, (dd * 16 + hi * 8) * 2);
#pragma unroll
    for (int d0 = 0; d0 < 8; ++d0) { const char* a = kb[d0 & 3] + (d0 >> 2) * 128;
        bf16x8 b0 = *reinterpret_cast<const bf16x8*>(a);
        bf16x8 b1 = *reinterpret_cast<const bf16x8*>(a + 32 * 256);
        p0 = __builtin_amdgcn_mfma_f32_32x32x16_bf16(b0, qr[d0], p0, 0, 0, 0);
        p1 = __builtin_amdgcn_mfma_f32_32x32x16_bf16(b1, qr[d0], p1, 0, 0, 0); }
}
template <int VB>
__device__ __forceinline__ void pv_tile(f32x16* o, int vb0, bf16x8 pa0, bf16x8 pa1, bf16x8 pa2, bf16x8 pa3) {
#define TRRD(dst, off) asm volatile("ds_read_b64_tr_b16 %0, %1 offset:%2" : "=&v"(dst) : "v"(vb0), "i"(off) : "memory")
#define PV_D0(d0) do { s16x4 l0, l1, l2, l3, h0, h1, h2, h3; constexpr int b_ = VB * SHM_V + v_rd_off(d0, 0, 0); \
        TRRD(l0, b_); TRRD(h0, b_ + 2048); TRRD(l1, b_ + 4096); TRRD(h1, b_ + 6144); TRRD(l2, b_ + 8192); TRRD(h2, b_ + 10240); TRRD(l3, b_ + 12288); TRRD(h3, b_ + 14336); \
        asm volatile("s_waitcnt lgkmcnt(0)" ::: "memory"); SBAR();   \
        o[d0] = __builtin_amdgcn_mfma_f32_32x32x16_bf16(pa0, (bf16x8){l0[0], l0[1], l0[2], l0[3], h0[0], h0[1], h0[2], h0[3]}, o[d0], 0, 0, 0);   \
        o[d0] = __builtin_amdgcn_mfma_f32_32x32x16_bf16(pa1, (bf16x8){l1[0], l1[1], l1[2], l1[3], h1[0], h1[1], h1[2], h1[3]}, o[d0], 0, 0, 0);   \
        o[d0] = __builtin_amdgcn_mfma_f32_32x32x16_bf16(pa2, (bf16x8){l2[0], l2[1], l2[2], l2[3], h2[0], h2[1], h2[2], h2[3]}, o[d0], 0, 0, 0);   \
        o[d0] = __builtin_amdgcn_mfma_f32_32x32x16_bf16(pa3, (bf16x8){l3[0], l3[1], l3[2], l3[3], h3[0], h3[1], h3[2], h3[3]}, o[d0], 0, 0, 0); } while (0)
    PV_D0(0); PV_D0(1); PV_D0(2); PV_D0(3);
#undef PV_D0
#undef TRRD
}

template <class TIn> struct BlockRef { const TIn* Q; const TIn* K; const TIn* V; const TIn* Kt; const TIn* Vt; bf16_t* O; int P0, nt, nrows, pad; };
template <class TIn> struct Seam {
    bf16x8 qr[8];
    bf16x8 st_v0, st_v1, st_k0, st_k1; f32x4 sf0, sf1, sf2, sf3;
    f32x4 tq[16];
};
template <bool SMP, class TIn> __device__ __forceinline__ const TIn* kvrow(const TIn* p, const TIn* pt, int k0, int rr, int sc) {
    if (SMP && k0 >= PAST) return pt + (unsigned)((rr < DSEQ ? rr : DSEQ - 1) * KS + sc);
    return p + (unsigned)((k0 + rr) * KS + sc);
}
#define VMW() asm volatile("s_waitcnt vmcnt(0)" ::: "memory")
#define VMWN(n) asm volatile("s_waitcnt vmcnt(%0)" :: "i"(n) : "memory")
#define SLOAD_H(R_, k0) do { S.st_v0 = load8<TIn>(kvrow<SMP, TIn>((R_).V, (R_).Vt, k0, sr, sc)); S.st_v1 = load8<TIn>(kvrow<SMP, TIn>((R_).V, (R_).Vt, k0, 32 + sr, sc));              \
                             S.st_k0 = load8<TIn>(kvrow<SMP, TIn>((R_).K, (R_).Kt, k0, sr, sc)); S.st_k1 = load8<TIn>(kvrow<SMP, TIn>((R_).K, (R_).Kt, k0, 32 + sr, sc)); } while (0)
#define SWRITE_HK(bf) do { *(bf16x8*)(K_lds + (bf) * SHM_K + kws) = S.st_k0; *(bf16x8*)(K_lds + (bf) * SHM_K + kws + 32 * 256) = S.st_k1; } while (0)
#define SWRITE_HV(bf) do { *(bf16x8*)(V_lds + (bf) * SHM_V + vst0) = S.st_v0; *(bf16x8*)(V_lds + (bf) * SHM_V + vst1) = S.st_v1; } while (0)
#define SWRITE_H(bf) do { SWRITE_HV(bf); SWRITE_HK(bf); } while (0)
#define SLOAD_F(p, pt, k0) do { const float* a_ = (const float*)kvrow<SMP, TIn>(p, pt, k0, sr, sc); const float* b_ = (const float*)kvrow<SMP, TIn>(p, pt, k0, 32 + sr, sc); \
                            S.sf0 = *(const f32x4*)a_; S.sf1 = *(const f32x4*)(a_ + 4); S.sf2 = *(const f32x4*)b_; S.sf3 = *(const f32x4*)(b_ + 4); } while (0)
#define SWRITE_KF(bf) do { *(bf16x8*)(K_lds + (bf) * SHM_K + kws) = pack8(S.sf0, S.sf1); *(bf16x8*)(K_lds + (bf) * SHM_K + kws + 32 * 256) = pack8(S.sf2, S.sf3); } while (0)
#define SWRITE_VF(bf) do { *(bf16x8*)(V_lds + (bf) * SHM_V + vst0) = pack8(S.sf0, S.sf1); *(bf16x8*)(V_lds + (bf) * SHM_V + vst1) = pack8(S.sf2, S.sf3); } while (0)
template <bool SMP, class TIn>
__device__ __forceinline__ void attn_prime(const BlockRef<TIn>& cur, char* lds, Seam<TIn>& S) {
    constexpr bool F32 = same_t<TIn, float>::v;
    const int tid = threadIdx.x, wid = __builtin_amdgcn_readfirstlane(tid >> 6), lane = tid & 63, r32 = lane & 31, hi = lane >> 5;
    const int sr = tid >> 4, sc = (tid & 15) * 8, kws = KSWZ(sr, sc * 2); char* K_lds = lds + 2 * SHM_V;
    for (int d0 = 0; d0 < 8; ++d0) S.qr[d0] = load8<TIn>(cur.Q + (unsigned)((wid * QBLK + r32) * QS + d0 * 16 + hi * 8));
    if constexpr (F32) { SLOAD_F(cur.K, cur.Kt, 0); VMW(); SWRITE_KF(0); SBAR(); SLOAD_F(cur.V, cur.Vt, 0); }
    else { SLOAD_H(cur, 0); VMW(); SWRITE_HK(0); }
    __syncthreads();
}
template <bool SMP, class TIn>
__device__ __forceinline__ void attn_block(const BlockRef<TIn>& cur, const BlockRef<TIn>& nxt, char* lds, Seam<TIn>& S) {
    constexpr bool F32 = same_t<TIn, float>::v;
    const int tid = threadIdx.x, wid = __builtin_amdgcn_readfirstlane(tid >> 6), lane = tid & 63, r32 = lane & 31, hi = lane >> 5;
    const int NT = cur.nt;
    const int qlo = cur.P0 + wid * QBLK;
    char* V_lds = lds; char* K_lds = lds + 2 * SHM_V;
    float* ws = (float*)(lds + 2 * SHM_V + 2 * SHM_K) + wid * 64; float* li_l = ws, * al_l = ws + 32;
    float m_reg = -1e30f, l_reg = 0; f32x16 o[4] = {};
    const int sr = tid >> 4, sc = (tid & 15) * 8, vst0 = v_st(sr, sc), vst1 = v_st(32 + sr, sc), kws = KSWZ(sr, sc * 2);
    const int vb0 = (int)(uintptr_t)V_lds + v_rd_base(lane);
#define RESC(a) do { if (__any((a) < 1.f)) { if (hi == 0) al_l[r32] = (a); asm volatile("s_waitcnt lgkmcnt(0)" ::: "memory");              \
                     for (int d_ = 0; d_ < 4; ++d_) for (int r = 0; r < 16; ++r) o[d_][r] *= al_l[crow(r, hi)]; } } while (0)
#define KBASE(t) ((t) * KVBLK)
#define MASKT(P0_, P1_, t) do { const float NEG_ = -__builtin_inff(); \
        if constexpr (SMP) { if ((t) == NT - 1) { _Pragma("unroll") for (int r_ = 0; r_ < 16; ++r_) P1_[r_] = NEG_; } } \
        else { if (KBASE(t) > (qlo & ~63)) { _Pragma("unroll") for (int r_ = 0; r_ < 16; ++r_) { P0_[r_] = NEG_; P1_[r_] = NEG_; } } } } while (0)
    constexpr int NQL = F32 ? 16 : 8;
#define SEAM_K0() do { VMWN(NQL); if constexpr (F32) { SWRITE_KF(0); SBAR(); SLOAD_F(nxt.V, nxt.Vt, 0); } else { SWRITE_HK(0); } SBAR(); } while (0)
    f32x16 pA0, pA1, pB0, pB1; float mnA, mnB, alA, alB; bf16x8 pa0, pa1, pa2, pa3;
    if constexpr (F32) { VMW(); SWRITE_VF(0); SBAR(); } else { SWRITE_HV(0); SBAR(); }
    if (NT > 1) { if constexpr (F32) SLOAD_F(cur.K, cur.Kt, KBASE(1)); else SLOAD_H(cur, KBASE(1)); }
    SBAR(); qkt<0>(pA0, pA1, K_lds, r32, hi, S.qr);
    if constexpr (F32) { if (NT > 1) { VMW(); SWRITE_KF(1); SBAR(); SLOAD_F(cur.V, cur.Vt, KBASE(1)); } }
    MASKT(pA0, pA1, 0); partialSM(pA0, pA1, m_reg, mnA, alA);
    if (NT > 1) { VMW(); if constexpr (F32) { SWRITE_VF(1); SBAR(); if (NT > 2) SLOAD_F(cur.K, cur.Kt, KBASE(2)); } else SWRITE_H(1); }
    __syncthreads();
#define HALF_STEP(PX0, PX1, mnX, alX, PY0, PY1, alY, t, KB, VB, SB) do {                                                      \
        SBAR(); qkt<KB>(PX0, PX1, K_lds, r32, hi, S.qr);                                             \
        finishSM(PY0, PY1, alY, l_reg, pa0, pa1, pa2, pa3); SBAR();                                                           \
        if ((t) + 1 < NT) { if constexpr (F32) { VMW(); SWRITE_KF(SB); SBAR(); SLOAD_F(cur.V, cur.Vt, KBASE((t) + 1)); }  \
                            else { SLOAD_H(cur, KBASE((t) + 1)); } SBAR(); }                                               \
        pv_tile<VB>(o, vb0, pa0, pa1, pa2, pa3); MASKT(PX0, PX1, (t)); partialSM(PX0, PX1, m_reg, mnX, alX);                                        \
        __syncthreads();                                                                                                      \
        if ((t) + 1 < NT) { VMW(); if constexpr (F32) { SWRITE_VF(SB); SBAR(); if ((t) + 2 < NT) SLOAD_F(cur.K, cur.Kt, KBASE((t) + 2)); } \
                            else { SWRITE_H(SB); } }                                                                          \
        RESC(alX); __syncthreads(); } while (0)
    for (int t = 1; t + 1 < NT; t += 2) {
        HALF_STEP(pB0, pB1, mnB, alB, pA0, pA1, alA, t, 1, 0, 0);
        HALF_STEP(pA0, pA1, mnA, alA, pB0, pB1, alB, t + 1, 0, 1, 1);
    }
    const bool even = (NT & 1) == 0;
    if (even) { SBAR(); qkt<1>(pB0, pB1, K_lds, r32, hi, S.qr); SBAR(); }
#define QROW(e) (nxt.Q + (unsigned)((wid * QBLK + r32) * QS + ((e) >> 1) * 16 + hi * 8 + ((e) & 1) * 4))
    if constexpr (F32) { SLOAD_F(nxt.K, nxt.Kt, 0); SBAR();
#pragma unroll
        for (int e = 0; e < 8; ++e) S.tq[e] = *(const f32x4*)QROW(e); }
    else { SLOAD_H(nxt, 0); SBAR();
#pragma unroll
        for (int d0 = 0; d0 < 8; ++d0) S.qr[d0] = load8<TIn>(nxt.Q + (unsigned)((wid * QBLK + r32) * QS + d0 * 16 + hi * 8)); }
    SBAR();
    finishSM(pA0, pA1, alA, l_reg, pa0, pa1, pa2, pa3); SBAR();
    if constexpr (F32) {
#pragma unroll
        for (int e = 8; e < 16; ++e) S.tq[e] = *(const f32x4*)QROW(e); SBAR(); }
#undef QROW
    pv_tile<0>(o, vb0, pa0, pa1, pa2, pa3);
    if (even) { MASKT(pB0, pB1, NT - 1); partialSM(pB0, pB1, m_reg, mnB, alB); __syncthreads(); RESC(alB);
        finishSM(pB0, pB1, alB, l_reg, pa0, pa1, pa2, pa3); SBAR(); pv_tile<1>(o, vb0, pa0, pa1, pa2, pa3); }
    SBAR(); SEAM_K0();
    if (hi == 0) li_l[r32] = l_reg; asm volatile("s_waitcnt lgkmcnt(0)" ::: "memory");
    float rli[16];
#pragma unroll
    for (int r = 0; r < 16; ++r) rli[r] = __builtin_amdgcn_rcpf(li_l[crow(r, hi)]);
    bf16_t* Ow = cur.O;
    const bool st_ok = wid * QBLK < cur.nrows;
#pragma unroll
    for (int r = 0; r < 16; ++r) { const int orow = crow(r, hi);
#pragma unroll
        for (int d0 = 0; d0 < 4; ++d0) { const float v = o[d0][r] * rli[r];
            const float vn = __shfl_xor(v, 1);
            if (st_ok && (r32 & 1) == 0) *(unsigned*)(Ow + (unsigned)((wid * QBLK + orow) * OS + d0 * 32 + r32)) = cvtpk(v, vn); } }
    if constexpr (F32) {
#pragma unroll
        for (int d0 = 0; d0 < 8; ++d0) S.qr[d0] = pack8(S.tq[2 * d0], S.tq[2 * d0 + 1]); }
    __syncthreads();
#undef RESC
#undef KBASE
#undef MASKT
#undef SEAM_K0
#undef HALF_STEP
}
#undef VMW
#undef VMWN
#undef SLOAD_H
#undef SWRITE_HK
#undef SWRITE_HV
#undef SWRITE_H
#undef SLOAD_F
#undef SWRITE_KF
#undef SWRITE_VF
}

namespace datt {
using att::crow; using att::cvtpk; using att::partialSM; using att::finishSM;
constexpr int SHM_V = 64 * 256 * 2, SHM_K = 64 * 128 * 2, L_V = 0, L_K = 2 * SHM_V, L_WS = 2 * SHM_V + 2 * SHM_K;
constexpr int QS = DM, KS = DM, OS = 2 * DM;
__device__ __forceinline__ int v_st2(int k, int c) { const int kk = (k & ~0xC) | ((k & 4) << 1) | ((k & 8) >> 1); return ((kk >> 3) * 8 + (c >> 5)) * 512 + ((kk & 7) * 32 + (c & 31)) * 2; }
struct DRef { const bf16_t* Q; const bf16_t* K; const bf16_t* V; bf16_t* O; int P0, pad; };
struct DSeam { bf16x8 qr[8]; };
template <int KB>
__device__ __forceinline__ void qkt(f32x16& p0, f32x16& p1, const LAS char* const* kb, const bf16x8* qr) {
    p0 = f32x16{}; p1 = f32x16{};
#define KRD(set, d0) do { const LAS char* a_ = kb[(d0) & 3] + (KB * SHM_K + ((d0) >> 2) * 128); set[0] = *reinterpret_cast<const LAS bf16x8*>(a_); set[1] = *reinterpret_cast<const LAS bf16x8*>(a_ + 32 * 256); } while (0)
#define KMM(set, d0) do { p0 = __builtin_amdgcn_mfma_f32_32x32x16_bf16(set[0], qr[d0], p0, 0, 0, 0); p1 = __builtin_amdgcn_mfma_f32_32x32x16_bf16(set[1], qr[d0], p1, 0, 0, 0); } while (0)
    bf16x8 ka[2], kc[2];
    KRD(ka, 0); KRD(kc, 1); SBAR();
    KMM(ka, 0); SBAR(); KRD(ka, 2); SBAR();
    KMM(kc, 1); SBAR(); KRD(kc, 3); SBAR();
    KMM(ka, 2); SBAR(); KRD(ka, 4); SBAR();
    KMM(kc, 3); SBAR(); KRD(kc, 5); SBAR();
    KMM(ka, 4); SBAR(); KRD(ka, 6); SBAR();
    KMM(kc, 5); SBAR(); KRD(kc, 7); SBAR();
    KMM(ka, 6); SBAR();
    KMM(kc, 7); SBAR();
#undef KRD
#undef KMM
}
template <int VB>
__device__ __forceinline__ void pv_tile(f32x16* o, int vb0, bf16x8 pa0, bf16x8 pa1, bf16x8 pa2, bf16x8 pa3) {
#define TRRD(dst, off) asm volatile("ds_read_b64_tr_b16 %0, %1 offset:%2" : "=&v"(dst) : "v"(vb0), "i"(off) : "memory")
#define PV_RD(S_, d0) do { constexpr int b_ = VB * SHM_V + (d0) * 512; \
        TRRD(S_[0], b_); TRRD(S_[1], b_ + 4096); TRRD(S_[2], b_ + 8192); TRRD(S_[3], b_ + 12288); TRRD(S_[4], b_ + 16384); TRRD(S_[5], b_ + 20480); TRRD(S_[6], b_ + 24576); TRRD(S_[7], b_ + 28672); } while (0)
#define PV_MM(S_, d0) do { \
        o[d0] = __builtin_amdgcn_mfma_f32_32x32x16_bf16(pa0, (bf16x8){S_[0][0], S_[0][1], S_[0][2], S_[0][3], S_[1][0], S_[1][1], S_[1][2], S_[1][3]}, o[d0], 0, 0, 0);   \
        o[d0] = __builtin_amdgcn_mfma_f32_32x32x16_bf16(pa1, (bf16x8){S_[2][0], S_[2][1], S_[2][2], S_[2][3], S_[3][0], S_[3][1], S_[3][2], S_[3][3]}, o[d0], 0, 0, 0);   \
        o[d0] = __builtin_amdgcn_mfma_f32_32x32x16_bf16(pa2, (bf16x8){S_[4][0], S_[4][1], S_[4][2], S_[4][3], S_[5][0], S_[5][1], S_[5][2], S_[5][3]}, o[d0], 0, 0, 0);   \
        o[d0] = __builtin_amdgcn_mfma_f32_32x32x16_bf16(pa3, (bf16x8){S_[6][0], S_[6][1], S_[6][2], S_[6][3], S_[7][0], S_[7][1], S_[7][2], S_[7][3]}, o[d0], 0, 0, 0); } while (0)
#define PV_W8() do { asm volatile("s_waitcnt lgkmcnt(8)" ::: "memory"); SBAR(); } while (0)
#define PV_W0() do { asm volatile("s_waitcnt lgkmcnt(0)" ::: "memory"); SBAR(); } while (0)
    s16x4 sa[8], sb[8];
    PV_RD(sa, 0); PV_RD(sb, 1); PV_W8(); PV_MM(sa, 0); SBAR();
    PV_RD(sa, 2); PV_W8(); PV_MM(sb, 1); SBAR();
    PV_RD(sb, 3); PV_W8(); PV_MM(sa, 2); SBAR();
    PV_RD(sa, 4); PV_W8(); PV_MM(sb, 3); SBAR();
    PV_RD(sb, 5); PV_W8(); PV_MM(sa, 4); SBAR();
    PV_RD(sa, 6); PV_W8(); PV_MM(sb, 5); SBAR();
    PV_RD(sb, 7); PV_W8(); PV_MM(sa, 6); SBAR();
    PV_W0(); PV_MM(sb, 7); SBAR();
#undef PV_RD
#undef PV_MM
#undef PV_W8
#undef PV_W0
#undef TRRD
}
#define DVMW() asm volatile("s_waitcnt vmcnt(0)" ::: "memory")
#define DLOADQ(R_) do { _Pragma("unroll") for (int d0_ = 0; d0_ < 8; ++d0_) S.qr[d0_] = *(const bf16x8*)((R_).Q + (unsigned)((wid * 32 + r32) * QS + d0_ * 16 + hi * 8)); } while (0)
#define DDMA(R_, k0, bf) do { \
        const __amdgpu_buffer_rsrc_t rk_ = __builtin_amdgcn_make_buffer_rsrc((void*)(R_).K, 0, 0x7ffffff0, 0x00020000), rv_ = __builtin_amdgcn_make_buffer_rsrc((void*)(R_).V, 0, 0x7ffffff0, 0x00020000); \
        _Pragma("unroll") for (int j_ = 0; j_ < 2; ++j_) __builtin_amdgcn_raw_ptr_buffer_load_lds(rk_, (LAS unsigned*)(lds + L_K + (bf) * SHM_K + (8 * j_ + wid) * 1024), 16, (int)(offK * 2u), (int)(((k0) + 32 * j_) * KS * 2), 0, 0); \
        _Pragma("unroll") for (int j_ = 0; j_ < 4; ++j_) __builtin_amdgcn_raw_ptr_buffer_load_lds(rv_, (LAS unsigned*)(lds + L_V + (bf) * SHM_V + (8 * j_ + wid) * 1024), 16, (int)(offV * 2u), (int)(((k0) + 16 * j_) * KS * 2), 0, 0); } while (0)
__device__ __forceinline__ void dattn_prime(const DRef& cur, LAS char* lds, DSeam& S) {
    const int tid = threadIdx.x, wid = __builtin_amdgcn_readfirstlane(tid >> 6), lane = tid & 63, r32 = lane & 31, hi = lane >> 5;
    const int rowK = 4 * wid + (lane >> 4); const unsigned offK = (unsigned)(rowK * KS + (((lane & 15) ^ (rowK & 7)) * 8));
    const int sub = 2 * wid + (lane >> 5), kk = (sub >> 3) * 8 + ((lane & 31) >> 2), kv = (kk & ~0xC) | ((kk & 4) << 1) | ((kk & 8) >> 1); const unsigned offV = (unsigned)(kv * KS + (sub & 7) * 32 + (lane & 3) * 8);
    DLOADQ(cur); DDMA(cur, 0, 0); DVMW();
    __syncthreads();
}
__device__ __forceinline__ void dattn_block(const DRef& cur, const DRef& nxt, LAS char* lds, DSeam& S) {
    const int tid = threadIdx.x, wid = __builtin_amdgcn_readfirstlane(tid >> 6), lane = tid & 63, r32 = lane & 31, hi = lane >> 5;
    const int NT = (cur.P0 + 255) / 64 + 1;
    const int qlo = cur.P0 + wid * 32;
    const LAS char* kbase[4];
#pragma unroll
    for (int dd = 0; dd < 4; ++dd) { int a_ = (int)(uintptr_t)(lds + L_K) + KSWZ(r32, (dd * 16 + hi * 8) * 2); asm volatile("" : "+v"(a_)); kbase[dd] = (const LAS char*)(uintptr_t)a_; }
    float* ws = (float*)(lds + L_WS) + wid * 64; float* li_l = ws, * al_l = ws + 32;
    float mnL_reg = 1e30f * (1.4426950408889634f * att::SCALE), mthr_reg = -1e30f, l_reg = 0; f32x16 o[8] = {};
    const int rowK = 4 * wid + (lane >> 4); const unsigned offK = (unsigned)(rowK * KS + (((lane & 15) ^ (rowK & 7)) * 8));
    const int sub = 2 * wid + (lane >> 5), kk = (sub >> 3) * 8 + ((lane & 31) >> 2), kv = (kk & ~0xC) | ((kk & 4) << 1) | ((kk & 8) >> 1); const unsigned offV = (unsigned)(kv * KS + (sub & 7) * 32 + (lane & 3) * 8);
    const int vb0 = (int)(uintptr_t)(lds + L_V) + att::v_rd_base(lane);
    f32x16 p0, p1; float mn, al; bf16x8 pa0, pa1, pa2, pa3;
    if (wid >= 4) __builtin_amdgcn_s_setprio(1);
#define DSTEP(t, B, NB) do { \
        if ((t) + 1 < NT) DDMA(cur, ((t) + 1) * 64, NB); else DDMA(nxt, 0, NB); \
        SBAR(); qkt<B>(p0, p1, kbase, S.qr); SBAR(); \
        if ((t) + 1 == NT) DLOADQ(nxt); \
        if (__builtin_expect((t) * 64 > (qlo & ~63), 0)) { asm volatile("" ::: "memory"); const float NEG_ = -__builtin_inff(); _Pragma("unroll") for (int r_ = 0; r_ < 16; ++r_) { p0[r_] = NEG_; p1[r_] = NEG_; } asm volatile("" : "+v"(p0), "+v"(p1)); } \
        att::partialSM2(p0, p1, mnL_reg, mthr_reg, al); finishSM(p0, p1, al, l_reg, pa0, pa1, pa2, pa3); SBAR(); \
        if (__any(al < 1.f)) { if (hi == 0) al_l[r32] = al; asm volatile("s_waitcnt lgkmcnt(0)" ::: "memory"); \
            _Pragma("unroll") for (int d_ = 0; d_ < 8; ++d_) _Pragma("unroll") for (int r = 0; r < 16; ++r) o[d_][r] *= al_l[crow(r, hi)]; } \
        pv_tile<B>(o, vb0, pa0, pa1, pa2, pa3); SBAR(); \
        DVMW(); __syncthreads(); } while (0)
    for (int t = 0; t < NT; t += 2) { DSTEP(t, 0, 1); DSTEP(t + 1, 1, 0); }
#undef DSTEP
    __builtin_amdgcn_s_setprio(0);
    if (hi == 0) li_l[r32] = l_reg; asm volatile("s_waitcnt lgkmcnt(0)" ::: "memory");
    float rli[16];
#pragma unroll
    for (int r = 0; r < 16; ++r) rli[r] = __builtin_amdgcn_rcpf(li_l[crow(r, hi)]);
#pragma unroll
    for (int r = 0; r < 16; ++r) { const int orow = crow(r, hi);
#pragma unroll
        for (int d0 = 0; d0 < 8; ++d0) { const float v = o[d0][r] * rli[r];
            const float vn = __shfl_xor(v, 1);
            if ((r32 & 1) == 0) *(unsigned*)(cur.O + (unsigned)((wid * 32 + orow) * OS + d0 * 32 + r32)) = cvtpk(v, vn); } }
}
#undef DVMW
#undef DLOADQ
#undef DDMA
}

struct Args { const float* in[38]; float* out; unsigned char* ws; int ph_lo, ph_hi; };
typedef const float* cfp_t;
typedef const __attribute__((address_space(4))) unsigned char* KP;
__device__ __forceinline__ KP kargs() { KP p = (KP)__builtin_amdgcn_kernarg_segment_ptr(); asm volatile("" : "+s"(p)); return p; }
struct Frame {
    LAS unsigned char* lds; KP kp;
    int tid, lane, wave, G, bid;
    __device__ __forceinline__ const float* in(int i) const { return *(const __attribute__((address_space(4))) cfp_t*)(kp + 8 * i); }
    __device__ __forceinline__ float* out() const { return *(float* const __attribute__((address_space(4)))*)(kp + 304); }
    __device__ __forceinline__ unsigned char* ws() const { return *(unsigned char* const __attribute__((address_space(4)))*)(kp + 312); }
};
static_assert(sizeof(Args) == 328, "Args layout");
enum { I_XP = 0, I_XS, I_SRE, I_SIM, I_SCONV, I_CK, I_CV, I_PP, I_PS, I_NMIX, I_ARE, I_AIM, I_LDT, I_BRE, I_BIM, I_CRE, I_CIM, I_SSMD, I_WGLU, I_NKV, I_WK, I_WV, I_WQ,
       I_LQ1, I_LK1, I_LQ2, I_LK2, I_NSUB, I_WO, I_NFFN, I_WUP, I_CONVW, I_CONVB, I_WDOWN, I_NPLE, I_WGATE, I_WPROJ, I_NFIN };

__device__ __forceinline__ void transpose_item(const float* W, int K, int N, bf16_t* WT, int row_off, const float* gain, int pairhalf, LAS float* scr, int item, int lane) {
    const int nblk = N / 32, kb = item / nblk, nb = item % nblk, k0 = 64 * kb, n0 = 32 * nb;
    int c0 = n0; if (pairhalf) c0 = ((n0 >> 7) & 1) * pairhalf + (n0 >> 8) * 128 + (n0 & 127);
#pragma unroll 8
    for (int i = 0; i < 32; ++i) { const int kk = 2 * i + (lane >> 5); float v = W[(size_t)(k0 + kk) * N + c0 + (lane & 31)]; if (gain) v *= gain[k0 + kk]; scr[kk * 33 + (lane & 31)] = v; }
    asm volatile("s_waitcnt lgkmcnt(0)" ::: "memory");
    const int c = lane & 7;
#pragma unroll
    for (int j = 0; j < 4; ++j) { const int n = (lane >> 3) + 8 * j; const LAS float* s = scr + (8 * c) * 33 + n;
        u32x4 o; o.x = cvt_pk_bf16(s[0 * 33], s[1 * 33]); o.y = cvt_pk_bf16(s[2 * 33], s[3 * 33]); o.z = cvt_pk_bf16(s[4 * 33], s[5 * 33]); o.w = cvt_pk_bf16(s[6 * 33], s[7 * 33]);
        *(u32x4*)(WT + (size_t)(row_off + n0 + n) * K + k0 + 8 * c) = o; }
    asm volatile("s_waitcnt lgkmcnt(0)" ::: "memory");
}

__device__ __forceinline__ void ssm_build_group(Frame& F, int g) {
    LAS f32x2* lbp = (LAS f32x2*)F.lds;
    LAS f32x2* Bb = lbp + 17 * 64;
    LAS f32x2* Cc = Bb + 64 * 16;
    LAS float* Kd = (LAS float*)(Cc + 16 * 64);
    LAS float* Dd = Kd + 4096;
    LAS f32x2* kt = (LAS f32x2*)(Dd + 16);
    const float* are = F.in(I_ARE) + g * 64; const float* aim = F.in(I_AIM) + g * 64;
    const int tid = F.tid;
    for (int i = tid; i < 17 * 64; i += NTHR) { const int d = i >> 6, p = i & 63; const double dt = exp((double)F.in(I_LDT)[g]); const double ar = are[p], ai = aim[p];
        const double mag = exp(ar * dt * d); double sn, cs; sincos(ai * dt * d, &sn, &cs); lbp[d * 64 + p] = (f32x2){(float)(mag * cs), (float)(mag * sn)}; }
    if (tid < 64) {
        const int p = tid; const double dt = exp((double)F.in(I_LDT)[g]); const double ar = are[p], ai = aim[p];
        const double mag = exp(ar * dt); double sn, cs; sincos(ai * dt, &sn, &cs); const double lr = mag * cs, li = mag * sn, den = ar * ar + ai * ai, nr = lr - 1.0;
        kt[p] = (f32x2){(float)((nr * ar + li * ai) / den), (float)((li * ar - nr * ai) / den)};
    }
    if (tid < 16) Dd[tid] = F.in(I_SSMD)[g * 16 + tid];
    __syncthreads();
    for (int i = tid; i < 1024; i += NTHR) { const int p = i >> 4, ch = i & 15; const float br = F.in(I_BRE)[((size_t)g * 64 + p) * 16 + ch], bi = F.in(I_BIM)[((size_t)g * 64 + p) * 16 + ch]; const f32x2 k = kt[p];
        Bb[i] = (f32x2){k.x * br - k.y * bi, k.x * bi + k.y * br};
        const int co = i >> 6, pp = i & 63; Cc[i] = (f32x2){F.in(I_CRE)[((size_t)g * 16 + co) * 64 + pp], F.in(I_CIM)[((size_t)g * 16 + co) * 64 + pp]}; }
    __syncthreads();
    for (int i = tid; i < 4096; i += NTHR) { const int d = i >> 8, co = (i >> 4) & 15, ch = i & 15; float s = 0.f;
        for (int p = 0; p < 64; ++p) { const f32x2 c = Cc[co * 64 + p], l = lbp[d * 64 + p], b = Bb[p * 16 + ch];
            const float wr = c.x * l.x - c.y * l.y, wi = c.x * l.y + c.y * l.x; s += wr * b.x - wi * b.y; }
        if (d == 0 && co == ch) s += Dd[co];
        Kd[i] = s; }
    __syncthreads();
    unsigned char* base = F.ws() + WS_SSM + (size_t)g * SSM_G_BYTES;
    for (int e = tid; e < 8 * 16 * 64; e += NTHR) { const int ln = e & 63, ks = (e >> 6) & 15, Mb = e >> 10; const int row = 32 * Mb + (ln & 31), t = row >> 4, co = row & 15, s = ks; float v[8];
#pragma unroll
        for (int j = 0; j < 8; ++j) { const int ch = 8 * (ln >> 5) + j; v[j] = (t >= s) ? Kd[((t - s) * 16 + co) * 16 + ch] : 0.f; }
        u32x4 o = {cvt_pk_bf16(v[0], v[1]), cvt_pk_bf16(v[2], v[3]), cvt_pk_bf16(v[4], v[5]), cvt_pk_bf16(v[6], v[7])}; *(u32x4*)(base + (size_t)e * 16) = o; }
    for (int e = tid; e < 4 * 16 * 64; e += NTHR) { const int ln = e & 63, ks = (e >> 6) & 15, Mb = e >> 10; const int hr = 32 * Mb + (ln & 31), c = hr >> 6, p = hr & 63, s = ks; float v[8]; const f32x2 l = lbp[(15 - s) * 64 + p];
#pragma unroll
        for (int j = 0; j < 8; ++j) { const f32x2 b = Bb[p * 16 + 8 * (ln >> 5) + j]; v[j] = c == 0 ? (l.x * b.x - l.y * b.y) : (l.x * b.y + l.y * b.x); }
        u32x4 o = {cvt_pk_bf16(v[0], v[1]), cvt_pk_bf16(v[2], v[3]), cvt_pk_bf16(v[4], v[5]), cvt_pk_bf16(v[6], v[7])}; *(u32x4*)(base + 131072 + (size_t)e * 16) = o; }
    for (int e = tid; e < 8 * 8 * 64; e += NTHR) { const int ln = e & 63, ks = (e >> 6) & 7, Mb = e >> 9; const int row = 32 * Mb + (ln & 31), t = row >> 4, co = row & 15; float v[8];
#pragma unroll
        for (int j = 0; j < 8; ++j) { const int hr = 16 * ks + 8 * (ln >> 5) + j, c = hr >> 6, p = hr & 63; const f32x2 cc = Cc[co * 64 + p], l = lbp[(t + 1) * 64 + p];
            v[j] = c == 0 ? (cc.x * l.x - cc.y * l.y) : -(cc.x * l.y + cc.y * l.x); }
        u32x4 o = {cvt_pk_bf16(v[0], v[1]), cvt_pk_bf16(v[2], v[3]), cvt_pk_bf16(v[4], v[5]), cvt_pk_bf16(v[6], v[7])}; *(u32x4*)(base + 196608 + (size_t)e * 16) = o; }
    if (tid < 64) ((f32x2*)(F.ws() + WS_L16))[g * 64 + tid] = lbp[16 * 64 + tid];
    __syncthreads();
}

__device__ __forceinline__ void rms_row_to_bf16(const float* xrow, const float* g, bf16_t* orow, int lane) {
    const f32x4* xr = (const f32x4*)xrow + lane; f32x4 v[8]; float s = 0.f;
#pragma unroll
    for (int j = 0; j < 8; ++j) { v[j] = xr[64 * j]; s += (v[j][0] * v[j][0] + v[j][1] * v[j][1]) + (v[j][2] * v[j][2] + v[j][3] * v[j][3]); }
    const float rstd = rsqrtf(wave_sum(s) * (1.f / DM) + EPS);
    u32x2* o8 = (u32x2*)orow + lane;
#pragma unroll
    for (int j = 0; j < 8; ++j) { const f32x4 gg = ((const f32x4*)g)[lane + 64 * j]; const f32x4 y = v[j] * rstd * gg; u32x2 w; w.x = cvt_pk_bf16(y[0], y[1]); w.y = cvt_pk_bf16(y[2], y[3]); o8[64 * j] = w; }
}
__device__ __forceinline__ void convert_p(Frame& F, int layer) {
    const float* pp = F.in(I_PP) + (size_t)layer * MP * PLE; const float* ps = F.in(I_PS) + (size_t)layer * MS * PLE; bf16_t* pb = (bf16_t*)(F.ws() + WS_PB);
    const size_t n8 = (size_t)MT * PLE / 8;
    for (size_t i = (size_t)F.bid * NTHR + F.tid; i < n8; i += (size_t)F.G * NTHR) { const size_t e = i * 8; const float* src = e < (size_t)MP * PLE ? pp + e : ps + (e - (size_t)MP * PLE);
        const f32x4 a = *(const f32x4*)src, b = *(const f32x4*)(src + 4); u32x4 w = {cvt_pk_bf16(a[0], a[1]), cvt_pk_bf16(a[2], a[3]), cvt_pk_bf16(b[0], b[1]), cvt_pk_bf16(b[2], b[3])}; *(u32x4*)(pb + e) = w; }
}
__device__ __forceinline__ int bg_slot(Frame& F, int word) {
    const int lane = __builtin_amdgcn_mbcnt_hi(~0u, __builtin_amdgcn_mbcnt_lo(~0u, 0u));
    unsigned tk = 0u; if (lane == 0) tk = __hip_atomic_fetch_add((LAS unsigned*)(F.lds + LDS_BYTES - 256) + 16 + word, 1u, __ATOMIC_RELAXED, __HIP_MEMORY_SCOPE_WORKGROUP);
    return __builtin_amdgcn_readfirstlane((int)tk) & 7;
}
template <int LIST> __device__ __forceinline__ void bg_work(Frame& F, int busy, int slot) {
    const int rem = busy < F.G ? busy : 0; int nb = F.G, bi = F.bid;
    if (rem != 0) { if (F.bid < rem) return; nb = F.G - rem; bi = F.bid - rem; }
    const int lane = __builtin_amdgcn_mbcnt_hi(~0u, __builtin_amdgcn_mbcnt_lo(~0u, 0u));
    LAS float* scr = (LAS float*)(F.lds + slot * 16384);
    const int gw = bi * NWAVES + slot, NGW = nb * NWAVES;
    constexpr int I_UP = 32 * 352, I_DN = 88 * 64, I_GT = 32 * 64, I_PJ = 4 * 64, I_SQ = 32 * 64;
    if constexpr (LIST == 0 || LIST == 3) { constexpr int l = LIST == 0 ? 0 : 1;
        for (int it = gw; it < I_UP; it += NGW) transpose_item(F.in(I_WUP) + (size_t)l * DM * DFF2, DM, DFF2, (bf16_t*)(F.ws() + WS_WUP) + (size_t)l * DFF2 * DM, 0, F.in(I_NFFN) + l * DM, DFF, scr, it, lane);
    } else if constexpr (LIST == 1 || LIST == 4) { constexpr int l = LIST == 1 ? 0 : 1;
        for (int it = gw; it < I_DN + I_GT + I_PJ; it += NGW) { int r = it;
            if (r < I_DN) { transpose_item(F.in(I_WDOWN) + (size_t)l * DFF * DM, DFF, DM, (bf16_t*)(F.ws() + WS_WDOWN) + (size_t)l * DM * DFF, 0, nullptr, 0, scr, r, lane); continue; } r -= I_DN;
            if (r < I_GT) { transpose_item(F.in(I_WGATE) + (size_t)l * DM * DM, DM, DM, (bf16_t*)(F.ws() + WS_WGATE) + (size_t)l * DM * DM, 0, F.in(I_NPLE) + l * DM, 0, scr, r, lane); continue; } r -= I_GT;
            transpose_item(F.in(I_WPROJ) + (size_t)l * PLE * DM, PLE, DM, (bf16_t*)(F.ws() + WS_WPROJ) + (size_t)l * DM * PLE, 0, nullptr, 0, scr, r, lane); }
    } else {
        for (int it = gw; it < 4 * I_SQ; it += NGW) { int r = it;
            if (r < I_SQ) { transpose_item(F.in(I_WQ), DM, DM, (bf16_t*)(F.ws() + WS_WQKV), 0, F.in(I_NMIX) + DM, 0, scr, r, lane); continue; } r -= I_SQ;
            if (r < I_SQ) { transpose_item(F.in(I_WK), DM, DM, (bf16_t*)(F.ws() + WS_WQKV), DM, F.in(I_NKV), 0, scr, r, lane); continue; } r -= I_SQ;
            if (r < I_SQ) { transpose_item(F.in(I_WV), DM, DM, (bf16_t*)(F.ws() + WS_WQKV), 2 * DM, F.in(I_NKV), 0, scr, r, lane); continue; } r -= I_SQ;
            transpose_item(F.in(I_WO), DM, DM, (bf16_t*)(F.ws() + WS_WO), 0, nullptr, 0, scr, r, lane); }
    }
}
__device__ __forceinline__ void p0_prologue(Frame& F) {
    for (int g = F.bid; g < NG; g += F.G) ssm_build_group(F, g);
    __syncthreads();
    LAS float* scr = (LAS float*)(F.lds + F.wave * 16384);
    const int gw = F.bid * NWAVES + F.wave, NGW = F.G * NWAVES;
    for (int it = gw; it < 32 * 128; it += NGW) transpose_item(F.in(I_WGLU), DM, 2 * DM, (bf16_t*)(F.ws() + WS_WGLU), 0, nullptr, DM, scr, it, F.lane);
    { float* rope = (float*)(F.ws() + WS_ROPE);
      for (int i = F.bid * NTHR + F.tid; i < SEQ * 16; i += F.G * NTHR) { const int pos = i >> 4, k = i & 15; const double inv = exp(-(double)k * (13.122363377404328 / 16.0)); double sn, cs; sincos((double)pos * inv, &sn, &cs);
          rope[(size_t)pos * 32 + k] = (float)cs; rope[(size_t)pos * 32 + 16 + k] = (float)sn; } }
    { float* cp_ = (float*)(F.ws() + WS_CONVP);
      for (int i = F.bid * NTHR + F.tid; i < 2 * DFF; i += F.G * NTHR) { const int l = i / DFF, c = i % DFF; const float* cw = F.in(I_CONVW) + (size_t)l * 3 * DFF2; const float* cb = F.in(I_CONVB) + (size_t)l * DFF2;
          float* r = cp_ + (size_t)(i & ~1) * 8 + (c & 1);
          r[0] = cw[c]; r[2] = cw[DFF2 + c]; r[4] = cw[2 * DFF2 + c]; r[6] = cb[c]; r[8] = cw[DFF + c]; r[10] = cw[DFF2 + DFF + c]; r[12] = cw[2 * DFF2 + DFF + c]; r[14] = cb[DFF + c]; } }
    convert_p(F, 0);
    bf16_t* ub = (bf16_t*)(F.ws() + WS_UB);
    for (int m = gw; m < MT; m += NGW) rms_row_to_bf16(m < MP ? F.in(I_XP) + (size_t)m * DM : F.in(I_XS) + (size_t)(m - MP) * DM, F.in(I_NMIX), ub + (size_t)m * DM, F.lane);
}

__device__ __forceinline__ void ssm_phase(Frame& F, bf16_t* dstb) {
    constexpr int L_G = 0, L_U = 65536, L_S0 = 98304, L_S1 = 116736, L_XB = 135168;
    const int tid = F.tid, wave = F.wave, lane = F.lane, n = lane & 31, hi = lane >> 5;
    bf16_t* ub = (bf16_t*)(F.ws() + WS_UB);
    const int sn_ = tid & 31, ss_ = tid >> 5;
    for (int item = F.bid; item < NBAT * NG + NG; item += F.G) {
        const bool smp = item >= NBAT * NG;
        const int g = smp ? item - NBAT * NG : item % NG, b = smp ? 0 : item / NG;
        const int nsteps = smp ? 1 : SEQ / 512; const int row0 = smp ? MP : b * SEQ;
        const unsigned char* mats = F.ws() + WS_SSM + (size_t)g * SSM_G_BYTES;
        __syncthreads();
        for (int i = tid; i < 4096; i += NTHR) *(LAS u32x4*)(F.lds + L_G + i * 16) = *(const u32x4*)(mats + 196608 + (size_t)i * 16);
        bf16x8 Kf[16], Hf[8];
#pragma unroll
        for (int ks = 0; ks < 16; ++ks) Kf[ks] = *(const bf16x8*)(mats + ((size_t)(wave * 16 + ks) * 64 + lane) * 16);
#pragma unroll
        for (int i = 0; i < 8; ++i) Hf[i] = *(const bf16x8*)(mats + 131072 + ((size_t)((wave & 3) * 16 + (wave >> 2) * 8 + i) * 64 + lane) * 16);
        f32x2 lam = {0.f, 0.f}, X = {0.f, 0.f};
        if (wave == 0) lam = ((const f32x2*)(F.ws() + WS_L16))[g * 64 + lane];
        { const bf16_t* src = ub + (size_t)(row0 + 16 * sn_ + ss_) * DM + 16 * g; const u32x4 a = *(const u32x4*)src, c = *(const u32x4*)(src + 8);
          LAS unsigned char* d = F.lds + L_U + ss_ * 1024 + sn_ * 32; *(LAS u32x4*)d = a; *(LAS u32x4*)(d + 16) = c; }
        __syncthreads();
        for (int step = 0; step < nsteps; ++step) {
            const int rowb = row0 + step * 512;
            LAS unsigned char* Ucur = F.lds + L_U + (step & 1) * 16384;
            u32x4 na = {0u, 0u, 0u, 0u}, nc = na;
            if (step + 1 < nsteps) { const bf16_t* src = ub + (size_t)(rowb + 512 + 16 * sn_ + ss_) * DM + 16 * g; na = *(const u32x4*)src; nc = *(const u32x4*)(src + 8); }
            { f32x16 sa = {};
#pragma unroll
              for (int i = 0; i < 8; ++i) { const bf16x8 uf = *(const LAS bf16x8*)(Ucur + ((wave >> 2) * 8 + i) * 1024 + n * 32 + hi * 16); sa = __builtin_amdgcn_mfma_f32_32x32x16_bf16(Hf[i], uf, sa, 0, 0, 0); }
              LAS float* Sp = (LAS float*)(F.lds + ((wave >> 2) ? L_S1 : L_S0));
#pragma unroll
              for (int r = 0; r < 16; ++r) Sp[(32 * (wave & 3) + att::crow(r, hi)) * 36 + n] = sa[r]; }
            __syncthreads();
            if (step > 0) { const LAS unsigned char* ysrc = F.lds + L_U + ((step - 1) & 1) * 16384 + ss_ * 1024 + sn_ * 32; const u32x4 ya0 = *(const LAS u32x4*)ysrc, ya1 = *(const LAS u32x4*)(ysrc + 16);
                bf16_t* dst = dstb + (size_t)(rowb - 512 + 16 * sn_ + ss_) * DM + 16 * g; *(u32x4*)dst = ya0; *(u32x4*)(dst + 8) = ya1; }
            if (wave == 0) {
                const LAS float* S0 = (const LAS float*)(F.lds + L_S0); const LAS float* S1 = (const LAS float*)(F.lds + L_S1);
                LAS bf16_t* Xb = (LAS bf16_t*)(F.lds + L_XB);
#pragma unroll 1
                for (int cg = 0; cg < 4; ++cg) {
                    f32x4 re[2], im[2];
#pragma unroll
                    for (int i = 0; i < 2; ++i) { re[i] = *(const LAS f32x4*)(S0 + lane * 36 + 8 * cg + 4 * i) + *(const LAS f32x4*)(S1 + lane * 36 + 8 * cg + 4 * i);
                                                  im[i] = *(const LAS f32x4*)(S0 + (64 + lane) * 36 + 8 * cg + 4 * i) + *(const LAS f32x4*)(S1 + (64 + lane) * 36 + 8 * cg + 4 * i); }
#pragma unroll
                    for (int k = 0; k < 8; ++k) { const int c = 8 * cg + k;
                        if (smp && !(c & 1)) { const size_t si = ((size_t)(c >> 1) * NG + g) * 64 + lane; X = (f32x2){F.in(I_SRE)[si], F.in(I_SIM)[si]}; }
                        Xb[c * 136 + lane] = (bf16_t)(cvt_pk_bf16(X.x, 0.f) & 0xffffu); Xb[c * 136 + 64 + lane] = (bf16_t)(cvt_pk_bf16(X.y, 0.f) & 0xffffu);
                        const float sr = re[k >> 2][k & 3], si2 = im[k >> 2][k & 3];
                        const float nx = lam.x * X.x - lam.y * X.y + sr, ny = lam.x * X.y + lam.y * X.x + si2; X = (f32x2){nx, ny};
                        if (smp && (c & 1)) { const size_t so = ((size_t)(c >> 1) * NG + g) * 64 + lane; F.out()[O_SRE_S + so] = X.x; F.out()[O_SIM_S + so] = X.y; } }
                }
            }
            f32x16 ya = {};
#pragma unroll
            for (int ks = 0; ks < 16; ++ks) if (ks <= 2 * wave + 1) { const bf16x8 uf = *(const LAS bf16x8*)(Ucur + ks * 1024 + n * 32 + hi * 16); ya = __builtin_amdgcn_mfma_f32_32x32x16_bf16(Kf[ks], uf, ya, 0, 0, 0); }
            if (step + 1 < nsteps) { LAS unsigned char* d = F.lds + L_U + ((step + 1) & 1) * 16384 + ss_ * 1024 + sn_ * 32; *(LAS u32x4*)d = na; *(LAS u32x4*)(d + 16) = nc; }
            __syncthreads();
#pragma unroll
            for (int i = 0; i < 8; ++i) { const bf16x8 gf = *(const LAS bf16x8*)(F.lds + L_G + ((wave * 8 + i) * 64 + lane) * 16); const bf16x8 xf = *(const LAS bf16x8*)(F.lds + L_XB + n * 272 + (16 * i + 8 * hi) * 2);
                ya = __builtin_amdgcn_mfma_f32_32x32x16_bf16(gf, xf, ya, 0, 0, 0); }
#pragma unroll
            for (int q = 0; q < 4; ++q) { const int tl = q >> 1, co = 8 * (q & 1) + 4 * hi;
                u32x2 w; w.x = cvt_pk_bf16(gelu_tanh(ya[4 * q]), gelu_tanh(ya[4 * q + 1])); w.y = cvt_pk_bf16(gelu_tanh(ya[4 * q + 2]), gelu_tanh(ya[4 * q + 3]));
                *(LAS u32x2*)(Ucur + (2 * wave + tl) * 1024 + n * 32 + co * 2) = w; }
        }
        __syncthreads();
        { const int ls = nsteps - 1; const LAS unsigned char* ysrc = F.lds + L_U + (ls & 1) * 16384 + ss_ * 1024 + sn_ * 32; const u32x4 ya0 = *(const LAS u32x4*)ysrc, ya1 = *(const LAS u32x4*)(ysrc + 16);
          bf16_t* dst = dstb + (size_t)(row0 + ls * 512 + 16 * sn_ + ss_) * DM + 16 * g; *(u32x4*)dst = ya0; *(u32x4*)(dst + 8) = ya1; }
        if (!smp && wave == 0) { const size_t so = ((size_t)b * NG + g) * 64 + lane; F.out()[O_SRE_P + so] = X.x; F.out()[O_SIM_P + so] = X.y; }
    }
}

__device__ __forceinline__ void fixup_phase(Frame& F, int layer) {
    const float* zs = (const float*)(F.ws() + WS_ZSIDE); bf16_t* act = (bf16_t*)(F.ws() + WS_BIG);
    const float* cw = F.in(I_CONVW) + (size_t)layer * 3 * DFF2; const float* cb = F.in(I_CONVB) + (size_t)layer * DFF2;
    constexpr int NC4 = DFF / 4;
    for (int i = F.bid * NTHR + F.tid; i < 256 * NC4; i += F.G * NTHR) {
        const int ht = i / NC4, c0 = (i % NC4) * 4; if ((ht & 127) == 0) continue;
        const float* zp = zs + (size_t)(ht - 1) * 4 * DFF2; const float* zc = zs + (size_t)ht * 4 * DFF2;
        f32x4 o0, o1;
        f32x4 cv0, cv1, cg0, cg1;
        { const f32x4 L0 = *(const f32x4*)(zp + 2 * DFF2 + c0), L1 = *(const f32x4*)(zp + 3 * DFF2 + c0), f0 = *(const f32x4*)(zc + c0), f1 = *(const f32x4*)(zc + DFF2 + c0);
          const f32x4 w0 = *(const f32x4*)(cw + c0), w1 = *(const f32x4*)(cw + DFF2 + c0), w2 = *(const f32x4*)(cw + 2 * DFF2 + c0), bb = *(const f32x4*)(cb + c0);
          cv0 = bb + w2 * f0 + w1 * L1 + w0 * L0; cv1 = bb + w2 * f1 + w1 * f0 + w0 * L1; }
        { const int c1 = DFF + c0; const f32x4 L0 = *(const f32x4*)(zp + 2 * DFF2 + c1), L1 = *(const f32x4*)(zp + 3 * DFF2 + c1), f0 = *(const f32x4*)(zc + c1), f1 = *(const f32x4*)(zc + DFF2 + c1);
          const f32x4 w0 = *(const f32x4*)(cw + c1), w1 = *(const f32x4*)(cw + DFF2 + c1), w2 = *(const f32x4*)(cw + 2 * DFF2 + c1), bb = *(const f32x4*)(cb + c1);
          cg0 = bb + w2 * f0 + w1 * L1 + w0 * L0; cg1 = bb + w2 * f1 + w1 * f0 + w0 * L1; }
#pragma unroll
        for (int j = 0; j < 4; ++j) { o0[j] = cv0[j] * cg0[j] * fsigmoid(cg0[j]); o1[j] = cv1[j] * cg1[j] * fsigmoid(cg1[j]); }
        u32x2 w; w.x = cvt_pk_bf16(o0[0], o0[1]); w.y = cvt_pk_bf16(o0[2], o0[3]); *(u32x2*)(act + (size_t)(128 * ht) * DFF + c0) = w;
        w.x = cvt_pk_bf16(o1[0], o1[1]); w.y = cvt_pk_bf16(o1[2], o1[3]); *(u32x2*)(act + (size_t)(128 * ht + 1) * DFF + c0) = w;
    }
}

__device__ __forceinline__ att::BlockRef<bf16_t> attn_ref_p(Frame& F, int L, int pass) {
    const int bh = L >> 5, x = L & 31, qb = pass ? 63 - x : x, b = bh >> 5, vhp = bh & 31, vh = vhp >> 1, vhalf = vhp & 1;
    att::BlockRef<bf16_t> r; const size_t row0 = (size_t)b * SEQ;
    r.Q = (const bf16_t*)(F.ws() + WS_UB) + (row0 + (size_t)qb * 256) * DM + vh * 128;
    r.K = (const bf16_t*)(F.ws() + WS_KB) + row0 * DM + vh * 128; r.V = (const bf16_t*)(F.ws() + WS_VB) + row0 * DM + (vh >> 1) * 256 + vhalf * 128; r.Kt = r.K; r.Vt = r.V;
    r.O = (bf16_t*)(F.ws() + WS_BIG) + (row0 + (size_t)qb * 256) * (2 * DM) + vh * 256 + vhalf * 128;
    r.P0 = qb * 256; r.nt = (r.P0 + 255) / 64 + 1; r.nrows = 256; r.pad = 0; return r;
}
__device__ __forceinline__ att::BlockRef<float> attn_ref_s(Frame& F, int L) {
    const int b = L >> 5, vhp = L & 31, vh = vhp >> 1, vhalf = vhp & 1;
    att::BlockRef<float> r;
    r.Q = (const float*)(F.ws() + WS_QS) + (size_t)b * DSEQ * DM + vh * 128;
    r.K = F.in(I_CK) + (size_t)b * PAST * DM + vh * 128; r.V = F.in(I_CV) + (size_t)b * PAST * DM + (vh >> 1) * 256 + vhalf * 128;
    r.Kt = F.out() + O_K_S + (size_t)b * DSEQ * DM + vh * 128; r.Vt = F.out() + O_V_S + (size_t)b * DSEQ * DM + (vh >> 1) * 256 + vhalf * 128;
    r.O = (bf16_t*)(F.ws() + WS_BIG) + ((size_t)MP + (size_t)b * DSEQ) * (2 * DM) + vh * 256 + vhalf * 128;
    r.P0 = PAST; r.nt = PAST / 64 + 1; r.nrows = DSEQ; r.pad = 0; return r;
}
__device__ __forceinline__ datt::DRef dattn_ref(Frame& F, int L, int pass) {
    const int bh = L >> 5, x = L & 31, qb = pass ? 63 - x : x, b = bh >> 4, vh = bh & 15;
    datt::DRef r; const size_t row0 = (size_t)b * SEQ;
    r.Q = (const bf16_t*)(F.ws() + WS_UB) + (row0 + (size_t)qb * 256) * DM + vh * 128;
    r.K = (const bf16_t*)(F.ws() + WS_KB) + row0 * DM + vh * 128; r.V = (const bf16_t*)(F.ws() + WS_VB) + row0 * DM + (vh >> 1) * 256;
    r.O = (bf16_t*)(F.ws() + WS_BIG) + (row0 + (size_t)qb * 256) * (2 * DM) + vh * 256;
    r.P0 = qb * 256; r.pad = 0; return r;
}
__device__ __forceinline__ int attn_item(int bid, int i, int G) { return G == 256 ? ((8 * i + (bid & 7)) << 5) + (bid >> 3) : bid + i * G; }
__device__ __forceinline__ void attn_phase_prompt(Frame& F) {
    constexpr int total = NBAT * 16 * 32; const int G = F.G, bid = F.bid;
    const int nit = G == 256 ? total / 256 : (total - bid + G - 1) / G; if (nit <= 0) return;
    int it = 0, pass = 0; datt::DRef cur = dattn_ref(F, attn_item(bid, 0, G), 0); datt::DSeam S;
    datt::dattn_prime(cur, (LAS char*)F.lds, S);
    for (;;) {
        const bool more_pass = pass == 0, more_item = it + 1 < nit, last = !more_pass && !more_item;
        int passn = pass + 1, itn = it; if (!more_pass) { passn = 0; itn = more_item ? it + 1 : it; }
        const datt::DRef nxt = last ? cur : dattn_ref(F, attn_item(bid, itn, G), passn);
        datt::dattn_block(cur, nxt, (LAS char*)F.lds, S);
        if (last) break;
        cur = nxt; pass = passn; it = itn;
    }
    asm volatile("s_waitcnt vmcnt(0)" ::: "memory"); __syncthreads();
}
__device__ __forceinline__ int attn_item_s(int bid, int i, int G) { return G == 256 ? i * 256 + (((bid & 7) * 8 + (bid >> 5)) << 2) + ((bid >> 3) & 3) : bid + i * G; }
__device__ __forceinline__ void attn_phase_sample(Frame& F) {
    constexpr int total = DB * 32; const int G = F.G, bid = F.bid;
    const int nit = G == 256 ? total / 256 : (total - bid + G - 1) / G; if (nit <= 0) return;
    int it = 0; att::BlockRef<float> cur = attn_ref_s(F, attn_item_s(bid, 0, G)); att::Seam<float> S;
    att::attn_prime<true, float>(cur, (char*)F.lds, S);
    for (;;) {
        const bool last = it + 1 >= nit;
        const att::BlockRef<float> nxt = last ? cur : attn_ref_s(F, attn_item_s(bid, it + 1, G));
        att::attn_block<true, float>(cur, nxt, (char*)F.lds, S);
        if (last) break;
        cur = nxt; ++it;
    }
}

__device__ __forceinline__ void combine_phase(Frame& F) {
    const float l1 = wave_sum(F.in(I_LQ1)[F.lane] * F.in(I_LK1)[F.lane] + F.in(I_LQ1)[64 + F.lane] * F.in(I_LK1)[64 + F.lane]);
    const float l2 = wave_sum(F.in(I_LQ2)[F.lane] * F.in(I_LK2)[F.lane] + F.in(I_LQ2)[64 + F.lane] * F.in(I_LK2)[64 + F.lane]);
    const float lam_init = 0.8f - 0.6f * 0.7408182206817179f;
    const float lam = expf(l1) - expf(l2) + lam_init, post = 1.0f - lam_init;
    const bf16_t* O = (const bf16_t*)(F.ws() + WS_BIG); bf16_t* ab = (bf16_t*)(F.ws() + WS_HB);
    const int hh = F.lane >> 3, cb = (F.lane & 7) * 8;
    f32x4 gs[8];
#pragma unroll
    for (int i = 0; i < 8; ++i) gs[i] = *(const f32x4*)(F.in(I_NSUB) + (i >> 1) * 64 + cb + (i & 1) * 4);
    const int gw = F.bid * NWAVES + F.wave, NGW = F.G * NWAVES;
    for (int m = gw; m < MT; m += NGW) {
        const u32x4* p1 = (const u32x4*)(O + (size_t)m * (2 * DM) + hh * 512 + cb); const u32x4* p2 = (const u32x4*)(O + (size_t)m * (2 * DM) + hh * 512 + 256 + cb);
        u32x4 a[4], c[4];
#pragma unroll
        for (int i = 0; i < 4; ++i) { a[i] = p1[8 * i]; c[i] = p2[8 * i]; }
        float d[32]; float ss = 0.f;
#pragma unroll
        for (int i = 0; i < 4; ++i)
#pragma unroll
            for (int j = 0; j < 4; ++j) { const float x0 = __uint_as_float(a[i][j] << 16) - lam * __uint_as_float(c[i][j] << 16), x1 = __uint_as_float(a[i][j] & 0xffff0000u) - lam * __uint_as_float(c[i][j] & 0xffff0000u);
                d[8 * i + 2 * j] = x0; d[8 * i + 2 * j + 1] = x1; ss += x0 * x0 + x1 * x1; }
        ss += __shfl_xor(ss, 1); ss += __shfl_xor(ss, 2); ss += __shfl_xor(ss, 4);
        const float rstd = rsqrtf(ss * (1.f / VD) + SUBLN_EPS) * post;
        u32x4* op = (u32x4*)(ab + (size_t)m * DM + hh * 256 + cb);
#pragma unroll
        for (int i = 0; i < 4; ++i) { u32x4 w;
#pragma unroll
            for (int j = 0; j < 4; ++j) w[j] = cvt_pk_bf16(d[8 * i + 2 * j] * rstd * gs[2 * i + (j >> 1)][2 * (j & 1)], d[8 * i + 2 * j + 1] * rstd * gs[2 * i + (j >> 1)][2 * (j & 1) + 1]);
            op[8 * i] = w; }
    }
}

__device__ __forceinline__ void final_phase(Frame& F, const float* part, float* dst) {
    const int gw = F.bid * NWAVES + F.wave, NGW = F.G * NWAVES; const float* g = F.in(I_NFIN); const bf16_t* hb = (const bf16_t*)(F.ws() + WS_HB);
    f32x4 gg[4][2];
#pragma unroll
    for (int j = 0; j < 4; ++j) { gg[j][0] = ((const f32x4*)g)[128 * j + 2 * F.lane]; gg[j][1] = ((const f32x4*)g)[128 * j + 2 * F.lane + 1]; }
    for (int m = gw; m < MT; m += NGW) {
        const float pv = F.lane < 32 ? part[part_idx(m >> 7, F.lane, m & 15) + ((m >> 4) & 7)] : 0.f;
        const float rstd = rsqrtf(wave_sum(pv) * (1.f / DM) + EPS);
        const u32x4* row = (const u32x4*)(hb + (size_t)m * DM) + F.lane; f32x4* orow = (f32x4*)(dst + (size_t)m * DM) + 2 * F.lane;
#pragma unroll
        for (int j = 0; j < 4; ++j) { const u32x4 w = row[64 * j];
            const f32x4 a = {__uint_as_float(w[0] << 16), __uint_as_float(w[0] & 0xffff0000u), __uint_as_float(w[1] << 16), __uint_as_float(w[1] & 0xffff0000u)};
            const f32x4 b2 = {__uint_as_float(w[2] << 16), __uint_as_float(w[2] & 0xffff0000u), __uint_as_float(w[3] << 16), __uint_as_float(w[3] & 0xffff0000u)};
            orow[128 * j] = a * rstd * gg[j][0]; orow[128 * j + 1] = b2 * rstd * gg[j][1]; }
    }
}


__device__ __forceinline__ void probe_mfma(Frame& F, int nit) {
    unsigned sd = (unsigned)F.tid * 2654435761u + (unsigned)F.bid * 40503u + 12345u;
    bf16x8 a[2], b[2];
#pragma unroll
    for (int i = 0; i < 2; ++i) { u32x4 wa, wb;
#pragma unroll
        for (int j = 0; j < 4; ++j) { sd = sd * 1664525u + 1013904223u; wa[j] = (sd & 0xbfffbfffu) | 0x3c003c00u; sd = sd * 1664525u + 1013904223u; wb[j] = (sd & 0xbfffbfffu) | 0x3c003c00u; }
        a[i] = *reinterpret_cast<bf16x8*>(&wa); b[i] = *reinterpret_cast<bf16x8*>(&wb); }
    f32x16 c[4] = {};
    for (int it = 0; it < nit; ++it) {
#pragma unroll
        for (int k = 0; k < 4; ++k) { c[k] = __builtin_amdgcn_mfma_f32_32x32x16_bf16(a[k & 1], b[k >> 1], c[k], 0, 0, 0); }
#pragma unroll
        for (int k = 0; k < 4; ++k) { c[k] = __builtin_amdgcn_mfma_f32_32x32x16_bf16(a[(k + 1) & 1], b[k >> 1], c[k], 0, 0, 0); }
        asm volatile("" : "+v"(a[0]), "+v"(b[0]));
    }
    float s = 0.f;
#pragma unroll
    for (int k = 0; k < 4; ++k) for (int r = 0; r < 16; ++r) s += c[k][r];
    if (s == 1.2345e-30f) *(float*)(F.ws() + WS_CTL + 65536) = s;
}
constexpr int NPHASE = 16;
__device__ __forceinline__ Frame mkframe(LAS unsigned char* lds) {
    Frame F; F.lds = lds; F.kp = kargs();
    int t = threadIdx.x; asm volatile("" : "+v"(t));
    F.wave = __builtin_amdgcn_readfirstlane(t >> 6);
    int ln = __builtin_amdgcn_mbcnt_hi(~0u, __builtin_amdgcn_mbcnt_lo(~0u, 0u)); asm volatile("" : "+v"(ln));
    F.lane = ln; F.tid = F.wave * 64 + ln; F.G = gridDim.x; F.bid = blockIdx.x;
    return F;
}
__device__ __forceinline__ bool ph_in(const Frame& F, int k) { const int lo = *(const __attribute__((address_space(4))) int*)(F.kp + 320), hi = *(const __attribute__((address_space(4))) int*)(F.kp + 324); return lo <= k && k < hi; }
template <unsigned PMASK, int K> __device__ __forceinline__ bool phase_on(const Frame& F) { if constexpr (((PMASK >> K) & 1u) == 0u) return false; else return ph_in(F, K); }
template <unsigned PMASK, int K> __device__ __forceinline__ void seam(LAS unsigned char* lds) {
    if constexpr (K + 1 < NPHASE && ((PMASK >> K) & 1u) && ((PMASK >> (K + 1)) & 1u)) {
        Frame F = mkframe(lds);
        if (ph_in(F, K) && ph_in(F, K + 1)) { XcdBarrier bar; bar.bar = (unsigned*)(F.ws() + WS_CTL) + CW_BAR; bar.x = xb_xcc_id(); bar.st = (volatile LAS unsigned*)(lds + LDS_BYTES - 256) + 8; xcd_barrier(bar); }
    }
}
template <class Epi> __device__ __forceinline__ void gemm_both(LAS unsigned char* ring, const bf16_t* A, const bf16_t* Bt, int N, int K, const Epi& E, int G, int bid, int skip = 0) {
    if (skip > 0 && skip < G) { if (bid < skip) return; G -= skip; bid -= skip; }
    const int wid = __builtin_amdgcn_readfirstlane((int)threadIdx.x >> 6);
    asm volatile("" : "+s"(K));
    { pg8::Gemm g{A, Bt, MP, N, K}; pg8::StaticOrder S; S.init(MP, N, G, bid); pg8::gemm_phase<Epi, pg8::StaticOrder, false>(ring, g, S, E, wid); }
    { pg8::Gemm g{A, Bt, MT, N, K}; pg8::HalfOrder H; H.init(MP / 256, N, G, bid); pg8::gemm_phase<Epi, pg8::HalfOrder, true>(ring, g, H, E, wid); }
}
template <int LAYER, int STEP> __device__ __forceinline__ void ffn_phase(Frame& F) {
    LAS unsigned char* ring = F.lds;
    bf16_t* const hb = (bf16_t*)(F.ws() + (LAYER == 0 ? WS_HB : WS_PP)); bf16_t* const ppb = (bf16_t*)(F.ws() + (LAYER == 0 ? WS_PP : WS_HB));
    float* const pin = (float*)(F.ws() + (LAYER == 0 ? WS_PART0 : WS_PART1)); float* const pout = (float*)(F.ws() + (LAYER == 0 ? WS_PART1 : WS_PART0));
    if constexpr (STEP == 0) {
        const float* cw = (const float*)(F.ws() + WS_CONVP) + (size_t)LAYER * DFF * 8; const float* cb = nullptr; const float* st = F.in(I_SCONV) + (size_t)LAYER * DB * 2 * DFF2;
        float* cp = F.out() + O_CONV_P + (size_t)LAYER * NBAT * 2 * DFF2; float* cs = F.out() + O_CONV_S + (size_t)LAYER * DB * 2 * DFF2;
        constexpr int NP = LAYER == 0 ? 64 : 32;
        EpiUp<NP> E{pin, (bf16_t*)(F.ws() + WS_BIG), cw, cb, st, (float*)(F.ws() + WS_ZSIDE), cp, cs, F.lds, (LAYER == 0 ? 1 : 2) << 20};
        gemm_both(ring, hb, (const bf16_t*)(F.ws() + WS_WUP) + (size_t)LAYER * DFF2 * DM, DFF2, DM, E, F.G, F.bid);
        if constexpr (LAYER == 0) bg_work<1>(F, 4 * (DFF2 / 256), bg_slot(F, 1));
    } else if constexpr (STEP == 1) { fixup_phase(F, LAYER);
    } else if constexpr (STEP == 2) {
        EpiResid E{hb, pout};
        gemm_both(ring, (const bf16_t*)(F.ws() + WS_BIG), (const bf16_t*)(F.ws() + WS_WDOWN) + (size_t)LAYER * DM * DFF, DM, DFF, E, F.G, F.bid);
    } else if constexpr (STEP == 3) {
        EpiBf16 E{ppb, DM};
        gemm_both(ring, (const bf16_t*)(F.ws() + WS_PB), (const bf16_t*)(F.ws() + WS_WPROJ) + (size_t)LAYER * DM * PLE, DM, PLE, E, F.G, F.bid, 4 * (DM / 256));
    } else {
        if constexpr (LAYER == 0) convert_p(F, 1);
        EpiPle E{pout, hb, ppb, pin, F.lds, (LAYER == 0 ? 3 : 4) << 20};
        gemm_both(ring, hb, (const bf16_t*)(F.ws() + WS_WGATE) + (size_t)LAYER * DM * DM, DM, DM, E, F.G, F.bid);
        if constexpr (LAYER == 0) { const int sl = bg_slot(F, 3); bg_work<3>(F, 4 * (DM / 256), sl); bg_work<2>(F, 4 * (DM / 256), sl); }
    }
}
template <unsigned PMASK> __global__ void __launch_bounds__(NTHR, 2) yoco_fwd(Args args) {
    extern __shared__ __attribute__((aligned(16))) unsigned char lds_raw[];
    LAS unsigned char* const lds = (LAS unsigned char*)lds_raw;
    (void)args;
    { Frame F = mkframe(lds);
      volatile LAS unsigned* MISC = (volatile LAS unsigned*)(lds + LDS_BYTES - 256);
      if (F.tid < 64) MISC[F.tid] = 0u;
      __syncthreads();
      if (MK_N_LAUNCHES == 1) (void)xcd_barrier_post((unsigned*)(F.ws() + WS_CTL) + CW_BAR, MISC + 8); }
    if (PROBE_MFMA) { Frame F = mkframe(lds); if (phase_on<PMASK, 0>(F)) probe_mfma(F, PROBE_MFMA); }
#define PH(K, ...) { Frame F = mkframe(lds); if (phase_on<PMASK, K>(F)) { __VA_ARGS__ } } seam<PMASK, K>(lds);
    if (PROBE_P2) { Frame F = mkframe(lds); if (phase_on<PMASK, 0>(F)) { p0_prologue(F); __syncthreads(); } }
    PH(0, p0_prologue(F);)
    if (PROBE_SSM2) { Frame F = mkframe(lds); if (phase_on<PMASK, 1>(F)) { ssm_phase(F, (bf16_t*)(F.ws() + WS_PP)); __syncthreads(); } }
    PH(1, ssm_phase(F, (bf16_t*)(F.ws() + WS_UB));)
    PH(2, { EpiGlu E{F.in(I_XP), F.in(I_XS), (bf16_t*)(F.ws() + WS_HB), (float*)(F.ws() + WS_PART0)};
            gemm_both(F.lds, (const bf16_t*)(F.ws() + WS_UB), (const bf16_t*)(F.ws() + WS_WGLU), 2 * DM, DM, E, F.G, F.bid); bg_work<0>(F, 4 * (2 * DM / 256), bg_slot(F, 0)); })
    if (PROBE_UP2) { Frame F = mkframe(lds); if (phase_on<PMASK, 3>(F)) { ffn_phase<0, 0>(F); } }
    PH(3, (ffn_phase<0, 0>(F));)
    if (PROBE_FF2) { Frame F = mkframe(lds); if (phase_on<PMASK, 4>(F)) { ffn_phase<0, 1>(F); } }
    PH(4, (ffn_phase<0, 1>(F));)
    { Frame F = mkframe(lds); if (phase_on<PMASK, 5>(F)) { ffn_phase<0, 2>(F); } }
    PH(5, (ffn_phase<0, 3>(F));)
    PH(6, (ffn_phase<0, 4>(F));)
    PH(7, { EpiQkv E{(const float*)(F.ws() + WS_PART0), (const float*)(F.ws() + WS_ROPE), (bf16_t*)(F.ws() + WS_UB), (float*)(F.ws() + WS_QS), (bf16_t*)(F.ws() + WS_KB), (bf16_t*)(F.ws() + WS_VB), F.out(), F.lds, 5 << 20};
            gemm_both(F.lds, (const bf16_t*)(F.ws() + WS_PP), (const bf16_t*)(F.ws() + WS_WQKV), 3 * DM, DM, E, F.G, F.bid); bg_work<4>(F, 4 * (3 * DM / 256), bg_slot(F, 4)); })
    { Frame F = mkframe(lds); if (phase_on<PMASK, 8>(F)) { attn_phase_prompt(F); } }
    if (PROBE_ATT2) { Frame F = mkframe(lds); if (phase_on<PMASK, 8>(F)) { attn_phase_prompt(F); } }
    if (PROBE_S2) { Frame F = mkframe(lds); if (phase_on<PMASK, 8>(F)) { attn_phase_sample(F); } }
    PH(8, attn_phase_sample(F);)
    if (PROBE_S2) { Frame F = mkframe(lds); if (phase_on<PMASK, 9>(F)) { combine_phase(F); } }
    PH(9, combine_phase(F);)
    PH(10, { EpiResid E{(bf16_t*)(F.ws() + WS_PP), (float*)(F.ws() + WS_PART1)};
             gemm_both(F.lds, (const bf16_t*)(F.ws() + WS_HB), (const bf16_t*)(F.ws() + WS_WO), DM, DM, E, F.G, F.bid); })
    if (PROBE_UP2) { Frame F = mkframe(lds); if (phase_on<PMASK, 11>(F)) { ffn_phase<1, 0>(F); } }
    PH(11, (ffn_phase<1, 0>(F));)
    if (PROBE_FF2) { Frame F = mkframe(lds); if (phase_on<PMASK, 12>(F)) { ffn_phase<1, 1>(F); } }
    PH(12, (ffn_phase<1, 1>(F));)
    { Frame F = mkframe(lds); if (phase_on<PMASK, 13>(F)) { ffn_phase<1, 2>(F); } }
    PH(13, (ffn_phase<1, 3>(F));)
    PH(14, (ffn_phase<1, 4>(F));)
    if (PROBE_FF2) { Frame F = mkframe(lds); if (phase_on<PMASK, 15>(F)) { final_phase(F, (const float*)(F.ws() + WS_PART1), (float*)(F.ws() + WS_UB)); } }
    PH(15, final_phase(F, (const float*)(F.ws() + WS_PART1), F.out());)
#undef PH
}

#ifndef PHASE_MASK
#define PHASE_MASK 0xFFFFu
#endif
template <unsigned PMASK> static bool prep_kernel() {
    if (hipFuncSetAttribute((const void*)yoco_fwd<PMASK>, hipFuncAttributeMaxDynamicSharedMemorySize, LDS_BYTES) != hipSuccess) { fprintf(stderr, "kernel_launch: hipFuncSetAttribute failed\n"); return false; }
    return true;
}
template <int P> static void launch_phases(int grid, Args& a, hipStream_t stream) {
    if constexpr (P < NPHASE) {
        if ((PHASE_MASK >> P) & 1u) { a.ph_lo = P; a.ph_hi = P + 1; hipLaunchKernelGGL(yoco_fwd<(1u << P)>, dim3(grid), dim3(NTHR), LDS_BYTES, stream, a); }
        launch_phases<P + 1>(grid, a, stream);
    }
}
template <int P> static bool prep_phases() { if constexpr (P < NPHASE) { return prep_kernel<(1u << P)>() && prep_phases<P + 1>(); } else return true; }
extern "C" void kernel_launch(void* const* d_in, const int* in_sizes, int n_in, void* d_out, int out_size, void* d_ws, size_t ws_size, hipStream_t stream) {
    static int grid = 0;
    if (grid == 0) {
        if (n_in != 38 || out_size != (int)O_END || ws_size < WS_END) { fprintf(stderr, "kernel_launch: unexpected shapes (n_in %d, out %d, ws %zu)\n", n_in, out_size, ws_size); grid = -1; return; }
        int dev = 0, cus = 0;
        if (hipGetDevice(&dev) != hipSuccess || hipDeviceGetAttribute(&cus, hipDeviceAttributeMultiprocessorCount, dev) != hipSuccess) { grid = -1; return; }
        bool ok;
        if constexpr (MK_N_LAUNCHES == 1) ok = prep_kernel<0xFFFFu>(); else ok = prep_phases<0>();
        if (!ok) { grid = -1; return; }
        (void)hipGetLastError();
        grid = cus;
    }
    if (grid < 0) return;
    (void)hipMemsetAsync((char*)d_ws + WS_CTL, 0, CTL_ZERO_BYTES, stream);
    Args a{};
    for (int i = 0; i < 38; ++i) a.in[i] = (const float*)d_in[i];
    a.out = (float*)d_out; a.ws = (unsigned char*)d_ws;
    if constexpr (MK_N_LAUNCHES == 1) { a.ph_lo = 0; a.ph_hi = NPHASE; hipLaunchKernelGGL(yoco_fwd<0xFFFFu>, dim3(grid), dim3(NTHR), LDS_BYTES, stream, a); }
    else launch_phases<0>(grid, a, stream);
}
```

```cpp
#include <hip/hip_runtime.h>
#include <cstdio>
#include <cstdint>

#ifndef MK_N_LAUNCHES
#define MK_N_LAUNCHES 1
#endif

#ifndef PROBE_ATT2
#define PROBE_ATT2 0
#endif
#ifndef PROBE_UP2
#define PROBE_UP2 0
#endif
#ifndef PROBE_G2
#define PROBE_G2 0
#endif
#ifndef PROBE_SSM2
#define PROBE_SSM2 0
#endif
#ifndef PROBE_MFMA
#define PROBE_MFMA 0
#endif
#ifndef PROBE_FF2
#define PROBE_FF2 0
#endif
#ifndef PROBE_PO2
#define PROBE_PO2 0
#endif
#ifndef PROBE_DOWN2
#define PROBE_DOWN2 0
#endif
#ifndef PROBE_P2
#define PROBE_P2 0
#endif
#ifndef PROBE_S2
#define PROBE_S2 0
#endif
#define LAS __attribute__((address_space(3)))
typedef unsigned short bf16_t;
typedef short bf16x8 __attribute__((ext_vector_type(8)));
typedef short s16x4 __attribute__((ext_vector_type(4)));
typedef float f32x4 __attribute__((ext_vector_type(4)));
typedef float f32x2 __attribute__((ext_vector_type(2)));
typedef float f32x16 __attribute__((ext_vector_type(16)));
typedef unsigned u32x4 __attribute__((ext_vector_type(4)));
typedef unsigned u32x2 __attribute__((ext_vector_type(2)));

constexpr int DM = 2048, SEQ = 16384, NBAT = 2, MP = NBAT * SEQ, DB = 16, DSEQ = 32, MS = DB * DSEQ, MT = MP + MS;
constexpr int NTILE = MT / 256;
constexpr int DFF = 5632, DFF2 = 2 * DFF, PLE = 256, PAST = 2048;
constexpr int NG = 128, NST = 64, NH = 8, HD = 128, VD = 256;
constexpr float EPS = 1e-6f, SUBLN_EPS = 1e-5f;
constexpr int NWAVES = 8, NTHR = 512;

constexpr size_t O_Y = 0, O_YS = 67108864, O_SRE_P = 68157440, O_SIM_P = 68173824, O_CONV_P = 68190208, O_K_P = 68280320, O_V_P = 135389184,
                 O_SRE_S = 202498048, O_SIM_S = 202629120, O_CONV_S = 202760192, O_K_S = 203481088, O_V_S = 204529664, O_END = 205578240;

constexpr size_t MiB = 1u << 20;
constexpr size_t WS_CTL = 0, CTL_ZERO_BYTES = 1 * MiB;
constexpr size_t WS_WGLU = 1 * MiB;
constexpr size_t WS_WUP = 17 * MiB;
constexpr size_t WS_WDOWN = 105 * MiB;
constexpr size_t WS_WGATE = 149 * MiB;
constexpr size_t WS_WPROJ = 165 * MiB;
constexpr size_t WS_WQKV = 167 * MiB;
constexpr size_t WS_WO = 191 * MiB;
constexpr size_t WS_ROPE = 199 * MiB;
constexpr size_t WS_L16 = 202 * MiB;
constexpr size_t WS_CONVP = 202 * MiB + 131072;
constexpr size_t WS_QS = 203 * MiB;
constexpr size_t WS_PB = 209 * MiB;
constexpr size_t WS_PART0 = 226 * MiB, WS_PART1 = 235 * MiB;
constexpr size_t WS_HB = 244 * MiB;
constexpr size_t WS_UB = 374 * MiB;
constexpr size_t WS_PP = 504 * MiB;
constexpr size_t WS_BIG = 634 * MiB;
constexpr size_t WS_KB = 894 * MiB;
constexpr size_t WS_VB = 1022 * MiB;
constexpr size_t WS_END = 1150 * MiB;
constexpr size_t WS_SSM = WS_KB;
constexpr size_t SSM_G_BYTES = 262144;
constexpr size_t WS_ZSIDE = WS_VB;

constexpr int CW_BAR = 4096;

constexpr int RING_BYTES = 131072, LDSCTL_OFF = RING_BYTES, LDS_BYTES = 147456;

__device__ __forceinline__ unsigned cvt_pk_bf16(float lo, float hi) { unsigned r; asm volatile("v_cvt_pk_bf16_f32 %0, %1, %2" : "=v"(r) : "v"(lo), "v"(hi)); return r; }
__device__ __forceinline__ float bf2f(unsigned short b) { return __uint_as_float(((unsigned)b) << 16); }
__device__ __forceinline__ float fsigmoid(float x) { return __builtin_amdgcn_rcpf(1.f + __expf(-x)); }
__device__ __forceinline__ float gelu_tanh(float x) { const float t = 1.5957691216f * (x + 0.044715f * x * x * x); return x * fsigmoid(t); }
__device__ __forceinline__ float wave_sum(float v) {
#pragma unroll
    for (int o = 1; o < 64; o <<= 1) v += __shfl_xor(v, o);
    return v;
}
template <class T> __device__ __forceinline__ T* at32(T* base, unsigned elem) { return (T*)((char*)base + elem * (unsigned)sizeof(T)); }
template <class T> __device__ __forceinline__ const T* at32(const T* base, unsigned elem) { return (const T*)((const char*)base + elem * (unsigned)sizeof(T)); }
template <int CTRL> __device__ __forceinline__ float dppf(float v) { return __int_as_float(__builtin_amdgcn_mov_dpp(__float_as_int(v), CTRL, 0xf, 0xf, false)); }
#define DPP_ROR1 0x121
#define DPP_ROR2 0x122

namespace pg8 {
constexpr int BM = 256, BK = 64, HALF = 128, HTB = HALF * BK * 2, STAGE_BYTES = 8 * HTB, NXCD = 8, WGM = 4;
__host__ __device__ __forceinline__ int lds_byte(int r, int c) { const int st = (r >> 4) * 2 + (c >> 5), rr = r & 15, cc = c & 31, ob = rr * 64 + cc * 2; return st * 1024 + (ob ^ (((ob >> 9) & 1) << 5)); }
__host__ __device__ __forceinline__ void stage_rc(int b, int& R, int& C) { const int st = b / 1024, sb = b % 1024, swz = sb ^ (((sb >> 9) & 1) << 5); R = (st >> 1) * 16 + swz / 64; C = (st & 1) * 32 + (swz % 64) / 2; }
__host__ __device__ __forceinline__ int perm32(int rho) { const int n = rho >> 4, i = rho & 15; return 8 * (i >> 2) + 4 * n + (i & 3); }

struct Unit { int pm, pn, rb, aih; };
struct Gemm { const bf16_t* A; const bf16_t* Bt; int M, N, K; };

struct StaticOrder {
    int nM, nN, nwg, G, c;
    __host__ __device__ void init(int M, int N, int G_, int c_) { nM = M / BM; nN = N / BM; nwg = nM * nN; G = G_; c = c_; }
    __host__ __device__ bool next(int i, Unit& u) const {
        const long L = (long)i * G + c; if (L >= nwg) return false;
        int wgid = (int)L; { const int q = nwg / NXCD, r = nwg % NXCD, xcd = wgid % NXCD, off = wgid / NXCD; wgid = (xcd < r ? xcd * (q + 1) : r * (q + 1) + (xcd - r) * q) + off; }
        const int nig = WGM * nN, gid = wgid / nig, fm = gid * WGM, gsz = (nM - fm) < WGM ? (nM - fm) : WGM;
        u.pm = fm + ((wgid % nig) % gsz); u.pn = (wgid % nig) / gsz; u.rb = u.pm * BM; u.aih = 0; return true;
    }
    __device__ __forceinline__ void a_ready(const Unit&) const {}
    __device__ __forceinline__ void done(const Unit&) const {}
};
struct HalfOrder {
    int nN, nwg, G, c, pm0;
    __host__ __device__ void init(int pm0_, int N, int G_, int c_) { pm0 = pm0_; nN = N / BM; nwg = 4 * nN; G = G_; c = c_; }
    __host__ __device__ bool next(int i, Unit& u) const {
        const long L = (long)i * G + c; if (L >= nwg) return false;
        const int idx = (int)L, sub = idx & 3; u.pn = idx >> 2; u.pm = pm0 + (sub >> 1); u.aih = sub & 1; u.rb = u.pm * BM + 64 * u.aih; return true;
    }
    __device__ __forceinline__ void a_ready(const Unit&) const {}
    __device__ __forceinline__ void done(const Unit&) const {}
};

#ifndef PG8_SP2
#define PG8_SP2 true
#endif
#ifndef PG8_ALIGN
#define PG8_ALIGN true
#endif
template <class Epi, class Sched, bool HALFM = false, bool ALIGN_EPI = PG8_ALIGN, bool SP2 = PG8_SP2>
__device__ __forceinline__ void gemm_phase(LAS unsigned char* lds, const Gemm g, const Sched& S, const Epi& E, const int wid  ) {
    int lane_ = __builtin_amdgcn_mbcnt_hi(~0u, __builtin_amdgcn_mbcnt_lo(~0u, 0u)); asm volatile("" : "+v"(lane_));
    const int lane = lane_, tid = wid * 64 + lane, wr = wid >> 2, wc = wid & 3, fr = lane & 15, fq = lane >> 4;
    const int K = g.K, nt = K / BK;
    unsigned voffA[2], voffB[2];
#pragma unroll
    for (int i = 0; i < 2; ++i) { int R, C; stage_rc(tid * 16 + i * 8192, R, C); const int Rb = Epi::PERM ? ((R & ~31) + perm32(R & 31)) : R;
        const int Ra = (R >> 6) * 128 + (R & 63);
        voffA[i] = (unsigned)(Ra * K + C) * 2u; voffB[i] = (unsigned)(Rb * K + C) * 2u; }
    const __amdgpu_buffer_rsrc_t rsA_ = __builtin_amdgcn_make_buffer_rsrc((void*)g.A, 0, 0x7ffffff0, 0x00020000), rsB_ = __builtin_amdgcn_make_buffer_rsrc((void*)g.Bt, 0, 0x7ffffff0, 0x00020000);
    const size_t kstep = (size_t)(BK * 2);
    const size_t hstepB = (size_t)HALF * K * 2, hstepA = (size_t)64 * K * 2;
    const size_t tstep = (size_t)BM * K * 2;
    const unsigned ldsw = (unsigned)wid * 1024u;
    const int aoff = lds_byte(wr * 64 + fr, fq * 8), boff = lds_byte(wc * 32 + fr, fq * 8);
#define PG8_SA(b, h) (((b) * 2 + (h)) * HTB)
#define PG8_SB(b, h) ((4 + (b) * 2 + (h)) * HTB)
#define PG8_STAGE(bufoff, gbase, voff) do { const int so_ = (int)(unsigned)((const char*)(gbase) - PG8_BASE_##voff); _Pragma("unroll") for (int _i = 0; _i < 2; ++_i) \
        __builtin_amdgcn_raw_ptr_buffer_load_lds(PG8_RS_##voff, (LAS unsigned*)(lds + (bufoff) + ldsw + _i * 8192), 16, (int)(voff)[_i], so_, 0, 0); } while (0)
#define PG8_BASE_voffA ((const char*)g.A)
#define PG8_BASE_voffB ((const char*)g.Bt)
#define PG8_RS_voffA rsA_
#define PG8_RS_voffB rsB_
#define PG8_LDA(dst, b, h) do { _Pragma("unroll") for (int m = 0; m < 4; ++m) _Pragma("unroll") for (int k = 0; k < 2; ++k) dst[m][k] = *(const LAS bf16x8*)(lds + PG8_SA(b, h) + aoff + m * 2048 + k * 1024); } while (0)
#define PG8_LDB(dst, b, h) do { _Pragma("unroll") for (int n = 0; n < 2; ++n) _Pragma("unroll") for (int k = 0; k < 2; ++k) dst[n][k] = *(const LAS bf16x8*)(lds + PG8_SB(b, h) + boff + n * 2048 + k * 1024); } while (0)
#define PG8_MMA(ai, bj, At, Bt) do { __builtin_amdgcn_s_setprio(1); _Pragma("unroll") for (int m = 0; m < 4; ++m) _Pragma("unroll") for (int n = 0; n < 2; ++n) _Pragma("unroll") for (int k = 0; k < 2; ++k) \
        acc[ai][bj][m][n] = __builtin_amdgcn_mfma_f32_16x16x32_bf16(Bt[n][k], At[m][k], acc[ai][bj][m][n], 0, 0, 0); __builtin_amdgcn_s_setprio(0); } while (0)
#define PG8_WAIT_V(n) asm volatile("s_waitcnt vmcnt(" #n ")" ::: "memory")
#define PG8_WAIT_L(n) asm volatile("s_waitcnt lgkmcnt(" #n ")" ::: "memory")
#define PG8_BAR __builtin_amdgcn_s_barrier()
#define PG8_SCHED __builtin_amdgcn_sched_barrier(0)
    Unit cur, nxt; int ui = 0;
    if (!S.next(0, cur)) return;
    f32x4 acc[2][2][4][2];
#pragma unroll
    for (int a = 0; a < 2; ++a)
#pragma unroll
        for (int b = 0; b < 2; ++b)
#pragma unroll
            for (int m = 0; m < 4; ++m)
#pragma unroll
                for (int n = 0; n < 2; ++n) acc[a][b][m][n] = (f32x4){0.f, 0.f, 0.f, 0.f};
    bf16x8 At[4][2], B0[2][2], B1[2][2];
    static_assert(SP2 || !HALFM, "half-M units: SP2 loop only");
    const char* cA = (const char*)g.A + (size_t)cur.pm * tstep + (size_t)cur.aih * hstepA; const char* cB = (const char*)g.Bt + (size_t)cur.pn * tstep;
    S.a_ready(cur);
    if constexpr (SP2) {
        PG8_STAGE(PG8_SB(0, 0), cB, voffB); PG8_STAGE(PG8_SB(0, 1), cB + hstepB, voffB); PG8_STAGE(PG8_SA(0, 0), cA, voffA); if constexpr (!HALFM) PG8_STAGE(PG8_SA(0, 1), cA + hstepA, voffA);
        if (wr == 1) PG8_BAR;
        if constexpr (HALFM) PG8_WAIT_V(0); else PG8_WAIT_V(2);
        PG8_BAR;
        PG8_STAGE(PG8_SB(1, 0), cB + kstep, voffB); PG8_STAGE(PG8_SA(1, 0), cA + kstep, voffA); PG8_STAGE(PG8_SB(1, 1), cB + hstepB + kstep, voffB);
        PG8_WAIT_V(6); PG8_BAR;
    } else {
    PG8_STAGE(PG8_SB(0, 0), cB, voffB); PG8_STAGE(PG8_SA(0, 0), cA, voffA); PG8_STAGE(PG8_SB(0, 1), cB + hstepB, voffB); PG8_STAGE(PG8_SA(0, 1), cA + hstepA, voffA);
    if (wr == 1) PG8_BAR;
    PG8_WAIT_V(4); PG8_BAR;
    PG8_STAGE(PG8_SB(1, 0), cB + kstep, voffB); PG8_STAGE(PG8_SA(1, 0), cA + kstep, voffA); PG8_STAGE(PG8_SB(1, 1), cB + hstepB + kstep, voffB);
    PG8_WAIT_V(6); PG8_BAR;
    }
    for (;;) {
        const bool has_next = S.next(ui + 1, nxt);
        const char* nA = has_next ? (const char*)g.A + (size_t)nxt.pm * tstep + (size_t)nxt.aih * hstepA : cA; const char* nB = has_next ? (const char*)g.Bt + (size_t)nxt.pn * tstep : cB;
        for (int t = 0; t < nt; t += 2) {
            const bool last = (t == nt - 2);
            const char* a1 = cA + (size_t)(t + 1) * kstep;
            const char* a2 = last ? nA : cA + (size_t)(t + 2) * kstep; const char* b2 = last ? nB : cB + (size_t)(t + 2) * kstep;
            const char* a3 = a2 + kstep; const char* b3 = b2 + kstep;
            if (last && has_next) S.a_ready(nxt);
            if constexpr (SP2) {
#define PG8_WAIT_VH() do { if constexpr (HALFM) PG8_WAIT_V(6); else PG8_WAIT_V(8); } while (0)
            PG8_LDB(B0, 0, 0); PG8_LDB(B1, 0, 1); PG8_SCHED; PG8_LDA(At, 0, 0); if constexpr (!HALFM) PG8_STAGE(PG8_SA(1, 1), a1 + hstepA, voffA);
            PG8_WAIT_VH(); PG8_WAIT_L(0); PG8_BAR; PG8_MMA(0, 0, At, B0); PG8_MMA(0, 1, At, B1); PG8_BAR; PG8_SCHED;
            if constexpr (!HALFM) PG8_LDA(At, 0, 1); PG8_STAGE(PG8_SB(0, 0), b2, voffB); PG8_STAGE(PG8_SB(0, 1), b2 + hstepB, voffB); PG8_STAGE(PG8_SA(0, 0), a2, voffA);
            PG8_WAIT_VH(); PG8_WAIT_L(0); PG8_BAR; if constexpr (!HALFM) { PG8_MMA(1, 0, At, B0); PG8_MMA(1, 1, At, B1); } PG8_BAR; PG8_SCHED;
            PG8_LDB(B0, 1, 0); PG8_LDB(B1, 1, 1); PG8_SCHED; PG8_LDA(At, 1, 0); if constexpr (!HALFM) PG8_STAGE(PG8_SA(0, 1), a2 + hstepA, voffA);
            PG8_WAIT_VH(); PG8_WAIT_L(0); PG8_BAR; PG8_MMA(0, 0, At, B0); PG8_MMA(0, 1, At, B1); PG8_BAR; PG8_SCHED;
            if constexpr (!HALFM) PG8_LDA(At, 1, 1); PG8_STAGE(PG8_SB(1, 0), b3, voffB); PG8_STAGE(PG8_SB(1, 1), b3 + hstepB, voffB); PG8_STAGE(PG8_SA(1, 0), a3, voffA);
            PG8_WAIT_VH(); PG8_WAIT_L(0); PG8_BAR; if constexpr (!HALFM) { PG8_MMA(1, 0, At, B0); PG8_MMA(1, 1, At, B1); } PG8_BAR; PG8_SCHED;
#undef PG8_WAIT_VH
            } else {
            PG8_LDB(B0, 0, 0); PG8_SCHED; PG8_LDA(At, 0, 0); PG8_STAGE(PG8_SA(1, 1), a1 + hstepA, voffA);
            PG8_WAIT_L(8); PG8_BAR; PG8_WAIT_L(0); PG8_MMA(0, 0, At, B0); PG8_BAR; PG8_SCHED;
            PG8_LDB(B1, 0, 1); PG8_STAGE(PG8_SB(0, 0), b2, voffB);
            PG8_BAR; PG8_WAIT_L(0); PG8_MMA(0, 1, At, B1); PG8_BAR;
            PG8_LDA(At, 0, 1); PG8_STAGE(PG8_SA(0, 0), a2, voffA);
            PG8_BAR; PG8_WAIT_L(0); PG8_MMA(1, 0, At, B0); PG8_BAR; PG8_SCHED;
            PG8_STAGE(PG8_SB(0, 1), b2 + hstepB, voffB);
            PG8_WAIT_V(6); PG8_BAR; PG8_MMA(1, 1, At, B1); PG8_BAR;
            PG8_LDB(B0, 1, 0); PG8_SCHED; PG8_LDA(At, 1, 0); PG8_STAGE(PG8_SA(0, 1), a2 + hstepA, voffA);
            PG8_WAIT_L(8); PG8_BAR; PG8_WAIT_L(0); PG8_MMA(0, 0, At, B0); PG8_BAR; PG8_SCHED;
            PG8_LDB(B1, 1, 1); PG8_STAGE(PG8_SB(1, 0), b3, voffB);
            PG8_BAR; PG8_WAIT_L(0); PG8_MMA(0, 1, At, B1); PG8_BAR;
            PG8_LDA(At, 1, 1); PG8_STAGE(PG8_SA(1, 0), a3, voffA);
            PG8_BAR; PG8_WAIT_L(0); PG8_MMA(1, 0, At, B0); PG8_BAR; PG8_SCHED;
            PG8_STAGE(PG8_SB(1, 1), b3 + hstepB, voffB);
            PG8_WAIT_V(6); PG8_BAR; PG8_MMA(1, 1, At, B1); PG8_BAR;
            }
        }
        if constexpr (ALIGN_EPI) { if (wr == 0) PG8_BAR; }
        E.template run<HALFM ? 1 : 2>(acc, cur, wr, wc, fr, fq); S.done(cur);
        if (!has_next) break;
#pragma unroll
        for (int a = 0; a < 2; ++a)
#pragma unroll
            for (int b = 0; b < 2; ++b)
#pragma unroll
                for (int m = 0; m < 4; ++m)
#pragma unroll
                    for (int n = 0; n < 2; ++n) acc[a][b][m][n] = (f32x4){0.f, 0.f, 0.f, 0.f};
        cur = nxt; cA = nA; cB = nB; ++ui;
        if constexpr (ALIGN_EPI) { if (wr == 1) PG8_BAR; }
    }
    PG8_WAIT_V(0);
    if constexpr (!ALIGN_EPI) { if (wr == 0) PG8_BAR; }
    PG8_BAR;
#undef PG8_SA
#undef PG8_SB
#undef PG8_STAGE
#undef PG8_BASE_voffA
#undef PG8_BASE_voffB
#undef PG8_RS_voffA
#undef PG8_RS_voffB
#undef PG8_LDA
#undef PG8_LDB
#undef PG8_MMA
#undef PG8_WAIT_V
#undef PG8_WAIT_L
#undef PG8_BAR
#undef PG8_SCHED
}
}
using pg8::Unit;

typedef f32x4 Acc[2][2][4][2];

__device__ __forceinline__ unsigned part_idx(int ph, int slot, int fr) { return (unsigned)(((ph * 64 + slot) * 16 + fr) * 8); }
constexpr int RSTD_LDS = RING_BYTES;
template <int NP, int NAI> __device__ __forceinline__ void load_rstd(const float* part, int rowbase, int fr, int fq, float (&rs)[2][4], LAS unsigned char* lds, int wid, int key) {
    LAS float* rc = (LAS float*)(lds + RSTD_LDS) + wid * 128; LAS int* tagp = (LAS int*)(lds + LDS_BYTES - 256) + 32 + wid;
    const int want = key | rowbase;
    if (__builtin_amdgcn_readfirstlane(*tagp) == want) {
#pragma unroll
        for (int ai = 0; ai < NAI; ++ai)
#pragma unroll
            for (int m = 0; m < 4; ++m) rs[ai][m] = rc[64 * ai + 16 * m + fr];
        return;
    }
    { const int ph = rowbase >> 7, q0 = (rowbase >> 4) & 7;
      f32x4 sacc[2] = {{0.f, 0.f, 0.f, 0.f}, {0.f, 0.f, 0.f, 0.f}};
#pragma unroll
      for (int i = 0; i < NP / 4; ++i) { const unsigned o_ = part_idx(ph, fq * (NP / 4) + i, fr) + q0;
#pragma unroll
          for (int ai = 0; ai < NAI; ++ai) sacc[ai] += *(const f32x4*)at32(part, o_ + 4 * ai);
          if ((i & 3) == 3) asm volatile("" : "+v"(sacc[0]), "+v"(sacc[1]));     }
#pragma unroll
      for (int ai = 0; ai < NAI; ++ai)
#pragma unroll
        for (int m = 0; m < 4; ++m) { float sv = sacc[ai][m]; sv += __shfl_xor(sv, 16); sv += __shfl_xor(sv, 32);
            rs[ai][m] = rsqrtf(sv * (1.0f / DM) + EPS);
            if (NAI == 2 && fq == 0) rc[64 * ai + 16 * m + fr] = rs[ai][m]; } }
    if (NAI == 2) { if (fr == 0 && fq == 0) *tagp = want; }
    asm volatile("s_waitcnt lgkmcnt(0)" ::: "memory");
}

template <int NAI> __device__ __forceinline__ void store_part4(float* part, const Unit& u, int wr, int slot, int fr, int fq, int ai, const f32x4 v) {
    if (fq == 0) *(f32x4*)at32(part, part_idx(u.pm * 2 + wr, slot, fr) + 4u * (unsigned)(NAI == 1 ? u.aih : ai)) = v;
}
struct EpiGlu {
    static constexpr bool PERM = true;
    const float* xp; const float* xs; bf16_t* hb; float* part;
    template <int NAI> __device__ __forceinline__ void run(Acc& acc, const Unit& u, int wr, int wc, int fr, int fq) const {
        asm volatile("" : "+v"(fr), "+v"(fq));
        const int rowbase = u.rb + wr * 128 + fr, col0 = u.pn * 128 + wc * 32 + 8 * fq;
        const bool smp = u.pm >= MP / 256; const float* xb = smp ? xs : xp; const int rsub = smp ? MP : 0;
#pragma unroll
        for (int ai = 0; ai < NAI; ++ai) {
            f32x4 xv[4][2]; f32x4 ssv;
#pragma unroll
            for (int m = 0; m < 4; ++m)
#pragma unroll
                for (int n = 0; n < 2; ++n) xv[m][n] = *(const f32x4*)at32(xb, (unsigned)((rowbase + 64 * ai + 16 * m - rsub) * DM + col0 + 4 * n));
#pragma unroll
            for (int m = 0; m < 4; ++m) {
                const int r = rowbase + 64 * ai + 16 * m; float ss = 0.f; u32x4 w;
#pragma unroll
                for (int n = 0; n < 2; ++n) {
                    const f32x4 a = acc[ai][0][m][n], b = acc[ai][1][m][n]; f32x4 o;
#pragma unroll
                    for (int j = 0; j < 4; ++j) { o[j] = xv[m][n][j] + a[j] * fsigmoid(b[j]); ss += o[j] * o[j]; }
                    w[2 * n] = cvt_pk_bf16(o[0], o[1]); w[2 * n + 1] = cvt_pk_bf16(o[2], o[3]);
                }
                *(u32x4*)at32(hb, (unsigned)(r * DM + col0)) = w;
                ss += __shfl_xor(ss, 16); ss += __shfl_xor(ss, 32);
                ssv[m] = ss;
            }
            store_part4<NAI>(part, u, wr, u.pn * 4 + wc, fr, fq, ai, ssv);
        }
    }
};

struct EpiResid {
    static constexpr bool PERM = true;
    bf16_t* hb; float* part;
    template <int NAI> __device__ __forceinline__ void run(Acc& acc, const Unit& u, int wr, int wc, int fr, int fq) const {
        asm volatile("" : "+v"(fr), "+v"(fq));
        const int rowbase = u.rb + wr * 128 + fr, col0 = u.pn * 256 + wc * 32 + 8 * fq;
#pragma unroll
        for (int ai = 0; ai < NAI; ++ai) {
            u32x4 hv[4][2]; f32x4 ssv;
#pragma unroll
            for (int m = 0; m < 4; ++m)
#pragma unroll
                for (int bj = 0; bj < 2; ++bj) hv[m][bj] = *(const u32x4*)at32((const bf16_t*)hb, (unsigned)((rowbase + 64 * ai + 16 * m) * DM + col0 + 128 * bj));
#pragma unroll
            for (int m = 0; m < 4; ++m) {
                const int r = rowbase + 64 * ai + 16 * m; float ss = 0.f;
#pragma unroll
                for (int bj = 0; bj < 2; ++bj) { u32x4 w;
#pragma unroll
                    for (int n = 0; n < 2; ++n) {
                        const unsigned h0 = hv[m][bj][2 * n], h1 = hv[m][bj][2 * n + 1]; const f32x4 a = acc[ai][bj][m][n];
                        const f32x4 o = {__uint_as_float(h0 << 16) + a[0], __uint_as_float(h0 & 0xffff0000u) + a[1], __uint_as_float(h1 << 16) + a[2], __uint_as_float(h1 & 0xffff0000u) + a[3]};
                        ss += (o[0] * o[0] + o[1] * o[1]) + (o[2] * o[2] + o[3] * o[3]);
                        w[2 * n] = cvt_pk_bf16(o[0], o[1]); w[2 * n + 1] = cvt_pk_bf16(o[2], o[3]);
                    }
                    *(u32x4*)at32(hb, (unsigned)(r * DM + col0 + 128 * bj)) = w; }
                ss += __shfl_xor(ss, 16); ss += __shfl_xor(ss, 32);
                ssv[m] = ss;
            }
            store_part4<NAI>(part, u, wr, u.pn * 4 + wc, fr, fq, ai, ssv);
        }
    }
};

struct EpiBf16 {
    static constexpr bool PERM = true;
    bf16_t* O; int ldc;
    template <int NAI> __device__ __forceinline__ void run(Acc& acc, const Unit& u, int wr, int wc, int fr, int fq) const {
        asm volatile("" : "+v"(fr), "+v"(fq));
        const int rowbase = u.rb + wr * 128 + fr, col0 = u.pn * 256 + wc * 32 + 8 * fq;
#pragma unroll
        for (int ai = 0; ai < NAI; ++ai)
#pragma unroll
            for (int m = 0; m < 4; ++m) { const unsigned ro = (unsigned)((rowbase + 64 * ai + 16 * m) * ldc + col0);
#pragma unroll
                for (int bj = 0; bj < 2; ++bj) { const f32x4 v0 = acc[ai][bj][m][0], v1 = acc[ai][bj][m][1];
                    u32x4 w = {cvt_pk_bf16(v0[0], v0[1]), cvt_pk_bf16(v0[2], v0[3]), cvt_pk_bf16(v1[0], v1[1]), cvt_pk_bf16(v1[2], v1[3])}; *(u32x4*)at32(O, ro + (unsigned)(bj * 128)) = w; } }
    }
};

struct EpiPle {
    static constexpr bool PERM = true;
    const float* partin; const bf16_t* hsrc; bf16_t* ppio; float* part; LAS unsigned char* lds; int key;
    template <int NAI> __device__ __forceinline__ void run(Acc& acc, const Unit& u, int wr, int wc, int fr, int fq) const {
        asm volatile("" : "+v"(fr), "+v"(fq));
        const int rowbase = u.rb + wr * 128 + fr, col0 = u.pn * 256 + wc * 32 + 8 * fq;
        float rs[2][4]; load_rstd<32, NAI>(partin, u.rb + wr * 128, fr, fq, rs, lds, wr * 4 + wc, key); f32x4 ssv = {0.f, 0.f, 0.f, 0.f};
#pragma unroll
        for (int q2 = 0; q2 < 2 * NAI; ++q2) {
            const int ai = q2 >> 1, m0 = (q2 & 1) * 2;
            u32x4 hv[2][2], pv[2][2];
#pragma unroll
            for (int mm = 0; mm < 2; ++mm)
#pragma unroll
                for (int bj = 0; bj < 2; ++bj) { const unsigned o_ = (unsigned)((rowbase + 64 * ai + 16 * (m0 + mm)) * DM + col0 + 128 * bj);
                    hv[mm][bj] = *(const u32x4*)at32(hsrc, o_); pv[mm][bj] = *(const u32x4*)at32((const bf16_t*)ppio, o_); }
#pragma unroll
            for (int mm = 0; mm < 2; ++mm) {
                const int m = m0 + mm, r = rowbase + 64 * ai + 16 * m; float ss = 0.f;
#pragma unroll
                for (int bj = 0; bj < 2; ++bj) { u32x4 w;
#pragma unroll
                    for (int n = 0; n < 2; ++n) {
                        const unsigned pw0 = pv[mm][bj][2 * n], pw1 = pv[mm][bj][2 * n + 1], h0 = hv[mm][bj][2 * n], h1 = hv[mm][bj][2 * n + 1];
                        const f32x4 a = acc[ai][bj][m][n] * rs[ai][m]; f32x4 o;
                        o[0] = __uint_as_float(h0 << 16) + __uint_as_float(pw0 << 16) * fsigmoid(a[0]); o[1] = __uint_as_float(h0 & 0xffff0000u) + __uint_as_float(pw0 & 0xffff0000u) * fsigmoid(a[1]);
                        o[2] = __uint_as_float(h1 << 16) + __uint_as_float(pw1 << 16) * fsigmoid(a[2]); o[3] = __uint_as_float(h1 & 0xffff0000u) + __uint_as_float(pw1 & 0xffff0000u) * fsigmoid(a[3]);
                        ss += (o[0] * o[0] + o[1] * o[1]) + (o[2] * o[2] + o[3] * o[3]);
                        w[2 * n] = cvt_pk_bf16(o[0], o[1]); w[2 * n + 1] = cvt_pk_bf16(o[2], o[3]);
                    }
                    *(u32x4*)at32(ppio, (unsigned)(r * DM + col0 + 128 * bj)) = w; }
                ss += __shfl_xor(ss, 16); ss += __shfl_xor(ss, 32);
                ssv[m] = ss;
            }
            if (q2 & 1) store_part4<NAI>(part, u, wr, u.pn * 4 + wc, fr, fq, ai, ssv);
        }
    }
};

template <int NP> struct EpiUp {
    static constexpr bool PERM = true;
    const float* partin; bf16_t* act; const float* cw; const float* cb; const float* state; float* zside; float* conv_p; float* conv_s; LAS unsigned char* lds; int key;
    template <int NAI> __device__ __forceinline__ void run(Acc& acc, const Unit& u, int wr, int wc, int fr, int fq) const {
        asm volatile("" : "+v"(fr), "+v"(fq));
        const bool sample = u.pm >= MP / 256;
        const int rowhalf = u.rb + wr * 128;
        { float rs[2][4]; load_rstd<NP, NAI>(partin, rowhalf, fr, fq, rs, lds, wr * 4 + wc, key);
#pragma unroll
          for (int ai = 0; ai < NAI; ++ai)
#pragma unroll
            for (int bj = 0; bj < 2; ++bj)
#pragma unroll
                for (int m = 0; m < 4; ++m)
#pragma unroll
                    for (int n = 0; n < 2; ++n) acc[ai][bj][m][n] = acc[ai][bj][m][n] * rs[ai][m]; }
        const int ht = u.pm * 2 + wr;
        const bool seqstart = (!sample) && ((ht & 127) == 0);
        const bool seqend = (!sample) && ((ht & 127) == 127);
        const int sb2 = ((rowhalf - MP) >> 5) * 2;
        const int c8 = u.pn * 128 + wc * 32 + 8 * fq;
#pragma unroll
        for (int n = 0; n < 2; ++n) {
            const int c0 = c8 + 4 * n;
            if (NAI == 2 && !sample) {
                if (fr < 2) { const unsigned o = (unsigned)((ht * 4 + fr) * DFF2 + c0); *(f32x4*)at32(zside, o) = acc[0][0][0][n]; *(f32x4*)at32(zside, o + DFF) = acc[0][1][0][n]; }
                if (fr >= 14) { const unsigned o = (unsigned)((ht * 4 + 2 + (fr - 14)) * DFF2 + c0); *(f32x4*)at32(zside, o) = acc[NAI - 1][0][3][n]; *(f32x4*)at32(zside, o + DFF) = acc[NAI - 1][1][3][n];
                    if (seqend) { const unsigned o2 = (unsigned)(((ht >> 7) * 2 + (fr - 14)) * DFF2 + c0); *(f32x4*)at32(conv_p, o2) = acc[NAI - 1][0][3][n]; *(f32x4*)at32(conv_p, o2 + DFF) = acc[NAI - 1][1][3][n]; } }
            } else if (sample && fr >= 14) {
#pragma unroll
                for (int qq = 1; qq < 4 * NAI; qq += 2) { const unsigned o2 = (unsigned)((sb2 + (qq >> 1) * 2 + (fr - 14)) * DFF2 + c0);
                    *(f32x4*)at32(conv_s, o2) = acc[qq >> 2][0][qq & 3][n]; *(f32x4*)at32(conv_s, o2 + DFF) = acc[qq >> 2][1][qq & 3][n]; }
            }
        }
        unsigned outp[4 * NAI][4];
        f32x4 nr0 = *(const f32x4*)at32(cw, (unsigned)(c8 * 8)), nr1 = *(const f32x4*)at32(cw, (unsigned)(c8 * 8 + 4)), nr2 = *(const f32x4*)at32(cw, (unsigned)(c8 * 8 + 8)), nr3 = *(const f32x4*)at32(cw, (unsigned)(c8 * 8 + 12));
#pragma unroll
        for (int n = 0; n < 2; ++n)
#pragma unroll
            for (int jp = 0; jp < 2; ++jp) {
                const int c0 = c8 + 4 * n + 2 * jp;
                const f32x4 ra = nr0, rb_ = nr1, rc_ = nr2, rd_ = nr3;
                asm volatile("" ::: "memory");
                if (n * 2 + jp < 3) { const unsigned o = (unsigned)((c0 + 2) * 8); nr0 = *(const f32x4*)at32(cw, o); nr1 = *(const f32x4*)at32(cw, o + 4); nr2 = *(const f32x4*)at32(cw, o + 8); nr3 = *(const f32x4*)at32(cw, o + 12); }
                const f32x2 w0v = {ra[0], ra[1]}, w1v = {ra[2], ra[3]}, w2v = {rb_[0], rb_[1]}, bv = {rb_[2], rb_[3]};
                const f32x2 w0g = {rc_[0], rc_[1]}, w1g = {rc_[2], rc_[3]}, w2g = {rd_[0], rd_[1]}, bg = {rd_[2], rd_[3]};
                f32x2 p1v = {0.f, 0.f}, p2v = p1v, p1g = p1v, p2g = p1v;
#pragma unroll
                for (int q = 0; q < 4 * NAI; ++q) {
                    const int ai = q >> 2, m = q & 3;
                    const f32x2 zv = {acc[ai][0][m][n][2 * jp], acc[ai][0][m][n][2 * jp + 1]}, zg = {acc[ai][1][m][n][2 * jp], acc[ai][1][m][n][2 * jp + 1]};
                    if (sample && !(q & 1)) {
                        f32x2 hv = {0.f, 0.f}, hg = hv;
                        if (fr >= 14) { const unsigned so = (unsigned)((sb2 + (q >> 1) * 2 + (fr - 14)) * DFF2 + c0); hv = *(const f32x2*)at32(state, so); hg = *(const f32x2*)at32(state, so + DFF); }
#pragma unroll
                        for (int j = 0; j < 2; ++j) { p1v[j] = dppf<DPP_ROR1>(hv[j]); p2v[j] = dppf<DPP_ROR2>(hv[j]); p1g[j] = dppf<DPP_ROR1>(hg[j]); p2g[j] = dppf<DPP_ROR2>(hg[j]); }
                    }
                    f32x2 r1v, r2v, r1g, r2g, P1v, P2v, P1g, P2g;
#pragma unroll
                    for (int j = 0; j < 2; ++j) {
                        r1v[j] = dppf<DPP_ROR1>(zv[j]); r2v[j] = dppf<DPP_ROR2>(zv[j]); r1g[j] = dppf<DPP_ROR1>(zg[j]); r2g[j] = dppf<DPP_ROR2>(zg[j]);
                        P1v[j] = fr >= 1 ? r1v[j] : p1v[j]; P2v[j] = fr >= 2 ? r2v[j] : p2v[j]; P1g[j] = fr >= 1 ? r1g[j] : p1g[j]; P2g[j] = fr >= 2 ? r2g[j] : p2g[j];
                    }
                    const f32x2 cv = __builtin_elementwise_fma(w0v, P2v, __builtin_elementwise_fma(w1v, P1v, __builtin_elementwise_fma(w2v, zv, bv)));
                    const f32x2 cg = __builtin_elementwise_fma(w0g, P2g, __builtin_elementwise_fma(w1g, P1g, __builtin_elementwise_fma(w2g, zg, bg)));
                    const f32x2 tt = cg * (f32x2){-1.4426950408889634f, -1.4426950408889634f};
                    f32x2 ee = {__builtin_amdgcn_exp2f(tt[0]), __builtin_amdgcn_exp2f(tt[1])}; ee = ee + (f32x2){1.f, 1.f};
                    const f32x2 sg = {__builtin_amdgcn_rcpf(ee[0]), __builtin_amdgcn_rcpf(ee[1])};
                    const f32x2 o = cv * cg * sg;
                    p1v = r1v; p2v = r2v; p1g = r1g; p2g = r2g;
                    outp[q][2 * n + jp] = cvt_pk_bf16(o[0], o[1]);
                }
            }
#pragma unroll
        for (int q = 0; q < 4 * NAI; ++q) {
            const bool deferred = (!sample) && q == 0 && fr < 2 && !seqstart;
            if (!deferred) { u32x4 w = {outp[q][0], outp[q][1], outp[q][2], outp[q][3]}; *(u32x4*)at32(act, (unsigned)((rowhalf + 16 * q + fr) * DFF + c8)) = w; }
        }
    }
};

struct EpiQkv {
    static constexpr bool PERM = false;
    const float* partin; const float* rope; bf16_t* qb; float* qs; bf16_t* kb; bf16_t* vb; float* out; LAS unsigned char* lds; int key;
    template <int NAI> __device__ __forceinline__ void run(Acc& acc, const Unit& u, int wr, int wc, int fr, int fq) const {
        asm volatile("" : "+v"(fr), "+v"(fq));
        const int rowhalf = u.rb + wr * 128;
        float rs[2][4]; load_rstd<32, NAI>(partin, rowhalf, fr, fq, rs, lds, wr * 4 + wc, key);
        const int which = u.pn >> 3, head = u.pn & 7;
#pragma unroll
        for (int ai = 0; ai < NAI; ++ai)
#pragma unroll
            for (int m = 0; m < 4; ++m) {
                const int r = rowhalf + 64 * ai + 16 * m + fr; const bool smp = r >= MP;
                const int pos = smp ? PAST + ((r - MP) & 31) : (r & (SEQ - 1));
                f32x4 cs = {1.f, 1.f, 1.f, 1.f}, sn = {0.f, 0.f, 0.f, 0.f};
                if (which < 2 && wc == 0) { cs = *(const f32x4*)at32(rope, (unsigned)(pos * 32 + 4 * fq)); sn = *(const f32x4*)at32(rope, (unsigned)(pos * 32 + 16 + 4 * fq)); }
#pragma unroll
                for (int bj = 0; bj < 2; ++bj) {
                    f32x4 v0 = acc[ai][bj][m][0] * rs[ai][m], v1 = acc[ai][bj][m][1] * rs[ai][m];
                    if (which < 2 && wc == 0) { const f32x4 a = v0, b = v1; v0 = a * cs - b * sn; v1 = b * cs + a * sn; }
                    const int c = head * 256 + bj * 128 + wc * 32 + 4 * fq;
                    u32x2 w0, w1; w0.x = cvt_pk_bf16(v0[0], v0[1]); w0.y = cvt_pk_bf16(v0[2], v0[3]); w1.x = cvt_pk_bf16(v1[0], v1[1]); w1.y = cvt_pk_bf16(v1[2], v1[3]);
                    if (which == 0) {
                        *(u32x2*)at32(qb, (unsigned)(r * DM + c)) = w0; *(u32x2*)at32(qb, (unsigned)(r * DM + c + 16)) = w1;
                        if (smp) { *(f32x4*)at32(qs, (unsigned)((r - MP) * DM + c)) = v0; *(f32x4*)at32(qs, (unsigned)((r - MP) * DM + c + 16)) = v1; }
                    } else {
                        float* ob = out + (smp ? (which == 1 ? O_K_S : O_V_S) : (which == 1 ? O_K_P : O_V_P)); const unsigned oo = (unsigned)((smp ? r - MP : r) * DM + c);
                        *(f32x4*)at32(ob, oo) = v0; *(f32x4*)at32(ob, oo + 16u) = v1;
                        if (!smp) { bf16_t* bp = (which == 1 ? kb : vb); *(u32x2*)at32(bp, (unsigned)(r * DM + c)) = w0; *(u32x2*)at32(bp, (unsigned)(r * DM + c + 16)) = w1; }
                    }
                }
            }
    }
};

#define XB_TMO      128
#define XB_XCNT(j)  (256  + 64 * (j))
#define XB_XSUB(j)  (1280 + 64 * (j))
#define XB_XGEN(j)  (2304 + 64 * (j))
#define XB_TOP      3328
#define XB_TOPGEN   3392
#define XCD_BAR_WORDS 3456
#define XB_SPIN_CAP (1u << 22)

__device__ __forceinline__ unsigned xb_ld(unsigned* p)              { return __hip_atomic_load(p, __ATOMIC_RELAXED, __HIP_MEMORY_SCOPE_AGENT); }
__device__ __forceinline__ unsigned xb_add(unsigned* p, unsigned v) { return __hip_atomic_fetch_add(p, v, __ATOMIC_RELAXED, __HIP_MEMORY_SCOPE_AGENT); }
__device__ __forceinline__ unsigned xb_xcc_id() { return (unsigned)__builtin_amdgcn_s_getreg((3 << 11) | 20) & 0xFu; }
#define XB_SPIN(cond, bar) do { unsigned _sp = 0; while (cond) { __builtin_amdgcn_s_sleep(1); \
    if ((++_sp & 255u) == 0u) { if (xb_ld(&(bar)[XB_TMO])) break; if (_sp > XB_SPIN_CAP) { atomicAdd(&(bar)[XB_TMO], 1u); break; } } } } while (0)

struct XcdBarrier { unsigned* bar; unsigned x; volatile LAS unsigned* st; };

__device__ __forceinline__ XcdBarrier xcd_barrier_post(unsigned* bar, volatile LAS unsigned* st) {
    XcdBarrier b; b.bar = bar; b.x = xb_xcc_id(); b.st = st;
    if (threadIdx.x == 0) (void)xb_add(&bar[XB_XCNT(b.x)], 1u);
    return b;
}
__device__ __forceinline__ void xcd_barrier_complete(unsigned* bar, unsigned x, unsigned& nloc, unsigned& nx) {
    const unsigned G = gridDim.x * gridDim.y * gridDim.z;
    unsigned sum, cnt, mine, sp = 0u;
    for (;;) {
        sum = 0u; cnt = 0u; mine = 0u;
#pragma unroll
        for (unsigned j = 0; j < 16; ++j) { const unsigned c = xb_ld(&bar[XB_XCNT(j)]); sum += c; cnt += (c > 0u) ? 1u : 0u; mine = (j == x) ? c : mine; }
        if (sum == G) break;
        __builtin_amdgcn_s_sleep(1);
        if ((++sp & 255u) == 0u) { if (xb_ld(&bar[XB_TMO])) break; if (sp > XB_SPIN_CAP) { atomicAdd(&bar[XB_TMO], 1u); break; } }
    }
    nloc = mine > 0u ? mine : 1u; nx = cnt > 0u ? cnt : 1u;
}
__device__ __forceinline__ void xcd_barrier(const XcdBarrier& b) {
    asm volatile("s_waitcnt vmcnt(0)" ::: "memory");
    __syncthreads();
    if (threadIdx.x == 0) {
        unsigned* bar = b.bar;
        __builtin_amdgcn_s_waitcnt(0);
        unsigned nloc = b.st[0], nx = b.st[1];
        if (nloc == 0u) { xcd_barrier_complete(bar, b.x, nloc, nx); b.st[0] = nloc; b.st[1] = nx; }
        const unsigned old = xb_add(&bar[XB_XSUB(b.x)], 1u);
        const unsigned gen = old / nloc;
        if (old + 1u == (gen + 1u) * nloc) {
            __builtin_amdgcn_fence(__ATOMIC_RELEASE, "agent");
            asm volatile("s_waitcnt vmcnt(0)" ::: "memory");
            const unsigned og = xb_add(&bar[XB_TOP], 1u);
            const unsigned tg = og / nx;
            if (og + 1u == (tg + 1u) * nx) xb_add(&bar[XB_TOPGEN], 1u);
            else XB_SPIN(xb_ld(&bar[XB_TOPGEN]) == tg, bar);
            __builtin_amdgcn_fence(__ATOMIC_ACQUIRE, "agent");
            xb_add(&bar[XB_XGEN(b.x)], 1u);
            asm volatile("s_waitcnt vmcnt(0)" ::: "memory");
        } else {
            XB_SPIN(xb_ld(&bar[XB_XGEN(b.x)]) == gen, bar);
            __builtin_amdgcn_fence(__ATOMIC_ACQUIRE, "agent");
            asm volatile("s_waitcnt vmcnt(0)" ::: "memory");
        }
    }
    __syncthreads();
}

namespace att {
constexpr float SCALE = 0.08838834764831845f, THR = 8.f;
constexpr int NW = 8, QBLK = 32, KVBLK = 64, QB = NW * QBLK, D = 128;
constexpr int SHM_V = KVBLK * D * 2, SHM_K = KVBLK * D * 2;
constexpr int LDS_ATT = 2 * SHM_V + 2 * SHM_K + NW * 64 * 4;
constexpr int QS = DM, KS = DM, OS = 2 * DM;
template <class A, class Bt> struct same_t { static constexpr bool v = false; };
template <class A> struct same_t<A, A> { static constexpr bool v = true; };
#define KSWZ(row, colB) ((row) * 256 + ((colB) ^ (((row) & 7) << 4)))
#define SBAR() __builtin_amdgcn_sched_barrier(0)
__device__ __forceinline__ int v_st(int k, int c) { const int kk = (k & ~0xC) | ((k & 4) << 1) | ((k & 8) >> 1); return ((kk >> 3) * 4 + (c >> 5)) * 512 + ((kk & 7) * 32 + (c & 31)) * 2; }
__device__ __forceinline__ int v_rd_base(int lane) { return ((lane & 3) << 3) | (((lane >> 2) & 3) << 6) | (((lane >> 4) & 1) << 5) | (((lane >> 5) & 1) << 8); }
constexpr int v_rd_off(int d0, int ks, int half) { return d0 * 512 + ks * 4096 + half * 2048; }
__device__ __forceinline__ int crow(int r, int hi) { return (r & 3) + 8 * (r >> 2) + 4 * hi; }
__device__ __forceinline__ unsigned cvtpk(float lo, float hi) { unsigned r; asm volatile("v_cvt_pk_bf16_f32 %0, %1, %2" : "=v"(r) : "v"(lo), "v"(hi)); return r; }
__device__ __forceinline__ bf16x8 pack8(f32x4 a, f32x4 b) { u32x4 w = {cvtpk(a[0], a[1]), cvtpk(a[2], a[3]), cvtpk(b[0], b[1]), cvtpk(b[2], b[3])}; return *reinterpret_cast<bf16x8*>(&w); }
template <class T> __device__ __forceinline__ bf16x8 load8(const T* p) {
    if constexpr (same_t<T, float>::v) { return pack8(*(const f32x4*)p, *(const f32x4*)(p + 4)); }
    else { return *reinterpret_cast<const bf16x8*>(p); }
}
__device__ __forceinline__ void partialSM(f32x16& p0, f32x16& p1, float& m_reg, float& mn, float& alpha) {
    float pmax;
    asm("v_max3_f32 %0, %1, %2, %3" : "=v"(pmax) : "v"(p0[0]), "v"(p0[1]), "v"(p0[2]));
#pragma unroll
    for (int r = 3; r < 15; r += 2) asm("v_max3_f32 %0, %0, %1, %2" : "+v"(pmax) : "v"(p0[r]), "v"(p0[r + 1]));
    asm("v_max3_f32 %0, %0, %1, %2" : "+v"(pmax) : "v"(p0[15]), "v"(p1[0]));
#pragma unroll
    for (int r = 1; r < 15; r += 2) asm("v_max3_f32 %0, %0, %1, %2" : "+v"(pmax) : "v"(p1[r]), "v"(p1[r + 1]));
    asm("v_max_f32 %0, %0, %1" : "+v"(pmax) : "v"(p1[15]));
    { auto rr = __builtin_amdgcn_permlane32_swap(__float_as_uint(pmax), __float_as_uint(pmax), false, false);
      asm("v_max_f32 %0, %1, %2" : "=v"(pmax) : "v"(__uint_as_float(rr[0])), "v"(__uint_as_float(rr[1]))); }
    constexpr float C2 = 1.4426950408889634f * SCALE;
    if (__builtin_expect(__all((pmax - m_reg) * SCALE <= THR), 1)) { mn = m_reg; alpha = 1.f; }
    else { mn = fmaxf(m_reg, pmax); alpha = __builtin_amdgcn_exp2f((m_reg - mn) * C2); m_reg = mn; }
    const float mnL = -mn * C2;
    for (int r = 0; r < 16; ++r) p0[r] = fmaf(p0[r], C2, mnL); for (int r = 0; r < 16; ++r) p1[r] = fmaf(p1[r], C2, mnL);
    for (int r = 0; r < 16; ++r) p0[r] = __builtin_amdgcn_exp2f(p0[r]);
}
__device__ __forceinline__ void partialSM2(f32x16& p0, f32x16& p1, float& mnL, float& mthr, float& alpha) {
    float pmax;
    asm("v_max3_f32 %0, %1, %2, %3" : "=v"(pmax) : "v"(p0[0]), "v"(p0[1]), "v"(p0[2]));
#pragma unroll
    for (int r = 3; r < 15; r += 2) asm("v_max3_f32 %0, %0, %1, %2" : "+v"(pmax) : "v"(p0[r]), "v"(p0[r + 1]));
    asm("v_max3_f32 %0, %0, %1, %2" : "+v"(pmax) : "v"(p0[15]), "v"(p1[0]));
#pragma unroll
    for (int r = 1; r < 15; r += 2) asm("v_max3_f32 %0, %0, %1, %2" : "+v"(pmax) : "v"(p1[r]), "v"(p1[r + 1]));
    asm("v_max_f32 %0, %0, %1" : "+v"(pmax) : "v"(p1[15]));
    { auto rr = __builtin_amdgcn_permlane32_swap(__float_as_uint(pmax), __float_as_uint(pmax), false, false);
      asm("v_max_f32 %0, %1, %2" : "=v"(pmax) : "v"(__uint_as_float(rr[0])), "v"(__uint_as_float(rr[1]))); }
    constexpr float C2 = 1.4426950408889634f * SCALE;
    if (__builtin_expect(__all(pmax <= mthr), 1)) { alpha = 1.f; }
    else { const float m_old = mnL * (-1.f / C2), mn = fmaxf(m_old, pmax); alpha = __builtin_amdgcn_exp2f((m_old - mn) * C2); mnL = -mn * C2; mthr = mn + THR / SCALE; }
    for (int r = 0; r < 16; ++r) p0[r] = fmaf(p0[r], C2, mnL); for (int r = 0; r < 16; ++r) p1[r] = fmaf(p1[r], C2, mnL);
    for (int r = 0; r < 16; ++r) p0[r] = __builtin_amdgcn_exp2f(p0[r]);
}
__device__ __forceinline__ void finishSM(f32x16& p0, f32x16& p1, float alpha, float& l_reg, bf16x8& pa0, bf16x8& pa1, bf16x8& pa2, bf16x8& pa3) {
    for (int r = 0; r < 16; ++r) p1[r] = __builtin_amdgcn_exp2f(p1[r]);
    float ps = 0; for (int r = 0; r < 16; ++r) ps += p0[r]; for (int r = 0; r < 16; ++r) ps += p1[r];
    { auto rr = __builtin_amdgcn_permlane32_swap(__float_as_uint(ps), __float_as_uint(ps), false, false);
      ps = __uint_as_float(rr[0]) + __uint_as_float(rr[1]); }
    l_reg = l_reg * alpha + ps;
#define PK4(P, B_, OUT) do { unsigned a0 = cvtpk(P[B_+0], P[B_+1]), a1 = cvtpk(P[B_+2], P[B_+3]);                          \
        unsigned b0 = cvtpk(P[B_+4], P[B_+5]), b1 = cvtpk(P[B_+6], P[B_+7]);                                             \
        auto r0 = __builtin_amdgcn_permlane32_swap(a0, b0, false, false); auto r1 = __builtin_amdgcn_permlane32_swap(a1, b1, false, false); \
        u32x4 w = {r0[0], r1[0], r0[1], r1[1]}; OUT = *reinterpret_cast<bf16x8*>(&w); } while (0)
    PK4(p0, 0, pa0); PK4(p0, 8, pa1); PK4(p1, 0, pa2); PK4(p1, 8, pa3);
#undef PK4
}
template <int KB>
__device__ __forceinline__ void qkt(f32x16& p0, f32x16& p1, const char* K_lds, int r32, int hi, const bf16x8* qr) {
    p0 = f32x16{}; p1 = f32x16{};
    const char* kb[4];
#pragma unroll
    for (int dd = 0; dd < 4; ++dd) kb[dd] = K_lds + KB * SHM_K + KSWZ(r32, (dd * 16 + hi * 8) * 2);
#pragma unroll
    for (int d0 = 0; d0 < 8; ++d0) { const char* a = kb[d0 & 3] + (d0 >> 2) * 128;
        bf16x8 b0 = *reinterpret_cast<const bf16x8*>(a);
        bf16x8 b1 = *reinterpret_cast<const bf16x8*>(a + 32 * 256);
        p0 = __builtin_amdgcn_mfma_f32_32x32x16_bf16(b0, qr[d0], p0, 0, 0, 0);
        p1 = __builtin_amdgcn_mfma_f32_32x32x16_bf16(b1, qr[d0], p1, 0, 0, 0); }
}
template <int VB>
__device__ __forceinline__ void pv_tile(f32x16* o, int vb0, bf16x8 pa0, bf16x8 pa1, bf16x8 pa2, bf16x8 pa3) {
#define TRRD(dst, off) asm volatile("ds_read_b64_tr_b16 %0, %1 offset:%2" : "=&v"(dst) : "v"(vb0), "i"(off) : "memory")
#define PV_D0(d0) do { s16x4 l0, l1, l2, l3, h0, h1, h2, h3; constexpr int b_ = VB * SHM_V + v_rd_off(d0, 0, 0); \
        TRRD(l0, b_); TRRD(h0, b_ + 2048); TRRD(l1, b_ + 4096); TRRD(h1, b_ + 6144); TRRD(l2, b_ + 8192); TRRD(h2, b_ + 10240); TRRD(l3, b_ + 12288); TRRD(h3, b_ + 14336); \
        asm volatile("s_waitcnt lgkmcnt(0)" ::: "memory"); SBAR();   \
        o[d0] = __builtin_amdgcn_mfma_f32_32x32x16_bf16(pa0, (bf16x8){l0[0], l0[1], l0[2], l0[3], h0[0], h0[1], h0[2], h0[3]}, o[d0], 0, 0, 0);   \
        o[d0] = __builtin_amdgcn_mfma_f32_32x32x16_bf16(pa1, (bf16x8){l1[0], l1[1], l1[2], l1[3], h1[0], h1[1], h1[2], h1[3]}, o[d0], 0, 0, 0);   \
        o[d0] = __builtin_amdgcn_mfma_f32_32x32x16_bf16(pa2, (bf16x8){l2[0], l2[1], l2[2], l2[3], h2[0], h2[1], h2[2], h2[3]}, o[d0], 0, 0, 0);   \
        o[d0] = __builtin_amdgcn_mfma_f32_32x32x16_bf16(pa3, (bf16x8){l3[0], l3[1], l3[2], l3[3], h3[0], h3[1], h3[2], h3[3]}, o[d0], 0, 0, 0); } while (0)
    PV_D0(0); PV_D0(1); PV_D0(2); PV_D0(3);
#undef PV_D0
#undef TRRD
}

template <class TIn> struct BlockRef { const TIn* Q; const TIn* K; const TIn* V; const TIn* Kt; const TIn* Vt; bf16_t* O; int P0, nt, nrows, pad; };
template <class TIn> struct Seam {
    bf16x8 qr[8];
    bf16x8 st_v0, st_v1, st_k0, st_k1; f32x4 sf0, sf1, sf2, sf3;
    f32x4 tq[16];
};
template <bool SMP, class TIn> __device__ __forceinline__ const TIn* kvrow(const TIn* p, const TIn* pt, int k0, int rr, int sc) {
    if (SMP && k0 >= PAST) return pt + (unsigned)((rr < DSEQ ? rr : DSEQ - 1) * KS + sc);
    return p + (unsigned)((k0 + rr) * KS + sc);
}
#define VMW() asm volatile("s_waitcnt vmcnt(0)" ::: "memory")
#define VMWN(n) asm volatile("s_waitcnt vmcnt(%0)" :: "i"(n) : "memory")
#define SLOAD_H(R_, k0) do { S.st_v0 = load8<TIn>(kvrow<SMP, TIn>((R_).V, (R_).Vt, k0, sr, sc)); S.st_v1 = load8<TIn>(kvrow<SMP, TIn>((R_).V, (R_).Vt, k0, 32 + sr, sc));              \
                             S.st_k0 = load8<TIn>(kvrow<SMP, TIn>((R_).K, (R_).Kt, k0, sr, sc)); S.st_k1 = load8<TIn>(kvrow<SMP, TIn>((R_).K, (R_).Kt, k0, 32 + sr, sc)); } while (0)
#define SWRITE_HK(bf) do { *(bf16x8*)(K_lds + (bf) * SHM_K + kws) = S.st_k0; *(bf16x8*)(K_lds + (bf) * SHM_K + kws + 32 * 256) = S.st_k1; } while (0)
#define SWRITE_HV(bf) do { *(bf16x8*)(V_lds + (bf) * SHM_V + vst0) = S.st_v0; *(bf16x8*)(V_lds + (bf) * SHM_V + vst1) = S.st_v1; } while (0)
#define SWRITE_H(bf) do { SWRITE_HV(bf); SWRITE_HK(bf); } while (0)
#define SLOAD_F(p, pt, k0) do { const float* a_ = (const float*)kvrow<SMP, TIn>(p, pt, k0, sr, sc); const float* b_ = (const float*)kvrow<SMP, TIn>(p, pt, k0, 32 + sr, sc); \
                            S.sf0 = *(const f32x4*)a_; S.sf1 = *(const f32x4*)(a_ + 4); S.sf2 = *(const f32x4*)b_; S.sf3 = *(const f32x4*)(b_ + 4); } while (0)
#define SWRITE_KF(bf) do { *(bf16x8*)(K_lds + (bf) * SHM_K + kws) = pack8(S.sf0, S.sf1); *(bf16x8*)(K_lds + (bf) * SHM_K + kws + 32 * 256) = pack8(S.sf2, S.sf3); } while (0)
#define SWRITE_VF(bf) do { *(bf16x8*)(V_lds + (bf) * SHM_V + vst0) = pack8(S.sf0, S.sf1); *(bf16x8*)(V_lds + (bf) * SHM_V + vst1) = pack8(S.sf2, S.sf3); } while (0)
template <bool SMP, class TIn>
__device__ __forceinline__ void attn_prime(const BlockRef<TIn>& cur, char* lds, Seam<TIn>& S) {
    constexpr bool F32 = same_t<TIn, float>::v;
    const int tid = threadIdx.x, wid = __builtin_amdgcn_readfirstlane(tid >> 6), lane = tid & 63, r32 = lane & 31, hi = lane >> 5;
    const int sr = tid >> 4, sc = (tid & 15) * 8, kws = KSWZ(sr, sc * 2); char* K_lds = lds + 2 * SHM_V;
    for (int d0 = 0; d0 < 8; ++d0) S.qr[d0] = load8<TIn>(cur.Q + (unsigned)((wid * QBLK + r32) * QS + d0 * 16 + hi * 8));
    if constexpr (F32) { SLOAD_F(cur.K, cur.Kt, 0); VMW(); SWRITE_KF(0); SBAR(); SLOAD_F(cur.V, cur.Vt, 0); }
    else { SLOAD_H(cur, 0); VMW(); SWRITE_HK(0); }
    __syncthreads();
}
template <bool SMP, class TIn>
__device__ __forceinline__ void attn_block(const BlockRef<TIn>& cur, const BlockRef<TIn>& nxt, char* lds, Seam<TIn>& S) {
    constexpr bool F32 = same_t<TIn, float>::v;
    const int tid = threadIdx.x, wid = __builtin_amdgcn_readfirstlane(tid >> 6), lane = tid & 63, r32 = lane & 31, hi = lane >> 5;
    const int NT = cur.nt;
    const int qlo = cur.P0 + wid * QBLK;
    char* V_lds = lds; char* K_lds = lds + 2 * SHM_V;
    float* ws = (float*)(lds + 2 * SHM_V + 2 * SHM_K) + wid * 64; float* li_l = ws, * al_l = ws + 32;
    float m_reg = -1e30f, l_reg = 0; f32x16 o[4] = {};
    const int sr = tid >> 4, sc = (tid & 15) * 8, vst0 = v_st(sr, sc), vst1 = v_st(32 + sr, sc), kws = KSWZ(sr, sc * 2);
    const int vb0 = (int)(uintptr_t)V_lds + v_rd_base(lane);
#define RESC(a) do { if (__any((a) < 1.f)) { if (hi == 0) al_l[r32] = (a); asm volatile("s_waitcnt lgkmcnt(0)" ::: "memory");              \
                     for (int d_ = 0; d_ < 4; ++d_) for (int r = 0; r < 16; ++r) o[d_][r] *= al_l[crow(r, hi)]; } } while (0)
#define KBASE(t) ((t) * KVBLK)
#define MASKT(P0_, P1_, t) do { const float NEG_ = -__builtin_inff(); \
        if constexpr (SMP) { if ((t) == NT - 1) { _Pragma("unroll") for (int r_ = 0; r_ < 16; ++r_) P1_[r_] = NEG_; } } \
        else { if (KBASE(t) > (qlo & ~63)) { _Pragma("unroll") for (int r_ = 0; r_ < 16; ++r_) { P0_[r_] = NEG_; P1_[r_] = NEG_; } } } } while (0)
    constexpr int NQL = F32 ? 16 : 8;
#define SEAM_K0() do { VMWN(NQL); if constexpr (F32) { SWRITE_KF(0); SBAR(); SLOAD_F(nxt.V, nxt.Vt, 0); } else { SWRITE_HK(0); } SBAR(); } while (0)
    f32x16 pA0, pA1, pB0, pB1; float mnA, mnB, alA, alB; bf16x8 pa0, pa1, pa2, pa3;
    if constexpr (F32) { VMW(); SWRITE_VF(0); SBAR(); } else { SWRITE_HV(0); SBAR(); }
    if (NT > 1) { if constexpr (F32) SLOAD_F(cur.K, cur.Kt, KBASE(1)); else SLOAD_H(cur, KBASE(1)); }
    SBAR(); qkt<0>(pA0, pA1, K_lds, r32, hi, S.qr);
    if constexpr (F32) { if (NT > 1) { VMW(); SWRITE_KF(1); SBAR(); SLOAD_F(cur.V, cur.Vt, KBASE(1)); } }
    MASKT(pA0, pA1, 0); partialSM(pA0, pA1, m_reg, mnA, alA);
    if (NT > 1) { VMW(); if constexpr (F32) { SWRITE_VF(1); SBAR(); if (NT > 2) SLOAD_F(cur.K, cur.Kt, KBASE(2)); } else SWRITE_H(1); }
    __syncthreads();
#define HALF_STEP(PX0, PX1, mnX, alX, PY0, PY1, alY, t, KB, VB, SB) do {                                                      \
        SBAR(); qkt<KB>(PX0, PX1, K_lds, r32, hi, S.qr);                                             \
        finishSM(PY0, PY1, alY, l_reg, pa0, pa1, pa2, pa3); SBAR();                                                           \
        if ((t) + 1 < NT) { if constexpr (F32) { VMW(); SWRITE_KF(SB); SBAR(); SLOAD_F(cur.V, cur.Vt, KBASE((t) + 1)); }  \
                            else { SLOAD_H(cur, KBASE((t) + 1)); } SBAR(); }                                               \
        pv_tile<VB>(o, vb0, pa0, pa1, pa2, pa3); MASKT(PX0, PX1, (t)); partialSM(PX0, PX1, m_reg, mnX, alX);                                        \
        __syncthreads();                                                                                                      \
        if ((t) + 1 < NT) { VMW(); if constexpr (F32) { SWRITE_VF(SB); SBAR(); if ((t) + 2 < NT) SLOAD_F(cur.K, cur.Kt, KBASE((t) + 2)); } \
                            else { SWRITE_H(SB); } }                                                                          \
        RESC(alX); __syncthreads(); } while (0)
    for (int t = 1; t + 1 < NT; t += 2) {
        HALF_STEP(pB0, pB1, mnB, alB, pA0, pA1, alA, t, 1, 0, 0);
        HALF_STEP(pA0, pA1, mnA, alA, pB0, pB1, alB, t + 1, 0, 1, 1);
    }
    const bool even = (NT & 1) == 0;
    if (even) { SBAR(); qkt<1>(pB0, pB1, K_lds, r32, hi, S.qr); SBAR(); }
#define QROW(e) (nxt.Q + (unsigned)((wid * QBLK + r32) * QS + ((e) >> 1) * 16 + hi * 8 + ((e) & 1) * 4))
    if constexpr (F32) { SLOAD_F(nxt.K, nxt.Kt, 0); SBAR();
#pragma unroll
        for (int e = 0; e < 8; ++e) S.tq[e] = *(const f32x4*)QROW(e); }
    else { SLOAD_H(nxt, 0); SBAR();
#pragma unroll
        for (int d0 = 0; d0 < 8; ++d0) S.qr[d0] = load8<TIn>(nxt.Q + (unsigned)((wid * QBLK + r32) * QS + d0 * 16 + hi * 8)); }
    SBAR();
    finishSM(pA0, pA1, alA, l_reg, pa0, pa1, pa2, pa3); SBAR();
    if constexpr (F32) {
#pragma unroll
        for (int e = 8; e < 16; ++e) S.tq[e] = *(const f32x4*)QROW(e); SBAR(); }
#undef QROW
    pv_tile<0>(o, vb0, pa0, pa1, pa2, pa3);
    if (even) { MASKT(pB0, pB1, NT - 1); partialSM(pB0, pB1, m_reg, mnB, alB); __syncthreads(); RESC(alB);
        finishSM(pB0, pB1, alB, l_reg, pa0, pa1, pa2, pa3); SBAR(); pv_tile<1>(o, vb0, pa0, pa1, pa2, pa3); }
    SBAR(); SEAM_K0();
    if (hi == 0) li_l[r32] = l_reg; asm volatile("s_waitcnt lgkmcnt(0)" ::: "memory");
    float rli[16];
#pragma unroll
    for (int r = 0; r < 16; ++r) rli[r] = __builtin_amdgcn_rcpf(li_l[crow(r, hi)]);
    bf16_t* Ow = cur.O;
    const bool st_ok = wid * QBLK < cur.nrows;
#pragma unroll
    for (int r = 0; r < 16; ++r) { const int orow = crow(r, hi);
#pragma unroll
        for (int d0 = 0; d0 < 4; ++d0) { const float v = o[d0][r] * rli[r];
            const float vn = __shfl_xor(v, 1);
            if (st_ok && (r32 & 1) == 0) *(unsigned*)(Ow + (unsigned)((wid * QBLK + orow) * OS + d0 * 32 + r32)) = cvtpk(v, vn); } }
    if constexpr (F32) {
#pragma unroll
        for (int d0 = 0; d0 < 8; ++d0) S.qr[d0] = pack8(S.tq[2 * d0], S.tq[2 * d0 + 1]); }
    __syncthreads();
#undef RESC
#undef KBASE
#undef MASKT
#undef SEAM_K0
#undef HALF_STEP
}
#undef VMW
#undef VMWN
#undef SLOAD_H
#undef SWRITE_HK
#undef SWRITE_HV
#undef SWRITE_H
#undef SLOAD_F
#undef SWRITE_KF
#undef SWRITE_VF
}

namespace datt {
using att::crow; using att::cvtpk; using att::partialSM; using att::finishSM;
constexpr int SHM_V = 64 * 256 * 2, SHM_K = 64 * 128 * 2, L_V = 0, L_K = 2 * SHM_V, L_WS = 2 * SHM_V + 2 * SHM_K;
constexpr int QS = DM, KS = DM, OS = 2 * DM;
__device__ __forceinline__ int v_st2(int k, int c) { const int kk = (k & ~0xC) | ((k & 4) << 1) | ((k & 8) >> 1); return ((kk >> 3) * 8 + (c >> 5)) * 512 + ((kk & 7) * 32 + (c & 31)) * 2; }
struct DRef { const bf16_t* Q; const bf16_t* K; const bf16_t* V; bf16_t* O; int P0, pad; };
struct DSeam { bf16x8 qr[8]; };
template <int KB>
__device__ __forceinline__ void qkt(f32x16& p0, f32x16& p1, const char* K_lds, int r32, int hi, const bf16x8* qr) {
    p0 = f32x16{}; p1 = f32x16{};
    const char* kb[4];
#pragma unroll
    for (int dd = 0; dd < 4; ++dd) kb[dd] = K_lds + KB * SHM_K + KSWZ(r32, (dd * 16 + hi * 8) * 2);
#define KRD(set, d0) do { const char* a_ = kb[(d0) & 3] + ((d0) >> 2) * 128; set[0] = *reinterpret_cast<const bf16x8*>(a_); set[1] = *reinterpret_cast<const bf16x8*>(a_ + 32 * 256); } while (0)
#define KMM(set, d0) do { p0 = __builtin_amdgcn_mfma_f32_32x32x16_bf16(set[0], qr[d0], p0, 0, 0, 0); p1 = __builtin_amdgcn_mfma_f32_32x32x16_bf16(set[1], qr[d0], p1, 0, 0, 0); } while (0)
    bf16x8 ka[2], kc[2];
    KRD(ka, 0); KRD(kc, 1); SBAR();
    KMM(ka, 0); SBAR(); KRD(ka, 2); SBAR();
    KMM(kc, 1); SBAR(); KRD(kc, 3); SBAR();
    KMM(ka, 2); SBAR(); KRD(ka, 4); SBAR();
    KMM(kc, 3); SBAR(); KRD(kc, 5); SBAR();
    KMM(ka, 4); SBAR(); KRD(ka, 6); SBAR();
    KMM(kc, 5); SBAR(); KRD(kc, 7); SBAR();
    KMM(ka, 6); SBAR();
    KMM(kc, 7); SBAR();
#undef KRD
#undef KMM
}
template <int VB>
__device__ __forceinline__ void pv_tile(f32x16* o, int vb0, bf16x8 pa0, bf16x8 pa1, bf16x8 pa2, bf16x8 pa3) {
#define TRRD(dst, off) asm volatile("ds_read_b64_tr_b16 %0, %1 offset:%2" : "=&v"(dst) : "v"(vb0), "i"(off) : "memory")
#define PV_RD(S_, d0) do { constexpr int b_ = VB * SHM_V + (d0) * 512; \
        TRRD(S_[0], b_); TRRD(S_[1], b_ + 4096); TRRD(S_[2], b_ + 8192); TRRD(S_[3], b_ + 12288); TRRD(S_[4], b_ + 16384); TRRD(S_[5], b_ + 20480); TRRD(S_[6], b_ + 24576); TRRD(S_[7], b_ + 28672); } while (0)
#define PV_MM(S_, d0) do { \
        o[d0] = __builtin_amdgcn_mfma_f32_32x32x16_bf16((bf16x8){S_[0][0], S_[0][1], S_[0][2], S_[0][3], S_[1][0], S_[1][1], S_[1][2], S_[1][3]}, pa0, o[d0], 0, 0, 0);   \
        o[d0] = __builtin_amdgcn_mfma_f32_32x32x16_bf16((bf16x8){S_[2][0], S_[2][1], S_[2][2], S_[2][3], S_[3][0], S_[3][1], S_[3][2], S_[3][3]}, pa1, o[d0], 0, 0, 0);   \
        o[d0] = __builtin_amdgcn_mfma_f32_32x32x16_bf16((bf16x8){S_[4][0], S_[4][1], S_[4][2], S_[4][3], S_[5][0], S_[5][1], S_[5][2], S_[5][3]}, pa2, o[d0], 0, 0, 0);   \
        o[d0] = __builtin_amdgcn_mfma_f32_32x32x16_bf16((bf16x8){S_[6][0], S_[6][1], S_[6][2], S_[6][3], S_[7][0], S_[7][1], S_[7][2], S_[7][3]}, pa3, o[d0], 0, 0, 0); } while (0)
#define PV_W8() do { asm volatile("s_waitcnt lgkmcnt(8)" ::: "memory"); SBAR(); } while (0)
#define PV_W0() do { asm volatile("s_waitcnt lgkmcnt(0)" ::: "memory"); SBAR(); } while (0)
    s16x4 sa[8], sb[8];
    PV_RD(sa, 0); PV_RD(sb, 1); PV_W8(); PV_MM(sa, 0); SBAR();
    PV_RD(sa, 2); PV_W8(); PV_MM(sb, 1); SBAR();
    PV_RD(sb, 3); PV_W8(); PV_MM(sa, 2); SBAR();
    PV_RD(sa, 4); PV_W8(); PV_MM(sb, 3); SBAR();
    PV_RD(sb, 5); PV_W8(); PV_MM(sa, 4); SBAR();
    PV_RD(sa, 6); PV_W8(); PV_MM(sb, 5); SBAR();
    PV_RD(sb, 7); PV_W8(); PV_MM(sa, 6); SBAR();
    PV_W0(); PV_MM(sb, 7); SBAR();
#undef PV_RD
#undef PV_MM
#undef PV_W8
#undef PV_W0
#undef TRRD
}
#define DVMW() asm volatile("s_waitcnt vmcnt(0)" ::: "memory")
#define DLOADQ(R_) do { _Pragma("unroll") for (int d0_ = 0; d0_ < 8; ++d0_) S.qr[d0_] = *(const bf16x8*)((R_).Q + (unsigned)((wid * 32 + r32) * QS + d0_ * 16 + hi * 8)); } while (0)
#define DDMA(R_, k0, bf) do { \
        const __amdgpu_buffer_rsrc_t rk_ = __builtin_amdgcn_make_buffer_rsrc((void*)(R_).K, 0, 0x7ffffff0, 0x00020000), rv_ = __builtin_amdgcn_make_buffer_rsrc((void*)(R_).V, 0, 0x7ffffff0, 0x00020000); \
        _Pragma("unroll") for (int j_ = 0; j_ < 2; ++j_) __builtin_amdgcn_raw_ptr_buffer_load_lds(rk_, (LAS unsigned*)(lds + L_K + (bf) * SHM_K + (8 * j_ + wid) * 1024), 16, (int)(offK * 2u), (int)(((k0) + 32 * j_) * KS * 2), 0, 0); \
        _Pragma("unroll") for (int j_ = 0; j_ < 4; ++j_) __builtin_amdgcn_raw_ptr_buffer_load_lds(rv_, (LAS unsigned*)(lds + L_V + (bf) * SHM_V + (8 * j_ + wid) * 1024), 16, (int)(offV * 2u), (int)(((k0) + 16 * j_) * KS * 2), 0, 0); } while (0)
__device__ __forceinline__ void dattn_prime(const DRef& cur, LAS char* lds, DSeam& S) {
    const int tid = threadIdx.x, wid = __builtin_amdgcn_readfirstlane(tid >> 6), lane = tid & 63, r32 = lane & 31, hi = lane >> 5;
    const int rowK = 4 * wid + (lane >> 4); const unsigned offK = (unsigned)(rowK * KS + (((lane & 15) ^ (rowK & 7)) * 8));
    const int sub = 2 * wid + (lane >> 5), kk = (sub >> 3) * 8 + ((lane & 31) >> 2), kv = (kk & ~0xC) | ((kk & 4) << 1) | ((kk & 8) >> 1); const unsigned offV = (unsigned)(kv * KS + (sub & 7) * 32 + (lane & 3) * 8);
    DLOADQ(cur); DDMA(cur, 0, 0); DVMW();
    __syncthreads();
}
__device__ __forceinline__ void dattn_block(const DRef& cur, const DRef& nxt, LAS char* lds, DSeam& S) {
    const int tid = threadIdx.x, wid = __builtin_amdgcn_readfirstlane(tid >> 6), lane = tid & 63, r32 = lane & 31, hi = lane >> 5;
    const int NT = (cur.P0 + 255) / 64 + 1;
    const int qlo = cur.P0 + wid * 32;
    const char* K_lds = (const char*)(lds + L_K);
    float* ws = (float*)(lds + L_WS) + wid * 64; float* li_l = ws, * al_l = ws + 32;
    float mnL_reg = 1e30f * (1.4426950408889634f * att::SCALE), mthr_reg = -1e30f, l_reg = 0; f32x16 o[8] = {};
    const int rowK = 4 * wid + (lane >> 4); const unsigned offK = (unsigned)(rowK * KS + (((lane & 15) ^ (rowK & 7)) * 8));
    const int sub = 2 * wid + (lane >> 5), kk = (sub >> 3) * 8 + ((lane & 31) >> 2), kv = (kk & ~0xC) | ((kk & 4) << 1) | ((kk & 8) >> 1); const unsigned offV = (unsigned)(kv * KS + (sub & 7) * 32 + (lane & 3) * 8);
    const int vb0 = (int)(uintptr_t)(lds + L_V) + att::v_rd_base(lane);
    f32x16 p0, p1; float mn, al; bf16x8 pa0, pa1, pa2, pa3;
    if (wid >= 4) __builtin_amdgcn_s_setprio(1);
#define DSTEP(t, B, NB) do { \
        if ((t) + 1 < NT) DDMA(cur, ((t) + 1) * 64, NB); else DDMA(nxt, 0, NB); \
        SBAR(); qkt<B>(p0, p1, K_lds, r32, hi, S.qr); SBAR(); \
        if ((t) + 1 == NT) DLOADQ(nxt); \
        if (__builtin_expect((t) * 64 > (qlo & ~63), 0)) { asm volatile("" ::: "memory"); const float NEG_ = -__builtin_inff(); _Pragma("unroll") for (int r_ = 0; r_ < 16; ++r_) { p0[r_] = NEG_; p1[r_] = NEG_; } asm volatile("" : "+v"(p0), "+v"(p1)); } \
        att::partialSM2(p0, p1, mnL_reg, mthr_reg, al); finishSM(p0, p1, al, l_reg, pa0, pa1, pa2, pa3); SBAR(); \
        if (__any(al < 1.f)) { \
            _Pragma("unroll") for (int d_ = 0; d_ < 8; ++d_) _Pragma("unroll") for (int r = 0; r < 16; ++r) o[d_][r] *= al; } \
        pv_tile<B>(o, vb0, pa0, pa1, pa2, pa3); SBAR(); \
        DVMW(); __syncthreads(); } while (0)
    for (int t = 0; t < NT; t += 2) { DSTEP(t, 0, 1); DSTEP(t + 1, 1, 0); }
#undef DSTEP
    __builtin_amdgcn_s_setprio(0);
    const float rl = __builtin_amdgcn_rcpf(l_reg);
    bf16_t* const obase = cur.O + (unsigned)((wid * 32 + r32) * OS + 8 * hi);
#pragma unroll
    for (int d0 = 0; d0 < 8; ++d0)
#pragma unroll
        for (int gp = 0; gp < 2; ++gp) {
            const unsigned a0 = cvtpk(o[d0][8 * gp + 0] * rl, o[d0][8 * gp + 1] * rl), a1 = cvtpk(o[d0][8 * gp + 2] * rl, o[d0][8 * gp + 3] * rl);
            const unsigned b0 = cvtpk(o[d0][8 * gp + 4] * rl, o[d0][8 * gp + 5] * rl), b1 = cvtpk(o[d0][8 * gp + 6] * rl, o[d0][8 * gp + 7] * rl);
            auto s0 = __builtin_amdgcn_permlane32_swap(a0, b0, false, false); auto s1 = __builtin_amdgcn_permlane32_swap(a1, b1, false, false);
            u32x4 w = {s0[0], s1[0], s0[1], s1[1]};
            *(u32x4*)(obase + d0 * 32 + 16 * gp) = w; }
}
#undef DVMW
#undef DLOADQ
#undef DDMA
}

struct Args { const float* in[38]; float* out; unsigned char* ws; int ph_lo, ph_hi; };
typedef const float* cfp_t;
typedef const __attribute__((address_space(4))) unsigned char* KP;
__device__ __forceinline__ KP kargs() { KP p = (KP)__builtin_amdgcn_kernarg_segment_ptr(); asm volatile("" : "+s"(p)); return p; }
struct Frame {
    LAS unsigned char* lds; KP kp;
    int tid, lane, wave, G, bid;
    __device__ __forceinline__ const float* in(int i) const { return *(const __attribute__((address_space(4))) cfp_t*)(kp + 8 * i); }
    __device__ __forceinline__ float* out() const { return *(float* const __attribute__((address_space(4)))*)(kp + 304); }
    __device__ __forceinline__ unsigned char* ws() const { return *(unsigned char* const __attribute__((address_space(4)))*)(kp + 312); }
};
static_assert(sizeof(Args) == 328, "Args layout");
enum { I_XP = 0, I_XS, I_SRE, I_SIM, I_SCONV, I_CK, I_CV, I_PP, I_PS, I_NMIX, I_ARE, I_AIM, I_LDT, I_BRE, I_BIM, I_CRE, I_CIM, I_SSMD, I_WGLU, I_NKV, I_WK, I_WV, I_WQ,
       I_LQ1, I_LK1, I_LQ2, I_LK2, I_NSUB, I_WO, I_NFFN, I_WUP, I_CONVW, I_CONVB, I_WDOWN, I_NPLE, I_WGATE, I_WPROJ, I_NFIN };

__device__ __forceinline__ void transpose_item(const float* W, int K, int N, bf16_t* WT, int row_off, const float* gain, int pairhalf, LAS float* scr, int item, int lane) {
    const int nblk = N / 32, kb = item / nblk, nb = item % nblk, k0 = 64 * kb, n0 = 32 * nb;
    int c0 = n0; if (pairhalf) c0 = ((n0 >> 7) & 1) * pairhalf + (n0 >> 8) * 128 + (n0 & 127);
#pragma unroll 8
    for (int i = 0; i < 32; ++i) { const int kk = 2 * i + (lane >> 5); float v = W[(size_t)(k0 + kk) * N + c0 + (lane & 31)]; if (gain) v *= gain[k0 + kk]; scr[kk * 33 + (lane & 31)] = v; }
    asm volatile("s_waitcnt lgkmcnt(0)" ::: "memory");
    const int c = lane & 7;
#pragma unroll
    for (int j = 0; j < 4; ++j) { const int n = (lane >> 3) + 8 * j; const LAS float* s = scr + (8 * c) * 33 + n;
        u32x4 o; o.x = cvt_pk_bf16(s[0 * 33], s[1 * 33]); o.y = cvt_pk_bf16(s[2 * 33], s[3 * 33]); o.z = cvt_pk_bf16(s[4 * 33], s[5 * 33]); o.w = cvt_pk_bf16(s[6 * 33], s[7 * 33]);
        *(u32x4*)(WT + (size_t)(row_off + n0 + n) * K + k0 + 8 * c) = o; }
    asm volatile("s_waitcnt lgkmcnt(0)" ::: "memory");
}

__device__ __forceinline__ void ssm_build_group(Frame& F, int g) {
    LAS f32x2* lbp = (LAS f32x2*)F.lds;
    LAS f32x2* Bb = lbp + 17 * 64;
    LAS f32x2* Cc = Bb + 64 * 16;
    LAS float* Kd = (LAS float*)(Cc + 16 * 64);
    LAS float* Dd = Kd + 4096;
    LAS f32x2* kt = (LAS f32x2*)(Dd + 16);
    const float* are = F.in(I_ARE) + g * 64; const float* aim = F.in(I_AIM) + g * 64;
    const int tid = F.tid;
    for (int i = tid; i < 17 * 64; i += NTHR) { const int d = i >> 6, p = i & 63; const double dt = exp((double)F.in(I_LDT)[g]); const double ar = are[p], ai = aim[p];
        const double mag = exp(ar * dt * d); double sn, cs; sincos(ai * dt * d, &sn, &cs); lbp[d * 64 + p] = (f32x2){(float)(mag * cs), (float)(mag * sn)}; }
    if (tid < 64) {
        const int p = tid; const double dt = exp((double)F.in(I_LDT)[g]); const double ar = are[p], ai = aim[p];
        const double mag = exp(ar * dt); double sn, cs; sincos(ai * dt, &sn, &cs); const double lr = mag * cs, li = mag * sn, den = ar * ar + ai * ai, nr = lr - 1.0;
        kt[p] = (f32x2){(float)((nr * ar + li * ai) / den), (float)((li * ar - nr * ai) / den)};
    }
    if (tid < 16) Dd[tid] = F.in(I_SSMD)[g * 16 + tid];
    __syncthreads();
    for (int i = tid; i < 1024; i += NTHR) { const int p = i >> 4, ch = i & 15; const float br = F.in(I_BRE)[((size_t)g * 64 + p) * 16 + ch], bi = F.in(I_BIM)[((size_t)g * 64 + p) * 16 + ch]; const f32x2 k = kt[p];
        Bb[i] = (f32x2){k.x * br - k.y * bi, k.x * bi + k.y * br};
        const int co = i >> 6, pp = i & 63; Cc[i] = (f32x2){F.in(I_CRE)[((size_t)g * 16 + co) * 64 + pp], F.in(I_CIM)[((size_t)g * 16 + co) * 64 + pp]}; }
    __syncthreads();
    for (int i = tid; i < 4096; i += NTHR) { const int d = i >> 8, co = (i >> 4) & 15, ch = i & 15; float s = 0.f;
        for (int p = 0; p < 64; ++p) { const f32x2 c = Cc[co * 64 + p], l = lbp[d * 64 + p], b = Bb[p * 16 + ch];
            const float wr = c.x * l.x - c.y * l.y, wi = c.x * l.y + c.y * l.x; s += wr * b.x - wi * b.y; }
        if (d == 0 && co == ch) s += Dd[co];
        Kd[i] = s; }
    __syncthreads();
    unsigned char* base = F.ws() + WS_SSM + (size_t)g * SSM_G_BYTES;
    for (int e = tid; e < 8 * 16 * 64; e += NTHR) { const int ln = e & 63, ks = (e >> 6) & 15, Mb = e >> 10; const int row = 32 * Mb + (ln & 31), t = row >> 4, co = row & 15, s = ks; float v[8];
#pragma unroll
        for (int j = 0; j < 8; ++j) { const int ch = 8 * (ln >> 5) + j; v[j] = (t >= s) ? Kd[((t - s) * 16 + co) * 16 + ch] : 0.f; }
        u32x4 o = {cvt_pk_bf16(v[0], v[1]), cvt_pk_bf16(v[2], v[3]), cvt_pk_bf16(v[4], v[5]), cvt_pk_bf16(v[6], v[7])}; *(u32x4*)(base + (size_t)e * 16) = o; }
    for (int e = tid; e < 4 * 16 * 64; e += NTHR) { const int ln = e & 63, ks = (e >> 6) & 15, Mb = e >> 10; const int hr = 32 * Mb + (ln & 31), c = hr >> 6, p = hr & 63, s = ks; float v[8]; const f32x2 l = lbp[(15 - s) * 64 + p];
#pragma unroll
        for (int j = 0; j < 8; ++j) { const f32x2 b = Bb[p * 16 + 8 * (ln >> 5) + j]; v[j] = c == 0 ? (l.x * b.x - l.y * b.y) : (l.x * b.y + l.y * b.x); }
        u32x4 o = {cvt_pk_bf16(v[0], v[1]), cvt_pk_bf16(v[2], v[3]), cvt_pk_bf16(v[4], v[5]), cvt_pk_bf16(v[6], v[7])}; *(u32x4*)(base + 131072 + (size_t)e * 16) = o; }
    for (int e = tid; e < 8 * 8 * 64; e += NTHR) { const int ln = e & 63, ks = (e >> 6) & 7, Mb = e >> 9; const int row = 32 * Mb + (ln & 31), t = row >> 4, co = row & 15; float v[8];
#pragma unroll
        for (int j = 0; j < 8; ++j) { const int hr = 16 * ks + 8 * (ln >> 5) + j, c = hr >> 6, p = hr & 63; const f32x2 cc = Cc[co * 64 + p], l = lbp[(t + 1) * 64 + p];
            v[j] = c == 0 ? (cc.x * l.x - cc.y * l.y) : -(cc.x * l.y + cc.y * l.x); }
        u32x4 o = {cvt_pk_bf16(v[0], v[1]), cvt_pk_bf16(v[2], v[3]), cvt_pk_bf16(v[4], v[5]), cvt_pk_bf16(v[6], v[7])}; *(u32x4*)(base + 196608 + (size_t)e * 16) = o; }
    if (tid < 64) ((f32x2*)(F.ws() + WS_L16))[g * 64 + tid] = lbp[16 * 64 + tid];
    __syncthreads();
}

__device__ __forceinline__ void rms_row_to_bf16(const float* xrow, const float* g, bf16_t* orow, int lane) {
    const f32x4* xr = (const f32x4*)xrow + lane; f32x4 v[8]; float s = 0.f;
#pragma unroll
    for (int j = 0; j < 8; ++j) { v[j] = xr[64 * j]; s += (v[j][0] * v[j][0] + v[j][1] * v[j][1]) + (v[j][2] * v[j][2] + v[j][3] * v[j][3]); }
    const float rstd = rsqrtf(wave_sum(s) * (1.f / DM) + EPS);
    u32x2* o8 = (u32x2*)orow + lane;
#pragma unroll
    for (int j = 0; j < 8; ++j) { const f32x4 gg = ((const f32x4*)g)[lane + 64 * j]; const f32x4 y = v[j] * rstd * gg; u32x2 w; w.x = cvt_pk_bf16(y[0], y[1]); w.y = cvt_pk_bf16(y[2], y[3]); o8[64 * j] = w; }
}
__device__ __forceinline__ void convert_p(Frame& F, int layer) {
    const float* pp = F.in(I_PP) + (size_t)layer * MP * PLE; const float* ps = F.in(I_PS) + (size_t)layer * MS * PLE; bf16_t* pb = (bf16_t*)(F.ws() + WS_PB);
    const size_t n8 = (size_t)MT * PLE / 8;
    for (size_t i = (size_t)F.bid * NTHR + F.tid; i < n8; i += (size_t)F.G * NTHR) { const size_t e = i * 8; const float* src = e < (size_t)MP * PLE ? pp + e : ps + (e - (size_t)MP * PLE);
        const f32x4 a = *(const f32x4*)src, b = *(const f32x4*)(src + 4); u32x4 w = {cvt_pk_bf16(a[0], a[1]), cvt_pk_bf16(a[2], a[3]), cvt_pk_bf16(b[0], b[1]), cvt_pk_bf16(b[2], b[3])}; *(u32x4*)(pb + e) = w; }
}
__device__ __forceinline__ int bg_slot(Frame& F, int word) {
    const int lane = __builtin_amdgcn_mbcnt_hi(~0u, __builtin_amdgcn_mbcnt_lo(~0u, 0u));
    unsigned tk = 0u; if (lane == 0) tk = __hip_atomic_fetch_add((LAS unsigned*)(F.lds + LDS_BYTES - 256) + 16 + word, 1u, __ATOMIC_RELAXED, __HIP_MEMORY_SCOPE_WORKGROUP);
    return __builtin_amdgcn_readfirstlane((int)tk) & 7;
}
template <int LIST> __device__ __forceinline__ void bg_work(Frame& F, int busy, int slot) {
    const int rem = busy < F.G ? busy : 0; int nb = F.G, bi = F.bid;
    if (rem != 0) { if (F.bid < rem) return; nb = F.G - rem; bi = F.bid - rem; }
    const int lane = __builtin_amdgcn_mbcnt_hi(~0u, __builtin_amdgcn_mbcnt_lo(~0u, 0u));
    LAS float* scr = (LAS float*)(F.lds + slot * 16384);
    const int gw = bi * NWAVES + slot, NGW = nb * NWAVES;
    constexpr int I_UP = 32 * 352, I_DN = 88 * 64, I_GT = 32 * 64, I_PJ = 4 * 64, I_SQ = 32 * 64;
    if constexpr (LIST == 0 || LIST == 3) { constexpr int l = LIST == 0 ? 0 : 1;
        for (int it = gw; it < I_UP; it += NGW) transpose_item(F.in(I_WUP) + (size_t)l * DM * DFF2, DM, DFF2, (bf16_t*)(F.ws() + WS_WUP) + (size_t)l * DFF2 * DM, 0, F.in(I_NFFN) + l * DM, DFF, scr, it, lane);
    } else if constexpr (LIST == 1 || LIST == 4) { constexpr int l = LIST == 1 ? 0 : 1;
        for (int it = gw; it < I_DN + I_GT + I_PJ; it += NGW) { int r = it;
            if (r < I_DN) { transpose_item(F.in(I_WDOWN) + (size_t)l * DFF * DM, DFF, DM, (bf16_t*)(F.ws() + WS_WDOWN) + (size_t)l * DM * DFF, 0, nullptr, 0, scr, r, lane); continue; } r -= I_DN;
            if (r < I_GT) { transpose_item(F.in(I_WGATE) + (size_t)l * DM * DM, DM, DM, (bf16_t*)(F.ws() + WS_WGATE) + (size_t)l * DM * DM, 0, F.in(I_NPLE) + l * DM, 0, scr, r, lane); continue; } r -= I_GT;
            transpose_item(F.in(I_WPROJ) + (size_t)l * PLE * DM, PLE, DM, (bf16_t*)(F.ws() + WS_WPROJ) + (size_t)l * DM * PLE, 0, nullptr, 0, scr, r, lane); }
    } else {
        for (int it = gw; it < 4 * I_SQ; it += NGW) { int r = it;
            if (r < I_SQ) { transpose_item(F.in(I_WQ), DM, DM, (bf16_t*)(F.ws() + WS_WQKV), 0, F.in(I_NMIX) + DM, 0, scr, r, lane); continue; } r -= I_SQ;
            if (r < I_SQ) { transpose_item(F.in(I_WK), DM, DM, (bf16_t*)(F.ws() + WS_WQKV), DM, F.in(I_NKV), 0, scr, r, lane); continue; } r -= I_SQ;
            if (r < I_SQ) { transpose_item(F.in(I_WV), DM, DM, (bf16_t*)(F.ws() + WS_WQKV), 2 * DM, F.in(I_NKV), 0, scr, r, lane); continue; } r -= I_SQ;
            transpose_item(F.in(I_WO), DM, DM, (bf16_t*)(F.ws() + WS_WO), 0, nullptr, 0, scr, r, lane); }
    }
}
__device__ __forceinline__ void p0_prologue(Frame& F) {
    for (int g = F.bid; g < NG; g += F.G) ssm_build_group(F, g);
    __syncthreads();
    LAS float* scr = (LAS float*)(F.lds + F.wave * 16384);
    const int gw = F.bid * NWAVES + F.wave, NGW = F.G * NWAVES;
    for (int it = gw; it < 32 * 128; it += NGW) transpose_item(F.in(I_WGLU), DM, 2 * DM, (bf16_t*)(F.ws() + WS_WGLU), 0, nullptr, DM, scr, it, F.lane);
    { float* rope = (float*)(F.ws() + WS_ROPE);
      for (int i = F.bid * NTHR + F.tid; i < SEQ * 16; i += F.G * NTHR) { const int pos = i >> 4, k = i & 15; const double inv = exp(-(double)k * (13.122363377404328 / 16.0)); double sn, cs; sincos((double)pos * inv, &sn, &cs);
          rope[(size_t)pos * 32 + k] = (float)cs; rope[(size_t)pos * 32 + 16 + k] = (float)sn; } }
    { float* cp_ = (float*)(F.ws() + WS_CONVP);
      for (int i = F.bid * NTHR + F.tid; i < 2 * DFF; i += F.G * NTHR) { const int l = i / DFF, c = i % DFF; const float* cw = F.in(I_CONVW) + (size_t)l * 3 * DFF2; const float* cb = F.in(I_CONVB) + (size_t)l * DFF2;
          float* r = cp_ + (size_t)(i & ~1) * 8 + (c & 1);
          r[0] = cw[c]; r[2] = cw[DFF2 + c]; r[4] = cw[2 * DFF2 + c]; r[6] = cb[c]; r[8] = cw[DFF + c]; r[10] = cw[DFF2 + DFF + c]; r[12] = cw[2 * DFF2 + DFF + c]; r[14] = cb[DFF + c]; } }
    convert_p(F, 0);
    bf16_t* ub = (bf16_t*)(F.ws() + WS_UB);
    for (int m = gw; m < MT; m += NGW) rms_row_to_bf16(m < MP ? F.in(I_XP) + (size_t)m * DM : F.in(I_XS) + (size_t)(m - MP) * DM, F.in(I_NMIX), ub + (size_t)m * DM, F.lane);
}

__device__ __forceinline__ void ssm_phase(Frame& F, bf16_t* dstb) {
    constexpr int L_G = 0, L_U = 65536, L_S0 = 98304, L_S1 = 116736, L_XB = 135168;
    const int tid = F.tid, wave = F.wave, lane = F.lane, n = lane & 31, hi = lane >> 5;
    bf16_t* ub = (bf16_t*)(F.ws() + WS_UB);
    const int sn_ = tid & 31, ss_ = tid >> 5;
    for (int item = F.bid; item < NBAT * NG + NG; item += F.G) {
        const bool smp = item >= NBAT * NG;
        const int g = smp ? item - NBAT * NG : item % NG, b = smp ? 0 : item / NG;
        const int nsteps = smp ? 1 : SEQ / 512; const int row0 = smp ? MP : b * SEQ;
        const unsigned char* mats = F.ws() + WS_SSM + (size_t)g * SSM_G_BYTES;
        __syncthreads();
        for (int i = tid; i < 4096; i += NTHR) *(LAS u32x4*)(F.lds + L_G + i * 16) = *(const u32x4*)(mats + 196608 + (size_t)i * 16);
        bf16x8 Kf[16], Hf[8];
#pragma unroll
        for (int ks = 0; ks < 16; ++ks) Kf[ks] = *(const bf16x8*)(mats + ((size_t)(wave * 16 + ks) * 64 + lane) * 16);
#pragma unroll
        for (int i = 0; i < 8; ++i) Hf[i] = *(const bf16x8*)(mats + 131072 + ((size_t)((wave & 3) * 16 + (wave >> 2) * 8 + i) * 64 + lane) * 16);
        f32x2 lam = {0.f, 0.f}, X = {0.f, 0.f};
        if (wave == 0) lam = ((const f32x2*)(F.ws() + WS_L16))[g * 64 + lane];
        { const bf16_t* src = ub + (size_t)(row0 + 16 * sn_ + ss_) * DM + 16 * g; const u32x4 a = *(const u32x4*)src, c = *(const u32x4*)(src + 8);
          LAS unsigned char* d = F.lds + L_U + ss_ * 1024 + sn_ * 32; *(LAS u32x4*)d = a; *(LAS u32x4*)(d + 16) = c; }
        __syncthreads();
        for (int step = 0; step < nsteps; ++step) {
            const int rowb = row0 + step * 512;
            LAS unsigned char* Ucur = F.lds + L_U + (step & 1) * 16384;
            u32x4 na = {0u, 0u, 0u, 0u}, nc = na;
            if (step + 1 < nsteps) { const bf16_t* src = ub + (size_t)(rowb + 512 + 16 * sn_ + ss_) * DM + 16 * g; na = *(const u32x4*)src; nc = *(const u32x4*)(src + 8); }
            { f32x16 sa = {};
#pragma unroll
              for (int i = 0; i < 8; ++i) { const bf16x8 uf = *(const LAS bf16x8*)(Ucur + ((wave >> 2) * 8 + i) * 1024 + n * 32 + hi * 16); sa = __builtin_amdgcn_mfma_f32_32x32x16_bf16(Hf[i], uf, sa, 0, 0, 0); }
              LAS float* Sp = (LAS float*)(F.lds + ((wave >> 2) ? L_S1 : L_S0));
#pragma unroll
              for (int r = 0; r < 16; ++r) Sp[(32 * (wave & 3) + att::crow(r, hi)) * 36 + n] = sa[r]; }
            __syncthreads();
            if (step > 0) { const LAS unsigned char* ysrc = F.lds + L_U + ((step - 1) & 1) * 16384 + ss_ * 1024 + sn_ * 32; const u32x4 ya0 = *(const LAS u32x4*)ysrc, ya1 = *(const LAS u32x4*)(ysrc + 16);
                bf16_t* dst = dstb + (size_t)(rowb - 512 + 16 * sn_ + ss_) * DM + 16 * g; *(u32x4*)dst = ya0; *(u32x4*)(dst + 8) = ya1; }
            if (wave == 0) {
                const LAS float* S0 = (const LAS float*)(F.lds + L_S0); const LAS float* S1 = (const LAS float*)(F.lds + L_S1);
                LAS bf16_t* Xb = (LAS bf16_t*)(F.lds + L_XB);
#pragma unroll 1
                for (int cg = 0; cg < 4; ++cg) {
                    f32x4 re[2], im[2];
#pragma unroll
                    for (int i = 0; i < 2; ++i) { re[i] = *(const LAS f32x4*)(S0 + lane * 36 + 8 * cg + 4 * i) + *(const LAS f32x4*)(S1 + lane * 36 + 8 * cg + 4 * i);
                                                  im[i] = *(const LAS f32x4*)(S0 + (64 + lane) * 36 + 8 * cg + 4 * i) + *(const LAS f32x4*)(S1 + (64 + lane) * 36 + 8 * cg + 4 * i); }
#pragma unroll
                    for (int k = 0; k < 8; ++k) { const int c = 8 * cg + k;
                        if (smp && !(c & 1)) { const size_t si = ((size_t)(c >> 1) * NG + g) * 64 + lane; X = (f32x2){F.in(I_SRE)[si], F.in(I_SIM)[si]}; }
                        Xb[c * 136 + lane] = (bf16_t)(cvt_pk_bf16(X.x, 0.f) & 0xffffu); Xb[c * 136 + 64 + lane] = (bf16_t)(cvt_pk_bf16(X.y, 0.f) & 0xffffu);
                        const float sr = re[k >> 2][k & 3], si2 = im[k >> 2][k & 3];
                        const float nx = lam.x * X.x - lam.y * X.y + sr, ny = lam.x * X.y + lam.y * X.x + si2; X = (f32x2){nx, ny};
                        if (smp && (c & 1)) { const size_t so = ((size_t)(c >> 1) * NG + g) * 64 + lane; F.out()[O_SRE_S + so] = X.x; F.out()[O_SIM_S + so] = X.y; } }
                }
            }
            f32x16 ya = {};
#pragma unroll
            for (int ks = 0; ks < 16; ++ks) if (ks <= 2 * wave + 1) { const bf16x8 uf = *(const LAS bf16x8*)(Ucur + ks * 1024 + n * 32 + hi * 16); ya = __builtin_amdgcn_mfma_f32_32x32x16_bf16(Kf[ks], uf, ya, 0, 0, 0); }
            if (step + 1 < nsteps) { LAS unsigned char* d = F.lds + L_U + ((step + 1) & 1) * 16384 + ss_ * 1024 + sn_ * 32; *(LAS u32x4*)d = na; *(LAS u32x4*)(d + 16) = nc; }
            __syncthreads();
#pragma unroll
            for (int i = 0; i < 8; ++i) { const bf16x8 gf = *(const LAS bf16x8*)(F.lds + L_G + ((wave * 8 + i) * 64 + lane) * 16); const bf16x8 xf = *(const LAS bf16x8*)(F.lds + L_XB + n * 272 + (16 * i + 8 * hi) * 2);
                ya = __builtin_amdgcn_mfma_f32_32x32x16_bf16(gf, xf, ya, 0, 0, 0); }
#pragma unroll
            for (int q = 0; q < 4; ++q) { const int tl = q >> 1, co = 8 * (q & 1) + 4 * hi;
                u32x2 w; w.x = cvt_pk_bf16(gelu_tanh(ya[4 * q]), gelu_tanh(ya[4 * q + 1])); w.y = cvt_pk_bf16(gelu_tanh(ya[4 * q + 2]), gelu_tanh(ya[4 * q + 3]));
                *(LAS u32x2*)(Ucur + (2 * wave + tl) * 1024 + n * 32 + co * 2) = w; }
        }
        __syncthreads();
        { const int ls = nsteps - 1; const LAS unsigned char* ysrc = F.lds + L_U + (ls & 1) * 16384 + ss_ * 1024 + sn_ * 32; const u32x4 ya0 = *(const LAS u32x4*)ysrc, ya1 = *(const LAS u32x4*)(ysrc + 16);
          bf16_t* dst = dstb + (size_t)(row0 + ls * 512 + 16 * sn_ + ss_) * DM + 16 * g; *(u32x4*)dst = ya0; *(u32x4*)(dst + 8) = ya1; }
        if (!smp && wave == 0) { const size_t so = ((size_t)b * NG + g) * 64 + lane; F.out()[O_SRE_P + so] = X.x; F.out()[O_SIM_P + so] = X.y; }
    }
}

__device__ __forceinline__ void fixup_phase(Frame& F, int layer) {
    const float* zs = (const float*)(F.ws() + WS_ZSIDE); bf16_t* act = (bf16_t*)(F.ws() + WS_BIG);
    const float* cw = F.in(I_CONVW) + (size_t)layer * 3 * DFF2; const float* cb = F.in(I_CONVB) + (size_t)layer * DFF2;
    constexpr int NC4 = DFF / 4;
    for (int i = F.bid * NTHR + F.tid; i < 256 * NC4; i += F.G * NTHR) {
        const int ht = i / NC4, c0 = (i % NC4) * 4; if ((ht & 127) == 0) continue;
        const float* zp = zs + (size_t)(ht - 1) * 4 * DFF2; const float* zc = zs + (size_t)ht * 4 * DFF2;
        f32x4 o0, o1;
        f32x4 cv0, cv1, cg0, cg1;
        { const f32x4 L0 = *(const f32x4*)(zp + 2 * DFF2 + c0), L1 = *(const f32x4*)(zp + 3 * DFF2 + c0), f0 = *(const f32x4*)(zc + c0), f1 = *(const f32x4*)(zc + DFF2 + c0);
          const f32x4 w0 = *(const f32x4*)(cw + c0), w1 = *(const f32x4*)(cw + DFF2 + c0), w2 = *(const f32x4*)(cw + 2 * DFF2 + c0), bb = *(const f32x4*)(cb + c0);
          cv0 = bb + w2 * f0 + w1 * L1 + w0 * L0; cv1 = bb + w2 * f1 + w1 * f0 + w0 * L1; }
        { const int c1 = DFF + c0; const f32x4 L0 = *(const f32x4*)(zp + 2 * DFF2 + c1), L1 = *(const f32x4*)(zp + 3 * DFF2 + c1), f0 = *(const f32x4*)(zc + c1), f1 = *(const f32x4*)(zc + DFF2 + c1);
          const f32x4 w0 = *(const f32x4*)(cw + c1), w1 = *(const f32x4*)(cw + DFF2 + c1), w2 = *(const f32x4*)(cw + 2 * DFF2 + c1), bb = *(const f32x4*)(cb + c1);
          cg0 = bb + w2 * f0 + w1 * L1 + w0 * L0; cg1 = bb + w2 * f1 + w1 * f0 + w0 * L1; }
#pragma unroll
        for (int j = 0; j < 4; ++j) { o0[j] = cv0[j] * cg0[j] * fsigmoid(cg0[j]); o1[j] = cv1[j] * cg1[j] * fsigmoid(cg1[j]); }
        u32x2 w; w.x = cvt_pk_bf16(o0[0], o0[1]); w.y = cvt_pk_bf16(o0[2], o0[3]); *(u32x2*)(act + (size_t)(128 * ht) * DFF + c0) = w;
        w.x = cvt_pk_bf16(o1[0], o1[1]); w.y = cvt_pk_bf16(o1[2], o1[3]); *(u32x2*)(act + (size_t)(128 * ht + 1) * DFF + c0) = w;
    }
}

__device__ __forceinline__ att::BlockRef<bf16_t> attn_ref_p(Frame& F, int L, int pass) {
    const int bh = L >> 5, x = L & 31, qb = pass ? 63 - x : x, b = bh >> 5, vhp = bh & 31, vh = vhp >> 1, vhalf = vhp & 1;
    att::BlockRef<bf16_t> r; const size_t row0 = (size_t)b * SEQ;
    r.Q = (const bf16_t*)(F.ws() + WS_UB) + (row0 + (size_t)qb * 256) * DM + vh * 128;
    r.K = (const bf16_t*)(F.ws() + WS_KB) + row0 * DM + vh * 128; r.V = (const bf16_t*)(F.ws() + WS_VB) + row0 * DM + (vh >> 1) * 256 + vhalf * 128; r.Kt = r.K; r.Vt = r.V;
    r.O = (bf16_t*)(F.ws() + WS_BIG) + (row0 + (size_t)qb * 256) * (2 * DM) + vh * 256 + vhalf * 128;
    r.P0 = qb * 256; r.nt = (r.P0 + 255) / 64 + 1; r.nrows = 256; r.pad = 0; return r;
}
__device__ __forceinline__ att::BlockRef<float> attn_ref_s(Frame& F, int L) {
    const int b = L >> 5, vhp = L & 31, vh = vhp >> 1, vhalf = vhp & 1;
    att::BlockRef<float> r;
    r.Q = (const float*)(F.ws() + WS_QS) + (size_t)b * DSEQ * DM + vh * 128;
    r.K = F.in(I_CK) + (size_t)b * PAST * DM + vh * 128; r.V = F.in(I_CV) + (size_t)b * PAST * DM + (vh >> 1) * 256 + vhalf * 128;
    r.Kt = F.out() + O_K_S + (size_t)b * DSEQ * DM + vh * 128; r.Vt = F.out() + O_V_S + (size_t)b * DSEQ * DM + (vh >> 1) * 256 + vhalf * 128;
    r.O = (bf16_t*)(F.ws() + WS_BIG) + ((size_t)MP + (size_t)b * DSEQ) * (2 * DM) + vh * 256 + vhalf * 128;
    r.P0 = PAST; r.nt = PAST / 64 + 1; r.nrows = DSEQ; r.pad = 0; return r;
}
__device__ __forceinline__ datt::DRef dattn_ref(Frame& F, int L, int pass) {
    const int bh = L >> 5, x = L & 31, qb = pass ? 63 - x : x, b = bh >> 4, vh = bh & 15;
    datt::DRef r; const size_t row0 = (size_t)b * SEQ;
    r.Q = (const bf16_t*)(F.ws() + WS_UB) + (row0 + (size_t)qb * 256) * DM + vh * 128;
    r.K = (const bf16_t*)(F.ws() + WS_KB) + row0 * DM + vh * 128; r.V = (const bf16_t*)(F.ws() + WS_VB) + row0 * DM + (vh >> 1) * 256;
    r.O = (bf16_t*)(F.ws() + WS_BIG) + (row0 + (size_t)qb * 256) * (2 * DM) + vh * 256;
    r.P0 = qb * 256; r.pad = 0; return r;
}
__device__ __forceinline__ int attn_item(int bid, int i, int G) { return G == 256 ? ((8 * i + (bid & 7)) << 5) + (bid >> 3) : bid + i * G; }
__device__ __forceinline__ void attn_phase_prompt(Frame& F) {
    constexpr int total = NBAT * 16 * 32; const int G = F.G, bid = F.bid;
    const int nit = G == 256 ? total / 256 : (total - bid + G - 1) / G; if (nit <= 0) return;
    int it = 0, pass = 0; datt::DRef cur = dattn_ref(F, attn_item(bid, 0, G), 0); datt::DSeam S;
    datt::dattn_prime(cur, (LAS char*)F.lds, S);
    for (;;) {
        const bool more_pass = pass == 0, more_item = it + 1 < nit, last = !more_pass && !more_item;
        int passn = pass + 1, itn = it; if (!more_pass) { passn = 0; itn = more_item ? it + 1 : it; }
        const datt::DRef nxt = last ? cur : dattn_ref(F, attn_item(bid, itn, G), passn);
        datt::dattn_block(cur, nxt, (LAS char*)F.lds, S);
        if (last) break;
        cur = nxt; pass = passn; it = itn;
    }
    asm volatile("s_waitcnt vmcnt(0)" ::: "memory"); __syncthreads();
}
__device__ __forceinline__ int attn_item_s(int bid, int i, int G) { return G == 256 ? i * 256 + (((bid & 7) * 8 + (bid >> 5)) << 2) + ((bid >> 3) & 3) : bid + i * G; }
__device__ __forceinline__ void attn_phase_sample(Frame& F) {
    constexpr int total = DB * 32; const int G = F.G, bid = F.bid;
    const int nit = G == 256 ? total / 256 : (total - bid + G - 1) / G; if (nit <= 0) return;
    int it = 0; att::BlockRef<float> cur = attn_ref_s(F, attn_item_s(bid, 0, G)); att::Seam<float> S;
    att::attn_prime<true, float>(cur, (char*)F.lds, S);
    for (;;) {
        const bool last = it + 1 >= nit;
        const att::BlockRef<float> nxt = last ? cur : attn_ref_s(F, attn_item_s(bid, it + 1, G));
        att::attn_block<true, float>(cur, nxt, (char*)F.lds, S);
        if (last) break;
        cur = nxt; ++it;
    }
}

__device__ __forceinline__ void combine_phase(Frame& F) {
    const float l1 = wave_sum(F.in(I_LQ1)[F.lane] * F.in(I_LK1)[F.lane] + F.in(I_LQ1)[64 + F.lane] * F.in(I_LK1)[64 + F.lane]);
    const float l2 = wave_sum(F.in(I_LQ2)[F.lane] * F.in(I_LK2)[F.lane] + F.in(I_LQ2)[64 + F.lane] * F.in(I_LK2)[64 + F.lane]);
    const float lam_init = 0.8f - 0.6f * 0.7408182206817179f;
    const float lam = expf(l1) - expf(l2) + lam_init, post = 1.0f - lam_init;
    const bf16_t* O = (const bf16_t*)(F.ws() + WS_BIG); bf16_t* ab = (bf16_t*)(F.ws() + WS_HB);
    const int hh = F.lane >> 3, cb = (F.lane & 7) * 8;
    f32x4 gs[8];
#pragma unroll
    for (int i = 0; i < 8; ++i) gs[i] = *(const f32x4*)(F.in(I_NSUB) + (i >> 1) * 64 + cb + (i & 1) * 4);
    const int gw = F.bid * NWAVES + F.wave, NGW = F.G * NWAVES;
    for (int m = gw; m < MT; m += NGW) {
        const u32x4* p1 = (const u32x4*)(O + (size_t)m * (2 * DM) + hh * 512 + cb); const u32x4* p2 = (const u32x4*)(O + (size_t)m * (2 * DM) + hh * 512 + 256 + cb);
        u32x4 a[4], c[4];
#pragma unroll
        for (int i = 0; i < 4; ++i) { a[i] = p1[8 * i]; c[i] = p2[8 * i]; }
        float d[32]; float ss = 0.f;
#pragma unroll
        for (int i = 0; i < 4; ++i)
#pragma unroll
            for (int j = 0; j < 4; ++j) { const float x0 = __uint_as_float(a[i][j] << 16) - lam * __uint_as_float(c[i][j] << 16), x1 = __uint_as_float(a[i][j] & 0xffff0000u) - lam * __uint_as_float(c[i][j] & 0xffff0000u);
                d[8 * i + 2 * j] = x0; d[8 * i + 2 * j + 1] = x1; ss += x0 * x0 + x1 * x1; }
        ss += __shfl_xor(ss, 1); ss += __shfl_xor(ss, 2); ss += __shfl_xor(ss, 4);
        const float rstd = rsqrtf(ss * (1.f / VD) + SUBLN_EPS) * post;
        u32x4* op = (u32x4*)(ab + (size_t)m * DM + hh * 256 + cb);
#pragma unroll
        for (int i = 0; i < 4; ++i) { u32x4 w;
#pragma unroll
            for (int j = 0; j < 4; ++j) w[j] = cvt_pk_bf16(d[8 * i + 2 * j] * rstd * gs[2 * i + (j >> 1)][2 * (j & 1)], d[8 * i + 2 * j + 1] * rstd * gs[2 * i + (j >> 1)][2 * (j & 1) + 1]);
            op[8 * i] = w; }
    }
}

__device__ __forceinline__ void final_phase(Frame& F, const float* part, float* dst) {
    const int gw = F.bid * NWAVES + F.wave, NGW = F.G * NWAVES; const float* g = F.in(I_NFIN); const bf16_t* hb = (const bf16_t*)(F.ws() + WS_HB);
    f32x4 gg[4][2];
#pragma unroll
    for (int j = 0; j < 4; ++j) { gg[j][0] = ((const f32x4*)g)[128 * j + 2 * F.lane]; gg[j][1] = ((const f32x4*)g)[128 * j + 2 * F.lane + 1]; }
    for (int m = gw; m < MT; m += NGW) {
        const float pv = F.lane < 32 ? part[part_idx(m >> 7, F.lane, m & 15) + ((m >> 4) & 7)] : 0.f;
        const float rstd = rsqrtf(wave_sum(pv) * (1.f / DM) + EPS);
        const u32x4* row = (const u32x4*)(hb + (size_t)m * DM) + F.lane; f32x4* orow = (f32x4*)(dst + (size_t)m * DM) + 2 * F.lane;
#pragma unroll
        for (int j = 0; j < 4; ++j) { const u32x4 w = row[64 * j];
            const f32x4 a = {__uint_as_float(w[0] << 16), __uint_as_float(w[0] & 0xffff0000u), __uint_as_float(w[1] << 16), __uint_as_float(w[1] & 0xffff0000u)};
            const f32x4 b2 = {__uint_as_float(w[2] << 16), __uint_as_float(w[2] & 0xffff0000u), __uint_as_float(w[3] << 16), __uint_as_float(w[3] & 0xffff0000u)};
            orow[128 * j] = a * rstd * gg[j][0]; orow[128 * j + 1] = b2 * rstd * gg[j][1]; }
    }
}


__device__ __forceinline__ void probe_mfma(Frame& F, int nit) {
    unsigned sd = (unsigned)F.tid * 2654435761u + (unsigned)F.bid * 40503u + 12345u;
    bf16x8 a[2], b[2];
#pragma unroll
    for (int i = 0; i < 2; ++i) { u32x4 wa, wb;
#pragma unroll
        for (int j = 0; j < 4; ++j) { sd = sd * 1664525u + 1013904223u; wa[j] = (sd & 0xbfffbfffu) | 0x3c003c00u; sd = sd * 1664525u + 1013904223u; wb[j] = (sd & 0xbfffbfffu) | 0x3c003c00u; }
        a[i] = *reinterpret_cast<bf16x8*>(&wa); b[i] = *reinterpret_cast<bf16x8*>(&wb); }
    f32x16 c[4] = {};
    for (int it = 0; it < nit; ++it) {
#pragma unroll
        for (int k = 0; k < 4; ++k) { c[k] = __builtin_amdgcn_mfma_f32_32x32x16_bf16(a[k & 1], b[k >> 1], c[k], 0, 0, 0); }
#pragma unroll
        for (int k = 0; k < 4; ++k) { c[k] = __builtin_amdgcn_mfma_f32_32x32x16_bf16(a[(k + 1) & 1], b[k >> 1], c[k], 0, 0, 0); }
        asm volatile("" : "+v"(a[0]), "+v"(b[0]));
    }
    float s = 0.f;
#pragma unroll
    for (int k = 0; k < 4; ++k) for (int r = 0; r < 16; ++r) s += c[k][r];
    if (s == 1.2345e-30f) *(float*)(F.ws() + WS_CTL + 65536) = s;
}
constexpr int NPHASE = 16;
__device__ __forceinline__ Frame mkframe(LAS unsigned char* lds) {
    Frame F; F.lds = lds; F.kp = kargs();
    int t = threadIdx.x; asm volatile("" : "+v"(t));
    F.wave = __builtin_amdgcn_readfirstlane(t >> 6);
    int ln = __builtin_amdgcn_mbcnt_hi(~0u, __builtin_amdgcn_mbcnt_lo(~0u, 0u)); asm volatile("" : "+v"(ln));
    F.lane = ln; F.tid = F.wave * 64 + ln; F.G = gridDim.x; F.bid = blockIdx.x;
    return F;
}
__device__ __forceinline__ bool ph_in(const Frame& F, int k) { const int lo = *(const __attribute__((address_space(4))) int*)(F.kp + 320), hi = *(const __attribute__((address_space(4))) int*)(F.kp + 324); return lo <= k && k < hi; }
template <unsigned PMASK, int K> __device__ __forceinline__ bool phase_on(const Frame& F) { if constexpr (((PMASK >> K) & 1u) == 0u) return false; else return ph_in(F, K); }
template <unsigned PMASK, int K> __device__ __forceinline__ void seam(LAS unsigned char* lds) {
    if constexpr (K + 1 < NPHASE && ((PMASK >> K) & 1u) && ((PMASK >> (K + 1)) & 1u)) {
        Frame F = mkframe(lds);
        if (ph_in(F, K) && ph_in(F, K + 1)) { XcdBarrier bar; bar.bar = (unsigned*)(F.ws() + WS_CTL) + CW_BAR; bar.x = xb_xcc_id(); bar.st = (volatile LAS unsigned*)(lds + LDS_BYTES - 256) + 8; xcd_barrier(bar); }
    }
}
template <class Epi> __device__ __forceinline__ void gemm_both(LAS unsigned char* ring, const bf16_t* A, const bf16_t* Bt, int N, int K, const Epi& E, int G, int bid, int skip = 0) {
    if (skip > 0 && skip < G) { if (bid < skip) return; G -= skip; bid -= skip; }
    const int wid = __builtin_amdgcn_readfirstlane((int)threadIdx.x >> 6);
    asm volatile("" : "+s"(K));
    { pg8::Gemm g{A, Bt, MP, N, K}; pg8::StaticOrder S; S.init(MP, N, G, bid); pg8::gemm_phase<Epi, pg8::StaticOrder, false>(ring, g, S, E, wid); }
    { pg8::Gemm g{A, Bt, MT, N, K}; pg8::HalfOrder H; H.init(MP / 256, N, G, bid); pg8::gemm_phase<Epi, pg8::HalfOrder, true>(ring, g, H, E, wid); }
}
template <int LAYER, int STEP> __device__ __forceinline__ void ffn_phase(Frame& F) {
    LAS unsigned char* ring = F.lds;
    bf16_t* const hb = (bf16_t*)(F.ws() + (LAYER == 0 ? WS_HB : WS_PP)); bf16_t* const ppb = (bf16_t*)(F.ws() + (LAYER == 0 ? WS_PP : WS_HB));
    float* const pin = (float*)(F.ws() + (LAYER == 0 ? WS_PART0 : WS_PART1)); float* const pout = (float*)(F.ws() + (LAYER == 0 ? WS_PART1 : WS_PART0));
    if constexpr (STEP == 0) {
        const float* cw = (const float*)(F.ws() + WS_CONVP) + (size_t)LAYER * DFF * 8; const float* cb = nullptr; const float* st = F.in(I_SCONV) + (size_t)LAYER * DB * 2 * DFF2;
        float* cp = F.out() + O_CONV_P + (size_t)LAYER * NBAT * 2 * DFF2; float* cs = F.out() + O_CONV_S + (size_t)LAYER * DB * 2 * DFF2;
        constexpr int NP = LAYER == 0 ? 64 : 32;
        EpiUp<NP> E{pin, (bf16_t*)(F.ws() + WS_BIG), cw, cb, st, (float*)(F.ws() + WS_ZSIDE), cp, cs, F.lds, (LAYER == 0 ? 1 : 2) << 20};
        gemm_both(ring, hb, (const bf16_t*)(F.ws() + WS_WUP) + (size_t)LAYER * DFF2 * DM, DFF2, DM, E, F.G, F.bid);
        if constexpr (LAYER == 0) bg_work<1>(F, 4 * (DFF2 / 256), bg_slot(F, 1));
    } else if constexpr (STEP == 1) { fixup_phase(F, LAYER);
    } else if constexpr (STEP == 2) {
        EpiResid E{hb, pout};
        gemm_both(ring, (const bf16_t*)(F.ws() + WS_BIG), (const bf16_t*)(F.ws() + WS_WDOWN) + (size_t)LAYER * DM * DFF, DM, DFF, E, F.G, F.bid);
    } else if constexpr (STEP == 3) {
        EpiBf16 E{ppb, DM};
        gemm_both(ring, (const bf16_t*)(F.ws() + WS_PB), (const bf16_t*)(F.ws() + WS_WPROJ) + (size_t)LAYER * DM * PLE, DM, PLE, E, F.G, F.bid, 4 * (DM / 256));
    } else {
        if constexpr (LAYER == 0) convert_p(F, 1);
        EpiPle E{pout, hb, ppb, pin, F.lds, (LAYER == 0 ? 3 : 4) << 20};
        gemm_both(ring, hb, (const bf16_t*)(F.ws() + WS_WGATE) + (size_t)LAYER * DM * DM, DM, DM, E, F.G, F.bid);
        if constexpr (LAYER == 0) { const int sl = bg_slot(F, 3); bg_work<3>(F, 4 * (DM / 256), sl); bg_work<2>(F, 4 * (DM / 256), sl); }
    }
}
template <unsigned PMASK> __global__ void __launch_bounds__(NTHR, 2) yoco_fwd(Args args) {
    extern __shared__ __attribute__((aligned(16))) unsigned char lds_raw[];
    LAS unsigned char* const lds = (LAS unsigned char*)lds_raw;
    (void)args;
    { Frame F = mkframe(lds);
      volatile LAS unsigned* MISC = (volatile LAS unsigned*)(lds + LDS_BYTES - 256);
      if (F.tid < 64) MISC[F.tid] = 0u;
      __syncthreads();
      if (MK_N_LAUNCHES == 1) (void)xcd_barrier_post((unsigned*)(F.ws() + WS_CTL) + CW_BAR, MISC + 8); }
    if (PROBE_MFMA) { Frame F = mkframe(lds); if (phase_on<PMASK, 0>(F)) probe_mfma(F, PROBE_MFMA); }
#define PH(K, ...) { Frame F = mkframe(lds); if (phase_on<PMASK, K>(F)) { __VA_ARGS__ } } seam<PMASK, K>(lds);
    if (PROBE_P2) { Frame F = mkframe(lds); if (phase_on<PMASK, 0>(F)) { p0_prologue(F); __syncthreads(); } }
    PH(0, p0_prologue(F);)
    if (PROBE_SSM2) { Frame F = mkframe(lds); if (phase_on<PMASK, 1>(F)) { ssm_phase(F, (bf16_t*)(F.ws() + WS_PP)); __syncthreads(); } }
    PH(1, ssm_phase(F, (bf16_t*)(F.ws() + WS_UB));)
    PH(2, { EpiGlu E{F.in(I_XP), F.in(I_XS), (bf16_t*)(F.ws() + WS_HB), (float*)(F.ws() + WS_PART0)};
            gemm_both(F.lds, (const bf16_t*)(F.ws() + WS_UB), (const bf16_t*)(F.ws() + WS_WGLU), 2 * DM, DM, E, F.G, F.bid); bg_work<0>(F, 4 * (2 * DM / 256), bg_slot(F, 0)); })
    if (PROBE_UP2) { Frame F = mkframe(lds); if (phase_on<PMASK, 3>(F)) { ffn_phase<0, 0>(F); } }
    PH(3, (ffn_phase<0, 0>(F));)
    if (PROBE_FF2) { Frame F = mkframe(lds); if (phase_on<PMASK, 4>(F)) { ffn_phase<0, 1>(F); } }
    PH(4, (ffn_phase<0, 1>(F));)
    { Frame F = mkframe(lds); if (phase_on<PMASK, 5>(F)) { ffn_phase<0, 2>(F); } }
    PH(5, (ffn_phase<0, 3>(F));)
    PH(6, (ffn_phase<0, 4>(F));)
    PH(7, { EpiQkv E{(const float*)(F.ws() + WS_PART0), (const float*)(F.ws() + WS_ROPE), (bf16_t*)(F.ws() + WS_UB), (float*)(F.ws() + WS_QS), (bf16_t*)(F.ws() + WS_KB), (bf16_t*)(F.ws() + WS_VB), F.out(), F.lds, 5 << 20};
            gemm_both(F.lds, (const bf16_t*)(F.ws() + WS_PP), (const bf16_t*)(F.ws() + WS_WQKV), 3 * DM, DM, E, F.G, F.bid); bg_work<4>(F, 4 * (3 * DM / 256), bg_slot(F, 4)); })
    { Frame F = mkframe(lds); if (phase_on<PMASK, 8>(F)) { attn_phase_prompt(F); } }
    if (PROBE_ATT2) { Frame F = mkframe(lds); if (phase_on<PMASK, 8>(F)) { attn_phase_prompt(F); } }
    if (PROBE_S2) { Frame F = mkframe(lds); if (phase_on<PMASK, 8>(F)) { attn_phase_sample(F); } }
    PH(8, attn_phase_sample(F);)
    if (PROBE_S2) { Frame F = mkframe(lds); if (phase_on<PMASK, 9>(F)) { combine_phase(F); } }
    PH(9, combine_phase(F);)
    PH(10, { EpiResid E{(bf16_t*)(F.ws() + WS_PP), (float*)(F.ws() + WS_PART1)};
             gemm_both(F.lds, (const bf16_t*)(F.ws() + WS_HB), (const bf16_t*)(F.ws() + WS_WO), DM, DM, E, F.G, F.bid); })
    if (PROBE_UP2) { Frame F = mkframe(lds); if (phase_on<PMASK, 11>(F)) { ffn_phase<1, 0>(F); } }
    PH(11, (ffn_phase<1, 0>(F));)
    if (PROBE_FF2) { Frame F = mkframe(lds); if (phase_on<PMASK, 12>(F)) { ffn_phase<1, 1>(F); } }
    PH(12, (ffn_phase<1, 1>(F));)
    { Frame F = mkframe(lds); if (phase_on<PMASK, 13>(F)) { ffn_phase<1, 2>(F); } }
    PH(13, (ffn_phase<1, 3>(F));)
    PH(14, (ffn_phase<1, 4>(F));)
    if (PROBE_FF2) { Frame F = mkframe(lds); if (phase_on<PMASK, 15>(F)) { final_phase(F, (const float*)(F.ws() + WS_PART1), (float*)(F.ws() + WS_UB)); } }
    PH(15, final_phase(F, (const float*)(F.ws() + WS_PART1), F.out());)
#undef PH
}

#ifndef PHASE_MASK
#define PHASE_MASK 0xFFFFu
#endif
template <unsigned PMASK> static bool prep_kernel() {
    if (hipFuncSetAttribute((const void*)yoco_fwd<PMASK>, hipFuncAttributeMaxDynamicSharedMemorySize, LDS_BYTES) != hipSuccess) { fprintf(stderr, "kernel_launch: hipFuncSetAttribute failed\n"); return false; }
    return true;
}
template <int P> static void launch_phases(int grid, Args& a, hipStream_t stream) {
    if constexpr (P < NPHASE) {
        if ((PHASE_MASK >> P) & 1u) { a.ph_lo = P; a.ph_hi = P + 1; hipLaunchKernelGGL(yoco_fwd<(1u << P)>, dim3(grid), dim3(NTHR), LDS_BYTES, stream, a); }
        launch_phases<P + 1>(grid, a, stream);
    }
}
template <int P> static bool prep_phases() { if constexpr (P < NPHASE) { return prep_kernel<(1u << P)>() && prep_phases<P + 1>(); } else return true; }
extern "C" void kernel_launch(void* const* d_in, const int* in_sizes, int n_in, void* d_out, int out_size, void* d_ws, size_t ws_size, hipStream_t stream) {
    static int grid = 0;
    if (grid == 0) {
        if (n_in != 38 || out_size != (int)O_END || ws_size < WS_END) { fprintf(stderr, "kernel_launch: unexpected shapes (n_in %d, out %d, ws %zu)\n", n_in, out_size, ws_size); grid = -1; return; }
        int dev = 0, cus = 0;
        if (hipGetDevice(&dev) != hipSuccess || hipDeviceGetAttribute(&cus, hipDeviceAttributeMultiprocessorCount, dev) != hipSuccess) { grid = -1; return; }
        bool ok;
        if constexpr (MK_N_LAUNCHES == 1) ok = prep_kernel<0xFFFFu>(); else ok = prep_phases<0>();
        if (!ok) { grid = -1; return; }
        (void)hipGetLastError();
        grid = cus;
    }
    if (grid < 0) return;
    (void)hipMemsetAsync((char*)d_ws + WS_CTL, 0, CTL_ZERO_BYTES, stream);
    Args a{};
    for (int i = 0; i < 38; ++i) a.in[i] = (const float*)d_in[i];
    a.out = (float*)d_out; a.ws = (unsigned char*)d_ws;
    if constexpr (MK_N_LAUNCHES == 1) { a.ph_lo = 0; a.ph_hi = NPHASE; hipLaunchKernelGGL(yoco_fwd<0xFFFFu>, dim3(grid), dim3(NTHR), LDS_BYTES, stream, a); }
    else launch_phases<0>(grid, a, stream);
}
```

```cpp
#include <hip/hip_runtime.h>
#include <cstdio>
#include <cstdint>

#ifndef MK_N_LAUNCHES
#define MK_N_LAUNCHES 1
#endif

#ifndef PROBE_ATT2
#define PROBE_ATT2 0
#endif
#ifndef PROBE_UP2
#define PROBE_UP2 0
#endif
#ifndef PROBE_G2
#define PROBE_G2 0
#endif
#ifndef PROBE_SSM2
#define PROBE_SSM2 0
#endif
#ifndef PROBE_MFMA
#define PROBE_MFMA 0
#endif
#ifndef PROBE_FF2
#define PROBE_FF2 0
#endif
#ifndef PROBE_PO2
#define PROBE_PO2 0
#endif
#ifndef PROBE_DOWN2
#define PROBE_DOWN2 0
#endif
#ifndef PROBE_P2
#define PROBE_P2 0
#endif
#ifndef PROBE_S2
#define PROBE_S2 0
#endif
#define LAS __attribute__((address_space(3)))
typedef unsigned short bf16_t;
typedef short bf16x8 __attribute__((ext_vector_type(8)));
typedef short s16x4 __attribute__((ext_vector_type(4)));
typedef float f32x4 __attribute__((ext_vector_type(4)));
typedef float f32x2 __attribute__((ext_vector_type(2)));
typedef float f32x16 __attribute__((ext_vector_type(16)));
typedef unsigned u32x4 __attribute__((ext_vector_type(4)));
typedef unsigned u32x2 __attribute__((ext_vector_type(2)));

constexpr int DM = 2048, SEQ = 16384, NBAT = 2, MP = NBAT * SEQ, DB = 16, DSEQ = 32, MS = DB * DSEQ, MT = MP + MS;
constexpr int NTILE = MT / 256;
constexpr int DFF = 5632, DFF2 = 2 * DFF, PLE = 256, PAST = 2048;
constexpr int NG = 128, NST = 64, NH = 8, HD = 128, VD = 256;
constexpr float EPS = 1e-6f, SUBLN_EPS = 1e-5f;
constexpr int NWAVES = 8, NTHR = 512;

constexpr size_t O_Y = 0, O_YS = 67108864, O_SRE_P = 68157440, O_SIM_P = 68173824, O_CONV_P = 68190208, O_K_P = 68280320, O_V_P = 135389184,
                 O_SRE_S = 202498048, O_SIM_S = 202629120, O_CONV_S = 202760192, O_K_S = 203481088, O_V_S = 204529664, O_END = 205578240;

constexpr size_t MiB = 1u << 20;
constexpr size_t WS_CTL = 0, CTL_ZERO_BYTES = 1 * MiB;
constexpr size_t WS_WGLU = 1 * MiB;
constexpr size_t WS_WUP = 17 * MiB;
constexpr size_t WS_WDOWN = 105 * MiB;
constexpr size_t WS_WGATE = 149 * MiB;
constexpr size_t WS_WPROJ = 165 * MiB;
constexpr size_t WS_WQKV = 167 * MiB;
constexpr size_t WS_WO = 191 * MiB;
constexpr size_t WS_ROPE = 199 * MiB;
constexpr size_t WS_L16 = 202 * MiB;
constexpr size_t WS_CONVP = 202 * MiB + 131072;
constexpr size_t WS_QS = 203 * MiB;
constexpr size_t WS_PB = 209 * MiB;
constexpr size_t WS_PART0 = 226 * MiB, WS_PART1 = 235 * MiB;
constexpr size_t WS_HB = 244 * MiB;
constexpr size_t WS_UB = 374 * MiB;
constexpr size_t WS_PP = 504 * MiB;
constexpr size_t WS_BIG = 634 * MiB;
constexpr size_t WS_KB = 894 * MiB;
constexpr size_t WS_VB = 1022 * MiB;
constexpr size_t WS_END = 1150 * MiB;
constexpr size_t WS_SSM = WS_KB;
constexpr size_t SSM_G_BYTES = 262144;
constexpr size_t WS_ZSIDE = WS_VB;

constexpr int CW_BAR = 4096;

constexpr int RING_BYTES = 131072, LDSCTL_OFF = RING_BYTES, LDS_BYTES = 147456;

__device__ __forceinline__ unsigned cvt_pk_bf16(float lo, float hi) { unsigned r; asm volatile("v_cvt_pk_bf16_f32 %0, %1, %2" : "=v"(r) : "v"(lo), "v"(hi)); return r; }
__device__ __forceinline__ float bf2f(unsigned short b) { return __uint_as_float(((unsigned)b) << 16); }
__device__ __forceinline__ float fsigmoid(float x) { return __builtin_amdgcn_rcpf(1.f + __expf(-x)); }
__device__ __forceinline__ float gelu_tanh(float x) { const float t = 1.5957691216f * (x + 0.044715f * x * x * x); return x * fsigmoid(t); }
__device__ __forceinline__ float wave_sum(float v) {
#pragma unroll
    for (int o = 1; o < 64; o <<= 1) v += __shfl_xor(v, o);
    return v;
}
template <class T> __device__ __forceinline__ T* at32(T* base, unsigned elem) { return (T*)((char*)base + elem * (unsigned)sizeof(T)); }
template <class T> __device__ __forceinline__ const T* at32(const T* base, unsigned elem) { return (const T*)((const char*)base + elem * (unsigned)sizeof(T)); }
template <int CTRL> __device__ __forceinline__ float dppf(float v) { return __int_as_float(__builtin_amdgcn_mov_dpp(__float_as_int(v), CTRL, 0xf, 0xf, false)); }
#define DPP_ROR1 0x121
#define DPP_ROR2 0x122

namespace pg8 {
constexpr int BM = 256, BK = 64, HALF = 128, HTB = HALF * BK * 2, STAGE_BYTES = 8 * HTB, NXCD = 8, WGM = 4;
__host__ __device__ __forceinline__ int lds_byte(int r, int c) { const int st = (r >> 4) * 2 + (c >> 5), rr = r & 15, cc = c & 31, ob = rr * 64 + cc * 2; return st * 1024 + (ob ^ (((ob >> 9) & 1) << 5)); }
__host__ __device__ __forceinline__ void stage_rc(int b, int& R, int& C) { const int st = b / 1024, sb = b % 1024, swz = sb ^ (((sb >> 9) & 1) << 5); R = (st >> 1) * 16 + swz / 64; C = (st & 1) * 32 + (swz % 64) / 2; }
__host__ __device__ __forceinline__ int perm32(int rho) { const int n = rho >> 4, i = rho & 15; return 8 * (i >> 2) + 4 * n + (i & 3); }

struct Unit { int pm, pn, rb, aih; };
struct Gemm { const bf16_t* A; const bf16_t* Bt; int M, N, K; };

struct StaticOrder {
    int nM, nN, nwg, G, c;
    __host__ __device__ void init(int M, int N, int G_, int c_) { nM = M / BM; nN = N / BM; nwg = nM * nN; G = G_; c = c_; }
    __host__ __device__ bool next(int i, Unit& u) const {
        const long L = (long)i * G + c; if (L >= nwg) return false;
        int wgid = (int)L; { const int q = nwg / NXCD, r = nwg % NXCD, xcd = wgid % NXCD, off = wgid / NXCD; wgid = (xcd < r ? xcd * (q + 1) : r * (q + 1) + (xcd - r) * q) + off; }
        const int nig = WGM * nN, gid = wgid / nig, fm = gid * WGM, gsz = (nM - fm) < WGM ? (nM - fm) : WGM;
        u.pm = fm + ((wgid % nig) % gsz); u.pn = (wgid % nig) / gsz; u.rb = u.pm * BM; u.aih = 0; return true;
    }
    __device__ __forceinline__ void a_ready(const Unit&) const {}
    __device__ __forceinline__ void done(const Unit&) const {}
};
struct HalfOrder {
    int nN, nwg, G, c, pm0;
    __host__ __device__ void init(int pm0_, int N, int G_, int c_) { pm0 = pm0_; nN = N / BM; nwg = 4 * nN; G = G_; c = c_; }
    __host__ __device__ bool next(int i, Unit& u) const {
        const long L = (long)i * G + c; if (L >= nwg) return false;
        const int idx = (int)L, sub = idx & 3; u.pn = idx >> 2; u.pm = pm0 + (sub >> 1); u.aih = sub & 1; u.rb = u.pm * BM + 64 * u.aih; return true;
    }
    __device__ __forceinline__ void a_ready(const Unit&) const {}
    __device__ __forceinline__ void done(const Unit&) const {}
};

#ifndef PG8_SP2
#define PG8_SP2 true
#endif
#ifndef PG8_ALIGN
#define PG8_ALIGN true
#endif
template <class Epi, class Sched, bool HALFM = false, bool ALIGN_EPI = PG8_ALIGN, bool SP2 = PG8_SP2>
__device__ __forceinline__ void gemm_phase(LAS unsigned char* lds, const Gemm g, const Sched& S, const Epi& E, const int wid  ) {
    int lane_ = __builtin_amdgcn_mbcnt_hi(~0u, __builtin_amdgcn_mbcnt_lo(~0u, 0u)); asm volatile("" : "+v"(lane_));
    const int lane = lane_, tid = wid * 64 + lane, wr = wid >> 2, wc = wid & 3, fr = lane & 15, fq = lane >> 4;
    const int K = g.K, nt = K / BK;
    unsigned voffA[2], voffB[2];
#pragma unroll
    for (int i = 0; i < 2; ++i) { int R, C; stage_rc(tid * 16 + i * 8192, R, C); const int Rb = Epi::PERM ? ((R & ~31) + perm32(R & 31)) : R;
        const int Ra = (R >> 6) * 128 + (R & 63);
        voffA[i] = (unsigned)(Ra * K + C) * 2u; voffB[i] = (unsigned)(Rb * K + C) * 2u; }
    const __amdgpu_buffer_rsrc_t rsA_ = __builtin_amdgcn_make_buffer_rsrc((void*)g.A, 0, 0x7ffffff0, 0x00020000), rsB_ = __builtin_amdgcn_make_buffer_rsrc((void*)g.Bt, 0, 0x7ffffff0, 0x00020000);
    const size_t kstep = (size_t)(BK * 2);
    const size_t hstepB = (size_t)HALF * K * 2, hstepA = (size_t)64 * K * 2;
    const size_t tstep = (size_t)BM * K * 2;
    const unsigned ldsw = (unsigned)wid * 1024u;
    const int aoff = lds_byte(wr * 64 + fr, fq * 8), boff = lds_byte(wc * 32 + fr, fq * 8);
#define PG8_SA(b, h) (((b) * 2 + (h)) * HTB)
#define PG8_SB(b, h) ((4 + (b) * 2 + (h)) * HTB)
#define PG8_STAGE(bufoff, gbase, voff) do { const int so_ = (int)(unsigned)((const char*)(gbase) - PG8_BASE_##voff); _Pragma("unroll") for (int _i = 0; _i < 2; ++_i) \
        __builtin_amdgcn_raw_ptr_buffer_load_lds(PG8_RS_##voff, (LAS unsigned*)(lds + (bufoff) + ldsw + _i * 8192), 16, (int)(voff)[_i], so_, 0, 0); } while (0)
#define PG8_BASE_voffA ((const char*)g.A)
#define PG8_BASE_voffB ((const char*)g.Bt)
#define PG8_RS_voffA rsA_
#define PG8_RS_voffB rsB_
#define PG8_LDA(dst, b, h) do { _Pragma("unroll") for (int m = 0; m < 4; ++m) _Pragma("unroll") for (int k = 0; k < 2; ++k) dst[m][k] = *(const LAS bf16x8*)(lds + PG8_SA(b, h) + aoff + m * 2048 + k * 1024); } while (0)
#define PG8_LDB(dst, b, h) do { _Pragma("unroll") for (int n = 0; n < 2; ++n) _Pragma("unroll") for (int k = 0; k < 2; ++k) dst[n][k] = *(const LAS bf16x8*)(lds + PG8_SB(b, h) + boff + n * 2048 + k * 1024); } while (0)
#define PG8_MMA(ai, bj, At, Bt) do { __builtin_amdgcn_s_setprio(1); _Pragma("unroll") for (int m = 0; m < 4; ++m) _Pragma("unroll") for (int n = 0; n < 2; ++n) _Pragma("unroll") for (int k = 0; k < 2; ++k) \
        acc[ai][bj][m][n] = __builtin_amdgcn_mfma_f32_16x16x32_bf16(Bt[n][k], At[m][k], acc[ai][bj][m][n], 0, 0, 0); __builtin_amdgcn_s_setprio(0); } while (0)
#define PG8_WAIT_V(n) asm volatile("s_waitcnt vmcnt(" #n ")" ::: "memory")
#define PG8_WAIT_L(n) asm volatile("s_waitcnt lgkmcnt(" #n ")" ::: "memory")
#define PG8_BAR __builtin_amdgcn_s_barrier()
#define PG8_SCHED __builtin_amdgcn_sched_barrier(0)
    Unit cur, nxt; int ui = 0;
    if (!S.next(0, cur)) return;
    f32x4 acc[2][2][4][2];
#pragma unroll
    for (int a = 0; a < 2; ++a)
#pragma unroll
        for (int b = 0; b < 2; ++b)
#pragma unroll
            for (int m = 0; m < 4; ++m)
#pragma unroll
                for (int n = 0; n < 2; ++n) acc[a][b][m][n] = (f32x4){0.f, 0.f, 0.f, 0.f};
    bf16x8 At[4][2], B0[2][2], B1[2][2];
    static_assert(SP2 || !HALFM, "half-M units: SP2 loop only");
    const char* cA = (const char*)g.A + (size_t)cur.pm * tstep + (size_t)cur.aih * hstepA; const char* cB = (const char*)g.Bt + (size_t)cur.pn * tstep;
    S.a_ready(cur);
    if constexpr (SP2) {
        PG8_STAGE(PG8_SB(0, 0), cB, voffB); PG8_STAGE(PG8_SB(0, 1), cB + hstepB, voffB); PG8_STAGE(PG8_SA(0, 0), cA, voffA); if constexpr (!HALFM) PG8_STAGE(PG8_SA(0, 1), cA + hstepA, voffA);
        if (wr == 1) PG8_BAR;
        if constexpr (HALFM) PG8_WAIT_V(0); else PG8_WAIT_V(2);
        PG8_BAR;
        PG8_STAGE(PG8_SB(1, 0), cB + kstep, voffB); PG8_STAGE(PG8_SA(1, 0), cA + kstep, voffA); PG8_STAGE(PG8_SB(1, 1), cB + hstepB + kstep, voffB);
        PG8_WAIT_V(6); PG8_BAR;
    } else {
    PG8_STAGE(PG8_SB(0, 0), cB, voffB); PG8_STAGE(PG8_SA(0, 0), cA, voffA); PG8_STAGE(PG8_SB(0, 1), cB + hstepB, voffB); PG8_STAGE(PG8_SA(0, 1), cA + hstepA, voffA);
    if (wr == 1) PG8_BAR;
    PG8_WAIT_V(4); PG8_BAR;
    PG8_STAGE(PG8_SB(1, 0), cB + kstep, voffB); PG8_STAGE(PG8_SA(1, 0), cA + kstep, voffA); PG8_STAGE(PG8_SB(1, 1), cB + hstepB + kstep, voffB);
    PG8_WAIT_V(6); PG8_BAR;
    }
    for (;;) {
        const bool has_next = S.next(ui + 1, nxt);
        const char* nA = has_next ? (const char*)g.A + (size_t)nxt.pm * tstep + (size_t)nxt.aih * hstepA : cA; const char* nB = has_next ? (const char*)g.Bt + (size_t)nxt.pn * tstep : cB;
        for (int t = 0; t < nt; t += 2) {
            const bool last = (t == nt - 2);
            const char* a1 = cA + (size_t)(t + 1) * kstep;
            const char* a2 = last ? nA : cA + (size_t)(t + 2) * kstep; const char* b2 = last ? nB : cB + (size_t)(t + 2) * kstep;
            const char* a3 = a2 + kstep; const char* b3 = b2 + kstep;
            if (last && has_next) S.a_ready(nxt);
            if constexpr (SP2) {
#define PG8_WAIT_VH() do { if constexpr (HALFM) PG8_WAIT_V(6); else PG8_WAIT_V(8); } while (0)
            PG8_LDB(B0, 0, 0); PG8_LDB(B1, 0, 1); PG8_SCHED; PG8_LDA(At, 0, 0); if constexpr (!HALFM) PG8_STAGE(PG8_SA(1, 1), a1 + hstepA, voffA);
            PG8_WAIT_VH(); PG8_WAIT_L(0); PG8_BAR; PG8_MMA(0, 0, At, B0); PG8_MMA(0, 1, At, B1); PG8_BAR; PG8_SCHED;
            if constexpr (!HALFM) PG8_LDA(At, 0, 1); PG8_STAGE(PG8_SB(0, 0), b2, voffB); PG8_STAGE(PG8_SB(0, 1), b2 + hstepB, voffB); PG8_STAGE(PG8_SA(0, 0), a2, voffA);
            PG8_WAIT_VH(); PG8_WAIT_L(0); PG8_BAR; if constexpr (!HALFM) { PG8_MMA(1, 0, At, B0); PG8_MMA(1, 1, At, B1); } PG8_BAR; PG8_SCHED;
            PG8_LDB(B0, 1, 0); PG8_LDB(B1, 1, 1); PG8_SCHED; PG8_LDA(At, 1, 0); if constexpr (!HALFM) PG8_STAGE(PG8_SA(0, 1), a2 + hstepA, voffA);
            PG8_WAIT_VH(); PG8_WAIT_L(0); PG8_BAR; PG8_MMA(0, 0, At, B0); PG8_MMA(0, 1, At, B1); PG8_BAR; PG8_SCHED;
            if constexpr (!HALFM) PG8_LDA(At, 1, 1); PG8_STAGE(PG8_SB(1, 0), b3, voffB); PG8_STAGE(PG8_SB(1, 1), b3 + hstepB, voffB); PG8_STAGE(PG8_SA(1, 0), a3, voffA);
            PG8_WAIT_VH(); PG8_WAIT_L(0); PG8_BAR; if constexpr (!HALFM) { PG8_MMA(1, 0, At, B0); PG8_MMA(1, 1, At, B1); } PG8_BAR; PG8_SCHED;
#undef PG8_WAIT_VH
            } else {
            PG8_LDB(B0, 0, 0); PG8_SCHED; PG8_LDA(At, 0, 0); PG8_STAGE(PG8_SA(1, 1), a1 + hstepA, voffA);
            PG8_WAIT_L(8); PG8_BAR; PG8_WAIT_L(0); PG8_MMA(0, 0, At, B0); PG8_BAR; PG8_SCHED;
            PG8_LDB(B1, 0, 1); PG8_STAGE(PG8_SB(0, 0), b2, voffB);
            PG8_BAR; PG8_WAIT_L(0); PG8_MMA(0, 1, At, B1); PG8_BAR;
            PG8_LDA(At, 0, 1); PG8_STAGE(PG8_SA(0, 0), a2, voffA);
            PG8_BAR; PG8_WAIT_L(0); PG8_MMA(1, 0, At, B0); PG8_BAR; PG8_SCHED;
            PG8_STAGE(PG8_SB(0, 1), b2 + hstepB, voffB);
            PG8_WAIT_V(6); PG8_BAR; PG8_MMA(1, 1, At, B1); PG8_BAR;
            PG8_LDB(B0, 1, 0); PG8_SCHED; PG8_LDA(At, 1, 0); PG8_STAGE(PG8_SA(0, 1), a2 + hstepA, voffA);
            PG8_WAIT_L(8); PG8_BAR; PG8_WAIT_L(0); PG8_MMA(0, 0, At, B0); PG8_BAR; PG8_SCHED;
            PG8_LDB(B1, 1, 1); PG8_STAGE(PG8_SB(1, 0), b3, voffB);
            PG8_BAR; PG8_WAIT_L(0); PG8_MMA(0, 1, At, B1); PG8_BAR;
            PG8_LDA(At, 1, 1); PG8_STAGE(PG8_SA(1, 0), a3, voffA);
            PG8_BAR; PG8_WAIT_L(0); PG8_MMA(1, 0, At, B0); PG8_BAR; PG8_SCHED;
            PG8_STAGE(PG8_SB(1, 1), b3 + hstepB, voffB);
            PG8_WAIT_V(6); PG8_BAR; PG8_MMA(1, 1, At, B1); PG8_BAR;
            }
        }
        if constexpr (ALIGN_EPI) { if (wr == 0) PG8_BAR; }
        E.template run<HALFM ? 1 : 2>(acc, cur, wr, wc, fr, fq); S.done(cur);
        if (!has_next) break;
#pragma unroll
        for (int a = 0; a < 2; ++a)
#pragma unroll
            for (int b = 0; b < 2; ++b)
#pragma unroll
                for (int m = 0; m < 4; ++m)
#pragma unroll
                    for (int n = 0; n < 2; ++n) acc[a][b][m][n] = (f32x4){0.f, 0.f, 0.f, 0.f};
        cur = nxt; cA = nA; cB = nB; ++ui;
        if constexpr (ALIGN_EPI) { if (wr == 1) PG8_BAR; }
    }
    PG8_WAIT_V(0);
    if constexpr (!ALIGN_EPI) { if (wr == 0) PG8_BAR; }
    PG8_BAR;
#undef PG8_SA
#undef PG8_SB
#undef PG8_STAGE
#undef PG8_BASE_voffA
#undef PG8_BASE_voffB
#undef PG8_RS_voffA
#undef PG8_RS_voffB
#undef PG8_LDA
#undef PG8_LDB
#undef PG8_MMA
#undef PG8_WAIT_V
#undef PG8_WAIT_L
#undef PG8_BAR
#undef PG8_SCHED
}
}
using pg8::Unit;

typedef f32x4 Acc[2][2][4][2];

__device__ __forceinline__ unsigned part_idx(int ph, int slot, int fr) { return (unsigned)(((ph * 64 + slot) * 16 + fr) * 8); }
constexpr int RSTD_LDS = RING_BYTES;
template <int NP, int NAI> __device__ __forceinline__ void load_rstd(const float* part, int rowbase, int fr, int fq, float (&rs)[2][4], LAS unsigned char* lds, int wid, int key) {
    LAS float* rc = (LAS float*)(lds + RSTD_LDS) + wid * 128; LAS int* tagp = (LAS int*)(lds + LDS_BYTES - 256) + 32 + wid;
    const int want = key | rowbase;
    if (__builtin_amdgcn_readfirstlane(*tagp) == want) {
#pragma unroll
        for (int ai = 0; ai < NAI; ++ai)
#pragma unroll
            for (int m = 0; m < 4; ++m) rs[ai][m] = rc[64 * ai + 16 * m + fr];
        return;
    }
    { const int ph = rowbase >> 7, q0 = (rowbase >> 4) & 7;
      f32x4 sacc[2] = {{0.f, 0.f, 0.f, 0.f}, {0.f, 0.f, 0.f, 0.f}};
#pragma unroll
      for (int i = 0; i < NP / 4; ++i) { const unsigned o_ = part_idx(ph, fq * (NP / 4) + i, fr) + q0;
#pragma unroll
          for (int ai = 0; ai < NAI; ++ai) sacc[ai] += *(const f32x4*)at32(part, o_ + 4 * ai);
          if ((i & 3) == 3) asm volatile("" : "+v"(sacc[0]), "+v"(sacc[1]));     }
#pragma unroll
      for (int ai = 0; ai < NAI; ++ai)
#pragma unroll
        for (int m = 0; m < 4; ++m) { float sv = sacc[ai][m]; sv += __shfl_xor(sv, 16); sv += __shfl_xor(sv, 32);
            rs[ai][m] = rsqrtf(sv * (1.0f / DM) + EPS);
            if (NAI == 2 && fq == 0) rc[64 * ai + 16 * m + fr] = rs[ai][m]; } }
    if (NAI == 2) { if (fr == 0 && fq == 0) *tagp = want; }
    asm volatile("s_waitcnt lgkmcnt(0)" ::: "memory");
}

template <int NAI> __device__ __forceinline__ void store_part4(float* part, const Unit& u, int wr, int slot, int fr, int fq, int ai, const f32x4 v) {
    if (fq == 0) *(f32x4*)at32(part, part_idx(u.pm * 2 + wr, slot, fr) + 4u * (unsigned)(NAI == 1 ? u.aih : ai)) = v;
}
struct EpiGlu {
    static constexpr bool PERM = true;
    const float* xp; const float* xs; bf16_t* hb; float* part;
    template <int NAI> __device__ __forceinline__ void run(Acc& acc, const Unit& u, int wr, int wc, int fr, int fq) const {
        asm volatile("" : "+v"(fr), "+v"(fq));
        const int rowbase = u.rb + wr * 128 + fr, col0 = u.pn * 128 + wc * 32 + 8 * fq;
        const bool smp = u.pm >= MP / 256; const float* xb = smp ? xs : xp; const int rsub = smp ? MP : 0;
#pragma unroll
        for (int ai = 0; ai < NAI; ++ai) {
            f32x4 xv[4][2]; f32x4 ssv;
#pragma unroll
            for (int m = 0; m < 4; ++m)
#pragma unroll
                for (int n = 0; n < 2; ++n) xv[m][n] = *(const f32x4*)at32(xb, (unsigned)((rowbase + 64 * ai + 16 * m - rsub) * DM + col0 + 4 * n));
#pragma unroll
            for (int m = 0; m < 4; ++m) {
                const int r = rowbase + 64 * ai + 16 * m; float ss = 0.f; u32x4 w;
#pragma unroll
                for (int n = 0; n < 2; ++n) {
                    const f32x4 a = acc[ai][0][m][n], b = acc[ai][1][m][n]; f32x4 o;
#pragma unroll
                    for (int j = 0; j < 4; ++j) { o[j] = xv[m][n][j] + a[j] * fsigmoid(b[j]); ss += o[j] * o[j]; }
                    w[2 * n] = cvt_pk_bf16(o[0], o[1]); w[2 * n + 1] = cvt_pk_bf16(o[2], o[3]);
                }
                *(u32x4*)at32(hb, (unsigned)(r * DM + col0)) = w;
                ss += __shfl_xor(ss, 16); ss += __shfl_xor(ss, 32);
                ssv[m] = ss;
            }
            store_part4<NAI>(part, u, wr, u.pn * 4 + wc, fr, fq, ai, ssv);
        }
    }
};

struct EpiResid {
    static constexpr bool PERM = true;
    bf16_t* hb; float* part;
    template <int NAI> __device__ __forceinline__ void run(Acc& acc, const Unit& u, int wr, int wc, int fr, int fq) const {
        asm volatile("" : "+v"(fr), "+v"(fq));
        const int rowbase = u.rb + wr * 128 + fr, col0 = u.pn * 256 + wc * 32 + 8 * fq;
#pragma unroll
        for (int ai = 0; ai < NAI; ++ai) {
            u32x4 hv[4][2]; f32x4 ssv;
#pragma unroll
            for (int m = 0; m < 4; ++m)
#pragma unroll
                for (int bj = 0; bj < 2; ++bj) hv[m][bj] = *(const u32x4*)at32((const bf16_t*)hb, (unsigned)((rowbase + 64 * ai + 16 * m) * DM + col0 + 128 * bj));
#pragma unroll
            for (int m = 0; m < 4; ++m) {
                const int r = rowbase + 64 * ai + 16 * m; float ss = 0.f;
#pragma unroll
                for (int bj = 0; bj < 2; ++bj) { u32x4 w;
#pragma unroll
                    for (int n = 0; n < 2; ++n) {
                        const unsigned h0 = hv[m][bj][2 * n], h1 = hv[m][bj][2 * n + 1]; const f32x4 a = acc[ai][bj][m][n];
                        const f32x4 o = {__uint_as_float(h0 << 16) + a[0], __uint_as_float(h0 & 0xffff0000u) + a[1], __uint_as_float(h1 << 16) + a[2], __uint_as_float(h1 & 0xffff0000u) + a[3]};
                        ss += (o[0] * o[0] + o[1] * o[1]) + (o[2] * o[2] + o[3] * o[3]);
                        w[2 * n] = cvt_pk_bf16(o[0], o[1]); w[2 * n + 1] = cvt_pk_bf16(o[2], o[3]);
                    }
                    *(u32x4*)at32(hb, (unsigned)(r * DM + col0 + 128 * bj)) = w; }
                ss += __shfl_xor(ss, 16); ss += __shfl_xor(ss, 32);
                ssv[m] = ss;
            }
            store_part4<NAI>(part, u, wr, u.pn * 4 + wc, fr, fq, ai, ssv);
        }
    }
};

struct EpiBf16 {
    static constexpr bool PERM = true;
    bf16_t* O; int ldc;
    template <int NAI> __device__ __forceinline__ void run(Acc& acc, const Unit& u, int wr, int wc, int fr, int fq) const {
        asm volatile("" : "+v"(fr), "+v"(fq));
        const int rowbase = u.rb + wr * 128 + fr, col0 = u.pn * 256 + wc * 32 + 8 * fq;
#pragma unroll
        for (int ai = 0; ai < NAI; ++ai)
#pragma unroll
            for (int m = 0; m < 4; ++m) { const unsigned ro = (unsigned)((rowbase + 64 * ai + 16 * m) * ldc + col0);
#pragma unroll
                for (int bj = 0; bj < 2; ++bj) { const f32x4 v0 = acc[ai][bj][m][0], v1 = acc[ai][bj][m][1];
                    u32x4 w = {cvt_pk_bf16(v0[0], v0[1]), cvt_pk_bf16(v0[2], v0[3]), cvt_pk_bf16(v1[0], v1[1]), cvt_pk_bf16(v1[2], v1[3])}; *(u32x4*)at32(O, ro + (unsigned)(bj * 128)) = w; } }
    }
};

struct EpiPle {
    static constexpr bool PERM = true;
    const float* partin; const bf16_t* hsrc; bf16_t* ppio; float* part; LAS unsigned char* lds; int key;
    template <int NAI> __device__ __forceinline__ void run(Acc& acc, const Unit& u, int wr, int wc, int fr, int fq) const {
        asm volatile("" : "+v"(fr), "+v"(fq));
        const int rowbase = u.rb + wr * 128 + fr, col0 = u.pn * 256 + wc * 32 + 8 * fq;
        float rs[2][4]; load_rstd<32, NAI>(partin, u.rb + wr * 128, fr, fq, rs, lds, wr * 4 + wc, key); f32x4 ssv = {0.f, 0.f, 0.f, 0.f};
#pragma unroll
        for (int q2 = 0; q2 < 2 * NAI; ++q2) {
            const int ai = q2 >> 1, m0 = (q2 & 1) * 2;
            u32x4 hv[2][2], pv[2][2];
#pragma unroll
            for (int mm = 0; mm < 2; ++mm)
#pragma unroll
                for (int bj = 0; bj < 2; ++bj) { const unsigned o_ = (unsigned)((rowbase + 64 * ai + 16 * (m0 + mm)) * DM + col0 + 128 * bj);
                    hv[mm][bj] = *(const u32x4*)at32(hsrc, o_); pv[mm][bj] = *(const u32x4*)at32((const bf16_t*)ppio, o_); }
#pragma unroll
            for (int mm = 0; mm < 2; ++mm) {
                const int m = m0 + mm, r = rowbase + 64 * ai + 16 * m; float ss = 0.f;
#pragma unroll
                for (int bj = 0; bj < 2; ++bj) { u32x4 w;
#pragma unroll
                    for (int n = 0; n < 2; ++n) {
                        const unsigned pw0 = pv[mm][bj][2 * n], pw1 = pv[mm][bj][2 * n + 1], h0 = hv[mm][bj][2 * n], h1 = hv[mm][bj][2 * n + 1];
                        const f32x4 a = acc[ai][bj][m][n] * rs[ai][m]; f32x4 o;
                        o[0] = __uint_as_float(h0 << 16) + __uint_as_float(pw0 << 16) * fsigmoid(a[0]); o[1] = __uint_as_float(h0 & 0xffff0000u) + __uint_as_float(pw0 & 0xffff0000u) * fsigmoid(a[1]);
                        o[2] = __uint_as_float(h1 << 16) + __uint_as_float(pw1 << 16) * fsigmoid(a[2]); o[3] = __uint_as_float(h1 & 0xffff0000u) + __uint_as_float(pw1 & 0xffff0000u) * fsigmoid(a[3]);
                        ss += (o[0] * o[0] + o[1] * o[1]) + (o[2] * o[2] + o[3] * o[3]);
                        w[2 * n] = cvt_pk_bf16(o[0], o[1]); w[2 * n + 1] = cvt_pk_bf16(o[2], o[3]);
                    }
                    *(u32x4*)at32(ppio, (unsigned)(r * DM + col0 + 128 * bj)) = w; }
                ss += __shfl_xor(ss, 16); ss += __shfl_xor(ss, 32);
                ssv[m] = ss;
            }
            if (q2 & 1) store_part4<NAI>(part, u, wr, u.pn * 4 + wc, fr, fq, ai, ssv);
        }
    }
};

template <int NP> struct EpiUp {
    static constexpr bool PERM = true;
    const float* partin; bf16_t* act; const float* cw; const float* cb; const float* state; float* zside; float* conv_p; float* conv_s; LAS unsigned char* lds; int key;
    template <int NAI> __device__ __forceinline__ void run(Acc& acc, const Unit& u, int wr, int wc, int fr, int fq) const {
        asm volatile("" : "+v"(fr), "+v"(fq));
        const bool sample = u.pm >= MP / 256;
        const int rowhalf = u.rb + wr * 128;
        { float rs[2][4]; load_rstd<NP, NAI>(partin, rowhalf, fr, fq, rs, lds, wr * 4 + wc, key);
#pragma unroll
          for (int ai = 0; ai < NAI; ++ai)
#pragma unroll
            for (int bj = 0; bj < 2; ++bj)
#pragma unroll
                for (int m = 0; m < 4; ++m)
#pragma unroll
                    for (int n = 0; n < 2; ++n) acc[ai][bj][m][n] = acc[ai][bj][m][n] * rs[ai][m]; }
        const int ht = u.pm * 2 + wr;
        const bool seqstart = (!sample) && ((ht & 127) == 0);
        const bool seqend = (!sample) && ((ht & 127) == 127);
        const int sb2 = ((rowhalf - MP) >> 5) * 2;
        const int c8 = u.pn * 128 + wc * 32 + 8 * fq;
#pragma unroll
        for (int n = 0; n < 2; ++n) {
            const int c0 = c8 + 4 * n;
            if (NAI == 2 && !sample) {
                if (fr < 2) { const unsigned o = (unsigned)((ht * 4 + fr) * DFF2 + c0); *(f32x4*)at32(zside, o) = acc[0][0][0][n]; *(f32x4*)at32(zside, o + DFF) = acc[0][1][0][n]; }
                if (fr >= 14) { const unsigned o = (unsigned)((ht * 4 + 2 + (fr - 14)) * DFF2 + c0); *(f32x4*)at32(zside, o) = acc[NAI - 1][0][3][n]; *(f32x4*)at32(zside, o + DFF) = acc[NAI - 1][1][3][n];
                    if (seqend) { const unsigned o2 = (unsigned)(((ht >> 7) * 2 + (fr - 14)) * DFF2 + c0); *(f32x4*)at32(conv_p, o2) = acc[NAI - 1][0][3][n]; *(f32x4*)at32(conv_p, o2 + DFF) = acc[NAI - 1][1][3][n]; } }
            } else if (sample && fr >= 14) {
#pragma unroll
                for (int qq = 1; qq < 4 * NAI; qq += 2) { const unsigned o2 = (unsigned)((sb2 + (qq >> 1) * 2 + (fr - 14)) * DFF2 + c0);
                    *(f32x4*)at32(conv_s, o2) = acc[qq >> 2][0][qq & 3][n]; *(f32x4*)at32(conv_s, o2 + DFF) = acc[qq >> 2][1][qq & 3][n]; }
            }
        }
        unsigned outp[4 * NAI][4];
        f32x4 nr0 = *(const f32x4*)at32(cw, (unsigned)(c8 * 8)), nr1 = *(const f32x4*)at32(cw, (unsigned)(c8 * 8 + 4)), nr2 = *(const f32x4*)at32(cw, (unsigned)(c8 * 8 + 8)), nr3 = *(const f32x4*)at32(cw, (unsigned)(c8 * 8 + 12));
#pragma unroll
        for (int n = 0; n < 2; ++n)
#pragma unroll
            for (int jp = 0; jp < 2; ++jp) {
                const int c0 = c8 + 4 * n + 2 * jp;
                const f32x4 ra = nr0, rb_ = nr1, rc_ = nr2, rd_ = nr3;
                asm volatile("" ::: "memory");
                if (n * 2 + jp < 3) { const unsigned o = (unsigned)((c0 + 2) * 8); nr0 = *(const f32x4*)at32(cw, o); nr1 = *(const f32x4*)at32(cw, o + 4); nr2 = *(const f32x4*)at32(cw, o + 8); nr3 = *(const f32x4*)at32(cw, o + 12); }
                const f32x2 w0v = {ra[0], ra[1]}, w1v = {ra[2], ra[3]}, w2v = {rb_[0], rb_[1]}, bv = {rb_[2], rb_[3]};
                const f32x2 w0g = {rc_[0], rc_[1]}, w1g = {rc_[2], rc_[3]}, w2g = {rd_[0], rd_[1]}, bg = {rd_[2], rd_[3]};
                f32x2 p1v = {0.f, 0.f}, p2v = p1v, p1g = p1v, p2g = p1v;
#pragma unroll
                for (int q = 0; q < 4 * NAI; ++q) {
                    const int ai = q >> 2, m = q & 3;
                    const f32x2 zv = {acc[ai][0][m][n][2 * jp], acc[ai][0][m][n][2 * jp + 1]}, zg = {acc[ai][1][m][n][2 * jp], acc[ai][1][m][n][2 * jp + 1]};
                    if (sample && !(q & 1)) {
                        f32x2 hv = {0.f, 0.f}, hg = hv;
                        if (fr >= 14) { const unsigned so = (unsigned)((sb2 + (q >> 1) * 2 + (fr - 14)) * DFF2 + c0); hv = *(const f32x2*)at32(state, so); hg = *(const f32x2*)at32(state, so + DFF); }
#pragma unroll
                        for (int j = 0; j < 2; ++j) { p1v[j] = dppf<DPP_ROR1>(hv[j]); p2v[j] = dppf<DPP_ROR2>(hv[j]); p1g[j] = dppf<DPP_ROR1>(hg[j]); p2g[j] = dppf<DPP_ROR2>(hg[j]); }
                    }
                    f32x2 r1v, r2v, r1g, r2g, P1v, P2v, P1g, P2g;
#pragma unroll
                    for (int j = 0; j < 2; ++j) {
                        r1v[j] = dppf<DPP_ROR1>(zv[j]); r2v[j] = dppf<DPP_ROR2>(zv[j]); r1g[j] = dppf<DPP_ROR1>(zg[j]); r2g[j] = dppf<DPP_ROR2>(zg[j]);
                        P1v[j] = fr >= 1 ? r1v[j] : p1v[j]; P2v[j] = fr >= 2 ? r2v[j] : p2v[j]; P1g[j] = fr >= 1 ? r1g[j] : p1g[j]; P2g[j] = fr >= 2 ? r2g[j] : p2g[j];
                    }
                    const f32x2 cv = __builtin_elementwise_fma(w0v, P2v, __builtin_elementwise_fma(w1v, P1v, __builtin_elementwise_fma(w2v, zv, bv)));
                    const f32x2 cg = __builtin_elementwise_fma(w0g, P2g, __builtin_elementwise_fma(w1g, P1g, __builtin_elementwise_fma(w2g, zg, bg)));
                    const f32x2 tt = cg * (f32x2){-1.4426950408889634f, -1.4426950408889634f};
                    f32x2 ee = {__builtin_amdgcn_exp2f(tt[0]), __builtin_amdgcn_exp2f(tt[1])}; ee = ee + (f32x2){1.f, 1.f};
                    const f32x2 sg = {__builtin_amdgcn_rcpf(ee[0]), __builtin_amdgcn_rcpf(ee[1])};
                    const f32x2 o = cv * cg * sg;
                    p1v = r1v; p2v = r2v; p1g = r1g; p2g = r2g;
                    outp[q][2 * n + jp] = cvt_pk_bf16(o[0], o[1]);
                }
            }
#pragma unroll
        for (int q = 0; q < 4 * NAI; ++q) {
            const bool deferred = (!sample) && q == 0 && fr < 2 && !seqstart;
            if (!deferred) { u32x4 w = {outp[q][0], outp[q][1], outp[q][2], outp[q][3]}; *(u32x4*)at32(act, (unsigned)((rowhalf + 16 * q + fr) * DFF + c8)) = w; }
        }
    }
};

struct EpiQkv {
    static constexpr bool PERM = false;
    const float* partin; const float* rope; bf16_t* qb; float* qs; bf16_t* kb; bf16_t* vb; float* out; LAS unsigned char* lds; int key;
    template <int NAI> __device__ __forceinline__ void run(Acc& acc, const Unit& u, int wr, int wc, int fr, int fq) const {
        asm volatile("" : "+v"(fr), "+v"(fq));
        const int rowhalf = u.rb + wr * 128;
        float rs[2][4]; load_rstd<32, NAI>(partin, rowhalf, fr, fq, rs, lds, wr * 4 + wc, key);
        const int which = u.pn >> 3, head = u.pn & 7;
#pragma unroll
        for (int ai = 0; ai < NAI; ++ai)
#pragma unroll
            for (int m = 0; m < 4; ++m) {
                const int r = rowhalf + 64 * ai + 16 * m + fr; const bool smp = r >= MP;
                const int pos = smp ? PAST + ((r - MP) & 31) : (r & (SEQ - 1));
                f32x4 cs = {1.f, 1.f, 1.f, 1.f}, sn = {0.f, 0.f, 0.f, 0.f};
                if (which < 2 && wc == 0) { cs = *(const f32x4*)at32(rope, (unsigned)(pos * 32 + 4 * fq)); sn = *(const f32x4*)at32(rope, (unsigned)(pos * 32 + 16 + 4 * fq)); }
#pragma unroll
                for (int bj = 0; bj < 2; ++bj) {
                    f32x4 v0 = acc[ai][bj][m][0] * rs[ai][m], v1 = acc[ai][bj][m][1] * rs[ai][m];
                    if (which < 2 && wc == 0) { const f32x4 a = v0, b = v1; v0 = a * cs - b * sn; v1 = b * cs + a * sn; }
                    const int c = head * 256 + bj * 128 + wc * 32 + 4 * fq;
                    u32x2 w0, w1; w0.x = cvt_pk_bf16(v0[0], v0[1]); w0.y = cvt_pk_bf16(v0[2], v0[3]); w1.x = cvt_pk_bf16(v1[0], v1[1]); w1.y = cvt_pk_bf16(v1[2], v1[3]);
                    if (which == 0) {
                        *(u32x2*)at32(qb, (unsigned)(r * DM + c)) = w0; *(u32x2*)at32(qb, (unsigned)(r * DM + c + 16)) = w1;
                        if (smp) { *(f32x4*)at32(qs, (unsigned)((r - MP) * DM + c)) = v0; *(f32x4*)at32(qs, (unsigned)((r - MP) * DM + c + 16)) = v1; }
                    } else {
                        float* ob = out + (smp ? (which == 1 ? O_K_S : O_V_S) : (which == 1 ? O_K_P : O_V_P)); const unsigned oo = (unsigned)((smp ? r - MP : r) * DM + c);
                        *(f32x4*)at32(ob, oo) = v0; *(f32x4*)at32(ob, oo + 16u) = v1;
                        if (!smp) { bf16_t* bp = (which == 1 ? kb : vb); *(u32x2*)at32(bp, (unsigned)(r * DM + c)) = w0; *(u32x2*)at32(bp, (unsigned)(r * DM + c + 16)) = w1; }
                    }
                }
            }
    }
};

#define XB_TMO      128
#define XB_XCNT(j)  (256  + 64 * (j))
#define XB_XSUB(j)  (1280 + 64 * (j))
#define XB_XGEN(j)  (2304 + 64 * (j))
#define XB_TOP      3328
#define XB_TOPGEN   3392
#define XCD_BAR_WORDS 3456
#define XB_SPIN_CAP (1u << 22)

__device__ __forceinline__ unsigned xb_ld(unsigned* p)              { return __hip_atomic_load(p, __ATOMIC_RELAXED, __HIP_MEMORY_SCOPE_AGENT); }
__device__ __forceinline__ unsigned xb_add(unsigned* p, unsigned v) { return __hip_atomic_fetch_add(p, v, __ATOMIC_RELAXED, __HIP_MEMORY_SCOPE_AGENT); }
__device__ __forceinline__ unsigned xb_xcc_id() { return (unsigned)__builtin_amdgcn_s_getreg((3 << 11) | 20) & 0xFu; }
#define XB_SPIN(cond, bar) do { unsigned _sp = 0; while (cond) { __builtin_amdgcn_s_sleep(1); \
    if ((++_sp & 255u) == 0u) { if (xb_ld(&(bar)[XB_TMO])) break; if (_sp > XB_SPIN_CAP) { atomicAdd(&(bar)[XB_TMO], 1u); break; } } } } while (0)

struct XcdBarrier { unsigned* bar; unsigned x; volatile LAS unsigned* st; };

__device__ __forceinline__ XcdBarrier xcd_barrier_post(unsigned* bar, volatile LAS unsigned* st) {
    XcdBarrier b; b.bar = bar; b.x = xb_xcc_id(); b.st = st;
    if (threadIdx.x == 0) (void)xb_add(&bar[XB_XCNT(b.x)], 1u);
    return b;
}
__device__ __forceinline__ void xcd_barrier_complete(unsigned* bar, unsigned x, unsigned& nloc, unsigned& nx) {
    const unsigned G = gridDim.x * gridDim.y * gridDim.z;
    unsigned sum, cnt, mine, sp = 0u;
    for (;;) {
        sum = 0u; cnt = 0u; mine = 0u;
#pragma unroll
        for (unsigned j = 0; j < 16; ++j) { const unsigned c = xb_ld(&bar[XB_XCNT(j)]); sum += c; cnt += (c > 0u) ? 1u : 0u; mine = (j == x) ? c : mine; }
        if (sum == G) break;
        __builtin_amdgcn_s_sleep(1);
        if ((++sp & 255u) == 0u) { if (xb_ld(&bar[XB_TMO])) break; if (sp > XB_SPIN_CAP) { atomicAdd(&bar[XB_TMO], 1u); break; } }
    }
    nloc = mine > 0u ? mine : 1u; nx = cnt > 0u ? cnt : 1u;
}
__device__ __forceinline__ void xcd_barrier(const XcdBarrier& b) {
    asm volatile("s_waitcnt vmcnt(0)" ::: "memory");
    __syncthreads();
    if (threadIdx.x == 0) {
        unsigned* bar = b.bar;
        __builtin_amdgcn_s_waitcnt(0);
        unsigned nloc = b.st[0], nx = b.st[1];
        if (nloc == 0u) { xcd_barrier_complete(bar, b.x, nloc, nx); b.st[0] = nloc; b.st[1] = nx; }
        const unsigned old = xb_add(&bar[XB_XSUB(b.x)], 1u);
        const unsigned gen = old / nloc;
        if (old + 1u == (gen + 1u) * nloc) {
            __builtin_amdgcn_fence(__ATOMIC_RELEASE, "agent");
            asm volatile("s_waitcnt vmcnt(0)" ::: "memory");
            const unsigned og = xb_add(&bar[XB_TOP], 1u);
            const unsigned tg = og / nx;
            if (og + 1u == (tg + 1u) * nx) xb_add(&bar[XB_TOPGEN], 1u);
            else XB_SPIN(xb_ld(&bar[XB_TOPGEN]) == tg, bar);
            __builtin_amdgcn_fence(__ATOMIC_ACQUIRE, "agent");
            xb_add(&bar[XB_XGEN(b.x)], 1u);
            asm volatile("s_waitcnt vmcnt(0)" ::: "memory");
        } else {
            XB_SPIN(xb_ld(&bar[XB_XGEN(b.x)]) == gen, bar);
            __builtin_amdgcn_fence(__ATOMIC_ACQUIRE, "agent");
            asm volatile("s_waitcnt vmcnt(0)" ::: "memory");
        }
    }
    __syncthreads();
}

namespace att {
constexpr float SCALE = 0.08838834764831845f, THR = 8.f;
constexpr int NW = 8, QBLK = 32, KVBLK = 64, QB = NW * QBLK, D = 128;
constexpr int SHM_V = KVBLK * D * 2, SHM_K = KVBLK * D * 2;
constexpr int LDS_ATT = 2 * SHM_V + 2 * SHM_K + NW * 64 * 4;
constexpr int QS = DM, KS = DM, OS = 2 * DM;
template <class A, class Bt> struct same_t { static constexpr bool v = false; };
template <class A> struct same_t<A, A> { static constexpr bool v = true; };
#define KSWZ(row, colB) ((row) * 256 + ((colB) ^ (((row) & 7) << 4)))
#define SBAR() __builtin_amdgcn_sched_barrier(0)
__device__ __forceinline__ int v_st(int k, int c) { const int kk = (k & ~0xC) | ((k & 4) << 1) | ((k & 8) >> 1); return ((kk >> 3) * 4 + (c >> 5)) * 512 + ((kk & 7) * 32 + (c & 31)) * 2; }
__device__ __forceinline__ int v_rd_base(int lane) { return ((lane & 3) << 3) | (((lane >> 2) & 3) << 6) | (((lane >> 4) & 1) << 5) | (((lane >> 5) & 1) << 8); }
constexpr int v_rd_off(int d0, int ks, int half) { return d0 * 512 + ks * 4096 + half * 2048; }
__device__ __forceinline__ int crow(int r, int hi) { return (r & 3) + 8 * (r >> 2) + 4 * hi; }
__device__ __forceinline__ unsigned cvtpk(float lo, float hi) { unsigned r; asm volatile("v_cvt_pk_bf16_f32 %0, %1, %2" : "=v"(r) : "v"(lo), "v"(hi)); return r; }
__device__ __forceinline__ bf16x8 pack8(f32x4 a, f32x4 b) { u32x4 w = {cvtpk(a[0], a[1]), cvtpk(a[2], a[3]), cvtpk(b[0], b[1]), cvtpk(b[2], b[3])}; return *reinterpret_cast<bf16x8*>(&w); }
template <class T> __device__ __forceinline__ bf16x8 load8(const T* p) {
    if constexpr (same_t<T, float>::v) { return pack8(*(const f32x4*)p, *(const f32x4*)(p + 4)); }
    else { return *reinterpret_cast<const bf16x8*>(p); }
}
__device__ __forceinline__ void partialSM(f32x16& p0, f32x16& p1, float& m_reg, float& mn, float& alpha) {
    float pmax;
    asm("v_max3_f32 %0, %1, %2, %3" : "=v"(pmax) : "v"(p0[0]), "v"(p0[1]), "v"(p0[2]));
#pragma unroll
    for (int r = 3; r < 15; r += 2) asm("v_max3_f32 %0, %0, %1, %2" : "+v"(pmax) : "v"(p0[r]), "v"(p0[r + 1]));
    asm("v_max3_f32 %0, %0, %1, %2" : "+v"(pmax) : "v"(p0[15]), "v"(p1[0]));
#pragma unroll
    for (int r = 1; r < 15; r += 2) asm("v_max3_f32 %0, %0, %1, %2" : "+v"(pmax) : "v"(p1[r]), "v"(p1[r + 1]));
    asm("v_max_f32 %0, %0, %1" : "+v"(pmax) : "v"(p1[15]));
    { auto rr = __builtin_amdgcn_permlane32_swap(__float_as_uint(pmax), __float_as_uint(pmax), false, false);
      asm("v_max_f32 %0, %1, %2" : "=v"(pmax) : "v"(__uint_as_float(rr[0])), "v"(__uint_as_float(rr[1]))); }
    constexpr float C2 = 1.4426950408889634f * SCALE;
    if (__builtin_expect(__all((pmax - m_reg) * SCALE <= THR), 1)) { mn = m_reg; alpha = 1.f; }
    else { mn = fmaxf(m_reg, pmax); alpha = __builtin_amdgcn_exp2f((m_reg - mn) * C2); m_reg = mn; }
    const float mnL = -mn * C2;
    for (int r = 0; r < 16; ++r) p0[r] = fmaf(p0[r], C2, mnL); for (int r = 0; r < 16; ++r) p1[r] = fmaf(p1[r], C2, mnL);
    for (int r = 0; r < 16; ++r) p0[r] = __builtin_amdgcn_exp2f(p0[r]);
}
__device__ __forceinline__ void partialSM2(f32x16& p0, f32x16& p1, float& mnL, float& mthr, float& alpha) {
    float pmax;
    asm("v_max3_f32 %0, %1, %2, %3" : "=v"(pmax) : "v"(p0[0]), "v"(p0[1]), "v"(p0[2]));
#pragma unroll
    for (int r = 3; r < 15; r += 2) asm("v_max3_f32 %0, %0, %1, %2" : "+v"(pmax) : "v"(p0[r]), "v"(p0[r + 1]));
    asm("v_max3_f32 %0, %0, %1, %2" : "+v"(pmax) : "v"(p0[15]), "v"(p1[0]));
#pragma unroll
    for (int r = 1; r < 15; r += 2) asm("v_max3_f32 %0, %0, %1, %2" : "+v"(pmax) : "v"(p1[r]), "v"(p1[r + 1]));
    asm("v_max_f32 %0, %0, %1" : "+v"(pmax) : "v"(p1[15]));
    { auto rr = __builtin_amdgcn_permlane32_swap(__float_as_uint(pmax), __float_as_uint(pmax), false, false);
      asm("v_max_f32 %0, %1, %2" : "=v"(pmax) : "v"(__uint_as_float(rr[0])), "v"(__uint_as_float(rr[1]))); }
    constexpr float C2 = 1.4426950408889634f * SCALE;
    if (__builtin_expect(__all(pmax <= mthr), 1)) { alpha = 1.f; }
    else { const float m_old = mnL * (-1.f / C2), mn = fmaxf(m_old, pmax); alpha = __builtin_amdgcn_exp2f((m_old - mn) * C2); mnL = -mn * C2; mthr = mn + THR / SCALE; }
    for (int r = 0; r < 16; ++r) p0[r] = fmaf(p0[r], C2, mnL); for (int r = 0; r < 16; ++r) p1[r] = fmaf(p1[r], C2, mnL);
    for (int r = 0; r < 16; ++r) p0[r] = __builtin_amdgcn_exp2f(p0[r]);
}
__device__ __forceinline__ void finishSM(f32x16& p0, f32x16& p1, float alpha, float& l_reg, bf16x8& pa0, bf16x8& pa1, bf16x8& pa2, bf16x8& pa3) {
    for (int r = 0; r < 16; ++r) p1[r] = __builtin_amdgcn_exp2f(p1[r]);
    float ps = 0; for (int r = 0; r < 16; ++r) ps += p0[r]; for (int r = 0; r < 16; ++r) ps += p1[r];
    { auto rr = __builtin_amdgcn_permlane32_swap(__float_as_uint(ps), __float_as_uint(ps), false, false);
      ps = __uint_as_float(rr[0]) + __uint_as_float(rr[1]); }
    l_reg = l_reg * alpha + ps;
#define PK4(P, B_, OUT) do { unsigned a0 = cvtpk(P[B_+0], P[B_+1]), a1 = cvtpk(P[B_+2], P[B_+3]);                          \
        unsigned b0 = cvtpk(P[B_+4], P[B_+5]), b1 = cvtpk(P[B_+6], P[B_+7]);                                             \
        auto r0 = __builtin_amdgcn_permlane32_swap(a0, b0, false, false); auto r1 = __builtin_amdgcn_permlane32_swap(a1, b1, false, false); \
        u32x4 w = {r0[0], r1[0], r0[1], r1[1]}; OUT = *reinterpret_cast<bf16x8*>(&w); } while (0)
    PK4(p0, 0, pa0); PK4(p0, 8, pa1); PK4(p1, 0, pa2); PK4(p1, 8, pa3);
#undef PK4
}
template <int KB>
__device__ __forceinline__ void qkt(f32x16& p0, f32x16& p1, const char* K_lds, int r32, int hi, const bf16x8* qr) {
    p0 = f32x16{}; p1 = f32x16{};
    const char* kb[4];
#pragma unroll
    for (int dd = 0; dd < 4; ++dd) kb[dd] = K_lds + KB * SHM_K + KSWZ(r32, (dd * 16 + hi * 8) * 2);
#pragma unroll
    for (int d0 = 0; d0 < 8; ++d0) { const char* a = kb[d0 & 3] + (d0 >> 2) * 128;
        bf16x8 b0 = *reinterpret_cast<const bf16x8*>(a);
        bf16x8 b1 = *reinterpret_cast<const bf16x8*>(a + 32 * 256);
        p0 = __builtin_amdgcn_mfma_f32_32x32x16_bf16(b0, qr[d0], p0, 0, 0, 0);
        p1 = __builtin_amdgcn_mfma_f32_32x32x16_bf16(b1, qr[d0], p1, 0, 0, 0); }
}
template <int VB>
__device__ __forceinline__ void pv_tile(f32x16* o, int vb0, bf16x8 pa0, bf16x8 pa1, bf16x8 pa2, bf16x8 pa3) {
#define TRRD(dst, off) asm volatile("ds_read_b64_tr_b16 %0, %1 offset:%2" : "=&v"(dst) : "v"(vb0), "i"(off) : "memory")
#define PV_D0(d0) do { s16x4 l0, l1, l2, l3, h0, h1, h2, h3; constexpr int b_ = VB * SHM_V + v_rd_off(d0, 0, 0); \
        TRRD(l0, b_); TRRD(h0, b_ + 2048); TRRD(l1, b_ + 4096); TRRD(h1, b_ + 6144); TRRD(l2, b_ + 8192); TRRD(h2, b_ + 10240); TRRD(l3, b_ + 12288); TRRD(h3, b_ + 14336); \
        asm volatile("s_waitcnt lgkmcnt(0)" ::: "memory"); SBAR();   \
        o[d0] = __builtin_amdgcn_mfma_f32_32x32x16_bf16(pa0, (bf16x8){l0[0], l0[1], l0[2], l0[3], h0[0], h0[1], h0[2], h0[3]}, o[d0], 0, 0, 0);   \
        o[d0] = __builtin_amdgcn_mfma_f32_32x32x16_bf16(pa1, (bf16x8){l1[0], l1[1], l1[2], l1[3], h1[0], h1[1], h1[2], h1[3]}, o[d0], 0, 0, 0);   \
        o[d0] = __builtin_amdgcn_mfma_f32_32x32x16_bf16(pa2, (bf16x8){l2[0], l2[1], l2[2], l2[3], h2[0], h2[1], h2[2], h2[3]}, o[d0], 0, 0, 0);   \
        o[d0] = __builtin_amdgcn_mfma_f32_32x32x16_bf16(pa3, (bf16x8){l3[0], l3[1], l3[2], l3[3], h3[0], h3[1], h3[2], h3[3]}, o[d0], 0, 0, 0); } while (0)
    PV_D0(0); PV_D0(1); PV_D0(2); PV_D0(3);
#undef PV_D0
#undef TRRD
}

template <class TIn> struct BlockRef { const TIn* Q; const TIn* K; const TIn* V; const TIn* Kt; const TIn* Vt; bf16_t* O; int P0, nt, nrows, pad; };
template <class TIn> struct Seam {
    bf16x8 qr[8];
    bf16x8 st_v0, st_v1, st_k0, st_k1; f32x4 sf0, sf1, sf2, sf3;
    f32x4 tq[16];
};
template <bool SMP, class TIn> __device__ __forceinline__ const TIn* kvrow(const TIn* p, const TIn* pt, int k0, int rr, int sc) {
    if (SMP && k0 >= PAST) return pt + (unsigned)((rr < DSEQ ? rr : DSEQ - 1) * KS + sc);
    return p + (unsigned)((k0 + rr) * KS + sc);
}
#define VMW() asm volatile("s_waitcnt vmcnt(0)" ::: "memory")
#define VMWN(n) asm volatile("s_waitcnt vmcnt(%0)" :: "i"(n) : "memory")
#define SLOAD_H(R_, k0) do { S.st_v0 = load8<TIn>(kvrow<SMP, TIn>((R_).V, (R_).Vt, k0, sr, sc)); S.st_v1 = load8<TIn>(kvrow<SMP, TIn>((R_).V, (R_).Vt, k0, 32 + sr, sc));              \
                             S.st_k0 = load8<TIn>(kvrow<SMP, TIn>((R_).K, (R_).Kt, k0, sr, sc)); S.st_k1 = load8<TIn>(kvrow<SMP, TIn>((R_).K, (R_).Kt, k0, 32 + sr, sc)); } while (0)
#define SWRITE_HK(bf) do { *(bf16x8*)(K_lds + (bf) * SHM_K + kws) = S.st_k0; *(bf16x8*)(K_lds + (bf) * SHM_K + kws + 32 * 256) = S.st_k1; } while (0)
#define SWRITE_HV(bf) do { *(bf16x8*)(V_lds + (bf) * SHM_V + vst0) = S.st_v0; *(bf16x8*)(V_lds + (bf) * SHM_V + vst1) = S.st_v1; } while (0)
#define SWRITE_H(bf) do { SWRITE_HV(bf); SWRITE_HK(bf); } while (0)
#define SLOAD_F(p, pt, k0) do { const float* a_ = (const float*)kvrow<SMP, TIn>(p, pt, k0, sr, sc); const float* b_ = (const float*)kvrow<SMP, TIn>(p, pt, k0, 32 + sr, sc); \
                            S.sf0 = *(const f32x4*)a_; S.sf1 = *(const f32x4*)(a_ + 4); S.sf2 = *(const f32x4*)b_; S.sf3 = *(const f32x4*)(b_ + 4); } while (0)
#define SWRITE_KF(bf) do { *(bf16x8*)(K_lds + (bf) * SHM_K + kws) = pack8(S.sf0, S.sf1); *(bf16x8*)(K_lds + (bf) * SHM_K + kws + 32 * 256) = pack8(S.sf2, S.sf3); } while (0)
#define SWRITE_VF(bf) do { *(bf16x8*)(V_lds + (bf) * SHM_V + vst0) = pack8(S.sf0, S.sf1); *(bf16x8*)(V_lds + (bf) * SHM_V + vst1) = pack8(S.sf2, S.sf3); } while (0)
template <bool SMP, class TIn>
__device__ __forceinline__ void attn_prime(const BlockRef<TIn>& cur, char* lds, Seam<TIn>& S) {
    constexpr bool F32 = same_t<TIn, float>::v;
    const int tid = threadIdx.x, wid = __builtin_amdgcn_readfirstlane(tid >> 6), lane = tid & 63, r32 = lane & 31, hi = lane >> 5;
    const int sr = tid >> 4, sc = (tid & 15) * 8, kws = KSWZ(sr, sc * 2); char* K_lds = lds + 2 * SHM_V;
    for (int d0 = 0; d0 < 8; ++d0) S.qr[d0] = load8<TIn>(cur.Q + (unsigned)((wid * QBLK + r32) * QS + d0 * 16 + hi * 8));
    if constexpr (F32) { SLOAD_F(cur.K, cur.Kt, 0); VMW(); SWRITE_KF(0); SBAR(); SLOAD_F(cur.V, cur.Vt, 0); }
    else { SLOAD_H(cur, 0); VMW(); SWRITE_HK(0); }
    __syncthreads();
}
template <bool SMP, class TIn>
__device__ __forceinline__ void attn_block(const BlockRef<TIn>& cur, const BlockRef<TIn>& nxt, char* lds, Seam<TIn>& S) {
    constexpr bool F32 = same_t<TIn, float>::v;
    const int tid = threadIdx.x, wid = __builtin_amdgcn_readfirstlane(tid >> 6), lane = tid & 63, r32 = lane & 31, hi = lane >> 5;
    const int NT = cur.nt;
    const int qlo = cur.P0 + wid * QBLK;
    char* V_lds = lds; char* K_lds = lds + 2 * SHM_V;
    float* ws = (float*)(lds + 2 * SHM_V + 2 * SHM_K) + wid * 64; float* li_l = ws, * al_l = ws + 32;
    float m_reg = -1e30f, l_reg = 0; f32x16 o[4] = {};
    const int sr = tid >> 4, sc = (tid & 15) * 8, vst0 = v_st(sr, sc), vst1 = v_st(32 + sr, sc), kws = KSWZ(sr, sc * 2);
    const int vb0 = (int)(uintptr_t)V_lds + v_rd_base(lane);
#define RESC(a) do { if (__any((a) < 1.f)) { if (hi == 0) al_l[r32] = (a); asm volatile("s_waitcnt lgkmcnt(0)" ::: "memory");              \
                     for (int d_ = 0; d_ < 4; ++d_) for (int r = 0; r < 16; ++r) o[d_][r] *= al_l[crow(r, hi)]; } } while (0)
#define KBASE(t) ((t) * KVBLK)
#define MASKT(P0_, P1_, t) do { const float NEG_ = -__builtin_inff(); \
        if constexpr (SMP) { if ((t) == NT - 1) { _Pragma("unroll") for (int r_ = 0; r_ < 16; ++r_) P1_[r_] = NEG_; } } \
        else { if (KBASE(t) > (qlo & ~63)) { _Pragma("unroll") for (int r_ = 0; r_ < 16; ++r_) { P0_[r_] = NEG_; P1_[r_] = NEG_; } } } } while (0)
    constexpr int NQL = F32 ? 16 : 8;
#define SEAM_K0() do { VMWN(NQL); if constexpr (F32) { SWRITE_KF(0); SBAR(); SLOAD_F(nxt.V, nxt.Vt, 0); } else { SWRITE_HK(0); } SBAR(); } while (0)
    f32x16 pA0, pA1, pB0, pB1; float mnA, mnB, alA, alB; bf16x8 pa0, pa1, pa2, pa3;
    if constexpr (F32) { VMW(); SWRITE_VF(0); SBAR(); } else { SWRITE_HV(0); SBAR(); }
    if (NT > 1) { if constexpr (F32) SLOAD_F(cur.K, cur.Kt, KBASE(1)); else SLOAD_H(cur, KBASE(1)); }
    SBAR(); qkt<0>(pA0, pA1, K_lds, r32, hi, S.qr);
    if constexpr (F32) { if (NT > 1) { VMW(); SWRITE_KF(1); SBAR(); SLOAD_F(cur.V, cur.Vt, KBASE(1)); } }
    MASKT(pA0, pA1, 0); partialSM(pA0, pA1, m_reg, mnA, alA);
    if (NT > 1) { VMW(); if constexpr (F32) { SWRITE_VF(1); SBAR(); if (NT > 2) SLOAD_F(cur.K, cur.Kt, KBASE(2)); } else SWRITE_H(1); }
    __syncthreads();
#define HALF_STEP(PX0, PX1, mnX, alX, PY0, PY1, alY, t, KB, VB, SB) do {                                                      \
        SBAR(); qkt<KB>(PX0, PX1, K_lds, r32, hi, S.qr);                                             \
        finishSM(PY0, PY1, alY, l_reg, pa0, pa1, pa2, pa3); SBAR();                                                           \
        if ((t) + 1 < NT) { if constexpr (F32) { VMW(); SWRITE_KF(SB); SBAR(); SLOAD_F(cur.V, cur.Vt, KBASE((t) + 1)); }  \
                            else { SLOAD_H(cur, KBASE((t) + 1)); } SBAR(); }                                               \
        pv_tile<VB>(o, vb0, pa0, pa1, pa2, pa3); MASKT(PX0, PX1, (t)); partialSM(PX0, PX1, m_reg, mnX, alX);                                        \
        __syncthreads();                                                                                                      \
        if ((t) + 1 < NT) { VMW(); if constexpr (F32) { SWRITE_VF(SB); SBAR(); if ((t) + 2 < NT) SLOAD_F(cur.K, cur.Kt, KBASE((t) + 2)); } \
                            else { SWRITE_H(SB); } }                                                                          \
        RESC(alX); __syncthreads(); } while (0)
    for (int t = 1; t + 1 < NT; t += 2) {
        HALF_STEP(pB0, pB1, mnB, alB, pA0, pA1, alA, t, 1, 0, 0);
        HALF_STEP(pA0, pA1, mnA, alA, pB0, pB1, alB, t + 1, 0, 1, 1);
    }
    const bool even = (NT & 1) == 0;
    if (even) { SBAR(); qkt<1>(pB0, pB1, K_lds, r32, hi, S.qr); SBAR(); }
#define QROW(e) (nxt.Q + (unsigned)((wid * QBLK + r32) * QS + ((e) >> 1) * 16 + hi * 8 + ((e) & 1) * 4))
    if constexpr (F32) { SLOAD_F(nxt.K, nxt.Kt, 0); SBAR();
#pragma unroll
        for (int e = 0; e < 8; ++e) S.tq[e] = *(const f32x4*)QROW(e); }
    else { SLOAD_H(nxt, 0); SBAR();
#pragma unroll
        for (int d0 = 0; d0 < 8; ++d0) S.qr[d0] = load8<TIn>(nxt.Q + (unsigned)((wid * QBLK + r32) * QS + d0 * 16 + hi * 8)); }
    SBAR();
    finishSM(pA0, pA1, alA, l_reg, pa0, pa1, pa2, pa3); SBAR();
    if constexpr (F32) {
#pragma unroll
        for (int e = 8; e < 16; ++e) S.tq[e] = *(const f32x4*)QROW(e); SBAR(); }
#undef QROW
    pv_tile<0>(o, vb0, pa0, pa1, pa2, pa3);
    if (even) { MASKT(pB0, pB1, NT - 1); partialSM(pB0, pB1, m_reg, mnB, alB); __syncthreads(); RESC(alB);
        finishSM(pB0, pB1, alB, l_reg, pa0, pa1, pa2, pa3); SBAR(); pv_tile<1>(o, vb0, pa0, pa1, pa2, pa3); }
    SBAR(); SEAM_K0();
    if (hi == 0) li_l[r32] = l_reg; asm volatile("s_waitcnt lgkmcnt(0)" ::: "memory");
    float rli[16];
#pragma unroll
    for (int r = 0; r < 16; ++r) rli[r] = __builtin_amdgcn_rcpf(li_l[crow(r, hi)]);
    bf16_t* Ow = cur.O;
    const bool st_ok = wid * QBLK < cur.nrows;
#pragma unroll
    for (int r = 0; r < 16; ++r) { const int orow = crow(r, hi);
#pragma unroll
        for (int d0 = 0; d0 < 4; ++d0) { const float v = o[d0][r] * rli[r];
            const float vn = __shfl_xor(v, 1);
            if (st_ok && (r32 & 1) == 0) *(unsigned*)(Ow + (unsigned)((wid * QBLK + orow) * OS + d0 * 32 + r32)) = cvtpk(v, vn); } }
    if constexpr (F32) {
#pragma unroll
        for (int d0 = 0; d0 < 8; ++d0) S.qr[d0] = pack8(S.tq[2 * d0], S.tq[2 * d0 + 1]); }
    __syncthreads();
#undef RESC
#undef KBASE
#undef MASKT
#undef SEAM_K0
#undef HALF_STEP
}
#undef VMW
#undef VMWN
#undef SLOAD_H
#undef SWRITE_HK
#undef SWRITE_HV
#undef SWRITE_H
#undef SLOAD_F
#undef SWRITE_KF
#undef SWRITE_VF
}

namespace datt {
using att::crow; using att::cvtpk; using att::partialSM; using att::finishSM;
constexpr int SHM_V = 64 * 256 * 2, SHM_K = 64 * 128 * 2, L_V = 0, L_K = 2 * SHM_V, L_WS = 2 * SHM_V + 2 * SHM_K;
constexpr int QS = DM, KS = DM, OS = 2 * DM;
__device__ __forceinline__ int v_st2(int k, int c) { const int kk = (k & ~0xC) | ((k & 4) << 1) | ((k & 8) >> 1); return ((kk >> 3) * 8 + (c >> 5)) * 512 + ((kk & 7) * 32 + (c & 31)) * 2; }
struct DRef { const bf16_t* Q; const bf16_t* K; const bf16_t* V; bf16_t* O; int P0, pad; };
struct DSeam { bf16x8 qr[8]; };
template <int KB>
__device__ __forceinline__ void qkt(f32x16& p0, f32x16& p1, const char* K_lds, int r32, int hi, const bf16x8* qr) {
    p0 = f32x16{}; p1 = f32x16{};
    const char* kb[4];
#pragma unroll
    for (int dd = 0; dd < 4; ++dd) kb[dd] = K_lds + KB * SHM_K + KSWZ(r32, (dd * 16 + hi * 8) * 2);
#define KRD(set, d0) do { const char* a_ = kb[(d0) & 3] + ((d0) >> 2) * 128; set[0] = *reinterpret_cast<const bf16x8*>(a_); set[1] = *reinterpret_cast<const bf16x8*>(a_ + 32 * 256); } while (0)
#define KMM(set, d0) do { p0 = __builtin_amdgcn_mfma_f32_32x32x16_bf16(set[0], qr[d0], p0, 0, 0, 0); p1 = __builtin_amdgcn_mfma_f32_32x32x16_bf16(set[1], qr[d0], p1, 0, 0, 0); } while (0)
    bf16x8 ka[2], kc[2];
    KRD(ka, 0); KRD(kc, 1); SBAR();
    KMM(ka, 0); SBAR(); KRD(ka, 2); SBAR();
    KMM(kc, 1); SBAR(); KRD(kc, 3); SBAR();
    KMM(ka, 2); SBAR(); KRD(ka, 4); SBAR();
    KMM(kc, 3); SBAR(); KRD(kc, 5); SBAR();
    KMM(ka, 4); SBAR(); KRD(ka, 6); SBAR();
    KMM(kc, 5); SBAR(); KRD(kc, 7); SBAR();
    KMM(ka, 6); SBAR();
    KMM(kc, 7); SBAR();
#undef KRD
#undef KMM
}
template <int B_> __device__ __forceinline__ bf16x8 pk4(const f32x16& P) {
    const unsigned a0 = cvtpk(P[B_ + 0], P[B_ + 1]), a1 = cvtpk(P[B_ + 2], P[B_ + 3]), b0 = cvtpk(P[B_ + 4], P[B_ + 5]), b1 = cvtpk(P[B_ + 6], P[B_ + 7]);
    auto r0 = __builtin_amdgcn_permlane32_swap(a0, b0, false, false); auto r1 = __builtin_amdgcn_permlane32_swap(a1, b1, false, false);
    u32x4 w = {r0[0], r1[0], r0[1], r1[1]}; return *reinterpret_cast<bf16x8*>(&w);
}
__device__ __forceinline__ void smA(const f32x16& p0, float& ps, bf16x8& pa0, bf16x8& pa1) {
    ps = 0.f;
#pragma unroll
    for (int r = 0; r < 16; ++r) ps += p0[r];
    pa0 = pk4<0>(p0); pa1 = pk4<8>(p0);
}
template <int VB>
__device__ __forceinline__ void pv_tile2(f32x16* o, int vb0, bf16x8 pa0, bf16x8 pa1, f32x16& p1, float& ps, float alpha, float& l_reg) {
#define TRRD(dst, off) asm volatile("ds_read_b64_tr_b16 %0, %1 offset:%2" : "=&v"(dst) : "v"(vb0), "i"(off) : "memory")
#define PV_RDA(S_, d0) do { constexpr int b_ = VB * SHM_V + (d0) * 512; TRRD(S_[0], b_); TRRD(S_[1], b_ + 4096); TRRD(S_[2], b_ + 8192); TRRD(S_[3], b_ + 12288); } while (0)
#define PV_RDB(S_, d0) do { constexpr int b_ = VB * SHM_V + (d0) * 512 + 16384; TRRD(S_[0], b_); TRRD(S_[1], b_ + 4096); TRRD(S_[2], b_ + 8192); TRRD(S_[3], b_ + 12288); } while (0)
#define PV_MM2(S_, d0, PA, PB) do { \
        o[d0] = __builtin_amdgcn_mfma_f32_32x32x16_bf16(PA, (bf16x8){S_[0][0], S_[0][1], S_[0][2], S_[0][3], S_[1][0], S_[1][1], S_[1][2], S_[1][3]}, o[d0], 0, 0, 0);   \
        o[d0] = __builtin_amdgcn_mfma_f32_32x32x16_bf16(PB, (bf16x8){S_[2][0], S_[2][1], S_[2][2], S_[2][3], S_[3][0], S_[3][1], S_[3][2], S_[3][3]}, o[d0], 0, 0, 0); } while (0)
#define PV_SL(i) do { p1[2 * (i)] = __builtin_amdgcn_exp2f(p1[2 * (i)]); p1[2 * (i) + 1] = __builtin_amdgcn_exp2f(p1[2 * (i) + 1]); ps += p1[2 * (i)] + p1[2 * (i) + 1]; } while (0)
#define PV_W4() do { asm volatile("s_waitcnt lgkmcnt(4)" ::: "memory"); SBAR(); } while (0)
#define PV_W0() do { asm volatile("s_waitcnt lgkmcnt(0)" ::: "memory"); SBAR(); } while (0)
    s16x4 sa[4], sb[4]; bf16x8 pa2, pa3;
    PV_RDA(sa, 0); PV_RDA(sb, 1); PV_W4(); PV_MM2(sa, 0, pa0, pa1); PV_SL(0); SBAR();
    PV_RDA(sa, 2); PV_W4(); PV_MM2(sb, 1, pa0, pa1); PV_SL(1); SBAR();
    PV_RDA(sb, 3); PV_W4(); PV_MM2(sa, 2, pa0, pa1); PV_SL(2); SBAR();
    PV_RDA(sa, 4); PV_W4(); PV_MM2(sb, 3, pa0, pa1); PV_SL(3); SBAR();
    PV_RDA(sb, 5); PV_W4(); PV_MM2(sa, 4, pa0, pa1); pa2 = pk4<0>(p1); PV_SL(4); SBAR();
    PV_RDA(sa, 6); PV_W4(); PV_MM2(sb, 5, pa0, pa1); PV_SL(5); SBAR();
    PV_RDA(sb, 7); PV_W4(); PV_MM2(sa, 6, pa0, pa1); PV_SL(6); SBAR();
    PV_RDB(sa, 0); PV_W4(); PV_MM2(sb, 7, pa0, pa1); PV_SL(7); SBAR();
    PV_RDB(sb, 1); PV_W4(); pa3 = pk4<8>(p1); PV_MM2(sa, 0, pa2, pa3);
    { auto rr = __builtin_amdgcn_permlane32_swap(__float_as_uint(ps), __float_as_uint(ps), false, false); ps = __uint_as_float(rr[0]) + __uint_as_float(rr[1]); l_reg = l_reg * alpha + ps; } SBAR();
    PV_RDB(sa, 2); PV_W4(); PV_MM2(sb, 1, pa2, pa3); SBAR();
    PV_RDB(sb, 3); PV_W4(); PV_MM2(sa, 2, pa2, pa3); SBAR();
    PV_RDB(sa, 4); PV_W4(); PV_MM2(sb, 3, pa2, pa3); SBAR();
    PV_RDB(sb, 5); PV_W4(); PV_MM2(sa, 4, pa2, pa3); SBAR();
    PV_RDB(sa, 6); PV_W4(); PV_MM2(sb, 5, pa2, pa3); SBAR();
    PV_RDB(sb, 7); PV_W4(); PV_MM2(sa, 6, pa2, pa3); SBAR();
    PV_W0(); PV_MM2(sb, 7, pa2, pa3); SBAR();
#undef TRRD
#undef PV_RDA
#undef PV_RDB
#undef PV_MM2
#undef PV_SL
#undef PV_W4
#undef PV_W0
}
template <int VB>
__device__ __forceinline__ void pv_tile(f32x16* o, int vb0, bf16x8 pa0, bf16x8 pa1, bf16x8 pa2, bf16x8 pa3) {
#define TRRD(dst, off) asm volatile("ds_read_b64_tr_b16 %0, %1 offset:%2" : "=&v"(dst) : "v"(vb0), "i"(off) : "memory")
#define PV_RD(S_, d0) do { constexpr int b_ = VB * SHM_V + (d0) * 512; \
        TRRD(S_[0], b_); TRRD(S_[1], b_ + 4096); TRRD(S_[2], b_ + 8192); TRRD(S_[3], b_ + 12288); TRRD(S_[4], b_ + 16384); TRRD(S_[5], b_ + 20480); TRRD(S_[6], b_ + 24576); TRRD(S_[7], b_ + 28672); } while (0)
#define PV_MM(S_, d0) do { \
        o[d0] = __builtin_amdgcn_mfma_f32_32x32x16_bf16(pa0, (bf16x8){S_[0][0], S_[0][1], S_[0][2], S_[0][3], S_[1][0], S_[1][1], S_[1][2], S_[1][3]}, o[d0], 0, 0, 0);   \
        o[d0] = __builtin_amdgcn_mfma_f32_32x32x16_bf16(pa1, (bf16x8){S_[2][0], S_[2][1], S_[2][2], S_[2][3], S_[3][0], S_[3][1], S_[3][2], S_[3][3]}, o[d0], 0, 0, 0);   \
        o[d0] = __builtin_amdgcn_mfma_f32_32x32x16_bf16(pa2, (bf16x8){S_[4][0], S_[4][1], S_[4][2], S_[4][3], S_[5][0], S_[5][1], S_[5][2], S_[5][3]}, o[d0], 0, 0, 0);   \
        o[d0] = __builtin_amdgcn_mfma_f32_32x32x16_bf16(pa3, (bf16x8){S_[6][0], S_[6][1], S_[6][2], S_[6][3], S_[7][0], S_[7][1], S_[7][2], S_[7][3]}, o[d0], 0, 0, 0); } while (0)
#define PV_W8() do { asm volatile("s_waitcnt lgkmcnt(8)" ::: "memory"); SBAR(); } while (0)
#define PV_W0() do { asm volatile("s_waitcnt lgkmcnt(0)" ::: "memory"); SBAR(); } while (0)
    s16x4 sa[8], sb[8];
    PV_RD(sa, 0); PV_RD(sb, 1); PV_W8(); PV_MM(sa, 0); SBAR();
    PV_RD(sa, 2); PV_W8(); PV_MM(sb, 1); SBAR();
    PV_RD(sb, 3); PV_W8(); PV_MM(sa, 2); SBAR();
    PV_RD(sa, 4); PV_W8(); PV_MM(sb, 3); SBAR();
    PV_RD(sb, 5); PV_W8(); PV_MM(sa, 4); SBAR();
    PV_RD(sa, 6); PV_W8(); PV_MM(sb, 5); SBAR();
    PV_RD(sb, 7); PV_W8(); PV_MM(sa, 6); SBAR();
    PV_W0(); PV_MM(sb, 7); SBAR();
#undef PV_RD
#undef PV_MM
#undef PV_W8
#undef PV_W0
#undef TRRD
}
#define DVMW() asm volatile("s_waitcnt vmcnt(0)" ::: "memory")
#define DLOADQ(R_) do { _Pragma("unroll") for (int d0_ = 0; d0_ < 8; ++d0_) S.qr[d0_] = *(const bf16x8*)((R_).Q + (unsigned)((wid * 32 + r32) * QS + d0_ * 16 + hi * 8)); } while (0)
#define DDMA(R_, k0, bf) do { \
        const __amdgpu_buffer_rsrc_t rk_ = __builtin_amdgcn_make_buffer_rsrc((void*)(R_).K, 0, 0x7ffffff0, 0x00020000), rv_ = __builtin_amdgcn_make_buffer_rsrc((void*)(R_).V, 0, 0x7ffffff0, 0x00020000); \
        _Pragma("unroll") for (int j_ = 0; j_ < 2; ++j_) __builtin_amdgcn_raw_ptr_buffer_load_lds(rk_, (LAS unsigned*)(lds + L_K + (bf) * SHM_K + (8 * j_ + wid) * 1024), 16, (int)(offK * 2u), (int)(((k0) + 32 * j_) * KS * 2), 0, 0); \
        _Pragma("unroll") for (int j_ = 0; j_ < 4; ++j_) __builtin_amdgcn_raw_ptr_buffer_load_lds(rv_, (LAS unsigned*)(lds + L_V + (bf) * SHM_V + (8 * j_ + wid) * 1024), 16, (int)(offV * 2u), (int)(((k0) + 16 * j_) * KS * 2), 0, 0); } while (0)
__device__ __forceinline__ void dattn_prime(const DRef& cur, LAS char* lds, DSeam& S) {
    const int tid = threadIdx.x, wid = __builtin_amdgcn_readfirstlane(tid >> 6), lane = tid & 63, r32 = lane & 31, hi = lane >> 5;
    const int rowK = 4 * wid + (lane >> 4); const unsigned offK = (unsigned)(rowK * KS + (((lane & 15) ^ (rowK & 7)) * 8));
    const int sub = 2 * wid + (lane >> 5), kk = (sub >> 3) * 8 + ((lane & 31) >> 2), kv = (kk & ~0xC) | ((kk & 4) << 1) | ((kk & 8) >> 1); const unsigned offV = (unsigned)(kv * KS + (sub & 7) * 32 + (lane & 3) * 8);
    DLOADQ(cur); DDMA(cur, 0, 0); DVMW();
    __syncthreads();
}
__device__ __forceinline__ void dattn_block(const DRef& cur, const DRef& nxt, LAS char* lds, DSeam& S) {
    const int tid = threadIdx.x, wid = __builtin_amdgcn_readfirstlane(tid >> 6), lane = tid & 63, r32 = lane & 31, hi = lane >> 5;
    const int NT = (cur.P0 + 255) / 64 + 1;
    const int qlo = cur.P0 + wid * 32;
    const char* K_lds = (const char*)(lds + L_K);
    float* ws = (float*)(lds + L_WS) + wid * 64; float* li_l = ws, * al_l = ws + 32;
    float mnL_reg = 1e30f * (1.4426950408889634f * att::SCALE), mthr_reg = -1e30f, l_reg = 0; f32x16 o[8] = {};
    const int rowK = 4 * wid + (lane >> 4); const unsigned offK = (unsigned)(rowK * KS + (((lane & 15) ^ (rowK & 7)) * 8));
    const int sub = 2 * wid + (lane >> 5), kk = (sub >> 3) * 8 + ((lane & 31) >> 2), kv = (kk & ~0xC) | ((kk & 4) << 1) | ((kk & 8) >> 1); const unsigned offV = (unsigned)(kv * KS + (sub & 7) * 32 + (lane & 3) * 8);
    const int vb0 = (int)(uintptr_t)(lds + L_V) + att::v_rd_base(lane);
    f32x16 p0, p1; float al, psum; bf16x8 pa0, pa1;
    if (wid >= 4) __builtin_amdgcn_s_setprio(1);
#define DSTEP(t, B, NB) do { \
        if ((t) + 1 < NT) DDMA(cur, ((t) + 1) * 64, NB); else DDMA(nxt, 0, NB); \
        SBAR(); qkt<B>(p0, p1, K_lds, r32, hi, S.qr); SBAR(); \
        if ((t) + 1 == NT) DLOADQ(nxt); \
        if (__builtin_expect((t) * 64 > (qlo & ~63), 0)) { asm volatile("" ::: "memory"); const float NEG_ = -__builtin_inff(); _Pragma("unroll") for (int r_ = 0; r_ < 16; ++r_) { p0[r_] = NEG_; p1[r_] = NEG_; } asm volatile("" : "+v"(p0), "+v"(p1)); } \
        att::partialSM2(p0, p1, mnL_reg, mthr_reg, al); smA(p0, psum, pa0, pa1); SBAR(); \
        if (__any(al < 1.f)) { if (hi == 0) al_l[r32] = al; asm volatile("s_waitcnt lgkmcnt(0)" ::: "memory"); \
            _Pragma("unroll") for (int d_ = 0; d_ < 8; ++d_) _Pragma("unroll") for (int r = 0; r < 16; ++r) o[d_][r] *= al_l[crow(r, hi)]; } \
        pv_tile2<B>(o, vb0, pa0, pa1, p1, psum, al, l_reg); SBAR(); \
        DVMW(); __syncthreads(); } while (0)
    for (int t = 0; t < NT; t += 2) { DSTEP(t, 0, 1); DSTEP(t + 1, 1, 0); }
#undef DSTEP
    __builtin_amdgcn_s_setprio(0);
    if (hi == 0) li_l[r32] = l_reg; asm volatile("s_waitcnt lgkmcnt(0)" ::: "memory");
    float rli[16];
#pragma unroll
    for (int r = 0; r < 16; ++r) rli[r] = __builtin_amdgcn_rcpf(li_l[crow(r, hi)]);
#pragma unroll
    for (int r = 0; r < 16; ++r) { const int orow = crow(r, hi);
#pragma unroll
        for (int d0 = 0; d0 < 8; ++d0) { const float v = o[d0][r] * rli[r];
            const float vn = __shfl_xor(v, 1);
            if ((r32 & 1) == 0) *(unsigned*)(cur.O + (unsigned)((wid * 32 + orow) * OS + d0 * 32 + r32)) = cvtpk(v, vn); } }
}
#undef DVMW
#undef DLOADQ
#undef DDMA
}

struct Args { const float* in[38]; float* out; unsigned char* ws; int ph_lo, ph_hi; };
typedef const float* cfp_t;
typedef const __attribute__((address_space(4))) unsigned char* KP;
__device__ __forceinline__ KP kargs() { KP p = (KP)__builtin_amdgcn_kernarg_segment_ptr(); asm volatile("" : "+s"(p)); return p; }
struct Frame {
    LAS unsigned char* lds; KP kp;
    int tid, lane, wave, G, bid;
    __device__ __forceinline__ const float* in(int i) const { return *(const __attribute__((address_space(4))) cfp_t*)(kp + 8 * i); }
    __device__ __forceinline__ float* out() const { return *(float* const __attribute__((address_space(4)))*)(kp + 304); }
    __device__ __forceinline__ unsigned char* ws() const { return *(unsigned char* const __attribute__((address_space(4)))*)(kp + 312); }
};
static_assert(sizeof(Args) == 328, "Args layout");
enum { I_XP = 0, I_XS, I_SRE, I_SIM, I_SCONV, I_CK, I_CV, I_PP, I_PS, I_NMIX, I_ARE, I_AIM, I_LDT, I_BRE, I_BIM, I_CRE, I_CIM, I_SSMD, I_WGLU, I_NKV, I_WK, I_WV, I_WQ,
       I_LQ1, I_LK1, I_LQ2, I_LK2, I_NSUB, I_WO, I_NFFN, I_WUP, I_CONVW, I_CONVB, I_WDOWN, I_NPLE, I_WGATE, I_WPROJ, I_NFIN };

__device__ __forceinline__ void transpose_item(const float* W, int K, int N, bf16_t* WT, int row_off, const float* gain, int pairhalf, LAS float* scr, int item, int lane) {
    const int nblk = N / 32, kb = item / nblk, nb = item % nblk, k0 = 64 * kb, n0 = 32 * nb;
    int c0 = n0; if (pairhalf) c0 = ((n0 >> 7) & 1) * pairhalf + (n0 >> 8) * 128 + (n0 & 127);
#pragma unroll 8
    for (int i = 0; i < 32; ++i) { const int kk = 2 * i + (lane >> 5); float v = W[(size_t)(k0 + kk) * N + c0 + (lane & 31)]; if (gain) v *= gain[k0 + kk]; scr[kk * 33 + (lane & 31)] = v; }
    asm volatile("s_waitcnt lgkmcnt(0)" ::: "memory");
    const int c = lane & 7;
#pragma unroll
    for (int j = 0; j < 4; ++j) { const int n = (lane >> 3) + 8 * j; const LAS float* s = scr + (8 * c) * 33 + n;
        u32x4 o; o.x = cvt_pk_bf16(s[0 * 33], s[1 * 33]); o.y = cvt_pk_bf16(s[2 * 33], s[3 * 33]); o.z = cvt_pk_bf16(s[4 * 33], s[5 * 33]); o.w = cvt_pk_bf16(s[6 * 33], s[7 * 33]);
        *(u32x4*)(WT + (size_t)(row_off + n0 + n) * K + k0 + 8 * c) = o; }
    asm volatile("s_waitcnt lgkmcnt(0)" ::: "memory");
}

__device__ __forceinline__ void ssm_build_group(Frame& F, int g) {
    LAS f32x2* lbp = (LAS f32x2*)F.lds;
    LAS f32x2* Bb = lbp + 17 * 64;
    LAS f32x2* Cc = Bb + 64 * 16;
    LAS float* Kd = (LAS float*)(Cc + 16 * 64);
    LAS float* Dd = Kd + 4096;
    LAS f32x2* kt = (LAS f32x2*)(Dd + 16);
    const float* are = F.in(I_ARE) + g * 64; const float* aim = F.in(I_AIM) + g * 64;
    const int tid = F.tid;
    for (int i = tid; i < 17 * 64; i += NTHR) { const int d = i >> 6, p = i & 63; const double dt = exp((double)F.in(I_LDT)[g]); const double ar = are[p], ai = aim[p];
        const double mag = exp(ar * dt * d); double sn, cs; sincos(ai * dt * d, &sn, &cs); lbp[d * 64 + p] = (f32x2){(float)(mag * cs), (float)(mag * sn)}; }
    if (tid < 64) {
        const int p = tid; const double dt = exp((double)F.in(I_LDT)[g]); const double ar = are[p], ai = aim[p];
        const double mag = exp(ar * dt); double sn, cs; sincos(ai * dt, &sn, &cs); const double lr = mag * cs, li = mag * sn, den = ar * ar + ai * ai, nr = lr - 1.0;
        kt[p] = (f32x2){(float)((nr * ar + li * ai) / den), (float)((li * ar - nr * ai) / den)};
    }
    if (tid < 16) Dd[tid] = F.in(I_SSMD)[g * 16 + tid];
    __syncthreads();
    for (int i = tid; i < 1024; i += NTHR) { const int p = i >> 4, ch = i & 15; const float br = F.in(I_BRE)[((size_t)g * 64 + p) * 16 + ch], bi = F.in(I_BIM)[((size_t)g * 64 + p) * 16 + ch]; const f32x2 k = kt[p];
        Bb[i] = (f32x2){k.x * br - k.y * bi, k.x * bi + k.y * br};
        const int co = i >> 6, pp = i & 63; Cc[i] = (f32x2){F.in(I_CRE)[((size_t)g * 16 + co) * 64 + pp], F.in(I_CIM)[((size_t)g * 16 + co) * 64 + pp]}; }
    __syncthreads();
    for (int i = tid; i < 4096; i += NTHR) { const int d = i >> 8, co = (i >> 4) & 15, ch = i & 15; float s = 0.f;
        for (int p = 0; p < 64; ++p) { const f32x2 c = Cc[co * 64 + p], l = lbp[d * 64 + p], b = Bb[p * 16 + ch];
            const float wr = c.x * l.x - c.y * l.y, wi = c.x * l.y + c.y * l.x; s += wr * b.x - wi * b.y; }
        if (d == 0 && co == ch) s += Dd[co];
        Kd[i] = s; }
    __syncthreads();
    unsigned char* base = F.ws() + WS_SSM + (size_t)g * SSM_G_BYTES;
    for (int e = tid; e < 8 * 16 * 64; e += NTHR) { const int ln = e & 63, ks = (e >> 6) & 15, Mb = e >> 10; const int row = 32 * Mb + (ln & 31), t = row >> 4, co = row & 15, s = ks; float v[8];
#pragma unroll
        for (int j = 0; j < 8; ++j) { const int ch = 8 * (ln >> 5) + j; v[j] = (t >= s) ? Kd[((t - s) * 16 + co) * 16 + ch] : 0.f; }
        u32x4 o = {cvt_pk_bf16(v[0], v[1]), cvt_pk_bf16(v[2], v[3]), cvt_pk_bf16(v[4], v[5]), cvt_pk_bf16(v[6], v[7])}; *(u32x4*)(base + (size_t)e * 16) = o; }
    for (int e = tid; e < 4 * 16 * 64; e += NTHR) { const int ln = e & 63, ks = (e >> 6) & 15, Mb = e >> 10; const int hr = 32 * Mb + (ln & 31), c = hr >> 6, p = hr & 63, s = ks; float v[8]; const f32x2 l = lbp[(15 - s) * 64 + p];
#pragma unroll
        for (int j = 0; j < 8; ++j) { const f32x2 b = Bb[p * 16 + 8 * (ln >> 5) + j]; v[j] = c == 0 ? (l.x * b.x - l.y * b.y) : (l.x * b.y + l.y * b.x); }
        u32x4 o = {cvt_pk_bf16(v[0], v[1]), cvt_pk_bf16(v[2], v[3]), cvt_pk_bf16(v[4], v[5]), cvt_pk_bf16(v[6], v[7])}; *(u32x4*)(base + 131072 + (size_t)e * 16) = o; }
    for (int e = tid; e < 8 * 8 * 64; e += NTHR) { const int ln = e & 63, ks = (e >> 6) & 7, Mb = e >> 9; const int row = 32 * Mb + (ln & 31), t = row >> 4, co = row & 15; float v[8];
#pragma unroll
        for (int j = 0; j < 8; ++j) { const int hr = 16 * ks + 8 * (ln >> 5) + j, c = hr >> 6, p = hr & 63; const f32x2 cc = Cc[co * 64 + p], l = lbp[(t + 1) * 64 + p];
            v[j] = c == 0 ? (cc.x * l.x - cc.y * l.y) : -(cc.x * l.y + cc.y * l.x); }
        u32x4 o = {cvt_pk_bf16(v[0], v[1]), cvt_pk_bf16(v[2], v[3]), cvt_pk_bf16(v[4], v[5]), cvt_pk_bf16(v[6], v[7])}; *(u32x4*)(base + 196608 + (size_t)e * 16) = o; }
    if (tid < 64) ((f32x2*)(F.ws() + WS_L16))[g * 64 + tid] = lbp[16 * 64 + tid];
    __syncthreads();
}

__device__ __forceinline__ void rms_row_to_bf16(const float* xrow, const float* g, bf16_t* orow, int lane) {
    const f32x4* xr = (const f32x4*)xrow + lane; f32x4 v[8]; float s = 0.f;
#pragma unroll
    for (int j = 0; j < 8; ++j) { v[j] = xr[64 * j]; s += (v[j][0] * v[j][0] + v[j][1] * v[j][1]) + (v[j][2] * v[j][2] + v[j][3] * v[j][3]); }
    const float rstd = rsqrtf(wave_sum(s) * (1.f / DM) + EPS);
    u32x2* o8 = (u32x2*)orow + lane;
#pragma unroll
    for (int j = 0; j < 8; ++j) { const f32x4 gg = ((const f32x4*)g)[lane + 64 * j]; const f32x4 y = v[j] * rstd * gg; u32x2 w; w.x = cvt_pk_bf16(y[0], y[1]); w.y = cvt_pk_bf16(y[2], y[3]); o8[64 * j] = w; }
}
__device__ __forceinline__ void convert_p(Frame& F, int layer) {
    const float* pp = F.in(I_PP) + (size_t)layer * MP * PLE; const float* ps = F.in(I_PS) + (size_t)layer * MS * PLE; bf16_t* pb = (bf16_t*)(F.ws() + WS_PB);
    const size_t n8 = (size_t)MT * PLE / 8;
    for (size_t i = (size_t)F.bid * NTHR + F.tid; i < n8; i += (size_t)F.G * NTHR) { const size_t e = i * 8; const float* src = e < (size_t)MP * PLE ? pp + e : ps + (e - (size_t)MP * PLE);
        const f32x4 a = *(const f32x4*)src, b = *(const f32x4*)(src + 4); u32x4 w = {cvt_pk_bf16(a[0], a[1]), cvt_pk_bf16(a[2], a[3]), cvt_pk_bf16(b[0], b[1]), cvt_pk_bf16(b[2], b[3])}; *(u32x4*)(pb + e) = w; }
}
__device__ __forceinline__ int bg_slot(Frame& F, int word) {
    const int lane = __builtin_amdgcn_mbcnt_hi(~0u, __builtin_amdgcn_mbcnt_lo(~0u, 0u));
    unsigned tk = 0u; if (lane == 0) tk = __hip_atomic_fetch_add((LAS unsigned*)(F.lds + LDS_BYTES - 256) + 16 + word, 1u, __ATOMIC_RELAXED, __HIP_MEMORY_SCOPE_WORKGROUP);
    return __builtin_amdgcn_readfirstlane((int)tk) & 7;
}
template <int LIST> __device__ __forceinline__ void bg_work(Frame& F, int busy, int slot) {
    const int rem = busy < F.G ? busy : 0; int nb = F.G, bi = F.bid;
    if (rem != 0) { if (F.bid < rem) return; nb = F.G - rem; bi = F.bid - rem; }
    const int lane = __builtin_amdgcn_mbcnt_hi(~0u, __builtin_amdgcn_mbcnt_lo(~0u, 0u));
    LAS float* scr = (LAS float*)(F.lds + slot * 16384);
    const int gw = bi * NWAVES + slot, NGW = nb * NWAVES;
    constexpr int I_UP = 32 * 352, I_DN = 88 * 64, I_GT = 32 * 64, I_PJ = 4 * 64, I_SQ = 32 * 64;
    if constexpr (LIST == 0 || LIST == 3) { constexpr int l = LIST == 0 ? 0 : 1;
        for (int it = gw; it < I_UP; it += NGW) transpose_item(F.in(I_WUP) + (size_t)l * DM * DFF2, DM, DFF2, (bf16_t*)(F.ws() + WS_WUP) + (size_t)l * DFF2 * DM, 0, F.in(I_NFFN) + l * DM, DFF, scr, it, lane);
    } else if constexpr (LIST == 1 || LIST == 4) { constexpr int l = LIST == 1 ? 0 : 1;
        for (int it = gw; it < I_DN + I_GT + I_PJ; it += NGW) { int r = it;
            if (r < I_DN) { transpose_item(F.in(I_WDOWN) + (size_t)l * DFF * DM, DFF, DM, (bf16_t*)(F.ws() + WS_WDOWN) + (size_t)l * DM * DFF, 0, nullptr, 0, scr, r, lane); continue; } r -= I_DN;
            if (r < I_GT) { transpose_item(F.in(I_WGATE) + (size_t)l * DM * DM, DM, DM, (bf16_t*)(F.ws() + WS_WGATE) + (size_t)l * DM * DM, 0, F.in(I_NPLE) + l * DM, 0, scr, r, lane); continue; } r -= I_GT;
            transpose_item(F.in(I_WPROJ) + (size_t)l * PLE * DM, PLE, DM, (bf16_t*)(F.ws() + WS_WPROJ) + (size_t)l * DM * PLE, 0, nullptr, 0, scr, r, lane); }
    } else {
        for (int it = gw; it < 4 * I_SQ; it += NGW) { int r = it;
            if (r < I_SQ) { transpose_item(F.in(I_WQ), DM, DM, (bf16_t*)(F.ws() + WS_WQKV), 0, F.in(I_NMIX) + DM, 0, scr, r, lane); continue; } r -= I_SQ;
            if (r < I_SQ) { transpose_item(F.in(I_WK), DM, DM, (bf16_t*)(F.ws() + WS_WQKV), DM, F.in(I_NKV), 0, scr, r, lane); continue; } r -= I_SQ;
            if (r < I_SQ) { transpose_item(F.in(I_WV), DM, DM, (bf16_t*)(F.ws() + WS_WQKV), 2 * DM, F.in(I_NKV), 0, scr, r, lane); continue; } r -= I_SQ;
            transpose_item(F.in(I_WO), DM, DM, (bf16_t*)(F.ws() + WS_WO), 0, nullptr, 0, scr, r, lane); }
    }
}
__device__ __forceinline__ void p0_prologue(Frame& F) {
    for (int g = F.bid; g < NG; g += F.G) ssm_build_group(F, g);
    __syncthreads();
    LAS float* scr = (LAS float*)(F.lds + F.wave * 16384);
    const int gw = F.bid * NWAVES + F.wave, NGW = F.G * NWAVES;
    for (int it = gw; it < 32 * 128; it += NGW) transpose_item(F.in(I_WGLU), DM, 2 * DM, (bf16_t*)(F.ws() + WS_WGLU), 0, nullptr, DM, scr, it, F.lane);
    { float* rope = (float*)(F.ws() + WS_ROPE);
      for (int i = F.bid * NTHR + F.tid; i < SEQ * 16; i += F.G * NTHR) { const int pos = i >> 4, k = i & 15; const double inv = exp(-(double)k * (13.122363377404328 / 16.0)); double sn, cs; sincos((double)pos * inv, &sn, &cs);
          rope[(size_t)pos * 32 + k] = (float)cs; rope[(size_t)pos * 32 + 16 + k] = (float)sn; } }
    { float* cp_ = (float*)(F.ws() + WS_CONVP);
      for (int i = F.bid * NTHR + F.tid; i < 2 * DFF; i += F.G * NTHR) { const int l = i / DFF, c = i % DFF; const float* cw = F.in(I_CONVW) + (size_t)l * 3 * DFF2; const float* cb = F.in(I_CONVB) + (size_t)l * DFF2;
          float* r = cp_ + (size_t)(i & ~1) * 8 + (c & 1);
          r[0] = cw[c]; r[2] = cw[DFF2 + c]; r[4] = cw[2 * DFF2 + c]; r[6] = cb[c]; r[8] = cw[DFF + c]; r[10] = cw[DFF2 + DFF + c]; r[12] = cw[2 * DFF2 + DFF + c]; r[14] = cb[DFF + c]; } }
    convert_p(F, 0);
    bf16_t* ub = (bf16_t*)(F.ws() + WS_UB);
    for (int m = gw; m < MT; m += NGW) rms_row_to_bf16(m < MP ? F.in(I_XP) + (size_t)m * DM : F.in(I_XS) + (size_t)(m - MP) * DM, F.in(I_NMIX), ub + (size_t)m * DM, F.lane);
}

__device__ __forceinline__ void ssm_phase(Frame& F, bf16_t* dstb) {
    constexpr int L_G = 0, L_U = 65536, L_S0 = 98304, L_S1 = 116736, L_XB = 135168;
    const int tid = F.tid, wave = F.wave, lane = F.lane, n = lane & 31, hi = lane >> 5;
    bf16_t* ub = (bf16_t*)(F.ws() + WS_UB);
    const int sn_ = tid & 31, ss_ = tid >> 5;
    for (int item = F.bid; item < NBAT * NG + NG; item += F.G) {
        const bool smp = item >= NBAT * NG;
        const int g = smp ? item - NBAT * NG : item % NG, b = smp ? 0 : item / NG;
        const int nsteps = smp ? 1 : SEQ / 512; const int row0 = smp ? MP : b * SEQ;
        const unsigned char* mats = F.ws() + WS_SSM + (size_t)g * SSM_G_BYTES;
        __syncthreads();
        for (int i = tid; i < 4096; i += NTHR) *(LAS u32x4*)(F.lds + L_G + i * 16) = *(const u32x4*)(mats + 196608 + (size_t)i * 16);
        bf16x8 Kf[16], Hf[8];
#pragma unroll
        for (int ks = 0; ks < 16; ++ks) Kf[ks] = *(const bf16x8*)(mats + ((size_t)(wave * 16 + ks) * 64 + lane) * 16);
#pragma unroll
        for (int i = 0; i < 8; ++i) Hf[i] = *(const bf16x8*)(mats + 131072 + ((size_t)((wave & 3) * 16 + (wave >> 2) * 8 + i) * 64 + lane) * 16);
        f32x2 lam = {0.f, 0.f}, X = {0.f, 0.f};
        if (wave == 0) lam = ((const f32x2*)(F.ws() + WS_L16))[g * 64 + lane];
        { const bf16_t* src = ub + (size_t)(row0 + 16 * sn_ + ss_) * DM + 16 * g; const u32x4 a = *(const u32x4*)src, c = *(const u32x4*)(src + 8);
          LAS unsigned char* d = F.lds + L_U + ss_ * 1024 + sn_ * 32; *(LAS u32x4*)d = a; *(LAS u32x4*)(d + 16) = c; }
        __syncthreads();
        for (int step = 0; step < nsteps; ++step) {
            const int rowb = row0 + step * 512;
            LAS unsigned char* Ucur = F.lds + L_U + (step & 1) * 16384;
            u32x4 na = {0u, 0u, 0u, 0u}, nc = na;
            if (step + 1 < nsteps) { const bf16_t* src = ub + (size_t)(rowb + 512 + 16 * sn_ + ss_) * DM + 16 * g; na = *(const u32x4*)src; nc = *(const u32x4*)(src + 8); }
            { f32x16 sa = {};
#pragma unroll
              for (int i = 0; i < 8; ++i) { const bf16x8 uf = *(const LAS bf16x8*)(Ucur + ((wave >> 2) * 8 + i) * 1024 + n * 32 + hi * 16); sa = __builtin_amdgcn_mfma_f32_32x32x16_bf16(Hf[i], uf, sa, 0, 0, 0); }
              LAS float* Sp = (LAS float*)(F.lds + ((wave >> 2) ? L_S1 : L_S0));
#pragma unroll
              for (int r = 0; r < 16; ++r) Sp[(32 * (wave & 3) + att::crow(r, hi)) * 36 + n] = sa[r]; }
            __syncthreads();
            if (step > 0) { const LAS unsigned char* ysrc = F.lds + L_U + ((step - 1) & 1) * 16384 + ss_ * 1024 + sn_ * 32; const u32x4 ya0 = *(const LAS u32x4*)ysrc, ya1 = *(const LAS u32x4*)(ysrc + 16);
                bf16_t* dst = dstb + (size_t)(rowb - 512 + 16 * sn_ + ss_) * DM + 16 * g; *(u32x4*)dst = ya0; *(u32x4*)(dst + 8) = ya1; }
            if (wave == 0) {
                const LAS float* S0 = (const LAS float*)(F.lds + L_S0); const LAS float* S1 = (const LAS float*)(F.lds + L_S1);
                LAS bf16_t* Xb = (LAS bf16_t*)(F.lds + L_XB);
#pragma unroll 1
                for (int cg = 0; cg < 4; ++cg) {
                    f32x4 re[2], im[2];
#pragma unroll
                    for (int i = 0; i < 2; ++i) { re[i] = *(const LAS f32x4*)(S0 + lane * 36 + 8 * cg + 4 * i) + *(const LAS f32x4*)(S1 + lane * 36 + 8 * cg + 4 * i);
                                                  im[i] = *(const LAS f32x4*)(S0 + (64 + lane) * 36 + 8 * cg + 4 * i) + *(const LAS f32x4*)(S1 + (64 + lane) * 36 + 8 * cg + 4 * i); }
#pragma unroll
                    for (int k = 0; k < 8; ++k) { const int c = 8 * cg + k;
                        if (smp && !(c & 1)) { const size_t si = ((size_t)(c >> 1) * NG + g) * 64 + lane; X = (f32x2){F.in(I_SRE)[si], F.in(I_SIM)[si]}; }
                        Xb[c * 136 + lane] = (bf16_t)(cvt_pk_bf16(X.x, 0.f) & 0xffffu); Xb[c * 136 + 64 + lane] = (bf16_t)(cvt_pk_bf16(X.y, 0.f) & 0xffffu);
                        const float sr = re[k >> 2][k & 3], si2 = im[k >> 2][k & 3];
                        const float nx = lam.x * X.x - lam.y * X.y + sr, ny = lam.x * X.y + lam.y * X.x + si2; X = (f32x2){nx, ny};
                        if (smp && (c & 1)) { const size_t so = ((size_t)(c >> 1) * NG + g) * 64 + lane; F.out()[O_SRE_S + so] = X.x; F.out()[O_SIM_S + so] = X.y; } }
                }
            }
            f32x16 ya = {};
#pragma unroll
            for (int ks = 0; ks < 16; ++ks) if (ks <= 2 * wave + 1) { const bf16x8 uf = *(const LAS bf16x8*)(Ucur + ks * 1024 + n * 32 + hi * 16); ya = __builtin_amdgcn_mfma_f32_32x32x16_bf16(Kf[ks], uf, ya, 0, 0, 0); }
            if (step + 1 < nsteps) { LAS unsigned char* d = F.lds + L_U + ((step + 1) & 1) * 16384 + ss_ * 1024 + sn_ * 32; *(LAS u32x4*)d = na; *(LAS u32x4*)(d + 16) = nc; }
            __syncthreads();
#pragma unroll
            for (int i = 0; i < 8; ++i) { const bf16x8 gf = *(const LAS bf16x8*)(F.lds + L_G + ((wave * 8 + i) * 64 + lane) * 16); const bf16x8 xf = *(const LAS bf16x8*)(F.lds + L_XB + n * 272 + (16 * i + 8 * hi) * 2);
                ya = __builtin_amdgcn_mfma_f32_32x32x16_bf16(gf, xf, ya, 0, 0, 0); }
#pragma unroll
            for (int q = 0; q < 4; ++q) { const int tl = q >> 1, co = 8 * (q & 1) + 4 * hi;
                u32x2 w; w.x = cvt_pk_bf16(gelu_tanh(ya[4 * q]), gelu_tanh(ya[4 * q + 1])); w.y = cvt_pk_bf16(gelu_tanh(ya[4 * q + 2]), gelu_tanh(ya[4 * q + 3]));
                *(LAS u32x2*)(Ucur + (2 * wave + tl) * 1024 + n * 32 + co * 2) = w; }
        }
        __syncthreads();
        { const int ls = nsteps - 1; const LAS unsigned char* ysrc = F.lds + L_U + (ls & 1) * 16384 + ss_ * 1024 + sn_ * 32; const u32x4 ya0 = *(const LAS u32x4*)ysrc, ya1 = *(const LAS u32x4*)(ysrc + 16);
          bf16_t* dst = dstb + (size_t)(row0 + ls * 512 + 16 * sn_ + ss_) * DM + 16 * g; *(u32x4*)dst = ya0; *(u32x4*)(dst + 8) = ya1; }
        if (!smp && wave == 0) { const size_t so = ((size_t)b * NG + g) * 64 + lane; F.out()[O_SRE_P + so] = X.x; F.out()[O_SIM_P + so] = X.y; }
    }
}

__device__ __forceinline__ void fixup_phase(Frame& F, int layer) {
    const float* zs = (const float*)(F.ws() + WS_ZSIDE); bf16_t* act = (bf16_t*)(F.ws() + WS_BIG);
    const float* cw = F.in(I_CONVW) + (size_t)layer * 3 * DFF2; const float* cb = F.in(I_CONVB) + (size_t)layer * DFF2;
    constexpr int NC4 = DFF / 4;
    for (int i = F.bid * NTHR + F.tid; i < 256 * NC4; i += F.G * NTHR) {
        const int ht = i / NC4, c0 = (i % NC4) * 4; if ((ht & 127) == 0) continue;
        const float* zp = zs + (size_t)(ht - 1) * 4 * DFF2; const float* zc = zs + (size_t)ht * 4 * DFF2;
        f32x4 o0, o1;
        f32x4 cv0, cv1, cg0, cg1;
        { const f32x4 L0 = *(const f32x4*)(zp + 2 * DFF2 + c0), L1 = *(const f32x4*)(zp + 3 * DFF2 + c0), f0 = *(const f32x4*)(zc + c0), f1 = *(const f32x4*)(zc + DFF2 + c0);
          const f32x4 w0 = *(const f32x4*)(cw + c0), w1 = *(const f32x4*)(cw + DFF2 + c0), w2 = *(const f32x4*)(cw + 2 * DFF2 + c0), bb = *(const f32x4*)(cb + c0);
          cv0 = bb + w2 * f0 + w1 * L1 + w0 * L0; cv1 = bb + w2 * f1 + w1 * f0 + w0 * L1; }
        { const int c1 = DFF + c0; const f32x4 L0 = *(const f32x4*)(zp + 2 * DFF2 + c1), L1 = *(const f32x4*)(zp + 3 * DFF2 + c1), f0 = *(const f32x4*)(zc + c1), f1 = *(const f32x4*)(zc + DFF2 + c1);
          const f32x4 w0 = *(const f32x4*)(cw + c1), w1 = *(const f32x4*)(cw + DFF2 + c1), w2 = *(const f32x4*)(cw + 2 * DFF2 + c1), bb = *(const f32x4*)(cb + c1);
          cg0 = bb + w2 * f0 + w1 * L1 + w0 * L0; cg1 = bb + w2 * f1 + w1 * f0 + w0 * L1; }
#pragma unroll
        for (int j = 0; j < 4; ++j) { o0[j] = cv0[j] * cg0[j] * fsigmoid(cg0[j]); o1[j] = cv1[j] * cg1[j] * fsigmoid(cg1[j]); }
        u32x2 w; w.x = cvt_pk_bf16(o0[0], o0[1]); w.y = cvt_pk_bf16(o0[2], o0[3]); *(u32x2*)(act + (size_t)(128 * ht) * DFF + c0) = w;
        w.x = cvt_pk_bf16(o1[0], o1[1]); w.y = cvt_pk_bf16(o1[2], o1[3]); *(u32x2*)(act + (size_t)(128 * ht + 1) * DFF + c0) = w;
    }
}

__device__ __forceinline__ att::BlockRef<bf16_t> attn_ref_p(Frame& F, int L, int pass) {
    const int bh = L >> 5, x = L & 31, qb = pass ? 63 - x : x, b = bh >> 5, vhp = bh & 31, vh = vhp >> 1, vhalf = vhp & 1;
    att::BlockRef<bf16_t> r; const size_t row0 = (size_t)b * SEQ;
    r.Q = (const bf16_t*)(F.ws() + WS_UB) + (row0 + (size_t)qb * 256) * DM + vh * 128;
    r.K = (const bf16_t*)(F.ws() + WS_KB) + row0 * DM + vh * 128; r.V = (const bf16_t*)(F.ws() + WS_VB) + row0 * DM + (vh >> 1) * 256 + vhalf * 128; r.Kt = r.K; r.Vt = r.V;
    r.O = (bf16_t*)(F.ws() + WS_BIG) + (row0 + (size_t)qb * 256) * (2 * DM) + vh * 256 + vhalf * 128;
    r.P0 = qb * 256; r.nt = (r.P0 + 255) / 64 + 1; r.nrows = 256; r.pad = 0; return r;
}
__device__ __forceinline__ att::BlockRef<float> attn_ref_s(Frame& F, int L) {
    const int b = L >> 5, vhp = L & 31, vh = vhp >> 1, vhalf = vhp & 1;
    att::BlockRef<float> r;
    r.Q = (const float*)(F.ws() + WS_QS) + (size_t)b * DSEQ * DM + vh * 128;
    r.K = F.in(I_CK) + (size_t)b * PAST * DM + vh * 128; r.V = F.in(I_CV) + (size_t)b * PAST * DM + (vh >> 1) * 256 + vhalf * 128;
    r.Kt = F.out() + O_K_S + (size_t)b * DSEQ * DM + vh * 128; r.Vt = F.out() + O_V_S + (size_t)b * DSEQ * DM + (vh >> 1) * 256 + vhalf * 128;
    r.O = (bf16_t*)(F.ws() + WS_BIG) + ((size_t)MP + (size_t)b * DSEQ) * (2 * DM) + vh * 256 + vhalf * 128;
    r.P0 = PAST; r.nt = PAST / 64 + 1; r.nrows = DSEQ; r.pad = 0; return r;
}
__device__ __forceinline__ datt::DRef dattn_ref(Frame& F, int L, int pass) {
    const int bh = L >> 5, x = L & 31, qb = pass ? 63 - x : x, b = bh >> 4, vh = bh & 15;
    datt::DRef r; const size_t row0 = (size_t)b * SEQ;
    r.Q = (const bf16_t*)(F.ws() + WS_UB) + (row0 + (size_t)qb * 256) * DM + vh * 128;
    r.K = (const bf16_t*)(F.ws() + WS_KB) + row0 * DM + vh * 128; r.V = (const bf16_t*)(F.ws() + WS_VB) + row0 * DM + (vh >> 1) * 256;
    r.O = (bf16_t*)(F.ws() + WS_BIG) + (row0 + (size_t)qb * 256) * (2 * DM) + vh * 256;
    r.P0 = qb * 256; r.pad = 0; return r;
}
__device__ __forceinline__ int attn_item(int bid, int i, int G) { return G == 256 ? ((8 * i + (bid & 7)) << 5) + (bid >> 3) : bid + i * G; }
__device__ __forceinline__ void attn_phase_prompt(Frame& F) {
    constexpr int total = NBAT * 16 * 32; const int G = F.G, bid = F.bid;
    const int nit = G == 256 ? total / 256 : (total - bid + G - 1) / G; if (nit <= 0) return;
    int it = 0, pass = 0; datt::DRef cur = dattn_ref(F, attn_item(bid, 0, G), 0); datt::DSeam S;
    datt::dattn_prime(cur, (LAS char*)F.lds, S);
    for (;;) {
        const bool more_pass = pass == 0, more_item = it + 1 < nit, last = !more_pass && !more_item;
        int passn = pass + 1, itn = it; if (!more_pass) { passn = 0; itn = more_item ? it + 1 : it; }
        const datt::DRef nxt = last ? cur : dattn_ref(F, attn_item(bid, itn, G), passn);
        datt::dattn_block(cur, nxt, (LAS char*)F.lds, S);
        if (last) break;
        cur = nxt; pass = passn; it = itn;
    }
    asm volatile("s_waitcnt vmcnt(0)" ::: "memory"); __syncthreads();
}
__device__ __forceinline__ int attn_item_s(int bid, int i, int G) { return G == 256 ? i * 256 + (((bid & 7) * 8 + (bid >> 5)) << 2) + ((bid >> 3) & 3) : bid + i * G; }
__device__ __forceinline__ void attn_phase_sample(Frame& F) {
    constexpr int total = DB * 32; const int G = F.G, bid = F.bid;
    const int nit = G == 256 ? total / 256 : (total - bid + G - 1) / G; if (nit <= 0) return;
    int it = 0; att::BlockRef<float> cur = attn_ref_s(F, attn_item_s(bid, 0, G)); att::Seam<float> S;
    att::attn_prime<true, float>(cur, (char*)F.lds, S);
    for (;;) {
        const bool last = it + 1 >= nit;
        const att::BlockRef<float> nxt = last ? cur : attn_ref_s(F, attn_item_s(bid, it + 1, G));
        att::attn_block<true, float>(cur, nxt, (char*)F.lds, S);
        if (last) break;
        cur = nxt; ++it;
    }
}

__device__ __forceinline__ void combine_phase(Frame& F) {
    const float l1 = wave_sum(F.in(I_LQ1)[F.lane] * F.in(I_LK1)[F.lane] + F.in(I_LQ1)[64 + F.lane] * F.in(I_LK1)[64 + F.lane]);
    const float l2 = wave_sum(F.in(I_LQ2)[F.lane] * F.in(I_LK2)[F.lane] + F.in(I_LQ2)[64 + F.lane] * F.in(I_LK2)[64 + F.lane]);
    const float lam_init = 0.8f - 0.6f * 0.7408182206817179f;
    const float lam = expf(l1) - expf(l2) + lam_init, post = 1.0f - lam_init;
    const bf16_t* O = (const bf16_t*)(F.ws() + WS_BIG); bf16_t* ab = (bf16_t*)(F.ws() + WS_HB);
    const int hh = F.lane >> 3, cb = (F.lane & 7) * 8;
    f32x4 gs[8];
#pragma unroll
    for (int i = 0; i < 8; ++i) gs[i] = *(const f32x4*)(F.in(I_NSUB) + (i >> 1) * 64 + cb + (i & 1) * 4);
    const int gw = F.bid * NWAVES + F.wave, NGW = F.G * NWAVES;
    for (int m = gw; m < MT; m += NGW) {
        const u32x4* p1 = (const u32x4*)(O + (size_t)m * (2 * DM) + hh * 512 + cb); const u32x4* p2 = (const u32x4*)(O + (size_t)m * (2 * DM) + hh * 512 + 256 + cb);
        u32x4 a[4], c[4];
#pragma unroll
        for (int i = 0; i < 4; ++i) { a[i] = p1[8 * i]; c[i] = p2[8 * i]; }
        float d[32]; float ss = 0.f;
#pragma unroll
        for (int i = 0; i < 4; ++i)
#pragma unroll
            for (int j = 0; j < 4; ++j) { const float x0 = __uint_as_float(a[i][j] << 16) - lam * __uint_as_float(c[i][j] << 16), x1 = __uint_as_float(a[i][j] & 0xffff0000u) - lam * __uint_as_float(c[i][j] & 0xffff0000u);
                d[8 * i + 2 * j] = x0; d[8 * i + 2 * j + 1] = x1; ss += x0 * x0 + x1 * x1; }
        ss += __shfl_xor(ss, 1); ss += __shfl_xor(ss, 2); ss += __shfl_xor(ss, 4);
        const float rstd = rsqrtf(ss * (1.f / VD) + SUBLN_EPS) * post;
        u32x4* op = (u32x4*)(ab + (size_t)m * DM + hh * 256 + cb);
#pragma unroll
        for (int i = 0; i < 4; ++i) { u32x4 w;
#pragma unroll
            for (int j = 0; j < 4; ++j) w[j] = cvt_pk_bf16(d[8 * i + 2 * j] * rstd * gs[2 * i + (j >> 1)][2 * (j & 1)], d[8 * i + 2 * j + 1] * rstd * gs[2 * i + (j >> 1)][2 * (j & 1) + 1]);
            op[8 * i] = w; }
    }
}

__device__ __forceinline__ void final_phase(Frame& F, const float* part, float* dst) {
    const int gw = F.bid * NWAVES + F.wave, NGW = F.G * NWAVES; const float* g = F.in(I_NFIN); const bf16_t* hb = (const bf16_t*)(F.ws() + WS_HB);
    f32x4 gg[4][2];
#pragma unroll
    for (int j = 0; j < 4; ++j) { gg[j][0] = ((const f32x4*)g)[128 * j + 2 * F.lane]; gg[j][1] = ((const f32x4*)g)[128 * j + 2 * F.lane + 1]; }
    for (int m = gw; m < MT; m += NGW) {
        const float pv = F.lane < 32 ? part[part_idx(m >> 7, F.lane, m & 15) + ((m >> 4) & 7)] : 0.f;
        const float rstd = rsqrtf(wave_sum(pv) * (1.f / DM) + EPS);
        const u32x4* row = (const u32x4*)(hb + (size_t)m * DM) + F.lane; f32x4* orow = (f32x4*)(dst + (size_t)m * DM) + 2 * F.lane;
#pragma unroll
        for (int j = 0; j < 4; ++j) { const u32x4 w = row[64 * j];
            const f32x4 a = {__uint_as_float(w[0] << 16), __uint_as_float(w[0] & 0xffff0000u), __uint_as_float(w[1] << 16), __uint_as_float(w[1] & 0xffff0000u)};
            const f32x4 b2 = {__uint_as_float(w[2] << 16), __uint_as_float(w[2] & 0xffff0000u), __uint_as_float(w[3] << 16), __uint_as_float(w[3] & 0xffff0000u)};
            orow[128 * j] = a * rstd * gg[j][0]; orow[128 * j + 1] = b2 * rstd * gg[j][1]; }
    }
}


__device__ __forceinline__ void probe_mfma(Frame& F, int nit) {
    unsigned sd = (unsigned)F.tid * 2654435761u + (unsigned)F.bid * 40503u + 12345u;
    bf16x8 a[2], b[2];
#pragma unroll
    for (int i = 0; i < 2; ++i) { u32x4 wa, wb;
#pragma unroll
        for (int j = 0; j < 4; ++j) { sd = sd * 1664525u + 1013904223u; wa[j] = (sd & 0xbfffbfffu) | 0x3c003c00u; sd = sd * 1664525u + 1013904223u; wb[j] = (sd & 0xbfffbfffu) | 0x3c003c00u; }
        a[i] = *reinterpret_cast<bf16x8*>(&wa); b[i] = *reinterpret_cast<bf16x8*>(&wb); }
    f32x16 c[4] = {};
    for (int it = 0; it < nit; ++it) {
#pragma unroll
        for (int k = 0; k < 4; ++k) { c[k] = __builtin_amdgcn_mfma_f32_32x32x16_bf16(a[k & 1], b[k >> 1], c[k], 0, 0, 0); }
#pragma unroll
        for (int k = 0; k < 4; ++k) { c[k] = __builtin_amdgcn_mfma_f32_32x32x16_bf16(a[(k + 1) & 1], b[k >> 1], c[k], 0, 0, 0); }
        asm volatile("" : "+v"(a[0]), "+v"(b[0]));
    }
    float s = 0.f;
#pragma unroll
    for (int k = 0; k < 4; ++k) for (int r = 0; r < 16; ++r) s += c[k][r];
    if (s == 1.2345e-30f) *(float*)(F.ws() + WS_CTL + 65536) = s;
}
constexpr int NPHASE = 16;
__device__ __forceinline__ Frame mkframe(LAS unsigned char* lds) {
    Frame F; F.lds = lds; F.kp = kargs();
    int t = threadIdx.x; asm volatile("" : "+v"(t));
    F.wave = __builtin_amdgcn_readfirstlane(t >> 6);
    int ln = __builtin_amdgcn_mbcnt_hi(~0u, __builtin_amdgcn_mbcnt_lo(~0u, 0u)); asm volatile("" : "+v"(ln));
    F.lane = ln; F.tid = F.wave * 64 + ln; F.G = gridDim.x; F.bid = blockIdx.x;
    return F;
}
__device__ __forceinline__ bool ph_in(const Frame& F, int k) { const int lo = *(const __attribute__((address_space(4))) int*)(F.kp + 320), hi = *(const __attribute__((address_space(4))) int*)(F.kp + 324); return lo <= k && k < hi; }
template <unsigned PMASK, int K> __device__ __forceinline__ bool phase_on(const Frame& F) { if constexpr (((PMASK >> K) & 1u) == 0u) return false; else return ph_in(F, K); }
template <unsigned PMASK, int K> __device__ __forceinline__ void seam(LAS unsigned char* lds) {
    if constexpr (K + 1 < NPHASE && ((PMASK >> K) & 1u) && ((PMASK >> (K + 1)) & 1u)) {
        Frame F = mkframe(lds);
        if (ph_in(F, K) && ph_in(F, K + 1)) { XcdBarrier bar; bar.bar = (unsigned*)(F.ws() + WS_CTL) + CW_BAR; bar.x = xb_xcc_id(); bar.st = (volatile LAS unsigned*)(lds + LDS_BYTES - 256) + 8; xcd_barrier(bar); }
    }
}
template <class Epi> __device__ __forceinline__ void gemm_both(LAS unsigned char* ring, const bf16_t* A, const bf16_t* Bt, int N, int K, const Epi& E, int G, int bid, int skip = 0) {
    if (skip > 0 && skip < G) { if (bid < skip) return; G -= skip; bid -= skip; }
    const int wid = __builtin_amdgcn_readfirstlane((int)threadIdx.x >> 6);
    asm volatile("" : "+s"(K));
    { pg8::Gemm g{A, Bt, MP, N, K}; pg8::StaticOrder S; S.init(MP, N, G, bid); pg8::gemm_phase<Epi, pg8::StaticOrder, false>(ring, g, S, E, wid); }
    { pg8::Gemm g{A, Bt, MT, N, K}; pg8::HalfOrder H; H.init(MP / 256, N, G, bid); pg8::gemm_phase<Epi, pg8::HalfOrder, true>(ring, g, H, E, wid); }
}
template <int LAYER, int STEP> __device__ __forceinline__ void ffn_phase(Frame& F) {
    LAS unsigned char* ring = F.lds;
    bf16_t* const hb = (bf16_t*)(F.ws() + (LAYER == 0 ? WS_HB : WS_PP)); bf16_t* const ppb = (bf16_t*)(F.ws() + (LAYER == 0 ? WS_PP : WS_HB));
    float* const pin = (float*)(F.ws() + (LAYER == 0 ? WS_PART0 : WS_PART1)); float* const pout = (float*)(F.ws() + (LAYER == 0 ? WS_PART1 : WS_PART0));
    if constexpr (STEP == 0) {
        const float* cw = (const float*)(F.ws() + WS_CONVP) + (size_t)LAYER * DFF * 8; const float* cb = nullptr; const float* st = F.in(I_SCONV) + (size_t)LAYER * DB * 2 * DFF2;
        float* cp = F.out() + O_CONV_P + (size_t)LAYER * NBAT * 2 * DFF2; float* cs = F.out() + O_CONV_S + (size_t)LAYER * DB * 2 * DFF2;
        constexpr int NP = LAYER == 0 ? 64 : 32;
        EpiUp<NP> E{pin, (bf16_t*)(F.ws() + WS_BIG), cw, cb, st, (float*)(F.ws() + WS_ZSIDE), cp, cs, F.lds, (LAYER == 0 ? 1 : 2) << 20};
        gemm_both(ring, hb, (const bf16_t*)(F.ws() + WS_WUP) + (size_t)LAYER * DFF2 * DM, DFF2, DM, E, F.G, F.bid);
        if constexpr (LAYER == 0) bg_work<1>(F, 4 * (DFF2 / 256), bg_slot(F, 1));
    } else if constexpr (STEP == 1) { fixup_phase(F, LAYER);
    } else if constexpr (STEP == 2) {
        EpiResid E{hb, pout};
        gemm_both(ring, (const bf16_t*)(F.ws() + WS_BIG), (const bf16_t*)(F.ws() + WS_WDOWN) + (size_t)LAYER * DM * DFF, DM, DFF, E, F.G, F.bid);
    } else if constexpr (STEP == 3) {
        EpiBf16 E{ppb, DM};
        gemm_both(ring, (const bf16_t*)(F.ws() + WS_PB), (const bf16_t*)(F.ws() + WS_WPROJ) + (size_t)LAYER * DM * PLE, DM, PLE, E, F.G, F.bid, 4 * (DM / 256));
    } else {
        if constexpr (LAYER == 0) convert_p(F, 1);
        EpiPle E{pout, hb, ppb, pin, F.lds, (LAYER == 0 ? 3 : 4) << 20};
        gemm_both(ring, hb, (const bf16_t*)(F.ws() + WS_WGATE) + (size_t)LAYER * DM * DM, DM, DM, E, F.G, F.bid);
        if constexpr (LAYER == 0) { const int sl = bg_slot(F, 3); bg_work<3>(F, 4 * (DM / 256), sl); bg_work<2>(F, 4 * (DM / 256), sl); }
    }
}
template <unsigned PMASK> __global__ void __launch_bounds__(NTHR, 2) yoco_fwd(Args args) {
    extern __shared__ __attribute__((aligned(16))) unsigned char lds_raw[];
    LAS unsigned char* const lds = (LAS unsigned char*)lds_raw;
    (void)args;
    { Frame F = mkframe(lds);
      volatile LAS unsigned* MISC = (volatile LAS unsigned*)(lds + LDS_BYTES - 256);
      if (F.tid < 64) MISC[F.tid] = 0u;
      __syncthreads();
      if (MK_N_LAUNCHES == 1) (void)xcd_barrier_post((unsigned*)(F.ws() + WS_CTL) + CW_BAR, MISC + 8); }
    if (PROBE_MFMA) { Frame F = mkframe(lds); if (phase_on<PMASK, 0>(F)) probe_mfma(F, PROBE_MFMA); }
#define PH(K, ...) { Frame F = mkframe(lds); if (phase_on<PMASK, K>(F)) { __VA_ARGS__ } } seam<PMASK, K>(lds);
    if (PROBE_P2) { Frame F = mkframe(lds); if (phase_on<PMASK, 0>(F)) { p0_prologue(F); __syncthreads(); } }
    PH(0, p0_prologue(F);)
    if (PROBE_SSM2) { Frame F = mkframe(lds); if (phase_on<PMASK, 1>(F)) { ssm_phase(F, (bf16_t*)(F.ws() + WS_PP)); __syncthreads(); } }
    PH(1, ssm_phase(F, (bf16_t*)(F.ws() + WS_UB));)
    PH(2, { EpiGlu E{F.in(I_XP), F.in(I_XS), (bf16_t*)(F.ws() + WS_HB), (float*)(F.ws() + WS_PART0)};
            gemm_both(F.lds, (const bf16_t*)(F.ws() + WS_UB), (const bf16_t*)(F.ws() + WS_WGLU), 2 * DM, DM, E, F.G, F.bid); bg_work<0>(F, 4 * (2 * DM / 256), bg_slot(F, 0)); })
    if (PROBE_UP2) { Frame F = mkframe(lds); if (phase_on<PMASK, 3>(F)) { ffn_phase<0, 0>(F); } }
    PH(3, (ffn_phase<0, 0>(F));)
    if (PROBE_FF2) { Frame F = mkframe(lds); if (phase_on<PMASK, 4>(F)) { ffn_phase<0, 1>(F); } }
    PH(4, (ffn_phase<0, 1>(F));)
    { Frame F = mkframe(lds); if (phase_on<PMASK, 5>(F)) { ffn_phase<0, 2>(F); } }
    PH(5, (ffn_phase<0, 3>(F));)
    PH(6, (ffn_phase<0, 4>(F));)
    PH(7, { EpiQkv E{(const float*)(F.ws() + WS_PART0), (const float*)(F.ws() + WS_ROPE), (bf16_t*)(F.ws() + WS_UB), (float*)(F.ws() + WS_QS), (bf16_t*)(F.ws() + WS_KB), (bf16_t*)(F.ws() + WS_VB), F.out(), F.lds, 5 << 20};
            gemm_both(F.lds, (const bf16_t*)(F.ws() + WS_PP), (const bf16_t*)(F.ws() + WS_WQKV), 3 * DM, DM, E, F.G, F.bid); bg_work<4>(F, 4 * (3 * DM / 256), bg_slot(F, 4)); })
    { Frame F = mkframe(lds); if (phase_on<PMASK, 8>(F)) { attn_phase_prompt(F); } }
    if (PROBE_ATT2) { Frame F = mkframe(lds); if (phase_on<PMASK, 8>(F)) { attn_phase_prompt(F); } }
    if (PROBE_S2) { Frame F = mkframe(lds); if (phase_on<PMASK, 8>(F)) { attn_phase_sample(F); } }
    PH(8, attn_phase_sample(F);)
    if (PROBE_S2) { Frame F = mkframe(lds); if (phase_on<PMASK, 9>(F)) { combine_phase(F); } }
    PH(9, combine_phase(F);)
    PH(10, { EpiResid E{(bf16_t*)(F.ws() + WS_PP), (float*)(F.ws() + WS_PART1)};
             gemm_both(F.lds, (const bf16_t*)(F.ws() + WS_HB), (const bf16_t*)(F.ws() + WS_WO), DM, DM, E, F.G, F.bid); })
    if (PROBE_UP2) { Frame F = mkframe(lds); if (phase_on<PMASK, 11>(F)) { ffn_phase<1, 0>(F); } }
    PH(11, (ffn_phase<1, 0>(F));)
    if (PROBE_FF2) { Frame F = mkframe(lds); if (phase_on<PMASK, 12>(F)) { ffn_phase<1, 1>(F); } }
    PH(12, (ffn_phase<1, 1>(F));)
    { Frame F = mkframe(lds); if (phase_on<PMASK, 13>(F)) { ffn_phase<1, 2>(F); } }
    PH(13, (ffn_phase<1, 3>(F));)
    PH(14, (ffn_phase<1, 4>(F));)
    if (PROBE_FF2) { Frame F = mkframe(lds); if (phase_on<PMASK, 15>(F)) { final_phase(F, (const float*)(F.ws() + WS_PART1), (float*)(F.ws() + WS_UB)); } }
    PH(15, final_phase(F, (const float*)(F.ws() + WS_PART1), F.out());)
#undef PH
}

#ifndef PHASE_MASK
#define PHASE_MASK 0xFFFFu
#endif
template <unsigned PMASK> static bool prep_kernel() {
    if (hipFuncSetAttribute((const void*)yoco_fwd<PMASK>, hipFuncAttributeMaxDynamicSharedMemorySize, LDS_BYTES) != hipSuccess) { fprintf(stderr, "kernel_launch: hipFuncSetAttribute failed\n"); return false; }
    return true;
}
template <int P> static void launch_phases(int grid, Args& a, hipStream_t stream) {
    if constexpr (P < NPHASE) {
        if ((PHASE_MASK >> P) & 1u) { a.ph_lo = P; a.ph_hi = P + 1; hipLaunchKernelGGL(yoco_fwd<(1u << P)>, dim3(grid), dim3(NTHR), LDS_BYTES, stream, a); }
        launch_phases<P + 1>(grid, a, stream);
    }
}
template <int P> static bool prep_phases() { if constexpr (P < NPHASE) { return prep_kernel<(1u << P)>() && prep_phases<P + 1>(); } else return true; }
extern "C" void kernel_launch(void* const* d_in, const int* in_sizes, int n_in, void* d_out, int out_size, void* d_ws, size_t ws_size, hipStream_t stream) {
    static int grid = 0;
    if (grid == 0) {
        if (n_in != 38 || out_size != (int)O_END || ws_size < WS_END) { fprintf(stderr, "kernel_launch: unexpected shapes (n_in %d, out %d, ws %zu)\n", n_in, out_size, ws_size); grid = -1; return; }
        int dev = 0, cus = 0;
        if (hipGetDevice(&dev) != hipSuccess || hipDeviceGetAttribute(&cus, hipDeviceAttributeMultiprocessorCount, dev) != hipSuccess) { grid = -1; return; }
        bool ok;
        if constexpr (MK_N_LAUNCHES == 1) ok = prep_kernel<0xFFFFu>(); else ok = prep_phases<0>();
        if (!ok) { grid = -1; return; }
        (void)hipGetLastError();
        grid = cus;
    }
    if (grid < 0) return;
    (void)hipMemsetAsync((char*)d_ws + WS_CTL, 0, CTL_ZERO_BYTES, stream);
    Args a{};
    for (int i = 0; i < 38; ++i) a.in[i] = (const float*)d_in[i];
    a.out = (float*)d_out; a.ws = (unsigned char*)d_ws;
    if constexpr (MK_N_LAUNCHES == 1) { a.ph_lo = 0; a.ph_hi = NPHASE; hipLaunchKernelGGL(yoco_fwd<0xFFFFu>, dim3(grid), dim3(NTHR), LDS_BYTES, stream, a); }
    else launch_phases<0>(grid, a, stream);
}
```

```cpp
#include <hip/hip_runtime.h>
#include <cstdio>
#include <cstdint>

#ifndef MK_N_LAUNCHES
#define MK_N_LAUNCHES 1
#endif

#ifndef PROBE_ATT2
#define PROBE_ATT2 0
#endif
#ifndef PROBE_UP2
#define PROBE_UP2 0
#endif
#ifndef PROBE_G2
#define PROBE_G2 0
#endif
#ifndef PROBE_SSM2
#define PROBE_SSM2 0
#endif
#ifndef PROBE_MFMA
#define PROBE_MFMA 0
#endif
#ifndef PROBE_FF2
#define PROBE_FF2 0
#endif
#ifndef PROBE_PO2
#define PROBE_PO2 0
#endif
#ifndef PROBE_DOWN2
#define PROBE_DOWN2 0
#endif
#ifndef PROBE_P2
#define PROBE_P2 0
#endif
#ifndef PROBE_S2
#define PROBE_S2 0
#endif
#define LAS __attribute__((address_space(3)))
typedef unsigned short bf16_t;
typedef short bf16x8 __attribute__((ext_vector_type(8)));
typedef short s16x4 __attribute__((ext_vector_type(4)));
typedef float f32x4 __attribute__((ext_vector_type(4)));
typedef float f32x2 __attribute__((ext_vector_type(2)));
typedef float f32x16 __attribute__((ext_vector_type(16)));
typedef unsigned u32x4 __attribute__((ext_vector_type(4)));
typedef unsigned u32x2 __attribute__((ext_vector_type(2)));

constexpr int DM = 2048, SEQ = 16384, NBAT = 2, MP = NBAT * SEQ, DB = 16, DSEQ = 32, MS = DB * DSEQ, MT = MP + MS;
constexpr int NTILE = MT / 256;
constexpr int DFF = 5632, DFF2 = 2 * DFF, PLE = 256, PAST = 2048;
constexpr int NG = 128, NST = 64, NH = 8, HD = 128, VD = 256;
constexpr float EPS = 1e-6f, SUBLN_EPS = 1e-5f;
constexpr int NWAVES = 8, NTHR = 512;

constexpr size_t O_Y = 0, O_YS = 67108864, O_SRE_P = 68157440, O_SIM_P = 68173824, O_CONV_P = 68190208, O_K_P = 68280320, O_V_P = 135389184,
                 O_SRE_S = 202498048, O_SIM_S = 202629120, O_CONV_S = 202760192, O_K_S = 203481088, O_V_S = 204529664, O_END = 205578240;

constexpr size_t MiB = 1u << 20;
constexpr size_t WS_CTL = 0, CTL_ZERO_BYTES = 1 * MiB;
constexpr size_t WS_WGLU = 1 * MiB;
constexpr size_t WS_WUP = 17 * MiB;
constexpr size_t WS_WDOWN = 105 * MiB;
constexpr size_t WS_WGATE = 149 * MiB;
constexpr size_t WS_WPROJ = 165 * MiB;
constexpr size_t WS_WQKV = 167 * MiB;
constexpr size_t WS_WO = 191 * MiB;
constexpr size_t WS_ROPE = 199 * MiB;
constexpr size_t WS_L16 = 202 * MiB;
constexpr size_t WS_CONVP = 202 * MiB + 131072;
constexpr size_t WS_QS = 203 * MiB;
constexpr size_t WS_PB = 209 * MiB;
constexpr size_t WS_PART0 = 226 * MiB, WS_PART1 = 235 * MiB;
constexpr size_t WS_HB = 244 * MiB;
constexpr size_t WS_UB = 374 * MiB;
constexpr size_t WS_PP = 504 * MiB;
constexpr size_t WS_BIG = 634 * MiB;
constexpr size_t WS_KB = 894 * MiB;
constexpr size_t WS_VB = 1022 * MiB;
constexpr size_t WS_END = 1150 * MiB;
constexpr size_t WS_SSM = WS_KB;
constexpr size_t SSM_G_BYTES = 262144;
constexpr size_t WS_ZSIDE = WS_VB;

constexpr int CW_BAR = 4096;

constexpr int RING_BYTES = 131072, LDSCTL_OFF = RING_BYTES, LDS_BYTES = 147456;

__device__ __forceinline__ unsigned cvt_pk_bf16(float lo, float hi) { unsigned r; asm volatile("v_cvt_pk_bf16_f32 %0, %1, %2" : "=v"(r) : "v"(lo), "v"(hi)); return r; }
__device__ __forceinline__ float bf2f(unsigned short b) { return __uint_as_float(((unsigned)b) << 16); }
__device__ __forceinline__ float fsigmoid(float x) { return __builtin_amdgcn_rcpf(1.f + __expf(-x)); }
__device__ __forceinline__ float gelu_tanh(float x) { const float t = 1.5957691216f * (x + 0.044715f * x * x * x); return x * fsigmoid(t); }
__device__ __forceinline__ float wave_sum(float v) {
#pragma unroll
    for (int o = 1; o < 64; o <<= 1) v += __shfl_xor(v, o);
    return v;
}
template <class T> __device__ __forceinline__ T* at32(T* base, unsigned elem) { return (T*)((char*)base + elem * (unsigned)sizeof(T)); }
template <class T> __device__ __forceinline__ const T* at32(const T* base, unsigned elem) { return (const T*)((const char*)base + elem * (unsigned)sizeof(T)); }
template <int CTRL> __device__ __forceinline__ float dppf(float v) { return __int_as_float(__builtin_amdgcn_mov_dpp(__float_as_int(v), CTRL, 0xf, 0xf, false)); }
#define DPP_ROR1 0x121
#define DPP_ROR2 0x122

namespace pg8 {
constexpr int BM = 256, BK = 64, HALF = 128, HTB = HALF * BK * 2, STAGE_BYTES = 8 * HTB, NXCD = 8, WGM = 4;
__host__ __device__ __forceinline__ int lds_byte(int r, int c) { const int st = (r >> 4) * 2 + (c >> 5), rr = r & 15, cc = c & 31, ob = rr * 64 + cc * 2; return st * 1024 + (ob ^ (((ob >> 9) & 1) << 5)); }
__host__ __device__ __forceinline__ void stage_rc(int b, int& R, int& C) { const int st = b / 1024, sb = b % 1024, swz = sb ^ (((sb >> 9) & 1) << 5); R = (st >> 1) * 16 + swz / 64; C = (st & 1) * 32 + (swz % 64) / 2; }
__host__ __device__ __forceinline__ int perm32(int rho) { const int n = rho >> 4, i = rho & 15; return 8 * (i >> 2) + 4 * n + (i & 3); }

struct Unit { int pm, pn, rb, aih; };
struct Gemm { const bf16_t* A; const bf16_t* Bt; int M, N, K; };

struct StaticOrder {
    int nM, nN, nwg, G, c;
    __host__ __device__ void init(int M, int N, int G_, int c_) { nM = M / BM; nN = N / BM; nwg = nM * nN; G = G_; c = c_; }
    __host__ __device__ bool next(int i, Unit& u) const {
        const long L = (long)i * G + c; if (L >= nwg) return false;
        int wgid = (int)L; { const int q = nwg / NXCD, r = nwg % NXCD, xcd = wgid % NXCD, off = wgid / NXCD; wgid = (xcd < r ? xcd * (q + 1) : r * (q + 1) + (xcd - r) * q) + off; }
        const int nig = WGM * nN, gid = wgid / nig, fm = gid * WGM, gsz = (nM - fm) < WGM ? (nM - fm) : WGM;
        u.pm = fm + ((wgid % nig) % gsz); u.pn = (wgid % nig) / gsz; u.rb = u.pm * BM; u.aih = 0; return true;
    }
    __device__ __forceinline__ void a_ready(const Unit&) const {}
    __device__ __forceinline__ void done(const Unit&) const {}
};
struct HalfOrder {
    int nN, nwg, G, c, pm0;
    __host__ __device__ void init(int pm0_, int N, int G_, int c_) { pm0 = pm0_; nN = N / BM; nwg = 4 * nN; G = G_; c = c_; }
    __host__ __device__ bool next(int i, Unit& u) const {
        const long L = (long)i * G + c; if (L >= nwg) return false;
        const int idx = (int)L, sub = idx & 3; u.pn = idx >> 2; u.pm = pm0 + (sub >> 1); u.aih = sub & 1; u.rb = u.pm * BM + 64 * u.aih; return true;
    }
    __device__ __forceinline__ void a_ready(const Unit&) const {}
    __device__ __forceinline__ void done(const Unit&) const {}
};

#ifndef PG8_SP2
#define PG8_SP2 true
#endif
#ifndef PG8_ALIGN
#define PG8_ALIGN true
#endif
template <class Epi, class Sched, bool HALFM = false, bool ALIGN_EPI = PG8_ALIGN, bool SP2 = PG8_SP2>
__device__ __forceinline__ void gemm_phase(LAS unsigned char* lds, const Gemm g, const Sched& S, const Epi& E, const int wid  ) {
    int lane_ = __builtin_amdgcn_mbcnt_hi(~0u, __builtin_amdgcn_mbcnt_lo(~0u, 0u)); asm volatile("" : "+v"(lane_));
    const int lane = lane_, tid = wid * 64 + lane, wr = wid >> 2, wc = wid & 3, fr = lane & 15, fq = lane >> 4;
    const int K = g.K, nt = K / BK;
    unsigned voffA[2], voffB[2];
#pragma unroll
    for (int i = 0; i < 2; ++i) { int R, C; stage_rc(tid * 16 + i * 8192, R, C); const int Rb = Epi::PERM ? ((R & ~31) + perm32(R & 31)) : R;
        const int Ra = (R >> 6) * 128 + (R & 63);
        voffA[i] = (unsigned)(Ra * K + C) * 2u; voffB[i] = (unsigned)(Rb * K + C) * 2u; }
    const __amdgpu_buffer_rsrc_t rsA_ = __builtin_amdgcn_make_buffer_rsrc((void*)g.A, 0, 0x7ffffff0, 0x00020000), rsB_ = __builtin_amdgcn_make_buffer_rsrc((void*)g.Bt, 0, 0x7ffffff0, 0x00020000);
    const size_t kstep = (size_t)(BK * 2);
    const size_t hstepB = (size_t)HALF * K * 2, hstepA = (size_t)64 * K * 2;
    const size_t tstep = (size_t)BM * K * 2;
    const unsigned ldsw = (unsigned)wid * 1024u;
    const int aoff = lds_byte(wr * 64 + fr, fq * 8), boff = lds_byte(wc * 32 + fr, fq * 8);
#define PG8_SA(b, h) (((b) * 2 + (h)) * HTB)
#define PG8_SB(b, h) ((4 + (b) * 2 + (h)) * HTB)
#define PG8_STAGE(bufoff, gbase, voff) do { const int so_ = (int)(unsigned)((const char*)(gbase) - PG8_BASE_##voff); _Pragma("unroll") for (int _i = 0; _i < 2; ++_i) \
        __builtin_amdgcn_raw_ptr_buffer_load_lds(PG8_RS_##voff, (LAS unsigned*)(lds + (bufoff) + ldsw + _i * 8192), 16, (int)(voff)[_i], so_, 0, 0); } while (0)
#define PG8_BASE_voffA ((const char*)g.A)
#define PG8_BASE_voffB ((const char*)g.Bt)
#define PG8_RS_voffA rsA_
#define PG8_RS_voffB rsB_
#define PG8_LDA(dst, b, h) do { _Pragma("unroll") for (int m = 0; m < 4; ++m) _Pragma("unroll") for (int k = 0; k < 2; ++k) dst[m][k] = *(const LAS bf16x8*)(lds + PG8_SA(b, h) + aoff + m * 2048 + k * 1024); } while (0)
#define PG8_LDB(dst, b, h) do { _Pragma("unroll") for (int n = 0; n < 2; ++n) _Pragma("unroll") for (int k = 0; k < 2; ++k) dst[n][k] = *(const LAS bf16x8*)(lds + PG8_SB(b, h) + boff + n * 2048 + k * 1024); } while (0)
#define PG8_MMA(ai, bj, At, Bt) do { __builtin_amdgcn_s_setprio(1); _Pragma("unroll") for (int m = 0; m < 4; ++m) _Pragma("unroll") for (int n = 0; n < 2; ++n) _Pragma("unroll") for (int k = 0; k < 2; ++k) \
        acc[ai][bj][m][n] = __builtin_amdgcn_mfma_f32_16x16x32_bf16(Bt[n][k], At[m][k], acc[ai][bj][m][n], 0, 0, 0); __builtin_amdgcn_s_setprio(0); } while (0)
#define PG8_WAIT_V(n) asm volatile("s_waitcnt vmcnt(" #n ")" ::: "memory")
#define PG8_WAIT_L(n) asm volatile("s_waitcnt lgkmcnt(" #n ")" ::: "memory")
#define PG8_BAR __builtin_amdgcn_s_barrier()
#define PG8_SCHED __builtin_amdgcn_sched_barrier(0)
    Unit cur, nxt; int ui = 0;
    if (!S.next(0, cur)) return;
    f32x4 acc[2][2][4][2];
#pragma unroll
    for (int a = 0; a < 2; ++a)
#pragma unroll
        for (int b = 0; b < 2; ++b)
#pragma unroll
            for (int m = 0; m < 4; ++m)
#pragma unroll
                for (int n = 0; n < 2; ++n) acc[a][b][m][n] = (f32x4){0.f, 0.f, 0.f, 0.f};
    bf16x8 At[4][2], B0[2][2], B1[2][2];
    static_assert(SP2 || !HALFM, "half-M units: SP2 loop only");
    const char* cA = (const char*)g.A + (size_t)cur.pm * tstep + (size_t)cur.aih * hstepA; const char* cB = (const char*)g.Bt + (size_t)cur.pn * tstep;
    S.a_ready(cur);
    if constexpr (SP2) {
        PG8_STAGE(PG8_SB(0, 0), cB, voffB); PG8_STAGE(PG8_SB(0, 1), cB + hstepB, voffB); PG8_STAGE(PG8_SA(0, 0), cA, voffA); if constexpr (!HALFM) PG8_STAGE(PG8_SA(0, 1), cA + hstepA, voffA);
        if (wr == 1) PG8_BAR;
        if constexpr (HALFM) PG8_WAIT_V(0); else PG8_WAIT_V(2);
        PG8_BAR;
        PG8_STAGE(PG8_SB(1, 0), cB + kstep, voffB); PG8_STAGE(PG8_SA(1, 0), cA + kstep, voffA); PG8_STAGE(PG8_SB(1, 1), cB + hstepB + kstep, voffB);
        PG8_WAIT_V(6); PG8_BAR;
    } else {
    PG8_STAGE(PG8_SB(0, 0), cB, voffB); PG8_STAGE(PG8_SA(0, 0), cA, voffA); PG8_STAGE(PG8_SB(0, 1), cB + hstepB, voffB); PG8_STAGE(PG8_SA(0, 1), cA + hstepA, voffA);
    if (wr == 1) PG8_BAR;
    PG8_WAIT_V(4); PG8_BAR;
    PG8_STAGE(PG8_SB(1, 0), cB + kstep, voffB); PG8_STAGE(PG8_SA(1, 0), cA + kstep, voffA); PG8_STAGE(PG8_SB(1, 1), cB + hstepB + kstep, voffB);
    PG8_WAIT_V(6); PG8_BAR;
    }
    for (;;) {
        const bool has_next = S.next(ui + 1, nxt);
        const char* nA = has_next ? (const char*)g.A + (size_t)nxt.pm * tstep + (size_t)nxt.aih * hstepA : cA; const char* nB = has_next ? (const char*)g.Bt + (size_t)nxt.pn * tstep : cB;
        for (int t = 0; t < nt; t += 2) {
            const bool last = (t == nt - 2);
            const char* a1 = cA + (size_t)(t + 1) * kstep;
            const char* a2 = last ? nA : cA + (size_t)(t + 2) * kstep; const char* b2 = last ? nB : cB + (size_t)(t + 2) * kstep;
            const char* a3 = a2 + kstep; const char* b3 = b2 + kstep;
            if (last && has_next) S.a_ready(nxt);
            if constexpr (SP2) {
#define PG8_WAIT_VH() do { if constexpr (HALFM) PG8_WAIT_V(6); else PG8_WAIT_V(8); } while (0)
            PG8_LDB(B0, 0, 0); PG8_LDB(B1, 0, 1); PG8_SCHED; PG8_LDA(At, 0, 0); if constexpr (!HALFM) PG8_STAGE(PG8_SA(1, 1), a1 + hstepA, voffA);
            PG8_WAIT_VH(); PG8_WAIT_L(0); PG8_BAR; PG8_MMA(0, 0, At, B0); PG8_MMA(0, 1, At, B1); PG8_BAR; PG8_SCHED;
            if constexpr (!HALFM) PG8_LDA(At, 0, 1); PG8_STAGE(PG8_SB(0, 0), b2, voffB); PG8_STAGE(PG8_SB(0, 1), b2 + hstepB, voffB); PG8_STAGE(PG8_SA(0, 0), a2, voffA);
            PG8_WAIT_VH(); PG8_WAIT_L(0); PG8_BAR; if constexpr (!HALFM) { PG8_MMA(1, 0, At, B0); PG8_MMA(1, 1, At, B1); } PG8_BAR; PG8_SCHED;
            PG8_LDB(B0, 1, 0); PG8_LDB(B1, 1, 1); PG8_SCHED; PG8_LDA(At, 1, 0); if constexpr (!HALFM) PG8_STAGE(PG8_SA(0, 1), a2 + hstepA, voffA);
            PG8_WAIT_VH(); PG8_WAIT_L(0); PG8_BAR; PG8_MMA(0, 0, At, B0); PG8_MMA(0, 1, At, B1); PG8_BAR; PG8_SCHED;
            if constexpr (!HALFM) PG8_LDA(At, 1, 1); PG8_STAGE(PG8_SB(1, 0), b3, voffB); PG8_STAGE(PG8_SB(1, 1), b3 + hstepB, voffB); PG8_STAGE(PG8_SA(1, 0), a3, voffA);
            PG8_WAIT_VH(); PG8_WAIT_L(0); PG8_BAR; if constexpr (!HALFM) { PG8_MMA(1, 0, At, B0); PG8_MMA(1, 1, At, B1); } PG8_BAR; PG8_SCHED;
#undef PG8_WAIT_VH
            } else {
            PG8_LDB(B0, 0, 0); PG8_SCHED; PG8_LDA(At, 0, 0); PG8_STAGE(PG8_SA(1, 1), a1 + hstepA, voffA);
            PG8_WAIT_L(8); PG8_BAR; PG8_WAIT_L(0); PG8_MMA(0, 0, At, B0); PG8_BAR; PG8_SCHED;
            PG8_LDB(B1, 0, 1); PG8_STAGE(PG8_SB(0, 0), b2, voffB);
            PG8_BAR; PG8_WAIT_L(0); PG8_MMA(0, 1, At, B1); PG8_BAR;
            PG8_LDA(At, 0, 1); PG8_STAGE(PG8_SA(0, 0), a2, voffA);
            PG8_BAR; PG8_WAIT_L(0); PG8_MMA(1, 0, At, B0); PG8_BAR; PG8_SCHED;
            PG8_STAGE(PG8_SB(0, 1), b2 + hstepB, voffB);
            PG8_WAIT_V(6); PG8_BAR; PG8_MMA(1, 1, At, B1); PG8_BAR;
            PG8_LDB(B0, 1, 0); PG8_SCHED; PG8_LDA(At, 1, 0); PG8_STAGE(PG8_SA(0, 1), a2 + hstepA, voffA);
            PG8_WAIT_L(8); PG8_BAR; PG8_WAIT_L(0); PG8_MMA(0, 0, At, B0); PG8_BAR; PG8_SCHED;
            PG8_LDB(B1, 1, 1); PG8_STAGE(PG8_SB(1, 0), b3, voffB);
            PG8_BAR; PG8_WAIT_L(0); PG8_MMA(0, 1, At, B1); PG8_BAR;
            PG8_LDA(At, 1, 1); PG8_STAGE(PG8_SA(1, 0), a3, voffA);
            PG8_BAR; PG8_WAIT_L(0); PG8_MMA(1, 0, At, B0); PG8_BAR; PG8_SCHED;
            PG8_STAGE(PG8_SB(1, 1), b3 + hstepB, voffB);
            PG8_WAIT_V(6); PG8_BAR; PG8_MMA(1, 1, At, B1); PG8_BAR;
            }
        }
        if constexpr (ALIGN_EPI) { if (wr == 0) PG8_BAR; }
        E.template run<HALFM ? 1 : 2>(acc, cur, wr, wc, fr, fq); S.done(cur);
        if (!has_next) break;
#pragma unroll
        for (int a = 0; a < 2; ++a)
#pragma unroll
            for (int b = 0; b < 2; ++b)
#pragma unroll
                for (int m = 0; m < 4; ++m)
#pragma unroll
                    for (int n = 0; n < 2; ++n) acc[a][b][m][n] = (f32x4){0.f, 0.f, 0.f, 0.f};
        cur = nxt; cA = nA; cB = nB; ++ui;
        if constexpr (ALIGN_EPI) { if (wr == 1) PG8_BAR; }
    }
    PG8_WAIT_V(0);
    if constexpr (!ALIGN_EPI) { if (wr == 0) PG8_BAR; }
    PG8_BAR;
#undef PG8_SA
#undef PG8_SB
#undef PG8_STAGE
#undef PG8_BASE_voffA
#undef PG8_BASE_voffB
#undef PG8_RS_voffA
#undef PG8_RS_voffB
#undef PG8_LDA
#undef PG8_LDB
#undef PG8_MMA
#undef PG8_WAIT_V
#undef PG8_WAIT_L
#undef PG8_BAR
#undef PG8_SCHED
}
}
using pg8::Unit;

typedef f32x4 Acc[2][2][4][2];

__device__ __forceinline__ unsigned part_idx(int ph, int slot, int fr) { return (unsigned)(((ph * 64 + slot) * 16 + fr) * 8); }
constexpr int RSTD_LDS = RING_BYTES;
template <int NP, int NAI> __device__ __forceinline__ void load_rstd(const float* part, int rowbase, int fr, int fq, float (&rs)[2][4], LAS unsigned char* lds, int wid, int key) {
    LAS float* rc = (LAS float*)(lds + RSTD_LDS) + wid * 128; LAS int* tagp = (LAS int*)(lds + LDS_BYTES - 256) + 32 + wid;
    const int want = key | rowbase;
    if (__builtin_amdgcn_readfirstlane(*tagp) == want) {
#pragma unroll
        for (int ai = 0; ai < NAI; ++ai)
#pragma unroll
            for (int m = 0; m < 4; ++m) rs[ai][m] = rc[64 * ai + 16 * m + fr];
        return;
    }
    { const int ph = rowbase >> 7, q0 = (rowbase >> 4) & 7;
      f32x4 sacc[2] = {{0.f, 0.f, 0.f, 0.f}, {0.f, 0.f, 0.f, 0.f}};
#pragma unroll
      for (int i = 0; i < NP / 4; ++i) { const unsigned o_ = part_idx(ph, fq * (NP / 4) + i, fr) + q0;
#pragma unroll
          for (int ai = 0; ai < NAI; ++ai) sacc[ai] += *(const f32x4*)at32(part, o_ + 4 * ai);
          if ((i & 3) == 3) asm volatile("" : "+v"(sacc[0]), "+v"(sacc[1]));     }
#pragma unroll
      for (int ai = 0; ai < NAI; ++ai)
#pragma unroll
        for (int m = 0; m < 4; ++m) { float sv = sacc[ai][m]; sv += __shfl_xor(sv, 16); sv += __shfl_xor(sv, 32);
            rs[ai][m] = rsqrtf(sv * (1.0f / DM) + EPS);
            if (NAI == 2 && fq == 0) rc[64 * ai + 16 * m + fr] = rs[ai][m]; } }
    if (NAI == 2) { if (fr == 0 && fq == 0) *tagp = want; }
    asm volatile("s_waitcnt lgkmcnt(0)" ::: "memory");
}

template <int NAI> __device__ __forceinline__ void store_part4(float* part, const Unit& u, int wr, int slot, int fr, int fq, int ai, const f32x4 v) {
    if (fq == 0) *(f32x4*)at32(part, part_idx(u.pm * 2 + wr, slot, fr) + 4u * (unsigned)(NAI == 1 ? u.aih : ai)) = v;
}
struct EpiGlu {
    static constexpr bool PERM = true;
    const float* xp; const float* xs; bf16_t* hb; float* part;
    template <int NAI> __device__ __forceinline__ void run(Acc& acc, const Unit& u, int wr, int wc, int fr, int fq) const {
        asm volatile("" : "+v"(fr), "+v"(fq));
        const int rowbase = u.rb + wr * 128 + fr, col0 = u.pn * 128 + wc * 32 + 8 * fq;
        const bool smp = u.pm >= MP / 256; const float* xb = smp ? xs : xp; const int rsub = smp ? MP : 0;
#pragma unroll
        for (int ai = 0; ai < NAI; ++ai) {
            f32x4 xv[4][2]; f32x4 ssv;
#pragma unroll
            for (int m = 0; m < 4; ++m)
#pragma unroll
                for (int n = 0; n < 2; ++n) xv[m][n] = *(const f32x4*)at32(xb, (unsigned)((rowbase + 64 * ai + 16 * m - rsub) * DM + col0 + 4 * n));
#pragma unroll
            for (int m = 0; m < 4; ++m) {
                const int r = rowbase + 64 * ai + 16 * m; float ss = 0.f; u32x4 w;
#pragma unroll
                for (int n = 0; n < 2; ++n) {
                    const f32x4 a = acc[ai][0][m][n], b = acc[ai][1][m][n]; f32x4 o;
#pragma unroll
                    for (int j = 0; j < 4; ++j) { o[j] = xv[m][n][j] + a[j] * fsigmoid(b[j]); ss += o[j] * o[j]; }
                    w[2 * n] = cvt_pk_bf16(o[0], o[1]); w[2 * n + 1] = cvt_pk_bf16(o[2], o[3]);
                }
                *(u32x4*)at32(hb, (unsigned)(r * DM + col0)) = w;
                ss += __shfl_xor(ss, 16); ss += __shfl_xor(ss, 32);
                ssv[m] = ss;
            }
            store_part4<NAI>(part, u, wr, u.pn * 4 + wc, fr, fq, ai, ssv);
        }
    }
};

struct EpiResid {
    static constexpr bool PERM = true;
    bf16_t* hb; float* part;
    template <int NAI> __device__ __forceinline__ void run(Acc& acc, const Unit& u, int wr, int wc, int fr, int fq) const {
        asm volatile("" : "+v"(fr), "+v"(fq));
        const int rowbase = u.rb + wr * 128 + fr, col0 = u.pn * 256 + wc * 32 + 8 * fq;
#pragma unroll
        for (int ai = 0; ai < NAI; ++ai) {
            u32x4 hv[4][2]; f32x4 ssv;
#pragma unroll
            for (int m = 0; m < 4; ++m)
#pragma unroll
                for (int bj = 0; bj < 2; ++bj) hv[m][bj] = *(const u32x4*)at32((const bf16_t*)hb, (unsigned)((rowbase + 64 * ai + 16 * m) * DM + col0 + 128 * bj));
#pragma unroll
            for (int m = 0; m < 4; ++m) {
                const int r = rowbase + 64 * ai + 16 * m; float ss = 0.f;
#pragma unroll
                for (int bj = 0; bj < 2; ++bj) { u32x4 w;
#pragma unroll
                    for (int n = 0; n < 2; ++n) {
                        const unsigned h0 = hv[m][bj][2 * n], h1 = hv[m][bj][2 * n + 1]; const f32x4 a = acc[ai][bj][m][n];
                        const f32x4 o = {__uint_as_float(h0 << 16) + a[0], __uint_as_float(h0 & 0xffff0000u) + a[1], __uint_as_float(h1 << 16) + a[2], __uint_as_float(h1 & 0xffff0000u) + a[3]};
                        ss += (o[0] * o[0] + o[1] * o[1]) + (o[2] * o[2] + o[3] * o[3]);
                        w[2 * n] = cvt_pk_bf16(o[0], o[1]); w[2 * n + 1] = cvt_pk_bf16(o[2], o[3]);
                    }
                    *(u32x4*)at32(hb, (unsigned)(r * DM + col0 + 128 * bj)) = w; }
                ss += __shfl_xor(ss, 16); ss += __shfl_xor(ss, 32);
                ssv[m] = ss;
            }
            store_part4<NAI>(part, u, wr, u.pn * 4 + wc, fr, fq, ai, ssv);
        }
    }
};

struct EpiBf16 {
    static constexpr bool PERM = true;
    bf16_t* O; int ldc;
    template <int NAI> __device__ __forceinline__ void run(Acc& acc, const Unit& u, int wr, int wc, int fr, int fq) const {
        asm volatile("" : "+v"(fr), "+v"(fq));
        const int rowbase = u.rb + wr * 128 + fr, col0 = u.pn * 256 + wc * 32 + 8 * fq;
#pragma unroll
        for (int ai = 0; ai < NAI; ++ai)
#pragma unroll
            for (int m = 0; m < 4; ++m) { const unsigned ro = (unsigned)((rowbase + 64 * ai + 16 * m) * ldc + col0);
#pragma unroll
                for (int bj = 0; bj < 2; ++bj) { const f32x4 v0 = acc[ai][bj][m][0], v1 = acc[ai][bj][m][1];
                    u32x4 w = {cvt_pk_bf16(v0[0], v0[1]), cvt_pk_bf16(v0[2], v0[3]), cvt_pk_bf16(v1[0], v1[1]), cvt_pk_bf16(v1[2], v1[3])}; *(u32x4*)at32(O, ro + (unsigned)(bj * 128)) = w; } }
    }
};

struct EpiPle {
    static constexpr bool PERM = true;
    const float* partin; const bf16_t* hsrc; bf16_t* ppio; float* part; LAS unsigned char* lds; int key;
    template <int NAI> __device__ __forceinline__ void run(Acc& acc, const Unit& u, int wr, int wc, int fr, int fq) const {
        asm volatile("" : "+v"(fr), "+v"(fq));
        const int rowbase = u.rb + wr * 128 + fr, col0 = u.pn * 256 + wc * 32 + 8 * fq;
        float rs[2][4]; load_rstd<32, NAI>(partin, u.rb + wr * 128, fr, fq, rs, lds, wr * 4 + wc, key); f32x4 ssv = {0.f, 0.f, 0.f, 0.f};
#pragma unroll
        for (int q2 = 0; q2 < 2 * NAI; ++q2) {
            const int ai = q2 >> 1, m0 = (q2 & 1) * 2;
            u32x4 hv[2][2], pv[2][2];
#pragma unroll
            for (int mm = 0; mm < 2; ++mm)
#pragma unroll
                for (int bj = 0; bj < 2; ++bj) { const unsigned o_ = (unsigned)((rowbase + 64 * ai + 16 * (m0 + mm)) * DM + col0 + 128 * bj);
                    hv[mm][bj] = *(const u32x4*)at32(hsrc, o_); pv[mm][bj] = *(const u32x4*)at32((const bf16_t*)ppio, o_); }
#pragma unroll
            for (int mm = 0; mm < 2; ++mm) {
                const int m = m0 + mm, r = rowbase + 64 * ai + 16 * m; float ss = 0.f;
#pragma unroll
                for (int bj = 0; bj < 2; ++bj) { u32x4 w;
#pragma unroll
                    for (int n = 0; n < 2; ++n) {
                        const unsigned pw0 = pv[mm][bj][2 * n], pw1 = pv[mm][bj][2 * n + 1], h0 = hv[mm][bj][2 * n], h1 = hv[mm][bj][2 * n + 1];
                        const f32x4 a = acc[ai][bj][m][n] * rs[ai][m]; f32x4 o;
                        o[0] = __uint_as_float(h0 << 16) + __uint_as_float(pw0 << 16) * fsigmoid(a[0]); o[1] = __uint_as_float(h0 & 0xffff0000u) + __uint_as_float(pw0 & 0xffff0000u) * fsigmoid(a[1]);
                        o[2] = __uint_as_float(h1 << 16) + __uint_as_float(pw1 << 16) * fsigmoid(a[2]); o[3] = __uint_as_float(h1 & 0xffff0000u) + __uint_as_float(pw1 & 0xffff0000u) * fsigmoid(a[3]);
                        ss += (o[0] * o[0] + o[1] * o[1]) + (o[2] * o[2] + o[3] * o[3]);
                        w[2 * n] = cvt_pk_bf16(o[0], o[1]); w[2 * n + 1] = cvt_pk_bf16(o[2], o[3]);
                    }
                    *(u32x4*)at32(ppio, (unsigned)(r * DM + col0 + 128 * bj)) = w; }
                ss += __shfl_xor(ss, 16); ss += __shfl_xor(ss, 32);
                ssv[m] = ss;
            }
            if (q2 & 1) store_part4<NAI>(part, u, wr, u.pn * 4 + wc, fr, fq, ai, ssv);
        }
    }
};

template <int NP> struct EpiUp {
    static constexpr bool PERM = true;
    const float* partin; bf16_t* act; const float* cw; const float* cb; const float* state; float* zside; float* conv_p; float* conv_s; LAS unsigned char* lds; int key;
    template <int NAI> __device__ __forceinline__ void run(Acc& acc, const Unit& u, int wr, int wc, int fr, int fq) const {
        asm volatile("" : "+v"(fr), "+v"(fq));
        const bool sample = u.pm >= MP / 256;
        const int rowhalf = u.rb + wr * 128;
        { float rs[2][4]; load_rstd<NP, NAI>(partin, rowhalf, fr, fq, rs, lds, wr * 4 + wc, key);
#pragma unroll
          for (int ai = 0; ai < NAI; ++ai)
#pragma unroll
            for (int bj = 0; bj < 2; ++bj)
#pragma unroll
                for (int m = 0; m < 4; ++m)
#pragma unroll
                    for (int n = 0; n < 2; ++n) acc[ai][bj][m][n] = acc[ai][bj][m][n] * rs[ai][m]; }
        const int ht = u.pm * 2 + wr;
        const bool seqstart = (!sample) && ((ht & 127) == 0);
        const bool seqend = (!sample) && ((ht & 127) == 127);
        const int sb2 = ((rowhalf - MP) >> 5) * 2;
        const int c8 = u.pn * 128 + wc * 32 + 8 * fq;
#pragma unroll
        for (int n = 0; n < 2; ++n) {
            const int c0 = c8 + 4 * n;
            if (NAI == 2 && !sample) {
                if (fr < 2) { const unsigned o = (unsigned)((ht * 4 + fr) * DFF2 + c0); *(f32x4*)at32(zside, o) = acc[0][0][0][n]; *(f32x4*)at32(zside, o + DFF) = acc[0][1][0][n]; }
                if (fr >= 14) { const unsigned o = (unsigned)((ht * 4 + 2 + (fr - 14)) * DFF2 + c0); *(f32x4*)at32(zside, o) = acc[NAI - 1][0][3][n]; *(f32x4*)at32(zside, o + DFF) = acc[NAI - 1][1][3][n];
                    if (seqend) { const unsigned o2 = (unsigned)(((ht >> 7) * 2 + (fr - 14)) * DFF2 + c0); *(f32x4*)at32(conv_p, o2) = acc[NAI - 1][0][3][n]; *(f32x4*)at32(conv_p, o2 + DFF) = acc[NAI - 1][1][3][n]; } }
            } else if (sample && fr >= 14) {
#pragma unroll
                for (int qq = 1; qq < 4 * NAI; qq += 2) { const unsigned o2 = (unsigned)((sb2 + (qq >> 1) * 2 + (fr - 14)) * DFF2 + c0);
                    *(f32x4*)at32(conv_s, o2) = acc[qq >> 2][0][qq & 3][n]; *(f32x4*)at32(conv_s, o2 + DFF) = acc[qq >> 2][1][qq & 3][n]; }
            }
        }
        unsigned outp[4 * NAI][4];
        f32x4 nr0 = *(const f32x4*)at32(cw, (unsigned)(c8 * 8)), nr1 = *(const f32x4*)at32(cw, (unsigned)(c8 * 8 + 4)), nr2 = *(const f32x4*)at32(cw, (unsigned)(c8 * 8 + 8)), nr3 = *(const f32x4*)at32(cw, (unsigned)(c8 * 8 + 12));
#pragma unroll
        for (int n = 0; n < 2; ++n)
#pragma unroll
            for (int jp = 0; jp < 2; ++jp) {
                const int c0 = c8 + 4 * n + 2 * jp;
                const f32x4 ra = nr0, rb_ = nr1, rc_ = nr2, rd_ = nr3;
                asm volatile("" ::: "memory");
                if (n * 2 + jp < 3) { const unsigned o = (unsigned)((c0 + 2) * 8); nr0 = *(const f32x4*)at32(cw, o); nr1 = *(const f32x4*)at32(cw, o + 4); nr2 = *(const f32x4*)at32(cw, o + 8); nr3 = *(const f32x4*)at32(cw, o + 12); }
                const f32x2 w0v = {ra[0], ra[1]}, w1v = {ra[2], ra[3]}, w2v = {rb_[0], rb_[1]}, bv = {rb_[2], rb_[3]};
                const f32x2 w0g = {rc_[0], rc_[1]}, w1g = {rc_[2], rc_[3]}, w2g = {rd_[0], rd_[1]}, bg = {rd_[2], rd_[3]};
                f32x2 p1v = {0.f, 0.f}, p2v = p1v, p1g = p1v, p2g = p1v;
#pragma unroll
                for (int q = 0; q < 4 * NAI; ++q) {
                    const int ai = q >> 2, m = q & 3;
                    const f32x2 zv = {acc[ai][0][m][n][2 * jp], acc[ai][0][m][n][2 * jp + 1]}, zg = {acc[ai][1][m][n][2 * jp], acc[ai][1][m][n][2 * jp + 1]};
                    if (sample && !(q & 1)) {
                        f32x2 hv = {0.f, 0.f}, hg = hv;
                        if (fr >= 14) { const unsigned so = (unsigned)((sb2 + (q >> 1) * 2 + (fr - 14)) * DFF2 + c0); hv = *(const f32x2*)at32(state, so); hg = *(const f32x2*)at32(state, so + DFF); }
#pragma unroll
                        for (int j = 0; j < 2; ++j) { p1v[j] = dppf<DPP_ROR1>(hv[j]); p2v[j] = dppf<DPP_ROR2>(hv[j]); p1g[j] = dppf<DPP_ROR1>(hg[j]); p2g[j] = dppf<DPP_ROR2>(hg[j]); }
                    }
                    f32x2 r1v, r2v, r1g, r2g, P1v, P2v, P1g, P2g;
#pragma unroll
                    for (int j = 0; j < 2; ++j) {
                        r1v[j] = dppf<DPP_ROR1>(zv[j]); r2v[j] = dppf<DPP_ROR2>(zv[j]); r1g[j] = dppf<DPP_ROR1>(zg[j]); r2g[j] = dppf<DPP_ROR2>(zg[j]);
                        P1v[j] = fr >= 1 ? r1v[j] : p1v[j]; P2v[j] = fr >= 2 ? r2v[j] : p2v[j]; P1g[j] = fr >= 1 ? r1g[j] : p1g[j]; P2g[j] = fr >= 2 ? r2g[j] : p2g[j];
                    }
                    const f32x2 cv = __builtin_elementwise_fma(w0v, P2v, __builtin_elementwise_fma(w1v, P1v, __builtin_elementwise_fma(w2v, zv, bv)));
                    const f32x2 cg = __builtin_elementwise_fma(w0g, P2g, __builtin_elementwise_fma(w1g, P1g, __builtin_elementwise_fma(w2g, zg, bg)));
                    const f32x2 tt = cg * (f32x2){-1.4426950408889634f, -1.4426950408889634f};
                    f32x2 ee = {__builtin_amdgcn_exp2f(tt[0]), __builtin_amdgcn_exp2f(tt[1])}; ee = ee + (f32x2){1.f, 1.f};
                    const f32x2 sg = {__builtin_amdgcn_rcpf(ee[0]), __builtin_amdgcn_rcpf(ee[1])};
                    const f32x2 o = cv * cg * sg;
                    p1v = r1v; p2v = r2v; p1g = r1g; p2g = r2g;
                    outp[q][2 * n + jp] = cvt_pk_bf16(o[0], o[1]);
                }
            }
#pragma unroll
        for (int q = 0; q < 4 * NAI; ++q) {
            const bool deferred = (!sample) && q == 0 && fr < 2 && !seqstart;
            if (!deferred) { u32x4 w = {outp[q][0], outp[q][1], outp[q][2], outp[q][3]}; *(u32x4*)at32(act, (unsigned)((rowhalf + 16 * q + fr) * DFF + c8)) = w; }
        }
    }
};

struct EpiQkv {
    static constexpr bool PERM = false;
    const float* partin; const float* rope; bf16_t* qb; float* qs; bf16_t* kb; bf16_t* vb; float* out; LAS unsigned char* lds; int key;
    template <int NAI> __device__ __forceinline__ void run(Acc& acc, const Unit& u, int wr, int wc, int fr, int fq) const {
        asm volatile("" : "+v"(fr), "+v"(fq));
        const int rowhalf = u.rb + wr * 128;
        float rs[2][4]; load_rstd<32, NAI>(partin, rowhalf, fr, fq, rs, lds, wr * 4 + wc, key);
        const int which = u.pn >> 3, head = u.pn & 7;
#pragma unroll
        for (int ai = 0; ai < NAI; ++ai)
#pragma unroll
            for (int m = 0; m < 4; ++m) {
                const int r = rowhalf + 64 * ai + 16 * m + fr; const bool smp = r >= MP;
                const int pos = smp ? PAST + ((r - MP) & 31) : (r & (SEQ - 1));
                f32x4 cs = {1.f, 1.f, 1.f, 1.f}, sn = {0.f, 0.f, 0.f, 0.f};
                if (which < 2 && wc == 0) { cs = *(const f32x4*)at32(rope, (unsigned)(pos * 32 + 4 * fq)); sn = *(const f32x4*)at32(rope, (unsigned)(pos * 32 + 16 + 4 * fq)); }
#pragma unroll
                for (int bj = 0; bj < 2; ++bj) {
                    f32x4 v0 = acc[ai][bj][m][0] * rs[ai][m], v1 = acc[ai][bj][m][1] * rs[ai][m];
                    if (which < 2 && wc == 0) { const f32x4 a = v0, b = v1; v0 = a * cs - b * sn; v1 = b * cs + a * sn; }
                    const int c = head * 256 + bj * 128 + wc * 32 + 4 * fq;
                    u32x2 w0, w1; w0.x = cvt_pk_bf16(v0[0], v0[1]); w0.y = cvt_pk_bf16(v0[2], v0[3]); w1.x = cvt_pk_bf16(v1[0], v1[1]); w1.y = cvt_pk_bf16(v1[2], v1[3]);
                    if (which == 0) {
                        *(u32x2*)at32(qb, (unsigned)(r * DM + c)) = w0; *(u32x2*)at32(qb, (unsigned)(r * DM + c + 16)) = w1;
                        if (smp) { *(f32x4*)at32(qs, (unsigned)((r - MP) * DM + c)) = v0; *(f32x4*)at32(qs, (unsigned)((r - MP) * DM + c + 16)) = v1; }
                    } else {
                        float* ob = out + (smp ? (which == 1 ? O_K_S : O_V_S) : (which == 1 ? O_K_P : O_V_P)); const unsigned oo = (unsigned)((smp ? r - MP : r) * DM + c);
                        *(f32x4*)at32(ob, oo) = v0; *(f32x4*)at32(ob, oo + 16u) = v1;
                        if (!smp) { bf16_t* bp = (which == 1 ? kb : vb); *(u32x2*)at32(bp, (unsigned)(r * DM + c)) = w0; *(u32x2*)at32(bp, (unsigned)(r * DM + c + 16)) = w1; }
                    }
                }
            }
    }
};

#define XB_TMO      128
#define XB_XCNT(j)  (256  + 64 * (j))
#define XB_XSUB(j)  (1280 + 64 * (j))
#define XB_XGEN(j)  (2304 + 64 * (j))
#define XB_TOP      3328
#define XB_TOPGEN   3392
#define XCD_BAR_WORDS 3456
#define XB_SPIN_CAP (1u << 22)

__device__ __forceinline__ unsigned xb_ld(unsigned* p)              { return __hip_atomic_load(p, __ATOMIC_RELAXED, __HIP_MEMORY_SCOPE_AGENT); }
__device__ __forceinline__ unsigned xb_add(unsigned* p, unsigned v) { return __hip_atomic_fetch_add(p, v, __ATOMIC_RELAXED, __HIP_MEMORY_SCOPE_AGENT); }
__device__ __forceinline__ unsigned xb_xcc_id() { return (unsigned)__builtin_amdgcn_s_getreg((3 << 11) | 20) & 0xFu; }
#define XB_SPIN(cond, bar) do { unsigned _sp = 0; while (cond) { __builtin_amdgcn_s_sleep(1); \
    if ((++_sp & 255u) == 0u) { if (xb_ld(&(bar)[XB_TMO])) break; if (_sp > XB_SPIN_CAP) { atomicAdd(&(bar)[XB_TMO], 1u); break; } } } } while (0)

struct XcdBarrier { unsigned* bar; unsigned x; volatile LAS unsigned* st; };

__device__ __forceinline__ XcdBarrier xcd_barrier_post(unsigned* bar, volatile LAS unsigned* st) {
    XcdBarrier b; b.bar = bar; b.x = xb_xcc_id(); b.st = st;
    if (threadIdx.x == 0) (void)xb_add(&bar[XB_XCNT(b.x)], 1u);
    return b;
}
__device__ __forceinline__ void xcd_barrier_complete(unsigned* bar, unsigned x, unsigned& nloc, unsigned& nx) {
    const unsigned G = gridDim.x * gridDim.y * gridDim.z;
    unsigned sum, cnt, mine, sp = 0u;
    for (;;) {
        sum = 0u; cnt = 0u; mine = 0u;
#pragma unroll
        for (unsigned j = 0; j < 16; ++j) { const unsigned c = xb_ld(&bar[XB_XCNT(j)]); sum += c; cnt += (c > 0u) ? 1u : 0u; mine = (j == x) ? c : mine; }
        if (sum == G) break;
        __builtin_amdgcn_s_sleep(1);
        if ((++sp & 255u) == 0u) { if (xb_ld(&bar[XB_TMO])) break; if (sp > XB_SPIN_CAP) { atomicAdd(&bar[XB_TMO], 1u); break; } }
    }
    nloc = mine > 0u ? mine : 1u; nx = cnt > 0u ? cnt : 1u;
}
__device__ __forceinline__ void xcd_barrier(const XcdBarrier& b) {
    asm volatile("s_waitcnt vmcnt(0)" ::: "memory");
    __syncthreads();
    if (threadIdx.x == 0) {
        unsigned* bar = b.bar;
        __builtin_amdgcn_s_waitcnt(0);
        unsigned nloc = b.st[0], nx = b.st[1];
        if (nloc == 0u) { xcd_barrier_complete(bar, b.x, nloc, nx); b.st[0] = nloc; b.st[1] = nx; }
        const unsigned old = xb_add(&bar[XB_XSUB(b.x)], 1u);
        const unsigned gen = old / nloc;
        if (old + 1u == (gen + 1u) * nloc) {
            __builtin_amdgcn_fence(__ATOMIC_RELEASE, "agent");
            asm volatile("s_waitcnt vmcnt(0)" ::: "memory");
            const unsigned og = xb_add(&bar[XB_TOP], 1u);
            const unsigned tg = og / nx;
            if (og + 1u == (tg + 1u) * nx) xb_add(&bar[XB_TOPGEN], 1u);
            else XB_SPIN(xb_ld(&bar[XB_TOPGEN]) == tg, bar);
            __builtin_amdgcn_fence(__ATOMIC_ACQUIRE, "agent");
            xb_add(&bar[XB_XGEN(b.x)], 1u);
            asm volatile("s_waitcnt vmcnt(0)" ::: "memory");
        } else {
            XB_SPIN(xb_ld(&bar[XB_XGEN(b.x)]) == gen, bar);
            __builtin_amdgcn_fence(__ATOMIC_ACQUIRE, "agent");
            asm volatile("s_waitcnt vmcnt(0)" ::: "memory");
        }
    }
    __syncthreads();
}

namespace att {
constexpr float SCALE = 0.08838834764831845f, THR = 8.f;
constexpr int NW = 8, QBLK = 32, KVBLK = 64, QB = NW * QBLK, D = 128;
constexpr int SHM_V = KVBLK * D * 2, SHM_K = KVBLK * D * 2;
constexpr int LDS_ATT = 2 * SHM_V + 2 * SHM_K + NW * 64 * 4;
constexpr int QS = DM, KS = DM, OS = 2 * DM;
template <class A, class Bt> struct same_t { static constexpr bool v = false; };
template <class A> struct same_t<A, A> { static constexpr bool v = true; };
#define KSWZ(row, colB) ((row) * 256 + ((colB) ^ (((row) & 7) << 4)))
#define SBAR() __builtin_amdgcn_sched_barrier(0)
__device__ __forceinline__ int v_st(int k, int c) { const int kk = (k & ~0xC) | ((k & 4) << 1) | ((k & 8) >> 1); return ((kk >> 3) * 4 + (c >> 5)) * 512 + ((kk & 7) * 32 + (c & 31)) * 2; }
__device__ __forceinline__ int v_rd_base(int lane) { return ((lane & 3) << 3) | (((lane >> 2) & 3) << 6) | (((lane >> 4) & 1) << 5) | (((lane >> 5) & 1) << 8); }
constexpr int v_rd_off(int d0, int ks, int half) { return d0 * 512 + ks * 4096 + half * 2048; }
__device__ __forceinline__ int crow(int r, int hi) { return (r & 3) + 8 * (r >> 2) + 4 * hi; }
__device__ __forceinline__ unsigned cvtpk(float lo, float hi) { unsigned r; asm volatile("v_cvt_pk_bf16_f32 %0, %1, %2" : "=v"(r) : "v"(lo), "v"(hi)); return r; }
__device__ __forceinline__ bf16x8 pack8(f32x4 a, f32x4 b) { u32x4 w = {cvtpk(a[0], a[1]), cvtpk(a[2], a[3]), cvtpk(b[0], b[1]), cvtpk(b[2], b[3])}; return *reinterpret_cast<bf16x8*>(&w); }
template <class T> __device__ __forceinline__ bf16x8 load8(const T* p) {
    if constexpr (same_t<T, float>::v) { return pack8(*(const f32x4*)p, *(const f32x4*)(p + 4)); }
    else { return *reinterpret_cast<const bf16x8*>(p); }
}
__device__ __forceinline__ void partialSM(f32x16& p0, f32x16& p1, float& m_reg, float& mn, float& alpha) {
    float pmax;
    asm("v_max3_f32 %0, %1, %2, %3" : "=v"(pmax) : "v"(p0[0]), "v"(p0[1]), "v"(p0[2]));
#pragma unroll
    for (int r = 3; r < 15; r += 2) asm("v_max3_f32 %0, %0, %1, %2" : "+v"(pmax) : "v"(p0[r]), "v"(p0[r + 1]));
    asm("v_max3_f32 %0, %0, %1, %2" : "+v"(pmax) : "v"(p0[15]), "v"(p1[0]));
#pragma unroll
    for (int r = 1; r < 15; r += 2) asm("v_max3_f32 %0, %0, %1, %2" : "+v"(pmax) : "v"(p1[r]), "v"(p1[r + 1]));
    asm("v_max_f32 %0, %0, %1" : "+v"(pmax) : "v"(p1[15]));
    { auto rr = __builtin_amdgcn_permlane32_swap(__float_as_uint(pmax), __float_as_uint(pmax), false, false);
      asm("v_max_f32 %0, %1, %2" : "=v"(pmax) : "v"(__uint_as_float(rr[0])), "v"(__uint_as_float(rr[1]))); }
    constexpr float C2 = 1.4426950408889634f * SCALE;
    if (__builtin_expect(__all((pmax - m_reg) * SCALE <= THR), 1)) { mn = m_reg; alpha = 1.f; }
    else { mn = fmaxf(m_reg, pmax); alpha = __builtin_amdgcn_exp2f((m_reg - mn) * C2); m_reg = mn; }
    const float mnL = -mn * C2;
    for (int r = 0; r < 16; ++r) p0[r] = fmaf(p0[r], C2, mnL); for (int r = 0; r < 16; ++r) p1[r] = fmaf(p1[r], C2, mnL);
    for (int r = 0; r < 16; ++r) p0[r] = __builtin_amdgcn_exp2f(p0[r]);
}
template <int NEXP = 16> __device__ __forceinline__ void partialSM2(f32x16& p0, f32x16& p1, float& mnL, float& mthr, float& alpha) {
    float pmax;
    asm("v_max3_f32 %0, %1, %2, %3" : "=v"(pmax) : "v"(p0[0]), "v"(p0[1]), "v"(p0[2]));
#pragma unroll
    for (int r = 3; r < 15; r += 2) asm("v_max3_f32 %0, %0, %1, %2" : "+v"(pmax) : "v"(p0[r]), "v"(p0[r + 1]));
    asm("v_max3_f32 %0, %0, %1, %2" : "+v"(pmax) : "v"(p0[15]), "v"(p1[0]));
#pragma unroll
    for (int r = 1; r < 15; r += 2) asm("v_max3_f32 %0, %0, %1, %2" : "+v"(pmax) : "v"(p1[r]), "v"(p1[r + 1]));
    asm("v_max_f32 %0, %0, %1" : "+v"(pmax) : "v"(p1[15]));
    { auto rr = __builtin_amdgcn_permlane32_swap(__float_as_uint(pmax), __float_as_uint(pmax), false, false);
      asm("v_max_f32 %0, %1, %2" : "=v"(pmax) : "v"(__uint_as_float(rr[0])), "v"(__uint_as_float(rr[1]))); }
    constexpr float C2 = 1.4426950408889634f * SCALE;
    if (__builtin_expect(__all(pmax <= mthr), 1)) { alpha = 1.f; }
    else { const float m_old = mnL * (-1.f / C2), mn = fmaxf(m_old, pmax); alpha = __builtin_amdgcn_exp2f((m_old - mn) * C2); mnL = -mn * C2; mthr = mn + THR / SCALE; }
    for (int r = 0; r < 16; ++r) p0[r] = fmaf(p0[r], C2, mnL); for (int r = 0; r < 16; ++r) p1[r] = fmaf(p1[r], C2, mnL);
    for (int r = 0; r < NEXP; ++r) p0[r] = __builtin_amdgcn_exp2f(p0[r]);
}
__device__ __forceinline__ void finishSM(f32x16& p0, f32x16& p1, float alpha, float& l_reg, bf16x8& pa0, bf16x8& pa1, bf16x8& pa2, bf16x8& pa3) {
    for (int r = 0; r < 16; ++r) p1[r] = __builtin_amdgcn_exp2f(p1[r]);
    float ps = 0; for (int r = 0; r < 16; ++r) ps += p0[r]; for (int r = 0; r < 16; ++r) ps += p1[r];
    { auto rr = __builtin_amdgcn_permlane32_swap(__float_as_uint(ps), __float_as_uint(ps), false, false);
      ps = __uint_as_float(rr[0]) + __uint_as_float(rr[1]); }
    l_reg = l_reg * alpha + ps;
#define PK4(P, B_, OUT) do { unsigned a0 = cvtpk(P[B_+0], P[B_+1]), a1 = cvtpk(P[B_+2], P[B_+3]);                          \
        unsigned b0 = cvtpk(P[B_+4], P[B_+5]), b1 = cvtpk(P[B_+6], P[B_+7]);                                             \
        auto r0 = __builtin_amdgcn_permlane32_swap(a0, b0, false, false); auto r1 = __builtin_amdgcn_permlane32_swap(a1, b1, false, false); \
        u32x4 w = {r0[0], r1[0], r0[1], r1[1]}; OUT = *reinterpret_cast<bf16x8*>(&w); } while (0)
    PK4(p0, 0, pa0); PK4(p0, 8, pa1); PK4(p1, 0, pa2); PK4(p1, 8, pa3);
#undef PK4
}
template <int KB>
__device__ __forceinline__ void qkt(f32x16& p0, f32x16& p1, const char* K_lds, int r32, int hi, const bf16x8* qr) {
    p0 = f32x16{}; p1 = f32x16{};
    const char* kb[4];
#pragma unroll
    for (int dd = 0; dd < 4; ++dd) kb[dd] = K_lds + KB * SHM_K + KSWZ(r32, (dd * 16 + hi * 8) * 2);
#pragma unroll
    for (int d0 = 0; d0 < 8; ++d0) { const char* a = kb[d0 & 3] + (d0 >> 2) * 128;
        bf16x8 b0 = *reinterpret_cast<const bf16x8*>(a);
        bf16x8 b1 = *reinterpret_cast<const bf16x8*>(a + 32 * 256);
        p0 = __builtin_amdgcn_mfma_f32_32x32x16_bf16(b0, qr[d0], p0, 0, 0, 0);
        p1 = __builtin_amdgcn_mfma_f32_32x32x16_bf16(b1, qr[d0], p1, 0, 0, 0); }
}
template <int VB>
__device__ __forceinline__ void pv_tile(f32x16* o, int vb0, bf16x8 pa0, bf16x8 pa1, bf16x8 pa2, bf16x8 pa3) {
#define TRRD(dst, off) asm volatile("ds_read_b64_tr_b16 %0, %1 offset:%2" : "=&v"(dst) : "v"(vb0), "i"(off) : "memory")
#define PV_D0(d0) do { s16x4 l0, l1, l2, l3, h0, h1, h2, h3; constexpr int b_ = VB * SHM_V + v_rd_off(d0, 0, 0); \
        TRRD(l0, b_); TRRD(h0, b_ + 2048); TRRD(l1, b_ + 4096); TRRD(h1, b_ + 6144); TRRD(l2, b_ + 8192); TRRD(h2, b_ + 10240); TRRD(l3, b_ + 12288); TRRD(h3, b_ + 14336); \
        asm volatile("s_waitcnt lgkmcnt(0)" ::: "memory"); SBAR();   \
        o[d0] = __builtin_amdgcn_mfma_f32_32x32x16_bf16(pa0, (bf16x8){l0[0], l0[1], l0[2], l0[3], h0[0], h0[1], h0[2], h0[3]}, o[d0], 0, 0, 0);   \
        o[d0] = __builtin_amdgcn_mfma_f32_32x32x16_bf16(pa1, (bf16x8){l1[0], l1[1], l1[2], l1[3], h1[0], h1[1], h1[2], h1[3]}, o[d0], 0, 0, 0);   \
        o[d0] = __builtin_amdgcn_mfma_f32_32x32x16_bf16(pa2, (bf16x8){l2[0], l2[1], l2[2], l2[3], h2[0], h2[1], h2[2], h2[3]}, o[d0], 0, 0, 0);   \
        o[d0] = __builtin_amdgcn_mfma_f32_32x32x16_bf16(pa3, (bf16x8){l3[0], l3[1], l3[2], l3[3], h3[0], h3[1], h3[2], h3[3]}, o[d0], 0, 0, 0); } while (0)
    PV_D0(0); PV_D0(1); PV_D0(2); PV_D0(3);
#undef PV_D0
#undef TRRD
}

template <class TIn> struct BlockRef { const TIn* Q; const TIn* K; const TIn* V; const TIn* Kt; const TIn* Vt; bf16_t* O; int P0, nt, nrows, pad; };
template <class TIn> struct Seam {
    bf16x8 qr[8];
    bf16x8 st_v0, st_v1, st_k0, st_k1; f32x4 sf0, sf1, sf2, sf3;
    f32x4 tq[16];
};
template <bool SMP, class TIn> __device__ __forceinline__ const TIn* kvrow(const TIn* p, const TIn* pt, int k0, int rr, int sc) {
    if (SMP && k0 >= PAST) return pt + (unsigned)((rr < DSEQ ? rr : DSEQ - 1) * KS + sc);
    return p + (unsigned)((k0 + rr) * KS + sc);
}
#define VMW() asm volatile("s_waitcnt vmcnt(0)" ::: "memory")
#define VMWN(n) asm volatile("s_waitcnt vmcnt(%0)" :: "i"(n) : "memory")
#define SLOAD_H(R_, k0) do { S.st_v0 = load8<TIn>(kvrow<SMP, TIn>((R_).V, (R_).Vt, k0, sr, sc)); S.st_v1 = load8<TIn>(kvrow<SMP, TIn>((R_).V, (R_).Vt, k0, 32 + sr, sc));              \
                             S.st_k0 = load8<TIn>(kvrow<SMP, TIn>((R_).K, (R_).Kt, k0, sr, sc)); S.st_k1 = load8<TIn>(kvrow<SMP, TIn>((R_).K, (R_).Kt, k0, 32 + sr, sc)); } while (0)
#define SWRITE_HK(bf) do { *(bf16x8*)(K_lds + (bf) * SHM_K + kws) = S.st_k0; *(bf16x8*)(K_lds + (bf) * SHM_K + kws + 32 * 256) = S.st_k1; } while (0)
#define SWRITE_HV(bf) do { *(bf16x8*)(V_lds + (bf) * SHM_V + vst0) = S.st_v0; *(bf16x8*)(V_lds + (bf) * SHM_V + vst1) = S.st_v1; } while (0)
#define SWRITE_H(bf) do { SWRITE_HV(bf); SWRITE_HK(bf); } while (0)
#define SLOAD_F(p, pt, k0) do { const float* a_ = (const float*)kvrow<SMP, TIn>(p, pt, k0, sr, sc); const float* b_ = (const float*)kvrow<SMP, TIn>(p, pt, k0, 32 + sr, sc); \
                            S.sf0 = *(const f32x4*)a_; S.sf1 = *(const f32x4*)(a_ + 4); S.sf2 = *(const f32x4*)b_; S.sf3 = *(const f32x4*)(b_ + 4); } while (0)
#define SWRITE_KF(bf) do { *(bf16x8*)(K_lds + (bf) * SHM_K + kws) = pack8(S.sf0, S.sf1); *(bf16x8*)(K_lds + (bf) * SHM_K + kws + 32 * 256) = pack8(S.sf2, S.sf3); } while (0)
#define SWRITE_VF(bf) do { *(bf16x8*)(V_lds + (bf) * SHM_V + vst0) = pack8(S.sf0, S.sf1); *(bf16x8*)(V_lds + (bf) * SHM_V + vst1) = pack8(S.sf2, S.sf3); } while (0)
template <bool SMP, class TIn>
__device__ __forceinline__ void attn_prime(const BlockRef<TIn>& cur, char* lds, Seam<TIn>& S) {
    constexpr bool F32 = same_t<TIn, float>::v;
    const int tid = threadIdx.x, wid = __builtin_amdgcn_readfirstlane(tid >> 6), lane = tid & 63, r32 = lane & 31, hi = lane >> 5;
    const int sr = tid >> 4, sc = (tid & 15) * 8, kws = KSWZ(sr, sc * 2); char* K_lds = lds + 2 * SHM_V;
    for (int d0 = 0; d0 < 8; ++d0) S.qr[d0] = load8<TIn>(cur.Q + (unsigned)((wid * QBLK + r32) * QS + d0 * 16 + hi * 8));
    if constexpr (F32) { SLOAD_F(cur.K, cur.Kt, 0); VMW(); SWRITE_KF(0); SBAR(); SLOAD_F(cur.V, cur.Vt, 0); }
    else { SLOAD_H(cur, 0); VMW(); SWRITE_HK(0); }
    __syncthreads();
}
template <bool SMP, class TIn>
__device__ __forceinline__ void attn_block(const BlockRef<TIn>& cur, const BlockRef<TIn>& nxt, char* lds, Seam<TIn>& S) {
    constexpr bool F32 = same_t<TIn, float>::v;
    const int tid = threadIdx.x, wid = __builtin_amdgcn_readfirstlane(tid >> 6), lane = tid & 63, r32 = lane & 31, hi = lane >> 5;
    const int NT = cur.nt;
    const int qlo = cur.P0 + wid * QBLK;
    char* V_lds = lds; char* K_lds = lds + 2 * SHM_V;
    float* ws = (float*)(lds + 2 * SHM_V + 2 * SHM_K) + wid * 64; float* li_l = ws, * al_l = ws + 32;
    float m_reg = -1e30f, l_reg = 0; f32x16 o[4] = {};
    const int sr = tid >> 4, sc = (tid & 15) * 8, vst0 = v_st(sr, sc), vst1 = v_st(32 + sr, sc), kws = KSWZ(sr, sc * 2);
    const int vb0 = (int)(uintptr_t)V_lds + v_rd_base(lane);
#define RESC(a) do { if (__any((a) < 1.f)) { if (hi == 0) al_l[r32] = (a); asm volatile("s_waitcnt lgkmcnt(0)" ::: "memory");              \
                     for (int d_ = 0; d_ < 4; ++d_) for (int r = 0; r < 16; ++r) o[d_][r] *= al_l[crow(r, hi)]; } } while (0)
#define KBASE(t) ((t) * KVBLK)
#define MASKT(P0_, P1_, t) do { const float NEG_ = -__builtin_inff(); \
        if constexpr (SMP) { if ((t) == NT - 1) { _Pragma("unroll") for (int r_ = 0; r_ < 16; ++r_) P1_[r_] = NEG_; } } \
        else { if (KBASE(t) > (qlo & ~63)) { _Pragma("unroll") for (int r_ = 0; r_ < 16; ++r_) { P0_[r_] = NEG_; P1_[r_] = NEG_; } } } } while (0)
    constexpr int NQL = F32 ? 16 : 8;
#define SEAM_K0() do { VMWN(NQL); if constexpr (F32) { SWRITE_KF(0); SBAR(); SLOAD_F(nxt.V, nxt.Vt, 0); } else { SWRITE_HK(0); } SBAR(); } while (0)
    f32x16 pA0, pA1, pB0, pB1; float mnA, mnB, alA, alB; bf16x8 pa0, pa1, pa2, pa3;
    if constexpr (F32) { VMW(); SWRITE_VF(0); SBAR(); } else { SWRITE_HV(0); SBAR(); }
    if (NT > 1) { if constexpr (F32) SLOAD_F(cur.K, cur.Kt, KBASE(1)); else SLOAD_H(cur, KBASE(1)); }
    SBAR(); qkt<0>(pA0, pA1, K_lds, r32, hi, S.qr);
    if constexpr (F32) { if (NT > 1) { VMW(); SWRITE_KF(1); SBAR(); SLOAD_F(cur.V, cur.Vt, KBASE(1)); } }
    MASKT(pA0, pA1, 0); partialSM(pA0, pA1, m_reg, mnA, alA);
    if (NT > 1) { VMW(); if constexpr (F32) { SWRITE_VF(1); SBAR(); if (NT > 2) SLOAD_F(cur.K, cur.Kt, KBASE(2)); } else SWRITE_H(1); }
    __syncthreads();
#define HALF_STEP(PX0, PX1, mnX, alX, PY0, PY1, alY, t, KB, VB, SB) do {                                                      \
        SBAR(); qkt<KB>(PX0, PX1, K_lds, r32, hi, S.qr);                                             \
        finishSM(PY0, PY1, alY, l_reg, pa0, pa1, pa2, pa3); SBAR();                                                           \
        if ((t) + 1 < NT) { if constexpr (F32) { VMW(); SWRITE_KF(SB); SBAR(); SLOAD_F(cur.V, cur.Vt, KBASE((t) + 1)); }  \
                            else { SLOAD_H(cur, KBASE((t) + 1)); } SBAR(); }                                               \
        pv_tile<VB>(o, vb0, pa0, pa1, pa2, pa3); MASKT(PX0, PX1, (t)); partialSM(PX0, PX1, m_reg, mnX, alX);                                        \
        __syncthreads();                                                                                                      \
        if ((t) + 1 < NT) { VMW(); if constexpr (F32) { SWRITE_VF(SB); SBAR(); if ((t) + 2 < NT) SLOAD_F(cur.K, cur.Kt, KBASE((t) + 2)); } \
                            else { SWRITE_H(SB); } }                                                                          \
        RESC(alX); __syncthreads(); } while (0)
    for (int t = 1; t + 1 < NT; t += 2) {
        HALF_STEP(pB0, pB1, mnB, alB, pA0, pA1, alA, t, 1, 0, 0);
        HALF_STEP(pA0, pA1, mnA, alA, pB0, pB1, alB, t + 1, 0, 1, 1);
    }
    const bool even = (NT & 1) == 0;
    if (even) { SBAR(); qkt<1>(pB0, pB1, K_lds, r32, hi, S.qr); SBAR(); }
#define QROW(e) (nxt.Q + (unsigned)((wid * QBLK + r32) * QS + ((e) >> 1) * 16 + hi * 8 + ((e) & 1) * 4))
    if constexpr (F32) { SLOAD_F(nxt.K, nxt.Kt, 0); SBAR();
#pragma unroll
        for (int e = 0; e < 8; ++e) S.tq[e] = *(const f32x4*)QROW(e); }
    else { SLOAD_H(nxt, 0); SBAR();
#pragma unroll
        for (int d0 = 0; d0 < 8; ++d0) S.qr[d0] = load8<TIn>(nxt.Q + (unsigned)((wid * QBLK + r32) * QS + d0 * 16 + hi * 8)); }
    SBAR();
    finishSM(pA0, pA1, alA, l_reg, pa0, pa1, pa2, pa3); SBAR();
    if constexpr (F32) {
#pragma unroll
        for (int e = 8; e < 16; ++e) S.tq[e] = *(const f32x4*)QROW(e); SBAR(); }
#undef QROW
    pv_tile<0>(o, vb0, pa0, pa1, pa2, pa3);
    if (even) { MASKT(pB0, pB1, NT - 1); partialSM(pB0, pB1, m_reg, mnB, alB); __syncthreads(); RESC(alB);
        finishSM(pB0, pB1, alB, l_reg, pa0, pa1, pa2, pa3); SBAR(); pv_tile<1>(o, vb0, pa0, pa1, pa2, pa3); }
    SBAR(); SEAM_K0();
    if (hi == 0) li_l[r32] = l_reg; asm volatile("s_waitcnt lgkmcnt(0)" ::: "memory");
    float rli[16];
#pragma unroll
    for (int r = 0; r < 16; ++r) rli[r] = __builtin_amdgcn_rcpf(li_l[crow(r, hi)]);
    bf16_t* Ow = cur.O;
    const bool st_ok = wid * QBLK < cur.nrows;
#pragma unroll
    for (int r = 0; r < 16; ++r) { const int orow = crow(r, hi);
#pragma unroll
        for (int d0 = 0; d0 < 4; ++d0) { const float v = o[d0][r] * rli[r];
            const float vn = __shfl_xor(v, 1);
            if (st_ok && (r32 & 1) == 0) *(unsigned*)(Ow + (unsigned)((wid * QBLK + orow) * OS + d0 * 32 + r32)) = cvtpk(v, vn); } }
    if constexpr (F32) {
#pragma unroll
        for (int d0 = 0; d0 < 8; ++d0) S.qr[d0] = pack8(S.tq[2 * d0], S.tq[2 * d0 + 1]); }
    __syncthreads();
#undef RESC
#undef KBASE
#undef MASKT
#undef SEAM_K0
#undef HALF_STEP
}
#undef VMW
#undef VMWN
#undef SLOAD_H
#undef SWRITE_HK
#undef SWRITE_HV
#undef SWRITE_H
#undef SLOAD_F
#undef SWRITE_KF
#undef SWRITE_VF
}

namespace datt {
using att::crow; using att::cvtpk; using att::partialSM; using att::finishSM;
constexpr int SHM_V = 64 * 256 * 2, SHM_K = 64 * 128 * 2, L_V = 0, L_K = 2 * SHM_V, L_WS = 2 * SHM_V + 2 * SHM_K;
constexpr int QS = DM, KS = DM, OS = 2 * DM;
__device__ __forceinline__ int v_st2(int k, int c) { const int kk = (k & ~0xC) | ((k & 4) << 1) | ((k & 8) >> 1); return ((kk >> 3) * 8 + (c >> 5)) * 512 + ((kk & 7) * 32 + (c & 31)) * 2; }
struct DRef { const bf16_t* Q; const bf16_t* K; const bf16_t* V; bf16_t* O; int P0, pad; };
struct DSeam { bf16x8 qr[8]; };
template <int KB>
__device__ __forceinline__ void qkt(f32x16& p0, f32x16& p1, const char* K_lds, int r32, int hi, const bf16x8* qr) {
    p0 = f32x16{}; p1 = f32x16{};
    const char* kb[4];
#pragma unroll
    for (int dd = 0; dd < 4; ++dd) kb[dd] = K_lds + KB * SHM_K + KSWZ(r32, (dd * 16 + hi * 8) * 2);
#define KRD(set, d0) do { const char* a_ = kb[(d0) & 3] + ((d0) >> 2) * 128; set[0] = *reinterpret_cast<const bf16x8*>(a_); set[1] = *reinterpret_cast<const bf16x8*>(a_ + 32 * 256); } while (0)
#define KMM(set, d0) do { p0 = __builtin_amdgcn_mfma_f32_32x32x16_bf16(set[0], qr[d0], p0, 0, 0, 0); p1 = __builtin_amdgcn_mfma_f32_32x32x16_bf16(set[1], qr[d0], p1, 0, 0, 0); } while (0)
    bf16x8 ka[2], kc[2];
    KRD(ka, 0); KRD(kc, 1); SBAR();
    KMM(ka, 0); SBAR(); KRD(ka, 2); SBAR();
    KMM(kc, 1); SBAR(); KRD(kc, 3); SBAR();
    KMM(ka, 2); SBAR(); KRD(ka, 4); SBAR();
    KMM(kc, 3); SBAR(); KRD(kc, 5); SBAR();
    KMM(ka, 4); SBAR(); KRD(ka, 6); SBAR();
    KMM(kc, 5); SBAR(); KRD(kc, 7); SBAR();
    KMM(ka, 6); SBAR();
    KMM(kc, 7); SBAR();
#undef KRD
#undef KMM
}
template <int B_> __device__ __forceinline__ bf16x8 pk4(const f32x16& P) {
    const unsigned a0 = cvtpk(P[B_ + 0], P[B_ + 1]), a1 = cvtpk(P[B_ + 2], P[B_ + 3]), b0 = cvtpk(P[B_ + 4], P[B_ + 5]), b1 = cvtpk(P[B_ + 6], P[B_ + 7]);
    auto r0 = __builtin_amdgcn_permlane32_swap(a0, b0, false, false); auto r1 = __builtin_amdgcn_permlane32_swap(a1, b1, false, false);
    u32x4 w = {r0[0], r1[0], r0[1], r1[1]}; return *reinterpret_cast<bf16x8*>(&w);
}
__device__ __forceinline__ void smA(const f32x16& p0, float& ps, bf16x8& pa0) {
    ps = 0.f;
#pragma unroll
    for (int r = 0; r < 8; ++r) ps += p0[r];
    pa0 = pk4<0>(p0);
}
template <int VB>
__device__ __forceinline__ void pv_tile2(f32x16* o, int vb0, bf16x8 pa0, f32x16& p0, f32x16& p1, float& ps, float alpha, float& l_reg) {
#define TRRD(dst, off) asm volatile("ds_read_b64_tr_b16 %0, %1 offset:%2" : "=&v"(dst) : "v"(vb0), "i"(off) : "memory")
#define PV_RD(S_, g, d0) do { constexpr int b_ = VB * SHM_V + (d0) * 512 + (g) * 8192; TRRD(S_[0], b_); TRRD(S_[1], b_ + 4096); } while (0)
#define PV_MM1(S_, d0, PA) do { o[d0] = __builtin_amdgcn_mfma_f32_32x32x16_bf16(PA, (bf16x8){S_[0][0], S_[0][1], S_[0][2], S_[0][3], S_[1][0], S_[1][1], S_[1][2], S_[1][3]}, o[d0], 0, 0, 0); } while (0)
#define PV_SL(P, r) do { P[r] = __builtin_amdgcn_exp2f(P[r]); ps += P[r]; } while (0)
#define PV_W(n) do { asm volatile("s_waitcnt lgkmcnt(" #n ")" ::: "memory"); SBAR(); } while (0)
    s16x4 s0[2], s1[2], s2[2]; bf16x8 pa1, pa2, pa3;
    PV_RD(s0, 0, 0); PV_RD(s1, 0, 1);
    PV_RD(s2, 0, 2); PV_W(4); PV_MM1(s0, 0, pa0); PV_SL(p0, 8); SBAR();
    PV_RD(s0, 0, 3); PV_W(4); PV_MM1(s1, 1, pa0); PV_SL(p0, 9); SBAR();
    PV_RD(s1, 0, 4); PV_W(4); PV_MM1(s2, 2, pa0); PV_SL(p0, 10); SBAR();
    PV_RD(s2, 0, 5); PV_W(4); PV_MM1(s0, 3, pa0); PV_SL(p0, 11); SBAR();
    PV_RD(s0, 0, 6); PV_W(4); PV_MM1(s1, 4, pa0); PV_SL(p0, 12); SBAR();
    PV_RD(s1, 0, 7); PV_W(4); PV_MM1(s2, 5, pa0); PV_SL(p0, 13); SBAR();
    PV_RD(s2, 1, 0); PV_W(4); PV_MM1(s0, 6, pa0); PV_SL(p0, 14); SBAR();
    PV_RD(s0, 1, 1); PV_W(4); PV_MM1(s1, 7, pa0); PV_SL(p0, 15); SBAR();
    PV_RD(s1, 1, 2); PV_W(4); pa1 = pk4<8>(p0); PV_MM1(s2, 0, pa1); PV_SL(p1, 0); SBAR();
    PV_RD(s2, 1, 3); PV_W(4); PV_MM1(s0, 1, pa1); PV_SL(p1, 1); SBAR();
    PV_RD(s0, 1, 4); PV_W(4); PV_MM1(s1, 2, pa1); PV_SL(p1, 2); SBAR();
    PV_RD(s1, 1, 5); PV_W(4); PV_MM1(s2, 3, pa1); PV_SL(p1, 3); SBAR();
    PV_RD(s2, 1, 6); PV_W(4); PV_MM1(s0, 4, pa1); PV_SL(p1, 4); SBAR();
    PV_RD(s0, 1, 7); PV_W(4); PV_MM1(s1, 5, pa1); PV_SL(p1, 5); SBAR();
    PV_RD(s1, 2, 0); PV_W(4); PV_MM1(s2, 6, pa1); PV_SL(p1, 6); SBAR();
    PV_RD(s2, 2, 1); PV_W(4); PV_MM1(s0, 7, pa1); PV_SL(p1, 7); SBAR();
    PV_RD(s0, 2, 2); PV_W(4); pa2 = pk4<0>(p1); PV_MM1(s1, 0, pa2); PV_SL(p1, 8); SBAR();
    PV_RD(s1, 2, 3); PV_W(4); PV_MM1(s2, 1, pa2); PV_SL(p1, 9); SBAR();
    PV_RD(s2, 2, 4); PV_W(4); PV_MM1(s0, 2, pa2); PV_SL(p1, 10); SBAR();
    PV_RD(s0, 2, 5); PV_W(4); PV_MM1(s1, 3, pa2); PV_SL(p1, 11); SBAR();
    PV_RD(s1, 2, 6); PV_W(4); PV_MM1(s2, 4, pa2); PV_SL(p1, 12); SBAR();
    PV_RD(s2, 2, 7); PV_W(4); PV_MM1(s0, 5, pa2); PV_SL(p1, 13); SBAR();
    PV_RD(s0, 3, 0); PV_W(4); PV_MM1(s1, 6, pa2); PV_SL(p1, 14); SBAR();
    PV_RD(s1, 3, 1); PV_W(4); PV_MM1(s2, 7, pa2); PV_SL(p1, 15); SBAR();
    PV_RD(s2, 3, 2); PV_W(4); pa3 = pk4<8>(p1); PV_MM1(s0, 0, pa3); { auto rr = __builtin_amdgcn_permlane32_swap(__float_as_uint(ps), __float_as_uint(ps), false, false); ps = __uint_as_float(rr[0]) + __uint_as_float(rr[1]); l_reg = l_reg * alpha + ps; } SBAR();
    PV_RD(s0, 3, 3); PV_W(4); PV_MM1(s1, 1, pa3); SBAR();
    PV_RD(s1, 3, 4); PV_W(4); PV_MM1(s2, 2, pa3); SBAR();
    PV_RD(s2, 3, 5); PV_W(4); PV_MM1(s0, 3, pa3); SBAR();
    PV_RD(s0, 3, 6); PV_W(4); PV_MM1(s1, 4, pa3); SBAR();
    PV_RD(s1, 3, 7); PV_W(4); PV_MM1(s2, 5, pa3); SBAR();
    PV_W(2); PV_MM1(s0, 6, pa3); SBAR();
    PV_W(0); PV_MM1(s1, 7, pa3); SBAR();
#undef TRRD
#undef PV_RD
#undef PV_MM1
#undef PV_SL
#undef PV_W
}
template <int VB>
__device__ __forceinline__ void pv_tile(f32x16* o, int vb0, bf16x8 pa0, bf16x8 pa1, bf16x8 pa2, bf16x8 pa3) {
#define TRRD(dst, off) asm volatile("ds_read_b64_tr_b16 %0, %1 offset:%2" : "=&v"(dst) : "v"(vb0), "i"(off) : "memory")
#define PV_RD(S_, d0) do { constexpr int b_ = VB * SHM_V + (d0) * 512; \
        TRRD(S_[0], b_); TRRD(S_[1], b_ + 4096); TRRD(S_[2], b_ + 8192); TRRD(S_[3], b_ + 12288); TRRD(S_[4], b_ + 16384); TRRD(S_[5], b_ + 20480); TRRD(S_[6], b_ + 24576); TRRD(S_[7], b_ + 28672); } while (0)
#define PV_MM(S_, d0) do { \
        o[d0] = __builtin_amdgcn_mfma_f32_32x32x16_bf16(pa0, (bf16x8){S_[0][0], S_[0][1], S_[0][2], S_[0][3], S_[1][0], S_[1][1], S_[1][2], S_[1][3]}, o[d0], 0, 0, 0);   \
        o[d0] = __builtin_amdgcn_mfma_f32_32x32x16_bf16(pa1, (bf16x8){S_[2][0], S_[2][1], S_[2][2], S_[2][3], S_[3][0], S_[3][1], S_[3][2], S_[3][3]}, o[d0], 0, 0, 0);   \
        o[d0] = __builtin_amdgcn_mfma_f32_32x32x16_bf16(pa2, (bf16x8){S_[4][0], S_[4][1], S_[4][2], S_[4][3], S_[5][0], S_[5][1], S_[5][2], S_[5][3]}, o[d0], 0, 0, 0);   \
        o[d0] = __builtin_amdgcn_mfma_f32_32x32x16_bf16(pa3, (bf16x8){S_[6][0], S_[6][1], S_[6][2], S_[6][3], S_[7][0], S_[7][1], S_[7][2], S_[7][3]}, o[d0], 0, 0, 0); } while (0)
#define PV_W8() do { asm volatile("s_waitcnt lgkmcnt(8)" ::: "memory"); SBAR(); } while (0)
#define PV_W0() do { asm volatile("s_waitcnt lgkmcnt(0)" ::: "memory"); SBAR(); } while (0)
    s16x4 sa[8], sb[8];
    PV_RD(sa, 0); PV_RD(sb, 1); PV_W8(); PV_MM(sa, 0); SBAR();
    PV_RD(sa, 2); PV_W8(); PV_MM(sb, 1); SBAR();
    PV_RD(sb, 3); PV_W8(); PV_MM(sa, 2); SBAR();
    PV_RD(sa, 4); PV_W8(); PV_MM(sb, 3); SBAR();
    PV_RD(sb, 5); PV_W8(); PV_MM(sa, 4); SBAR();
    PV_RD(sa, 6); PV_W8(); PV_MM(sb, 5); SBAR();
    PV_RD(sb, 7); PV_W8(); PV_MM(sa, 6); SBAR();
    PV_W0(); PV_MM(sb, 7); SBAR();
#undef PV_RD
#undef PV_MM
#undef PV_W8
#undef PV_W0
#undef TRRD
}
#define DVMW() asm volatile("s_waitcnt vmcnt(0)" ::: "memory")
#define DLOADQ(R_) do { _Pragma("unroll") for (int d0_ = 0; d0_ < 8; ++d0_) S.qr[d0_] = *(const bf16x8*)((R_).Q + (unsigned)((wid * 32 + r32) * QS + d0_ * 16 + hi * 8)); } while (0)
#define DDMA(R_, k0, bf) do { \
        const __amdgpu_buffer_rsrc_t rk_ = __builtin_amdgcn_make_buffer_rsrc((void*)(R_).K, 0, 0x7ffffff0, 0x00020000), rv_ = __builtin_amdgcn_make_buffer_rsrc((void*)(R_).V, 0, 0x7ffffff0, 0x00020000); \
        _Pragma("unroll") for (int j_ = 0; j_ < 2; ++j_) __builtin_amdgcn_raw_ptr_buffer_load_lds(rk_, (LAS unsigned*)(lds + L_K + (bf) * SHM_K + (8 * j_ + wid) * 1024), 16, (int)(offK * 2u), (int)(((k0) + 32 * j_) * KS * 2), 0, 0); \
        _Pragma("unroll") for (int j_ = 0; j_ < 4; ++j_) __builtin_amdgcn_raw_ptr_buffer_load_lds(rv_, (LAS unsigned*)(lds + L_V + (bf) * SHM_V + (8 * j_ + wid) * 1024), 16, (int)(offV * 2u), (int)(((k0) + 16 * j_) * KS * 2), 0, 0); } while (0)
__device__ __forceinline__ void dattn_prime(const DRef& cur, LAS char* lds, DSeam& S) {
    const int tid = threadIdx.x, wid = __builtin_amdgcn_readfirstlane(tid >> 6), lane = tid & 63, r32 = lane & 31, hi = lane >> 5;
    const int rowK = 4 * wid + (lane >> 4); const unsigned offK = (unsigned)(rowK * KS + (((lane & 15) ^ (rowK & 7)) * 8));
    const int sub = 2 * wid + (lane >> 5), kk = (sub >> 3) * 8 + ((lane & 31) >> 2), kv = (kk & ~0xC) | ((kk & 4) << 1) | ((kk & 8) >> 1); const unsigned offV = (unsigned)(kv * KS + (sub & 7) * 32 + (lane & 3) * 8);
    DLOADQ(cur); DDMA(cur, 0, 0); DVMW();
    __syncthreads();
}
__device__ __forceinline__ void dattn_block(const DRef& cur, const DRef& nxt, LAS char* lds, DSeam& S) {
    const int tid = threadIdx.x, wid = __builtin_amdgcn_readfirstlane(tid >> 6), lane = tid & 63, r32 = lane & 31, hi = lane >> 5;
    const int NT = (cur.P0 + 255) / 64 + 1;
    const int qlo = cur.P0 + wid * 32;
    const char* K_lds = (const char*)(lds + L_K);
    float* ws = (float*)(lds + L_WS) + wid * 64; float* li_l = ws, * al_l = ws + 32;
    float mnL_reg = 1e30f * (1.4426950408889634f * att::SCALE), mthr_reg = -1e30f, l_reg = 0; f32x16 o[8] = {};
    const int rowK = 4 * wid + (lane >> 4); const unsigned offK = (unsigned)(rowK * KS + (((lane & 15) ^ (rowK & 7)) * 8));
    const int sub = 2 * wid + (lane >> 5), kk = (sub >> 3) * 8 + ((lane & 31) >> 2), kv = (kk & ~0xC) | ((kk & 4) << 1) | ((kk & 8) >> 1); const unsigned offV = (unsigned)(kv * KS + (sub & 7) * 32 + (lane & 3) * 8);
    const int vb0 = (int)(uintptr_t)(lds + L_V) + att::v_rd_base(lane);
    f32x16 p0, p1; float al, psum; bf16x8 pa0;
    if (wid >= 4) __builtin_amdgcn_s_setprio(1);
#define DSTEP(t, B, NB) do { \
        if ((t) + 1 < NT) DDMA(cur, ((t) + 1) * 64, NB); else DDMA(nxt, 0, NB); \
        SBAR(); qkt<B>(p0, p1, K_lds, r32, hi, S.qr); SBAR(); \
        if ((t) + 1 == NT) DLOADQ(nxt); \
        if (__builtin_expect((t) * 64 > (qlo & ~63), 0)) { asm volatile("" ::: "memory"); const float NEG_ = -__builtin_inff(); _Pragma("unroll") for (int r_ = 0; r_ < 16; ++r_) { p0[r_] = NEG_; p1[r_] = NEG_; } asm volatile("" : "+v"(p0), "+v"(p1)); } \
        att::partialSM2<8>(p0, p1, mnL_reg, mthr_reg, al); smA(p0, psum, pa0); SBAR(); \
        if (__any(al < 1.f)) { if (hi == 0) al_l[r32] = al; asm volatile("s_waitcnt lgkmcnt(0)" ::: "memory"); \
            _Pragma("unroll") for (int d_ = 0; d_ < 8; ++d_) _Pragma("unroll") for (int r = 0; r < 16; ++r) o[d_][r] *= al_l[crow(r, hi)]; } \
        pv_tile2<B>(o, vb0, pa0, p0, p1, psum, al, l_reg); SBAR(); \
        DVMW(); __syncthreads(); } while (0)
    for (int t = 0; t < NT; t += 2) { DSTEP(t, 0, 1); DSTEP(t + 1, 1, 0); }
#undef DSTEP
    __builtin_amdgcn_s_setprio(0);
    if (hi == 0) li_l[r32] = l_reg; asm volatile("s_waitcnt lgkmcnt(0)" ::: "memory");
    float rli[16];
#pragma unroll
    for (int r = 0; r < 16; ++r) rli[r] = __builtin_amdgcn_rcpf(li_l[crow(r, hi)]);
#pragma unroll
    for (int r = 0; r < 16; ++r) { const int orow = crow(r, hi);
#pragma unroll
        for (int d0 = 0; d0 < 8; ++d0) { const float v = o[d0][r] * rli[r];
            const float vn = __shfl_xor(v, 1);
            if ((r32 & 1) == 0) *(unsigned*)(cur.O + (unsigned)((wid * 32 + orow) * OS + d0 * 32 + r32)) = cvtpk(v, vn); } }
}
#undef DVMW
#undef DLOADQ
#undef DDMA
}

struct Args { const float* in[38]; float* out; unsigned char* ws; int ph_lo, ph_hi; };
typedef const float* cfp_t;
typedef const __attribute__((address_space(4))) unsigned char* KP;
__device__ __forceinline__ KP kargs() { KP p = (KP)__builtin_amdgcn_kernarg_segment_ptr(); asm volatile("" : "+s"(p)); return p; }
struct Frame {
    LAS unsigned char* lds; KP kp;
    int tid, lane, wave, G, bid;
    __device__ __forceinline__ const float* in(int i) const { return *(const __attribute__((address_space(4))) cfp_t*)(kp + 8 * i); }
    __device__ __forceinline__ float* out() const { return *(float* const __attribute__((address_space(4)))*)(kp + 304); }
    __device__ __forceinline__ unsigned char* ws() const { return *(unsigned char* const __attribute__((address_space(4)))*)(kp + 312); }
};
static_assert(sizeof(Args) == 328, "Args layout");
enum { I_XP = 0, I_XS, I_SRE, I_SIM, I_SCONV, I_CK, I_CV, I_PP, I_PS, I_NMIX, I_ARE, I_AIM, I_LDT, I_BRE, I_BIM, I_CRE, I_CIM, I_SSMD, I_WGLU, I_NKV, I_WK, I_WV, I_WQ,
       I_LQ1, I_LK1, I_LQ2, I_LK2, I_NSUB, I_WO, I_NFFN, I_WUP, I_CONVW, I_CONVB, I_WDOWN, I_NPLE, I_WGATE, I_WPROJ, I_NFIN };

__device__ __forceinline__ void transpose_item(const float* W, int K, int N, bf16_t* WT, int row_off, const float* gain, int pairhalf, LAS float* scr, int item, int lane) {
    const int nblk = N / 32, kb = item / nblk, nb = item % nblk, k0 = 64 * kb, n0 = 32 * nb;
    int c0 = n0; if (pairhalf) c0 = ((n0 >> 7) & 1) * pairhalf + (n0 >> 8) * 128 + (n0 & 127);
#pragma unroll 8
    for (int i = 0; i < 32; ++i) { const int kk = 2 * i + (lane >> 5); float v = W[(size_t)(k0 + kk) * N + c0 + (lane & 31)]; if (gain) v *= gain[k0 + kk]; scr[kk * 33 + (lane & 31)] = v; }
    asm volatile("s_waitcnt lgkmcnt(0)" ::: "memory");
    const int c = lane & 7;
#pragma unroll
    for (int j = 0; j < 4; ++j) { const int n = (lane >> 3) + 8 * j; const LAS float* s = scr + (8 * c) * 33 + n;
        u32x4 o; o.x = cvt_pk_bf16(s[0 * 33], s[1 * 33]); o.y = cvt_pk_bf16(s[2 * 33], s[3 * 33]); o.z = cvt_pk_bf16(s[4 * 33], s[5 * 33]); o.w = cvt_pk_bf16(s[6 * 33], s[7 * 33]);
        *(u32x4*)(WT + (size_t)(row_off + n0 + n) * K + k0 + 8 * c) = o; }
    asm volatile("s_waitcnt lgkmcnt(0)" ::: "memory");
}

__device__ __forceinline__ void ssm_build_group(Frame& F, int g) {
    LAS f32x2* lbp = (LAS f32x2*)F.lds;
    LAS f32x2* Bb = lbp + 17 * 64;
    LAS f32x2* Cc = Bb + 64 * 16;
    LAS float* Kd = (LAS float*)(Cc + 16 * 64);
    LAS float* Dd = Kd + 4096;
    LAS f32x2* kt = (LAS f32x2*)(Dd + 16);
    const float* are = F.in(I_ARE) + g * 64; const float* aim = F.in(I_AIM) + g * 64;
    const int tid = F.tid;
    for (int i = tid; i < 17 * 64; i += NTHR) { const int d = i >> 6, p = i & 63; const double dt = exp((double)F.in(I_LDT)[g]); const double ar = are[p], ai = aim[p];
        const double mag = exp(ar * dt * d); double sn, cs; sincos(ai * dt * d, &sn, &cs); lbp[d * 64 + p] = (f32x2){(float)(mag * cs), (float)(mag * sn)}; }
    if (tid < 64) {
        const int p = tid; const double dt = exp((double)F.in(I_LDT)[g]); const double ar = are[p], ai = aim[p];
        const double mag = exp(ar * dt); double sn, cs; sincos(ai * dt, &sn, &cs); const double lr = mag * cs, li = mag * sn, den = ar * ar + ai * ai, nr = lr - 1.0;
        kt[p] = (f32x2){(float)((nr * ar + li * ai) / den), (float)((li * ar - nr * ai) / den)};
    }
    if (tid < 16) Dd[tid] = F.in(I_SSMD)[g * 16 + tid];
    __syncthreads();
    for (int i = tid; i < 1024; i += NTHR) { const int p = i >> 4, ch = i & 15; const float br = F.in(I_BRE)[((size_t)g * 64 + p) * 16 + ch], bi = F.in(I_BIM)[((size_t)g * 64 + p) * 16 + ch]; const f32x2 k = kt[p];
        Bb[i] = (f32x2){k.x * br - k.y * bi, k.x * bi + k.y * br};
        const int co = i >> 6, pp = i & 63; Cc[i] = (f32x2){F.in(I_CRE)[((size_t)g * 16 + co) * 64 + pp], F.in(I_CIM)[((size_t)g * 16 + co) * 64 + pp]}; }
    __syncthreads();
    for (int i = tid; i < 4096; i += NTHR) { const int d = i >> 8, co = (i >> 4) & 15, ch = i & 15; float s = 0.f;
        for (int p = 0; p < 64; ++p) { const f32x2 c = Cc[co * 64 + p], l = lbp[d * 64 + p], b = Bb[p * 16 + ch];
            const float wr = c.x * l.x - c.y * l.y, wi = c.x * l.y + c.y * l.x; s += wr * b.x - wi * b.y; }
        if (d == 0 && co == ch) s += Dd[co];
        Kd[i] = s; }
    __syncthreads();
    unsigned char* base = F.ws() + WS_SSM + (size_t)g * SSM_G_BYTES;
    for (int e = tid; e < 8 * 16 * 64; e += NTHR) { const int ln = e & 63, ks = (e >> 6) & 15, Mb = e >> 10; const int row = 32 * Mb + (ln & 31), t = row >> 4, co = row & 15, s = ks; float v[8];
#pragma unroll
        for (int j = 0; j < 8; ++j) { const int ch = 8 * (ln >> 5) + j; v[j] = (t >= s) ? Kd[((t - s) * 16 + co) * 16 + ch] : 0.f; }
        u32x4 o = {cvt_pk_bf16(v[0], v[1]), cvt_pk_bf16(v[2], v[3]), cvt_pk_bf16(v[4], v[5]), cvt_pk_bf16(v[6], v[7])}; *(u32x4*)(base + (size_t)e * 16) = o; }
    for (int e = tid; e < 4 * 16 * 64; e += NTHR) { const int ln = e & 63, ks = (e >> 6) & 15, Mb = e >> 10; const int hr = 32 * Mb + (ln & 31), c = hr >> 6, p = hr & 63, s = ks; float v[8]; const f32x2 l = lbp[(15 - s) * 64 + p];
#pragma unroll
        for (int j = 0; j < 8; ++j) { const f32x2 b = Bb[p * 16 + 8 * (ln >> 5) + j]; v[j] = c == 0 ? (l.x * b.x - l.y * b.y) : (l.x * b.y + l.y * b.x); }
        u32x4 o = {cvt_pk_bf16(v[0], v[1]), cvt_pk_bf16(v[2], v[3]), cvt_pk_bf16(v[4], v[5]), cvt_pk_bf16(v[6], v[7])}; *(u32x4*)(base + 131072 + (size_t)e * 16) = o; }
    for (int e = tid; e < 8 * 8 * 64; e += NTHR) { const int ln = e & 63, ks = (e >> 6) & 7, Mb = e >> 9; const int row = 32 * Mb + (ln & 31), t = row >> 4, co = row & 15; float v[8];
#pragma unroll
        for (int j = 0; j < 8; ++j) { const int hr = 16 * ks + 8 * (ln >> 5) + j, c = hr >> 6, p = hr & 63; const f32x2 cc = Cc[co * 64 + p], l = lbp[(t + 1) * 64 + p];
            v[j] = c == 0 ? (cc.x * l.x - cc.y * l.y) : -(cc.x * l.y + cc.y * l.x); }
        u32x4 o = {cvt_pk_bf16(v[0], v[1]), cvt_pk_bf16(v[2], v[3]), cvt_pk_bf16(v[4], v[5]), cvt_pk_bf16(v[6], v[7])}; *(u32x4*)(base + 196608 + (size_t)e * 16) = o; }
    if (tid < 64) ((f32x2*)(F.ws() + WS_L16))[g * 64 + tid] = lbp[16 * 64 + tid];
    __syncthreads();
}

__device__ __forceinline__ void rms_row_to_bf16(const float* xrow, const float* g, bf16_t* orow, int lane) {
    const f32x4* xr = (const f32x4*)xrow + lane; f32x4 v[8]; float s = 0.f;
#pragma unroll
    for (int j = 0; j < 8; ++j) { v[j] = xr[64 * j]; s += (v[j][0] * v[j][0] + v[j][1] * v[j][1]) + (v[j][2] * v[j][2] + v[j][3] * v[j][3]); }
    const float rstd = rsqrtf(wave_sum(s) * (1.f / DM) + EPS);
    u32x2* o8 = (u32x2*)orow + lane;
#pragma unroll
    for (int j = 0; j < 8; ++j) { const f32x4 gg = ((const f32x4*)g)[lane + 64 * j]; const f32x4 y = v[j] * rstd * gg; u32x2 w; w.x = cvt_pk_bf16(y[0], y[1]); w.y = cvt_pk_bf16(y[2], y[3]); o8[64 * j] = w; }
}
__device__ __forceinline__ void convert_p(Frame& F, int layer) {
    const float* pp = F.in(I_PP) + (size_t)layer * MP * PLE; const float* ps = F.in(I_PS) + (size_t)layer * MS * PLE; bf16_t* pb = (bf16_t*)(F.ws() + WS_PB);
    const size_t n8 = (size_t)MT * PLE / 8;
    for (size_t i = (size_t)F.bid * NTHR + F.tid; i < n8; i += (size_t)F.G * NTHR) { const size_t e = i * 8; const float* src = e < (size_t)MP * PLE ? pp + e : ps + (e - (size_t)MP * PLE);
        const f32x4 a = *(const f32x4*)src, b = *(const f32x4*)(src + 4); u32x4 w = {cvt_pk_bf16(a[0], a[1]), cvt_pk_bf16(a[2], a[3]), cvt_pk_bf16(b[0], b[1]), cvt_pk_bf16(b[2], b[3])}; *(u32x4*)(pb + e) = w; }
}
__device__ __forceinline__ int bg_slot(Frame& F, int word) {
    const int lane = __builtin_amdgcn_mbcnt_hi(~0u, __builtin_amdgcn_mbcnt_lo(~0u, 0u));
    unsigned tk = 0u; if (lane == 0) tk = __hip_atomic_fetch_add((LAS unsigned*)(F.lds + LDS_BYTES - 256) + 16 + word, 1u, __ATOMIC_RELAXED, __HIP_MEMORY_SCOPE_WORKGROUP);
    return __builtin_amdgcn_readfirstlane((int)tk) & 7;
}
template <int LIST> __device__ __forceinline__ void bg_work(Frame& F, int busy, int slot) {
    const int rem = busy < F.G ? busy : 0; int nb = F.G, bi = F.bid;
    if (rem != 0) { if (F.bid < rem) return; nb = F.G - rem; bi = F.bid - rem; }
    const int lane = __builtin_amdgcn_mbcnt_hi(~0u, __builtin_amdgcn_mbcnt_lo(~0u, 0u));
    LAS float* scr = (LAS float*)(F.lds + slot * 16384);
    const int gw = bi * NWAVES + slot, NGW = nb * NWAVES;
    constexpr int I_UP = 32 * 352, I_DN = 88 * 64, I_GT = 32 * 64, I_PJ = 4 * 64, I_SQ = 32 * 64;
    if constexpr (LIST == 0 || LIST == 3) { constexpr int l = LIST == 0 ? 0 : 1;
        for (int it = gw; it < I_UP; it += NGW) transpose_item(F.in(I_WUP) + (size_t)l * DM * DFF2, DM, DFF2, (bf16_t*)(F.ws() + WS_WUP) + (size_t)l * DFF2 * DM, 0, F.in(I_NFFN) + l * DM, DFF, scr, it, lane);
    } else if constexpr (LIST == 1 || LIST == 4) { constexpr int l = LIST == 1 ? 0 : 1;
        for (int it = gw; it < I_DN + I_GT + I_PJ; it += NGW) { int r = it;
            if (r < I_DN) { transpose_item(F.in(I_WDOWN) + (size_t)l * DFF * DM, DFF, DM, (bf16_t*)(F.ws() + WS_WDOWN) + (size_t)l * DM * DFF, 0, nullptr, 0, scr, r, lane); continue; } r -= I_DN;
            if (r < I_GT) { transpose_item(F.in(I_WGATE) + (size_t)l * DM * DM, DM, DM, (bf16_t*)(F.ws() + WS_WGATE) + (size_t)l * DM * DM, 0, F.in(I_NPLE) + l * DM, 0, scr, r, lane); continue; } r -= I_GT;
            transpose_item(F.in(I_WPROJ) + (size_t)l * PLE * DM, PLE, DM, (bf16_t*)(F.ws() + WS_WPROJ) + (size_t)l * DM * PLE, 0, nullptr, 0, scr, r, lane); }
    } else {
        for (int it = gw; it < 4 * I_SQ; it += NGW) { int r = it;
            if (r < I_SQ) { transpose_item(F.in(I_WQ), DM, DM, (bf16_t*)(F.ws() + WS_WQKV), 0, F.in(I_NMIX) + DM, 0, scr, r, lane); continue; } r -= I_SQ;
            if (r < I_SQ) { transpose_item(F.in(I_WK), DM, DM, (bf16_t*)(F.ws() + WS_WQKV), DM, F.in(I_NKV), 0, scr, r, lane); continue; } r -= I_SQ;
            if (r < I_SQ) { transpose_item(F.in(I_WV), DM, DM, (bf16_t*)(F.ws() + WS_WQKV), 2 * DM, F.in(I_NKV), 0, scr, r, lane); continue; } r -= I_SQ;
            transpose_item(F.in(I_WO), DM, DM, (bf16_t*)(F.ws() + WS_WO), 0, nullptr, 0, scr, r, lane); }
    }
}
__device__ __forceinline__ void p0_prologue(Frame& F) {
    for (int g = F.bid; g < NG; g += F.G) ssm_build_group(F, g);
    __syncthreads();
    LAS float* scr = (LAS float*)(F.lds + F.wave * 16384);
    const int gw = F.bid * NWAVES + F.wave, NGW = F.G * NWAVES;
    for (int it = gw; it < 32 * 128; it += NGW) transpose_item(F.in(I_WGLU), DM, 2 * DM, (bf16_t*)(F.ws() + WS_WGLU), 0, nullptr, DM, scr, it, F.lane);
    { float* rope = (float*)(F.ws() + WS_ROPE);
      for (int i = F.bid * NTHR + F.tid; i < SEQ * 16; i += F.G * NTHR) { const int pos = i >> 4, k = i & 15; const double inv = exp(-(double)k * (13.122363377404328 / 16.0)); double sn, cs; sincos((double)pos * inv, &sn, &cs);
          rope[(size_t)pos * 32 + k] = (float)cs; rope[(size_t)pos * 32 + 16 + k] = (float)sn; } }
    { float* cp_ = (float*)(F.ws() + WS_CONVP);
      for (int i = F.bid * NTHR + F.tid; i < 2 * DFF; i += F.G * NTHR) { const int l = i / DFF, c = i % DFF; const float* cw = F.in(I_CONVW) + (size_t)l * 3 * DFF2; const float* cb = F.in(I_CONVB) + (size_t)l * DFF2;
          float* r = cp_ + (size_t)(i & ~1) * 8 + (c & 1);
          r[0] = cw[c]; r[2] = cw[DFF2 + c]; r[4] = cw[2 * DFF2 + c]; r[6] = cb[c]; r[8] = cw[DFF + c]; r[10] = cw[DFF2 + DFF + c]; r[12] = cw[2 * DFF2 + DFF + c]; r[14] = cb[DFF + c]; } }
    convert_p(F, 0);
    bf16_t* ub = (bf16_t*)(F.ws() + WS_UB);
    for (int m = gw; m < MT; m += NGW) rms_row_to_bf16(m < MP ? F.in(I_XP) + (size_t)m * DM : F.in(I_XS) + (size_t)(m - MP) * DM, F.in(I_NMIX), ub + (size_t)m * DM, F.lane);
}

__device__ __forceinline__ void ssm_phase(Frame& F, bf16_t* dstb) {
    constexpr int L_G = 0, L_U = 65536, L_S0 = 98304, L_S1 = 116736, L_XB = 135168;
    const int tid = F.tid, wave = F.wave, lane = F.lane, n = lane & 31, hi = lane >> 5;
    bf16_t* ub = (bf16_t*)(F.ws() + WS_UB);
    const int sn_ = tid & 31, ss_ = tid >> 5;
    for (int item = F.bid; item < NBAT * NG + NG; item += F.G) {
        const bool smp = item >= NBAT * NG;
        const int g = smp ? item - NBAT * NG : item % NG, b = smp ? 0 : item / NG;
        const int nsteps = smp ? 1 : SEQ / 512; const int row0 = smp ? MP : b * SEQ;
        const unsigned char* mats = F.ws() + WS_SSM + (size_t)g * SSM_G_BYTES;
        __syncthreads();
        for (int i = tid; i < 4096; i += NTHR) *(LAS u32x4*)(F.lds + L_G + i * 16) = *(const u32x4*)(mats + 196608 + (size_t)i * 16);
        bf16x8 Kf[16], Hf[8];
#pragma unroll
        for (int ks = 0; ks < 16; ++ks) Kf[ks] = *(const bf16x8*)(mats + ((size_t)(wave * 16 + ks) * 64 + lane) * 16);
#pragma unroll
        for (int i = 0; i < 8; ++i) Hf[i] = *(const bf16x8*)(mats + 131072 + ((size_t)((wave & 3) * 16 + (wave >> 2) * 8 + i) * 64 + lane) * 16);
        f32x2 lam = {0.f, 0.f}, X = {0.f, 0.f};
        if (wave == 0) lam = ((const f32x2*)(F.ws() + WS_L16))[g * 64 + lane];
        { const bf16_t* src = ub + (size_t)(row0 + 16 * sn_ + ss_) * DM + 16 * g; const u32x4 a = *(const u32x4*)src, c = *(const u32x4*)(src + 8);
          LAS unsigned char* d = F.lds + L_U + ss_ * 1024 + sn_ * 32; *(LAS u32x4*)d = a; *(LAS u32x4*)(d + 16) = c; }
        __syncthreads();
        for (int step = 0; step < nsteps; ++step) {
            const int rowb = row0 + step * 512;
            LAS unsigned char* Ucur = F.lds + L_U + (step & 1) * 16384;
            u32x4 na = {0u, 0u, 0u, 0u}, nc = na;
            if (step + 1 < nsteps) { const bf16_t* src = ub + (size_t)(rowb + 512 + 16 * sn_ + ss_) * DM + 16 * g; na = *(const u32x4*)src; nc = *(const u32x4*)(src + 8); }
            { f32x16 sa = {};
#pragma unroll
              for (int i = 0; i < 8; ++i) { const bf16x8 uf = *(const LAS bf16x8*)(Ucur + ((wave >> 2) * 8 + i) * 1024 + n * 32 + hi * 16); sa = __builtin_amdgcn_mfma_f32_32x32x16_bf16(Hf[i], uf, sa, 0, 0, 0); }
              LAS float* Sp = (LAS float*)(F.lds + ((wave >> 2) ? L_S1 : L_S0));
#pragma unroll
              for (int r = 0; r < 16; ++r) Sp[(32 * (wave & 3) + att::crow(r, hi)) * 36 + n] = sa[r]; }
            __syncthreads();
            if (step > 0) { const LAS unsigned char* ysrc = F.lds + L_U + ((step - 1) & 1) * 16384 + ss_ * 1024 + sn_ * 32; const u32x4 ya0 = *(const LAS u32x4*)ysrc, ya1 = *(const LAS u32x4*)(ysrc + 16);
                bf16_t* dst = dstb + (size_t)(rowb - 512 + 16 * sn_ + ss_) * DM + 16 * g; *(u32x4*)dst = ya0; *(u32x4*)(dst + 8) = ya1; }
            if (wave == 0) {
                const LAS float* S0 = (const LAS float*)(F.lds + L_S0); const LAS float* S1 = (const LAS float*)(F.lds + L_S1);
                LAS bf16_t* Xb = (LAS bf16_t*)(F.lds + L_XB);
#pragma unroll 1
                for (int cg = 0; cg < 4; ++cg) {
                    f32x4 re[2], im[2];
#pragma unroll
                    for (int i = 0; i < 2; ++i) { re[i] = *(const LAS f32x4*)(S0 + lane * 36 + 8 * cg + 4 * i) + *(const LAS f32x4*)(S1 + lane * 36 + 8 * cg + 4 * i);
                                                  im[i] = *(const LAS f32x4*)(S0 + (64 + lane) * 36 + 8 * cg + 4 * i) + *(const LAS f32x4*)(S1 + (64 + lane) * 36 + 8 * cg + 4 * i); }
#pragma unroll
                    for (int k = 0; k < 8; ++k) { const int c = 8 * cg + k;
                        if (smp && !(c & 1)) { const size_t si = ((size_t)(c >> 1) * NG + g) * 64 + lane; X = (f32x2){F.in(I_SRE)[si], F.in(I_SIM)[si]}; }
                        Xb[c * 136 + lane] = (bf16_t)(cvt_pk_bf16(X.x, 0.f) & 0xffffu); Xb[c * 136 + 64 + lane] = (bf16_t)(cvt_pk_bf16(X.y, 0.f) & 0xffffu);
                        const float sr = re[k >> 2][k & 3], si2 = im[k >> 2][k & 3];
                        const float nx = lam.x * X.x - lam.y * X.y + sr, ny = lam.x * X.y + lam.y * X.x + si2; X = (f32x2){nx, ny};
                        if (smp && (c & 1)) { const size_t so = ((size_t)(c >> 1) * NG + g) * 64 + lane; F.out()[O_SRE_S + so] = X.x; F.out()[O_SIM_S + so] = X.y; } }
                }
            }
            f32x16 ya = {};
#pragma unroll
            for (int ks = 0; ks < 16; ++ks) if (ks <= 2 * wave + 1) { const bf16x8 uf = *(const LAS bf16x8*)(Ucur + ks * 1024 + n * 32 + hi * 16); ya = __builtin_amdgcn_mfma_f32_32x32x16_bf16(Kf[ks], uf, ya, 0, 0, 0); }
            if (step + 1 < nsteps) { LAS unsigned char* d = F.lds + L_U + ((step + 1) & 1) * 16384 + ss_ * 1024 + sn_ * 32; *(LAS u32x4*)d = na; *(LAS u32x4*)(d + 16) = nc; }
            __syncthreads();
#pragma unroll
            for (int i = 0; i < 8; ++i) { const bf16x8 gf = *(const LAS bf16x8*)(F.lds + L_G + ((wave * 8 + i) * 64 + lane) * 16); const bf16x8 xf = *(const LAS bf16x8*)(F.lds + L_XB + n * 272 + (16 * i + 8 * hi) * 2);
                ya = __builtin_amdgcn_mfma_f32_32x32x16_bf16(gf, xf, ya, 0, 0, 0); }
#pragma unroll
            for (int q = 0; q < 4; ++q) { const int tl = q >> 1, co = 8 * (q & 1) + 4 * hi;
                u32x2 w; w.x = cvt_pk_bf16(gelu_tanh(ya[4 * q]), gelu_tanh(ya[4 * q + 1])); w.y = cvt_pk_bf16(gelu_tanh(ya[4 * q + 2]), gelu_tanh(ya[4 * q + 3]));
                *(LAS u32x2*)(Ucur + (2 * wave + tl) * 1024 + n * 32 + co * 2) = w; }
        }
        __syncthreads();
        { const int ls = nsteps - 1; const LAS unsigned char* ysrc = F.lds + L_U + (ls & 1) * 16384 + ss_ * 1024 + sn_ * 32; const u32x4 ya0 = *(const LAS u32x4*)ysrc, ya1 = *(const LAS u32x4*)(ysrc + 16);
          bf16_t* dst = dstb + (size_t)(row0 + ls * 512 + 16 * sn_ + ss_) * DM + 16 * g; *(u32x4*)dst = ya0; *(u32x4*)(dst + 8) = ya1; }
        if (!smp && wave == 0) { const size_t so = ((size_t)b * NG + g) * 64 + lane; F.out()[O_SRE_P + so] = X.x; F.out()[O_SIM_P + so] = X.y; }
    }
}

__device__ __forceinline__ void fixup_phase(Frame& F, int layer) {
    const float* zs = (const float*)(F.ws() + WS_ZSIDE); bf16_t* act = (bf16_t*)(F.ws() + WS_BIG);
    const float* cw = F.in(I_CONVW) + (size_t)layer * 3 * DFF2; const float* cb = F.in(I_CONVB) + (size_t)layer * DFF2;
    constexpr int NC4 = DFF / 4;
    for (int i = F.bid * NTHR + F.tid; i < 256 * NC4; i += F.G * NTHR) {
        const int ht = i / NC4, c0 = (i % NC4) * 4; if ((ht & 127) == 0) continue;
        const float* zp = zs + (size_t)(ht - 1) * 4 * DFF2; const float* zc = zs + (size_t)ht * 4 * DFF2;
        f32x4 o0, o1;
        f32x4 cv0, cv1, cg0, cg1;
        { const f32x4 L0 = *(const f32x4*)(zp + 2 * DFF2 + c0), L1 = *(const f32x4*)(zp + 3 * DFF2 + c0), f0 = *(const f32x4*)(zc + c0), f1 = *(const f32x4*)(zc + DFF2 + c0);
          const f32x4 w0 = *(const f32x4*)(cw + c0), w1 = *(const f32x4*)(cw + DFF2 + c0), w2 = *(const f32x4*)(cw + 2 * DFF2 + c0), bb = *(const f32x4*)(cb + c0);
          cv0 = bb + w2 * f0 + w1 * L1 + w0 * L0; cv1 = bb + w2 * f1 + w1 * f0 + w0 * L1; }
        { const int c1 = DFF + c0; const f32x4 L0 = *(const f32x4*)(zp + 2 * DFF2 + c1), L1 = *(const f32x4*)(zp + 3 * DFF2 + c1), f0 = *(const f32x4*)(zc + c1), f1 = *(const f32x4*)(zc + DFF2 + c1);
          const f32x4 w0 = *(const f32x4*)(cw + c1), w1 = *(const f32x4*)(cw + DFF2 + c1), w2 = *(const f32x4*)(cw + 2 * DFF2 + c1), bb = *(const f32x4*)(cb + c1);
          cg0 = bb + w2 * f0 + w1 * L1 + w0 * L0; cg1 = bb + w2 * f1 + w1 * f0 + w0 * L1; }
#pragma unroll
        for (int j = 0; j < 4; ++j) { o0[j] = cv0[j] * cg0[j] * fsigmoid(cg0[j]); o1[j] = cv1[j] * cg1[j] * fsigmoid(cg1[j]); }
        u32x2 w; w.x = cvt_pk_bf16(o0[0], o0[1]); w.y = cvt_pk_bf16(o0[2], o0[3]); *(u32x2*)(act + (size_t)(128 * ht) * DFF + c0) = w;
        w.x = cvt_pk_bf16(o1[0], o1[1]); w.y = cvt_pk_bf16(o1[2], o1[3]); *(u32x2*)(act + (size_t)(128 * ht + 1) * DFF + c0) = w;
    }
}

__device__ __forceinline__ att::BlockRef<bf16_t> attn_ref_p(Frame& F, int L, int pass) {
    const int bh = L >> 5, x = L & 31, qb = pass ? 63 - x : x, b = bh >> 5, vhp = bh & 31, vh = vhp >> 1, vhalf = vhp & 1;
    att::BlockRef<bf16_t> r; const size_t row0 = (size_t)b * SEQ;
    r.Q = (const bf16_t*)(F.ws() + WS_UB) + (row0 + (size_t)qb * 256) * DM + vh * 128;
    r.K = (const bf16_t*)(F.ws() + WS_KB) + row0 * DM + vh * 128; r.V = (const bf16_t*)(F.ws() + WS_VB) + row0 * DM + (vh >> 1) * 256 + vhalf * 128; r.Kt = r.K; r.Vt = r.V;
    r.O = (bf16_t*)(F.ws() + WS_BIG) + (row0 + (size_t)qb * 256) * (2 * DM) + vh * 256 + vhalf * 128;
    r.P0 = qb * 256; r.nt = (r.P0 + 255) / 64 + 1; r.nrows = 256; r.pad = 0; return r;
}
__device__ __forceinline__ att::BlockRef<float> attn_ref_s(Frame& F, int L) {
    const int b = L >> 5, vhp = L & 31, vh = vhp >> 1, vhalf = vhp & 1;
    att::BlockRef<float> r;
    r.Q = (const float*)(F.ws() + WS_QS) + (size_t)b * DSEQ * DM + vh * 128;
    r.K = F.in(I_CK) + (size_t)b * PAST * DM + vh * 128; r.V = F.in(I_CV) + (size_t)b * PAST * DM + (vh >> 1) * 256 + vhalf * 128;
    r.Kt = F.out() + O_K_S + (size_t)b * DSEQ * DM + vh * 128; r.Vt = F.out() + O_V_S + (size_t)b * DSEQ * DM + (vh >> 1) * 256 + vhalf * 128;
    r.O = (bf16_t*)(F.ws() + WS_BIG) + ((size_t)MP + (size_t)b * DSEQ) * (2 * DM) + vh * 256 + vhalf * 128;
    r.P0 = PAST; r.nt = PAST / 64 + 1; r.nrows = DSEQ; r.pad = 0; return r;
}
__device__ __forceinline__ datt::DRef dattn_ref(Frame& F, int L, int pass) {
    const int bh = L >> 5, x = L & 31, qb = pass ? 63 - x : x, b = bh >> 4, vh = bh & 15;
    datt::DRef r; const size_t row0 = (size_t)b * SEQ;
    r.Q = (const bf16_t*)(F.ws() + WS_UB) + (row0 + (size_t)qb * 256) * DM + vh * 128;
    r.K = (const bf16_t*)(F.ws() + WS_KB) + row0 * DM + vh * 128; r.V = (const bf16_t*)(F.ws() + WS_VB) + row0 * DM + (vh >> 1) * 256;
    r.O = (bf16_t*)(F.ws() + WS_BIG) + (row0 + (size_t)qb * 256) * (2 * DM) + vh * 256;
    r.P0 = qb * 256; r.pad = 0; return r;
}
__device__ __forceinline__ int attn_item(int bid, int i, int G) { return G == 256 ? ((8 * i + (bid & 7)) << 5) + (bid >> 3) : bid + i * G; }
__device__ __forceinline__ void attn_phase_prompt(Frame& F) {
    constexpr int total = NBAT * 16 * 32; const int G = F.G, bid = F.bid;
    const int nit = G == 256 ? total / 256 : (total - bid + G - 1) / G; if (nit <= 0) return;
    int it = 0, pass = 0; datt::DRef cur = dattn_ref(F, attn_item(bid, 0, G), 0); datt::DSeam S;
    datt::dattn_prime(cur, (LAS char*)F.lds, S);
    for (;;) {
        const bool more_pass = pass == 0, more_item = it + 1 < nit, last = !more_pass && !more_item;
        int passn = pass + 1, itn = it; if (!more_pass) { passn = 0; itn = more_item ? it + 1 : it; }
        const datt::DRef nxt = last ? cur : dattn_ref(F, attn_item(bid, itn, G), passn);
        datt::dattn_block(cur, nxt, (LAS char*)F.lds, S);
        if (last) break;
        cur = nxt; pass = passn; it = itn;
    }
    asm volatile("s_waitcnt vmcnt(0)" ::: "memory"); __syncthreads();
}
__device__ __forceinline__ int attn_item_s(int bid, int i, int G) { return G == 256 ? i * 256 + (((bid & 7) * 8 + (bid >> 5)) << 2) + ((bid >> 3) & 3) : bid + i * G; }
__device__ __forceinline__ void attn_phase_sample(Frame& F) {
    constexpr int total = DB * 32; const int G = F.G, bid = F.bid;
    const int nit = G == 256 ? total / 256 : (total - bid + G - 1) / G; if (nit <= 0) return;
    int it = 0; att::BlockRef<float> cur = attn_ref_s(F, attn_item_s(bid, 0, G)); att::Seam<float> S;
    att::attn_prime<true, float>(cur, (char*)F.lds, S);
    for (;;) {
        const bool last = it + 1 >= nit;
        const att::BlockRef<float> nxt = last ? cur : attn_ref_s(F, attn_item_s(bid, it + 1, G));
        att::attn_block<true, float>(cur, nxt, (char*)F.lds, S);
        if (last) break;
        cur = nxt; ++it;
    }
}

__device__ __forceinline__ void combine_phase(Frame& F) {
    const float l1 = wave_sum(F.in(I_LQ1)[F.lane] * F.in(I_LK1)[F.lane] + F.in(I_LQ1)[64 + F.lane] * F.in(I_LK1)[64 + F.lane]);
    const float l2 = wave_sum(F.in(I_LQ2)[F.lane] * F.in(I_LK2)[F.lane] + F.in(I_LQ2)[64 + F.lane] * F.in(I_LK2)[64 + F.lane]);
    const float lam_init = 0.8f - 0.6f * 0.7408182206817179f;
    const float lam = expf(l1) - expf(l2) + lam_init, post = 1.0f - lam_init;
    const bf16_t* O = (const bf16_t*)(F.ws() + WS_BIG); bf16_t* ab = (bf16_t*)(F.ws() + WS_HB);
    const int hh = F.lane >> 3, cb = (F.lane & 7) * 8;
    f32x4 gs[8];
#pragma unroll
    for (int i = 0; i < 8; ++i) gs[i] = *(const f32x4*)(F.in(I_NSUB) + (i >> 1) * 64 + cb + (i & 1) * 4);
    const int gw = F.bid * NWAVES + F.wave, NGW = F.G * NWAVES;
    for (int m = gw; m < MT; m += NGW) {
        const u32x4* p1 = (const u32x4*)(O + (size_t)m * (2 * DM) + hh * 512 + cb); const u32x4* p2 = (const u32x4*)(O + (size_t)m * (2 * DM) + hh * 512 + 256 + cb);
        u32x4 a[4], c[4];
#pragma unroll
        for (int i = 0; i < 4; ++i) { a[i] = p1[8 * i]; c[i] = p2[8 * i]; }
        float d[32]; float ss = 0.f;
#pragma unroll
        for (int i = 0; i < 4; ++i)
#pragma unroll
            for (int j = 0; j < 4; ++j) { const float x0 = __uint_as_float(a[i][j] << 16) - lam * __uint_as_float(c[i][j] << 16), x1 = __uint_as_float(a[i][j] & 0xffff0000u) - lam * __uint_as_float(c[i][j] & 0xffff0000u);
                d[8 * i + 2 * j] = x0; d[8 * i + 2 * j + 1] = x1; ss += x0 * x0 + x1 * x1; }
        ss += __shfl_xor(ss, 1); ss += __shfl_xor(ss, 2); ss += __shfl_xor(ss, 4);
        const float rstd = rsqrtf(ss * (1.f / VD) + SUBLN_EPS) * post;
        u32x4* op = (u32x4*)(ab + (size_t)m * DM + hh * 256 + cb);
#pragma unroll
        for (int i = 0; i < 4; ++i) { u32x4 w;
#pragma unroll
            for (int j = 0; j < 4; ++j) w[j] = cvt_pk_bf16(d[8 * i + 2 * j] * rstd * gs[2 * i + (j >> 1)][2 * (j & 1)], d[8 * i + 2 * j + 1] * rstd * gs[2 * i + (j >> 1)][2 * (j & 1) + 1]);
            op[8 * i] = w; }
    }
}

__device__ __forceinline__ void final_phase(Frame& F, const float* part, float* dst) {
    const int gw = F.bid * NWAVES + F.wave, NGW = F.G * NWAVES; const float* g = F.in(I_NFIN); const bf16_t* hb = (const bf16_t*)(F.ws() + WS_HB);
    f32x4 gg[4][2];
#pragma unroll
    for (int j = 0; j < 4; ++j) { gg[j][0] = ((const f32x4*)g)[128 * j + 2 * F.lane]; gg[j][1] = ((const f32x4*)g)[128 * j + 2 * F.lane + 1]; }
    for (int m = gw; m < MT; m += NGW) {
        const float pv = F.lane < 32 ? part[part_idx(m >> 7, F.lane, m & 15) + ((m >> 4) & 7)] : 0.f;
        const float rstd = rsqrtf(wave_sum(pv) * (1.f / DM) + EPS);
        const u32x4* row = (const u32x4*)(hb + (size_t)m * DM) + F.lane; f32x4* orow = (f32x4*)(dst + (size_t)m * DM) + 2 * F.lane;
#pragma unroll
        for (int j = 0; j < 4; ++j) { const u32x4 w = row[64 * j];
            const f32x4 a = {__uint_as_float(w[0] << 16), __uint_as_float(w[0] & 0xffff0000u), __uint_as_float(w[1] << 16), __uint_as_float(w[1] & 0xffff0000u)};
            const f32x4 b2 = {__uint_as_float(w[2] << 16), __uint_as_float(w[2] & 0xffff0000u), __uint_as_float(w[3] << 16), __uint_as_float(w[3] & 0xffff0000u)};
            orow[128 * j] = a * rstd * gg[j][0]; orow[128 * j + 1] = b2 * rstd * gg[j][1]; }
    }
}


__device__ __forceinline__ void probe_mfma(Frame& F, int nit) {
    unsigned sd = (unsigned)F.tid * 2654435761u + (unsigned)F.bid * 40503u + 12345u;
    bf16x8 a[2], b[2];
#pragma unroll
    for (int i = 0; i < 2; ++i) { u32x4 wa, wb;
#pragma unroll
        for (int j = 0; j < 4; ++j) { sd = sd * 1664525u + 1013904223u; wa[j] = (sd & 0xbfffbfffu) | 0x3c003c00u; sd = sd * 1664525u + 1013904223u; wb[j] = (sd & 0xbfffbfffu) | 0x3c003c00u; }
        a[i] = *reinterpret_cast<bf16x8*>(&wa); b[i] = *reinterpret_cast<bf16x8*>(&wb); }
    f32x16 c[4] = {};
    for (int it = 0; it < nit; ++it) {
#pragma unroll
        for (int k = 0; k < 4; ++k) { c[k] = __builtin_amdgcn_mfma_f32_32x32x16_bf16(a[k & 1], b[k >> 1], c[k], 0, 0, 0); }
#pragma unroll
        for (int k = 0; k < 4; ++k) { c[k] = __builtin_amdgcn_mfma_f32_32x32x16_bf16(a[(k + 1) & 1], b[k >> 1], c[k], 0, 0, 0); }
        asm volatile("" : "+v"(a[0]), "+v"(b[0]));
    }
    float s = 0.f;
#pragma unroll
    for (int k = 0; k < 4; ++k) for (int r = 0; r < 16; ++r) s += c[k][r];
    if (s == 1.2345e-30f) *(float*)(F.ws() + WS_CTL + 65536) = s;
}
constexpr int NPHASE = 16;
__device__ __forceinline__ Frame mkframe(LAS unsigned char* lds) {
    Frame F; F.lds = lds; F.kp = kargs();
    int t = threadIdx.x; asm volatile("" : "+v"(t));
    F.wave = __builtin_amdgcn_readfirstlane(t >> 6);
    int ln = __builtin_amdgcn_mbcnt_hi(~0u, __builtin_amdgcn_mbcnt_lo(~0u, 0u)); asm volatile("" : "+v"(ln));
    F.lane = ln; F.tid = F.wave * 64 + ln; F.G = gridDim.x; F.bid = blockIdx.x;
    return F;
}
__device__ __forceinline__ bool ph_in(const Frame& F, int k) { const int lo = *(const __attribute__((address_space(4))) int*)(F.kp + 320), hi = *(const __attribute__((address_space(4))) int*)(F.kp + 324); return lo <= k && k < hi; }
template <unsigned PMASK, int K> __device__ __forceinline__ bool phase_on(const Frame& F) { if constexpr (((PMASK >> K) & 1u) == 0u) return false; else return ph_in(F, K); }
template <unsigned PMASK, int K> __device__ __forceinline__ void seam(LAS unsigned char* lds) {
    if constexpr (K + 1 < NPHASE && ((PMASK >> K) & 1u) && ((PMASK >> (K + 1)) & 1u)) {
        Frame F = mkframe(lds);
        if (ph_in(F, K) && ph_in(F, K + 1)) { XcdBarrier bar; bar.bar = (unsigned*)(F.ws() + WS_CTL) + CW_BAR; bar.x = xb_xcc_id(); bar.st = (volatile LAS unsigned*)(lds + LDS_BYTES - 256) + 8; xcd_barrier(bar); }
    }
}
template <class Epi> __device__ __forceinline__ void gemm_both(LAS unsigned char* ring, const bf16_t* A, const bf16_t* Bt, int N, int K, const Epi& E, int G, int bid, int skip = 0) {
    if (skip > 0 && skip < G) { if (bid < skip) return; G -= skip; bid -= skip; }
    const int wid = __builtin_amdgcn_readfirstlane((int)threadIdx.x >> 6);
    asm volatile("" : "+s"(K));
    { pg8::Gemm g{A, Bt, MP, N, K}; pg8::StaticOrder S; S.init(MP, N, G, bid); pg8::gemm_phase<Epi, pg8::StaticOrder, false>(ring, g, S, E, wid); }
    { pg8::Gemm g{A, Bt, MT, N, K}; pg8::HalfOrder H; H.init(MP / 256, N, G, bid); pg8::gemm_phase<Epi, pg8::HalfOrder, true>(ring, g, H, E, wid); }
}
template <int LAYER, int STEP> __device__ __forceinline__ void ffn_phase(Frame& F) {
    LAS unsigned char* ring = F.lds;
    bf16_t* const hb = (bf16_t*)(F.ws() + (LAYER == 0 ? WS_HB : WS_PP)); bf16_t* const ppb = (bf16_t*)(F.ws() + (LAYER == 0 ? WS_PP : WS_HB));
    float* const pin = (float*)(F.ws() + (LAYER == 0 ? WS_PART0 : WS_PART1)); float* const pout = (float*)(F.ws() + (LAYER == 0 ? WS_PART1 : WS_PART0));
    if constexpr (STEP == 0) {
        const float* cw = (const float*)(F.ws() + WS_CONVP) + (size_t)LAYER * DFF * 8; const float* cb = nullptr; const float* st = F.in(I_SCONV) + (size_t)LAYER * DB * 2 * DFF2;
        float* cp = F.out() + O_CONV_P + (size_t)LAYER * NBAT * 2 * DFF2; float* cs = F.out() + O_CONV_S + (size_t)LAYER * DB * 2 * DFF2;
        constexpr int NP = LAYER == 0 ? 64 : 32;
        EpiUp<NP> E{pin, (bf16_t*)(F.ws() + WS_BIG), cw, cb, st, (float*)(F.ws() + WS_ZSIDE), cp, cs, F.lds, (LAYER == 0 ? 1 : 2) << 20};
        gemm_both(ring, hb, (const bf16_t*)(F.ws() + WS_WUP) + (size_t)LAYER * DFF2 * DM, DFF2, DM, E, F.G, F.bid);
        if constexpr (LAYER == 0) bg_work<1>(F, 4 * (DFF2 / 256), bg_slot(F, 1));
    } else if constexpr (STEP == 1) { fixup_phase(F, LAYER);
    } else if constexpr (STEP == 2) {
        EpiResid E{hb, pout};
        gemm_both(ring, (const bf16_t*)(F.ws() + WS_BIG), (const bf16_t*)(F.ws() + WS_WDOWN) + (size_t)LAYER * DM * DFF, DM, DFF, E, F.G, F.bid);
    } else if constexpr (STEP == 3) {
        EpiBf16 E{ppb, DM};
        gemm_both(ring, (const bf16_t*)(F.ws() + WS_PB), (const bf16_t*)(F.ws() + WS_WPROJ) + (size_t)LAYER * DM * PLE, DM, PLE, E, F.G, F.bid, 4 * (DM / 256));
    } else {
        if constexpr (LAYER == 0) convert_p(F, 1);
        EpiPle E{pout, hb, ppb, pin, F.lds, (LAYER == 0 ? 3 : 4) << 20};
        gemm_both(ring, hb, (const bf16_t*)(F.ws() + WS_WGATE) + (size_t)LAYER * DM * DM, DM, DM, E, F.G, F.bid);
        if constexpr (LAYER == 0) { const int sl = bg_slot(F, 3); bg_work<3>(F, 4 * (DM / 256), sl); bg_work<2>(F, 4 * (DM / 256), sl); }
    }
}
template <unsigned PMASK> __global__ void __launch_bounds__(NTHR, 2) yoco_fwd(Args args) {
    extern __shared__ __attribute__((aligned(16))) unsigned char lds_raw[];
    LAS unsigned char* const lds = (LAS unsigned char*)lds_raw;
    (void)args;
    { Frame F = mkframe(lds);
      volatile LAS unsigned* MISC = (volatile LAS unsigned*)(lds + LDS_BYTES - 256);
      if (F.tid < 64) MISC[F.tid] = 0u;
      __syncthreads();
      if (MK_N_LAUNCHES == 1) (void)xcd_barrier_post((unsigned*)(F.ws() + WS_CTL) + CW_BAR, MISC + 8); }
    if (PROBE_MFMA) { Frame F = mkframe(lds); if (phase_on<PMASK, 0>(F)) probe_mfma(F, PROBE_MFMA); }
#define PH(K, ...) { Frame F = mkframe(lds); if (phase_on<PMASK, K>(F)) { __VA_ARGS__ } } seam<PMASK, K>(lds);
    if (PROBE_P2) { Frame F = mkframe(lds); if (phase_on<PMASK, 0>(F)) { p0_prologue(F); __syncthreads(); } }
    PH(0, p0_prologue(F);)
    if (PROBE_SSM2) { Frame F = mkframe(lds); if (phase_on<PMASK, 1>(F)) { ssm_phase(F, (bf16_t*)(F.ws() + WS_PP)); __syncthreads(); } }
    PH(1, ssm_phase(F, (bf16_t*)(F.ws() + WS_UB));)
    PH(2, { EpiGlu E{F.in(I_XP), F.in(I_XS), (bf16_t*)(F.ws() + WS_HB), (float*)(F.ws() + WS_PART0)};
            gemm_both(F.lds, (const bf16_t*)(F.ws() + WS_UB), (const bf16_t*)(F.ws() + WS_WGLU), 2 * DM, DM, E, F.G, F.bid); bg_work<0>(F, 4 * (2 * DM / 256), bg_slot(F, 0)); })
    if (PROBE_UP2) { Frame F = mkframe(lds); if (phase_on<PMASK, 3>(F)) { ffn_phase<0, 0>(F); } }
    PH(3, (ffn_phase<0, 0>(F));)
    if (PROBE_FF2) { Frame F = mkframe(lds); if (phase_on<PMASK, 4>(F)) { ffn_phase<0, 1>(F); } }
    PH(4, (ffn_phase<0, 1>(F));)
    { Frame F = mkframe(lds); if (phase_on<PMASK, 5>(F)) { ffn_phase<0, 2>(F); } }
    PH(5, (ffn_phase<0, 3>(F));)
    PH(6, (ffn_phase<0, 4>(F));)
    PH(7, { EpiQkv E{(const float*)(F.ws() + WS_PART0), (const float*)(F.ws() + WS_ROPE), (bf16_t*)(F.ws() + WS_UB), (float*)(F.ws() + WS_QS), (bf16_t*)(F.ws() + WS_KB), (bf16_t*)(F.ws() + WS_VB), F.out(), F.lds, 5 << 20};
            gemm_both(F.lds, (const bf16_t*)(F.ws() + WS_PP), (const bf16_t*)(F.ws() + WS_WQKV), 3 * DM, DM, E, F.G, F.bid); bg_work<4>(F, 4 * (3 * DM / 256), bg_slot(F, 4)); })
    { Frame F = mkframe(lds); if (phase_on<PMASK, 8>(F)) { attn_phase_prompt(F); } }
    if (PROBE_ATT2) { Frame F = mkframe(lds); if (phase_on<PMASK, 8>(F)) { attn_phase_prompt(F); } }
    if (PROBE_S2) { Frame F = mkframe(lds); if (phase_on<PMASK, 8>(F)) { attn_phase_sample(F); } }
    PH(8, attn_phase_sample(F);)
    if (PROBE_S2) { Frame F = mkframe(lds); if (phase_on<PMASK, 9>(F)) { combine_phase(F); } }
    PH(9, combine_phase(F);)
    PH(10, { EpiResid E{(bf16_t*)(F.ws() + WS_PP), (float*)(F.ws() + WS_PART1)};
             gemm_both(F.lds, (const bf16_t*)(F.ws() + WS_HB), (const bf16_t*)(F.ws() + WS_WO), DM, DM, E, F.G, F.bid); })
    if (PROBE_UP2) { Frame F = mkframe(lds); if (phase_on<PMASK, 11>(F)) { ffn_phase<1, 0>(F); } }
    PH(11, (ffn_phase<1, 0>(F));)
    if (PROBE_FF2) { Frame F = mkframe(lds); if (phase_on<PMASK, 12>(F)) { ffn_phase<1, 1>(F); } }
    PH(12, (ffn_phase<1, 1>(F));)
    { Frame F = mkframe(lds); if (phase_on<PMASK, 13>(F)) { ffn_phase<1, 2>(F); } }
    PH(13, (ffn_phase<1, 3>(F));)
    PH(14, (ffn_phase<1, 4>(F));)
    if (PROBE_FF2) { Frame F = mkframe(lds); if (phase_on<PMASK, 15>(F)) { final_phase(F, (const float*)(F.ws() + WS_PART1), (float*)(F.ws() + WS_UB)); } }
    PH(15, final_phase(F, (const float*)(F.ws() + WS_PART1), F.out());)
#undef PH
}

#ifndef PHASE_MASK
#define PHASE_MASK 0xFFFFu
#endif
template <unsigned PMASK> static bool prep_kernel() {
    if (hipFuncSetAttribute((const void*)yoco_fwd<PMASK>, hipFuncAttributeMaxDynamicSharedMemorySize, LDS_BYTES) != hipSuccess) { fprintf(stderr, "kernel_launch: hipFuncSetAttribute failed\n"); return false; }
    return true;
}
template <int P> static void launch_phases(int grid, Args& a, hipStream_t stream) {
    if constexpr (P < NPHASE) {
        if ((PHASE_MASK >> P) & 1u) { a.ph_lo = P; a.ph_hi = P + 1; hipLaunchKernelGGL(yoco_fwd<(1u << P)>, dim3(grid), dim3(NTHR), LDS_BYTES, stream, a); }
        launch_phases<P + 1>(grid, a, stream);
    }
}
template <int P> static bool prep_phases() { if constexpr (P < NPHASE) { return prep_kernel<(1u << P)>() && prep_phases<P + 1>(); } else return true; }
extern "C" void kernel_launch(void* const* d_in, const int* in_sizes, int n_in, void* d_out, int out_size, void* d_ws, size_t ws_size, hipStream_t stream) {
    static int grid = 0;
    if (grid == 0) {
        if (n_in != 38 || out_size != (int)O_END || ws_size < WS_END) { fprintf(stderr, "kernel_launch: unexpected shapes (n_in %d, out %d, ws %zu)\n", n_in, out_size, ws_size); grid = -1; return; }
        int dev = 0, cus = 0;
        if (hipGetDevice(&dev) != hipSuccess || hipDeviceGetAttribute(&cus, hipDeviceAttributeMultiprocessorCount, dev) != hipSuccess) { grid = -1; return; }
        bool ok;
        if constexpr (MK_N_LAUNCHES == 1) ok = prep_kernel<0xFFFFu>(); else ok = prep_phases<0>();
        if (!ok) { grid = -1; return; }
        (void)hipGetLastError();
        grid = cus;
    }
    if (grid < 0) return;
    (void)hipMemsetAsync((char*)d_ws + WS_CTL, 0, CTL_ZERO_BYTES, stream);
    Args a{};
    for (int i = 0; i < 38; ++i) a.in[i] = (const float*)d_in[i];
    a.out = (float*)d_out; a.ws = (unsigned char*)d_ws;
    if constexpr (MK_N_LAUNCHES == 1) { a.ph_lo = 0; a.ph_hi = NPHASE; hipLaunchKernelGGL(yoco_fwd<0xFFFFu>, dim3(grid), dim3(NTHR), LDS_BYTES, stream, a); }
    else launch_phases<0>(grid, a, stream);
}
```

```cpp
#include <hip/hip_runtime.h>
#include <cstdio>
#include <cstdint>

#ifndef MK_N_LAUNCHES
#define MK_N_LAUNCHES 1
#endif

#ifndef PROBE_ATT2
#define PROBE_ATT2 0
#endif
#ifndef PROBE_UP2
#define PROBE_UP2 0
#endif
#ifndef PROBE_G2
#define PROBE_G2 0
#endif
#ifndef PROBE_SSM2
#define PROBE_SSM2 0
#endif
#ifndef PROBE_MFMA
#define PROBE_MFMA 0
#endif
#ifndef PROBE_FF2
#define PROBE_FF2 0
#endif
#ifndef PROBE_PO2
#define PROBE_PO2 0
#endif
#ifndef PROBE_DOWN2
#define PROBE_DOWN2 0
#endif
#ifndef PROBE_P2
#define PROBE_P2 0
#endif
#ifndef PROBE_S2
#define PROBE_S2 0
#endif
#define LAS __attribute__((address_space(3)))
typedef unsigned short bf16_t;
typedef short bf16x8 __attribute__((ext_vector_type(8)));
typedef short s16x4 __attribute__((ext_vector_type(4)));
typedef float f32x4 __attribute__((ext_vector_type(4)));
typedef float f32x2 __attribute__((ext_vector_type(2)));
typedef float f32x16 __attribute__((ext_vector_type(16)));
typedef unsigned u32x4 __attribute__((ext_vector_type(4)));
typedef unsigned u32x2 __attribute__((ext_vector_type(2)));

constexpr int DM = 2048, SEQ = 16384, NBAT = 2, MP = NBAT * SEQ, DB = 16, DSEQ = 32, MS = DB * DSEQ, MT = MP + MS;
constexpr int NTILE = MT / 256;
constexpr int DFF = 5632, DFF2 = 2 * DFF, PLE = 256, PAST = 2048;
constexpr int NG = 128, NST = 64, NH = 8, HD = 128, VD = 256;
constexpr float EPS = 1e-6f, SUBLN_EPS = 1e-5f;
constexpr int NWAVES = 8, NTHR = 512;

constexpr size_t O_Y = 0, O_YS = 67108864, O_SRE_P = 68157440, O_SIM_P = 68173824, O_CONV_P = 68190208, O_K_P = 68280320, O_V_P = 135389184,
                 O_SRE_S = 202498048, O_SIM_S = 202629120, O_CONV_S = 202760192, O_K_S = 203481088, O_V_S = 204529664, O_END = 205578240;

constexpr size_t MiB = 1u << 20;
constexpr size_t WS_CTL = 0, CTL_ZERO_BYTES = 1 * MiB;
constexpr size_t WS_WGLU = 1 * MiB;
constexpr size_t WS_WUP = 17 * MiB;
constexpr size_t WS_WDOWN = 105 * MiB;
constexpr size_t WS_WGATE = 149 * MiB;
constexpr size_t WS_WPROJ = 165 * MiB;
constexpr size_t WS_WQKV = 167 * MiB;
constexpr size_t WS_WO = 191 * MiB;
constexpr size_t WS_ROPE = 199 * MiB;
constexpr size_t WS_L16 = 202 * MiB;
constexpr size_t WS_CONVP = 202 * MiB + 131072;
constexpr size_t WS_QS = 203 * MiB;
constexpr size_t WS_PB = 209 * MiB;
constexpr size_t WS_PART0 = 226 * MiB, WS_PART1 = 235 * MiB;
constexpr size_t WS_HB = 244 * MiB;
constexpr size_t WS_UB = 374 * MiB;
constexpr size_t WS_PP = 504 * MiB;
constexpr size_t WS_BIG = 634 * MiB;
constexpr size_t WS_KB = 894 * MiB;
constexpr size_t WS_VB = 1022 * MiB;
constexpr size_t WS_END = 1150 * MiB;
constexpr size_t WS_SSM = WS_KB;
constexpr size_t SSM_G_BYTES = 262144;
constexpr size_t WS_ZSIDE = WS_VB;

constexpr int CW_BAR = 4096;

constexpr int RING_BYTES = 131072, LDSCTL_OFF = RING_BYTES, LDS_BYTES = 147456;

__device__ __forceinline__ unsigned cvt_pk_bf16(float lo, float hi) { unsigned r; asm volatile("v_cvt_pk_bf16_f32 %0, %1, %2" : "=v"(r) : "v"(lo), "v"(hi)); return r; }
__device__ __forceinline__ float bf2f(unsigned short b) { return __uint_as_float(((unsigned)b) << 16); }
__device__ __forceinline__ float fsigmoid(float x) { return __builtin_amdgcn_rcpf(1.f + __expf(-x)); }
__device__ __forceinline__ float gelu_tanh(float x) { const float t = 1.5957691216f * (x + 0.044715f * x * x * x); return x * fsigmoid(t); }
__device__ __forceinline__ float wave_sum(float v) {
#pragma unroll
    for (int o = 1; o < 64; o <<= 1) v += __shfl_xor(v, o);
    return v;
}
template <class T> __device__ __forceinline__ T* at32(T* base, unsigned elem) { return (T*)((char*)base + elem * (unsigned)sizeof(T)); }
template <class T> __device__ __forceinline__ const T* at32(const T* base, unsigned elem) { return (const T*)((const char*)base + elem * (unsigned)sizeof(T)); }
template <int CTRL> __device__ __forceinline__ float dppf(float v) { return __int_as_float(__builtin_amdgcn_mov_dpp(__float_as_int(v), CTRL, 0xf, 0xf, false)); }
#define DPP_ROR1 0x121
#define DPP_ROR2 0x122

namespace pg8 {
constexpr int BM = 256, BK = 64, HALF = 128, HTB = HALF * BK * 2, STAGE_BYTES = 8 * HTB, NXCD = 8, WGM = 4;
__host__ __device__ __forceinline__ int lds_byte(int r, int c) { const int st = (r >> 4) * 2 + (c >> 5), rr = r & 15, cc = c & 31, ob = rr * 64 + cc * 2; return st * 1024 + (ob ^ (((ob >> 9) & 1) << 5)); }
__host__ __device__ __forceinline__ void stage_rc(int b, int& R, int& C) { const int st = b / 1024, sb = b % 1024, swz = sb ^ (((sb >> 9) & 1) << 5); R = (st >> 1) * 16 + swz / 64; C = (st & 1) * 32 + (swz % 64) / 2; }
__host__ __device__ __forceinline__ int perm32(int rho) { const int n = rho >> 4, i = rho & 15; return 8 * (i >> 2) + 4 * n + (i & 3); }

struct Unit { int pm, pn, rb, aih; };
struct Gemm { const bf16_t* A; const bf16_t* Bt; int M, N, K; };

struct StaticOrder {
    int nM, nN, nwg, G, c;
    __host__ __device__ void init(int M, int N, int G_, int c_) { nM = M / BM; nN = N / BM; nwg = nM * nN; G = G_; c = c_; }
    __host__ __device__ bool next(int i, Unit& u) const {
        const long L = (long)i * G + c; if (L >= nwg) return false;
        int wgid = (int)L; { const int q = nwg / NXCD, r = nwg % NXCD, xcd = wgid % NXCD, off = wgid / NXCD; wgid = (xcd < r ? xcd * (q + 1) : r * (q + 1) + (xcd - r) * q) + off; }
        const int nig = WGM * nN, gid = wgid / nig, fm = gid * WGM, gsz = (nM - fm) < WGM ? (nM - fm) : WGM;
        u.pm = fm + ((wgid % nig) % gsz); u.pn = (wgid % nig) / gsz; u.rb = u.pm * BM; u.aih = 0; return true;
    }
    __device__ __forceinline__ void a_ready(const Unit&) const {}
    __device__ __forceinline__ void done(const Unit&) const {}
};
struct HalfOrder {
    int nN, nwg, G, c, pm0;
    __host__ __device__ void init(int pm0_, int N, int G_, int c_) { pm0 = pm0_; nN = N / BM; nwg = 4 * nN; G = G_; c = c_; }
    __host__ __device__ bool next(int i, Unit& u) const {
        const long L = (long)i * G + c; if (L >= nwg) return false;
        const int idx = (int)L, sub = idx & 3; u.pn = idx >> 2; u.pm = pm0 + (sub >> 1); u.aih = sub & 1; u.rb = u.pm * BM + 64 * u.aih; return true;
    }
    __device__ __forceinline__ void a_ready(const Unit&) const {}
    __device__ __forceinline__ void done(const Unit&) const {}
};

#ifndef PG8_SP2
#define PG8_SP2 true
#endif
#ifndef PG8_ALIGN
#define PG8_ALIGN true
#endif
template <class Epi, class Sched, bool HALFM = false, bool ALIGN_EPI = PG8_ALIGN, bool SP2 = PG8_SP2>
__device__ __forceinline__ void gemm_phase(LAS unsigned char* lds, const Gemm g, const Sched& S, const Epi& E, const int wid  ) {
    int lane_ = __builtin_amdgcn_mbcnt_hi(~0u, __builtin_amdgcn_mbcnt_lo(~0u, 0u)); asm volatile("" : "+v"(lane_));
    const int lane = lane_, tid = wid * 64 + lane, wr = wid >> 2, wc = wid & 3, fr = lane & 15, fq = lane >> 4;
    const int K = g.K, nt = K / BK;
    unsigned voffA[2], voffB[2];
#pragma unroll
    for (int i = 0; i < 2; ++i) { int R, C; stage_rc(tid * 16 + i * 8192, R, C); const int Rb = Epi::PERM ? ((R & ~31) + perm32(R & 31)) : R;
        const int Ra = (R >> 6) * 128 + (R & 63);
        voffA[i] = (unsigned)(Ra * K + C) * 2u; voffB[i] = (unsigned)(Rb * K + C) * 2u; }
    const __amdgpu_buffer_rsrc_t rsA_ = __builtin_amdgcn_make_buffer_rsrc((void*)g.A, 0, 0x7ffffff0, 0x00020000), rsB_ = __builtin_amdgcn_make_buffer_rsrc((void*)g.Bt, 0, 0x7ffffff0, 0x00020000);
    const size_t kstep = (size_t)(BK * 2);
    const size_t hstepB = (size_t)HALF * K * 2, hstepA = (size_t)64 * K * 2;
    const size_t tstep = (size_t)BM * K * 2;
    const unsigned ldsw = (unsigned)wid * 1024u;
    const int aoff = lds_byte(wr * 64 + fr, fq * 8), boff = lds_byte(wc * 32 + fr, fq * 8);
#define PG8_SA(b, h) (((b) * 2 + (h)) * HTB)
#define PG8_SB(b, h) ((4 + (b) * 2 + (h)) * HTB)
#define PG8_STAGE(bufoff, gbase, voff) do { const int so_ = (int)(unsigned)((const char*)(gbase) - PG8_BASE_##voff); _Pragma("unroll") for (int _i = 0; _i < 2; ++_i) \
        __builtin_amdgcn_raw_ptr_buffer_load_lds(PG8_RS_##voff, (LAS unsigned*)(lds + (bufoff) + ldsw + _i * 8192), 16, (int)(voff)[_i], so_, 0, 0); } while (0)
#define PG8_BASE_voffA ((const char*)g.A)
#define PG8_BASE_voffB ((const char*)g.Bt)
#define PG8_RS_voffA rsA_
#define PG8_RS_voffB rsB_
#define PG8_LDA(dst, b, h) do { _Pragma("unroll") for (int m = 0; m < 4; ++m) _Pragma("unroll") for (int k = 0; k < 2; ++k) dst[m][k] = *(const LAS bf16x8*)(lds + PG8_SA(b, h) + aoff + m * 2048 + k * 1024); } while (0)
#define PG8_LDB(dst, b, h) do { _Pragma("unroll") for (int n = 0; n < 2; ++n) _Pragma("unroll") for (int k = 0; k < 2; ++k) dst[n][k] = *(const LAS bf16x8*)(lds + PG8_SB(b, h) + boff + n * 2048 + k * 1024); } while (0)
#define PG8_MMA(ai, bj, At, Bt) do { __builtin_amdgcn_s_setprio(1); _Pragma("unroll") for (int m = 0; m < 4; ++m) _Pragma("unroll") for (int n = 0; n < 2; ++n) _Pragma("unroll") for (int k = 0; k < 2; ++k) \
        acc[ai][bj][m][n] = __builtin_amdgcn_mfma_f32_16x16x32_bf16(Bt[n][k], At[m][k], acc[ai][bj][m][n], 0, 0, 0); __builtin_amdgcn_s_setprio(0); } while (0)
#define PG8_WAIT_V(n) asm volatile("s_waitcnt vmcnt(" #n ")" ::: "memory")
#define PG8_WAIT_L(n) asm volatile("s_waitcnt lgkmcnt(" #n ")" ::: "memory")
#define PG8_BAR __builtin_amdgcn_s_barrier()
#define PG8_SCHED __builtin_amdgcn_sched_barrier(0)
    Unit cur, nxt; int ui = 0;
    if (!S.next(0, cur)) return;
    f32x4 acc[2][2][4][2];
#pragma unroll
    for (int a = 0; a < 2; ++a)
#pragma unroll
        for (int b = 0; b < 2; ++b)
#pragma unroll
            for (int m = 0; m < 4; ++m)
#pragma unroll
                for (int n = 0; n < 2; ++n) acc[a][b][m][n] = (f32x4){0.f, 0.f, 0.f, 0.f};
    bf16x8 At[4][2], B0[2][2], B1[2][2];
    static_assert(SP2 || !HALFM, "half-M units: SP2 loop only");
    const char* cA = (const char*)g.A + (size_t)cur.pm * tstep + (size_t)cur.aih * hstepA; const char* cB = (const char*)g.Bt + (size_t)cur.pn * tstep;
    S.a_ready(cur);
    if constexpr (SP2) {
        PG8_STAGE(PG8_SB(0, 0), cB, voffB); PG8_STAGE(PG8_SB(0, 1), cB + hstepB, voffB); PG8_STAGE(PG8_SA(0, 0), cA, voffA); if constexpr (!HALFM) PG8_STAGE(PG8_SA(0, 1), cA + hstepA, voffA);
        if (wr == 1) PG8_BAR;
        if constexpr (HALFM) PG8_WAIT_V(0); else PG8_WAIT_V(2);
        PG8_BAR;
        PG8_STAGE(PG8_SB(1, 0), cB + kstep, voffB); PG8_STAGE(PG8_SA(1, 0), cA + kstep, voffA); PG8_STAGE(PG8_SB(1, 1), cB + hstepB + kstep, voffB);
        PG8_WAIT_V(6); PG8_BAR;
    } else {
    PG8_STAGE(PG8_SB(0, 0), cB, voffB); PG8_STAGE(PG8_SA(0, 0), cA, voffA); PG8_STAGE(PG8_SB(0, 1), cB + hstepB, voffB); PG8_STAGE(PG8_SA(0, 1), cA + hstepA, voffA);
    if (wr == 1) PG8_BAR;
    PG8_WAIT_V(4); PG8_BAR;
    PG8_STAGE(PG8_SB(1, 0), cB + kstep, voffB); PG8_STAGE(PG8_SA(1, 0), cA + kstep, voffA); PG8_STAGE(PG8_SB(1, 1), cB + hstepB + kstep, voffB);
    PG8_WAIT_V(6); PG8_BAR;
    }
    for (;;) {
        const bool has_next = S.next(ui + 1, nxt);
        const char* nA = has_next ? (const char*)g.A + (size_t)nxt.pm * tstep + (size_t)nxt.aih * hstepA : cA; const char* nB = has_next ? (const char*)g.Bt + (size_t)nxt.pn * tstep : cB;
        for (int t = 0; t < nt; t += 2) {
            const bool last = (t == nt - 2);
            const char* a1 = cA + (size_t)(t + 1) * kstep;
            const char* a2 = last ? nA : cA + (size_t)(t + 2) * kstep; const char* b2 = last ? nB : cB + (size_t)(t + 2) * kstep;
            const char* a3 = a2 + kstep; const char* b3 = b2 + kstep;
            if (last && has_next) S.a_ready(nxt);
            if constexpr (SP2) {
#define PG8_WAIT_VH() do { if constexpr (HALFM) PG8_WAIT_V(6); else PG8_WAIT_V(8); } while (0)
            PG8_LDB(B0, 0, 0); PG8_LDB(B1, 0, 1); PG8_SCHED; PG8_LDA(At, 0, 0); if constexpr (!HALFM) PG8_STAGE(PG8_SA(1, 1), a1 + hstepA, voffA);
            PG8_WAIT_VH(); PG8_WAIT_L(0); PG8_BAR; PG8_MMA(0, 0, At, B0); PG8_MMA(0, 1, At, B1); PG8_BAR; PG8_SCHED;
            if constexpr (!HALFM) PG8_LDA(At, 0, 1); PG8_STAGE(PG8_SB(0, 0), b2, voffB); PG8_STAGE(PG8_SB(0, 1), b2 + hstepB, voffB); PG8_STAGE(PG8_SA(0, 0), a2, voffA);
            PG8_WAIT_VH(); PG8_WAIT_L(0); PG8_BAR; if constexpr (!HALFM) { PG8_MMA(1, 0, At, B0); PG8_MMA(1, 1, At, B1); } PG8_BAR; PG8_SCHED;
            PG8_LDB(B0, 1, 0); PG8_LDB(B1, 1, 1); PG8_SCHED; PG8_LDA(At, 1, 0); if constexpr (!HALFM) PG8_STAGE(PG8_SA(0, 1), a2 + hstepA, voffA);
            PG8_WAIT_VH(); PG8_WAIT_L(0); PG8_BAR; PG8_MMA(0, 0, At, B0); PG8_MMA(0, 1, At, B1); PG8_BAR; PG8_SCHED;
            if constexpr (!HALFM) PG8_LDA(At, 1, 1); PG8_STAGE(PG8_SB(1, 0), b3, voffB); PG8_STAGE(PG8_SB(1, 1), b3 + hstepB, voffB); PG8_STAGE(PG8_SA(1, 0), a3, voffA);
            PG8_WAIT_VH(); PG8_WAIT_L(0); PG8_BAR; if constexpr (!HALFM) { PG8_MMA(1, 0, At, B0); PG8_MMA(1, 1, At, B1); } PG8_BAR; PG8_SCHED;
#undef PG8_WAIT_VH
            } else {
            PG8_LDB(B0, 0, 0); PG8_SCHED; PG8_LDA(At, 0, 0); PG8_STAGE(PG8_SA(1, 1), a1 + hstepA, voffA);
            PG8_WAIT_L(8); PG8_BAR; PG8_WAIT_L(0); PG8_MMA(0, 0, At, B0); PG8_BAR; PG8_SCHED;
            PG8_LDB(B1, 0, 1); PG8_STAGE(PG8_SB(0, 0), b2, voffB);
            PG8_BAR; PG8_WAIT_L(0); PG8_MMA(0, 1, At, B1); PG8_BAR;
            PG8_LDA(At, 0, 1); PG8_STAGE(PG8_SA(0, 0), a2, voffA);
            PG8_BAR; PG8_WAIT_L(0); PG8_MMA(1, 0, At, B0); PG8_BAR; PG8_SCHED;
            PG8_STAGE(PG8_SB(0, 1), b2 + hstepB, voffB);
            PG8_WAIT_V(6); PG8_BAR; PG8_MMA(1, 1, At, B1); PG8_BAR;
            PG8_LDB(B0, 1, 0); PG8_SCHED; PG8_LDA(At, 1, 0); PG8_STAGE(PG8_SA(0, 1), a2 + hstepA, voffA);
            PG8_WAIT_L(8); PG8_BAR; PG8_WAIT_L(0); PG8_MMA(0, 0, At, B0); PG8_BAR; PG8_SCHED;
            PG8_LDB(B1, 1, 1); PG8_STAGE(PG8_SB(1, 0), b3, voffB);
            PG8_BAR; PG8_WAIT_L(0); PG8_MMA(0, 1, At, B1); PG8_BAR;
            PG8_LDA(At, 1, 1); PG8_STAGE(PG8_SA(1, 0), a3, voffA);
            PG8_BAR; PG8_WAIT_L(0); PG8_MMA(1, 0, At, B0); PG8_BAR; PG8_SCHED;
            PG8_STAGE(PG8_SB(1, 1), b3 + hstepB, voffB);
            PG8_WAIT_V(6); PG8_BAR; PG8_MMA(1, 1, At, B1); PG8_BAR;
            }
        }
        if constexpr (ALIGN_EPI) { if (wr == 0) PG8_BAR; }
        E.template run<HALFM ? 1 : 2>(acc, cur, wr, wc, fr, fq); S.done(cur);
        if (!has_next) break;
#pragma unroll
        for (int a = 0; a < 2; ++a)
#pragma unroll
            for (int b = 0; b < 2; ++b)
#pragma unroll
                for (int m = 0; m < 4; ++m)
#pragma unroll
                    for (int n = 0; n < 2; ++n) acc[a][b][m][n] = (f32x4){0.f, 0.f, 0.f, 0.f};
        cur = nxt; cA = nA; cB = nB; ++ui;
        if constexpr (ALIGN_EPI) { if (wr == 1) PG8_BAR; }
    }
    PG8_WAIT_V(0);
    if constexpr (!ALIGN_EPI) { if (wr == 0) PG8_BAR; }
    PG8_BAR;
#undef PG8_SA
#undef PG8_SB
#undef PG8_STAGE
#undef PG8_BASE_voffA
#undef PG8_BASE_voffB
#undef PG8_RS_voffA
#undef PG8_RS_voffB
#undef PG8_LDA
#undef PG8_LDB
#undef PG8_MMA
#undef PG8_WAIT_V
#undef PG8_WAIT_L
#undef PG8_BAR
#undef PG8_SCHED
}
}
using pg8::Unit;

typedef f32x4 Acc[2][2][4][2];

__device__ __forceinline__ unsigned part_idx(int ph, int slot, int fr) { return (unsigned)(((ph * 64 + slot) * 16 + fr) * 8); }
constexpr int RSTD_LDS = RING_BYTES;
template <int NP, int NAI> __device__ __forceinline__ void load_rstd(const float* part, int rowbase, int fr, int fq, float (&rs)[2][4], LAS unsigned char* lds, int wid, int key) {
    LAS float* rc = (LAS float*)(lds + RSTD_LDS) + wid * 128; LAS int* tagp = (LAS int*)(lds + LDS_BYTES - 256) + 32 + wid;
    const int want = key | rowbase;
    if (__builtin_amdgcn_readfirstlane(*tagp) == want) {
#pragma unroll
        for (int ai = 0; ai < NAI; ++ai)
#pragma unroll
            for (int m = 0; m < 4; ++m) rs[ai][m] = rc[64 * ai + 16 * m + fr];
        return;
    }
    { const int ph = rowbase >> 7, q0 = (rowbase >> 4) & 7;
      f32x4 sacc[2] = {{0.f, 0.f, 0.f, 0.f}, {0.f, 0.f, 0.f, 0.f}};
#pragma unroll
      for (int i = 0; i < NP / 4; ++i) { const unsigned o_ = part_idx(ph, fq * (NP / 4) + i, fr) + q0;
#pragma unroll
          for (int ai = 0; ai < NAI; ++ai) sacc[ai] += *(const f32x4*)at32(part, o_ + 4 * ai);
          if ((i & 3) == 3) asm volatile("" : "+v"(sacc[0]), "+v"(sacc[1]));     }
#pragma unroll
      for (int ai = 0; ai < NAI; ++ai)
#pragma unroll
        for (int m = 0; m < 4; ++m) { float sv = sacc[ai][m]; sv += __shfl_xor(sv, 16); sv += __shfl_xor(sv, 32);
            rs[ai][m] = rsqrtf(sv * (1.0f / DM) + EPS);
            if (NAI == 2 && fq == 0) rc[64 * ai + 16 * m + fr] = rs[ai][m]; } }
    if (NAI == 2) { if (fr == 0 && fq == 0) *tagp = want; }
    asm volatile("s_waitcnt lgkmcnt(0)" ::: "memory");
}

template <int NAI> __device__ __forceinline__ void store_part4(float* part, const Unit& u, int wr, int slot, int fr, int fq, int ai, const f32x4 v) {
    if (fq == 0) *(f32x4*)at32(part, part_idx(u.pm * 2 + wr, slot, fr) + 4u * (unsigned)(NAI == 1 ? u.aih : ai)) = v;
}
struct EpiGlu {
    static constexpr bool PERM = true;
    const float* xp; const float* xs; bf16_t* hb; float* part;
    template <int NAI> __device__ __forceinline__ void run(Acc& acc, const Unit& u, int wr, int wc, int fr, int fq) const {
        asm volatile("" : "+v"(fr), "+v"(fq));
        const int rowbase = u.rb + wr * 128 + fr, col0 = u.pn * 128 + wc * 32 + 8 * fq;
        const bool smp = u.pm >= MP / 256; const float* xb = smp ? xs : xp; const int rsub = smp ? MP : 0;
#pragma unroll
        for (int ai = 0; ai < NAI; ++ai) {
            f32x4 xv[4][2]; f32x4 ssv;
#pragma unroll
            for (int m = 0; m < 4; ++m)
#pragma unroll
                for (int n = 0; n < 2; ++n) xv[m][n] = *(const f32x4*)at32(xb, (unsigned)((rowbase + 64 * ai + 16 * m - rsub) * DM + col0 + 4 * n));
#pragma unroll
            for (int m = 0; m < 4; ++m) {
                const int r = rowbase + 64 * ai + 16 * m; float ss = 0.f; u32x4 w;
#pragma unroll
                for (int n = 0; n < 2; ++n) {
                    const f32x4 a = acc[ai][0][m][n], b = acc[ai][1][m][n]; f32x4 o;
#pragma unroll
                    for (int j = 0; j < 4; ++j) { o[j] = xv[m][n][j] + a[j] * fsigmoid(b[j]); ss += o[j] * o[j]; }
                    w[2 * n] = cvt_pk_bf16(o[0], o[1]); w[2 * n + 1] = cvt_pk_bf16(o[2], o[3]);
                }
                *(u32x4*)at32(hb, (unsigned)(r * DM + col0)) = w;
                ss += __shfl_xor(ss, 16); ss += __shfl_xor(ss, 32);
                ssv[m] = ss;
            }
            store_part4<NAI>(part, u, wr, u.pn * 4 + wc, fr, fq, ai, ssv);
        }
    }
};

struct EpiResid {
    static constexpr bool PERM = true;
    bf16_t* hb; float* part;
    template <int NAI> __device__ __forceinline__ void run(Acc& acc, const Unit& u, int wr, int wc, int fr, int fq) const {
        asm volatile("" : "+v"(fr), "+v"(fq));
        const int rowbase = u.rb + wr * 128 + fr, col0 = u.pn * 256 + wc * 32 + 8 * fq;
#pragma unroll
        for (int ai = 0; ai < NAI; ++ai) {
            u32x4 hv[4][2]; f32x4 ssv;
#pragma unroll
            for (int m = 0; m < 4; ++m)
#pragma unroll
                for (int bj = 0; bj < 2; ++bj) hv[m][bj] = *(const u32x4*)at32((const bf16_t*)hb, (unsigned)((rowbase + 64 * ai + 16 * m) * DM + col0 + 128 * bj));
#pragma unroll
            for (int m = 0; m < 4; ++m) {
                const int r = rowbase + 64 * ai + 16 * m; float ss = 0.f;
#pragma unroll
                for (int bj = 0; bj < 2; ++bj) { u32x4 w;
#pragma unroll
                    for (int n = 0; n < 2; ++n) {
                        const unsigned h0 = hv[m][bj][2 * n], h1 = hv[m][bj][2 * n + 1]; const f32x4 a = acc[ai][bj][m][n];
                        const f32x4 o = {__uint_as_float(h0 << 16) + a[0], __uint_as_float(h0 & 0xffff0000u) + a[1], __uint_as_float(h1 << 16) + a[2], __uint_as_float(h1 & 0xffff0000u) + a[3]};
                        ss += (o[0] * o[0] + o[1] * o[1]) + (o[2] * o[2] + o[3] * o[3]);
                        w[2 * n] = cvt_pk_bf16(o[0], o[1]); w[2 * n + 1] = cvt_pk_bf16(o[2], o[3]);
                    }
                    *(u32x4*)at32(hb, (unsigned)(r * DM + col0 + 128 * bj)) = w; }
                ss += __shfl_xor(ss, 16); ss += __shfl_xor(ss, 32);
                ssv[m] = ss;
            }
            store_part4<NAI>(part, u, wr, u.pn * 4 + wc, fr, fq, ai, ssv);
        }
    }
};

struct EpiBf16 {
    static constexpr bool PERM = true;
    bf16_t* O; int ldc;
    template <int NAI> __device__ __forceinline__ void run(Acc& acc, const Unit& u, int wr, int wc, int fr, int fq) const {
        asm volatile("" : "+v"(fr), "+v"(fq));
        const int rowbase = u.rb + wr * 128 + fr, col0 = u.pn * 256 + wc * 32 + 8 * fq;
#pragma unroll
        for (int ai = 0; ai < NAI; ++ai)
#pragma unroll
            for (int m = 0; m < 4; ++m) { const unsigned ro = (unsigned)((rowbase + 64 * ai + 16 * m) * ldc + col0);
#pragma unroll
                for (int bj = 0; bj < 2; ++bj) { const f32x4 v0 = acc[ai][bj][m][0], v1 = acc[ai][bj][m][1];
                    u32x4 w = {cvt_pk_bf16(v0[0], v0[1]), cvt_pk_bf16(v0[2], v0[3]), cvt_pk_bf16(v1[0], v1[1]), cvt_pk_bf16(v1[2], v1[3])}; *(u32x4*)at32(O, ro + (unsigned)(bj * 128)) = w; } }
    }
};

struct EpiPle {
    static constexpr bool PERM = true;
    const float* partin; const bf16_t* hsrc; bf16_t* ppio; float* part; LAS unsigned char* lds; int key;
    template <int NAI> __device__ __forceinline__ void run(Acc& acc, const Unit& u, int wr, int wc, int fr, int fq) const {
        asm volatile("" : "+v"(fr), "+v"(fq));
        const int rowbase = u.rb + wr * 128 + fr, col0 = u.pn * 256 + wc * 32 + 8 * fq;
        float rs[2][4]; load_rstd<32, NAI>(partin, u.rb + wr * 128, fr, fq, rs, lds, wr * 4 + wc, key); f32x4 ssv = {0.f, 0.f, 0.f, 0.f};
#pragma unroll
        for (int q2 = 0; q2 < 2 * NAI; ++q2) {
            const int ai = q2 >> 1, m0 = (q2 & 1) * 2;
            u32x4 hv[2][2], pv[2][2];
#pragma unroll
            for (int mm = 0; mm < 2; ++mm)
#pragma unroll
                for (int bj = 0; bj < 2; ++bj) { const unsigned o_ = (unsigned)((rowbase + 64 * ai + 16 * (m0 + mm)) * DM + col0 + 128 * bj);
                    hv[mm][bj] = *(const u32x4*)at32(hsrc, o_); pv[mm][bj] = *(const u32x4*)at32((const bf16_t*)ppio, o_); }
#pragma unroll
            for (int mm = 0; mm < 2; ++mm) {
                const int m = m0 + mm, r = rowbase + 64 * ai + 16 * m; float ss = 0.f;
#pragma unroll
                for (int bj = 0; bj < 2; ++bj) { u32x4 w;
#pragma unroll
                    for (int n = 0; n < 2; ++n) {
                        const unsigned pw0 = pv[mm][bj][2 * n], pw1 = pv[mm][bj][2 * n + 1], h0 = hv[mm][bj][2 * n], h1 = hv[mm][bj][2 * n + 1];
                        const f32x4 a = acc[ai][bj][m][n] * rs[ai][m]; f32x4 o;
                        o[0] = __uint_as_float(h0 << 16) + __uint_as_float(pw0 << 16) * fsigmoid(a[0]); o[1] = __uint_as_float(h0 & 0xffff0000u) + __uint_as_float(pw0 & 0xffff0000u) * fsigmoid(a[1]);
                        o[2] = __uint_as_float(h1 << 16) + __uint_as_float(pw1 << 16) * fsigmoid(a[2]); o[3] = __uint_as_float(h1 & 0xffff0000u) + __uint_as_float(pw1 & 0xffff0000u) * fsigmoid(a[3]);
                        ss += (o[0] * o[0] + o[1] * o[1]) + (o[2] * o[2] + o[3] * o[3]);
                        w[2 * n] = cvt_pk_bf16(o[0], o[1]); w[2 * n + 1] = cvt_pk_bf16(o[2], o[3]);
                    }
                    *(u32x4*)at32(ppio, (unsigned)(r * DM + col0 + 128 * bj)) = w; }
                ss += __shfl_xor(ss, 16); ss += __shfl_xor(ss, 32);
                ssv[m] = ss;
            }
            if (q2 & 1) store_part4<NAI>(part, u, wr, u.pn * 4 + wc, fr, fq, ai, ssv);
        }
    }
};

template <int NP> struct EpiUp {
    static constexpr bool PERM = true;
    const float* partin; bf16_t* act; const float* cw; const float* cb; const float* state; float* zside; float* conv_p; float* conv_s; LAS unsigned char* lds; int key;
    template <int NAI> __device__ __forceinline__ void run(Acc& acc, const Unit& u, int wr, int wc, int fr, int fq) const {
        asm volatile("" : "+v"(fr), "+v"(fq));
        const bool sample = u.pm >= MP / 256;
        const int rowhalf = u.rb + wr * 128;
        { float rs[2][4]; load_rstd<NP, NAI>(partin, rowhalf, fr, fq, rs, lds, wr * 4 + wc, key);
#pragma unroll
          for (int ai = 0; ai < NAI; ++ai)
#pragma unroll
            for (int bj = 0; bj < 2; ++bj)
#pragma unroll
                for (int m = 0; m < 4; ++m)
#pragma unroll
                    for (int n = 0; n < 2; ++n) acc[ai][bj][m][n] = acc[ai][bj][m][n] * rs[ai][m]; }
        const int ht = u.pm * 2 + wr;
        const bool seqstart = (!sample) && ((ht & 127) == 0);
        const bool seqend = (!sample) && ((ht & 127) == 127);
        const int sb2 = ((rowhalf - MP) >> 5) * 2;
        const int c8 = u.pn * 128 + wc * 32 + 8 * fq;
#pragma unroll
        for (int n = 0; n < 2; ++n) {
            const int c0 = c8 + 4 * n;
            if (NAI == 2 && !sample) {
                if (fr < 2) { const unsigned o = (unsigned)((ht * 4 + fr) * DFF2 + c0); *(f32x4*)at32(zside, o) = acc[0][0][0][n]; *(f32x4*)at32(zside, o + DFF) = acc[0][1][0][n]; }
                if (fr >= 14) { const unsigned o = (unsigned)((ht * 4 + 2 + (fr - 14)) * DFF2 + c0); *(f32x4*)at32(zside, o) = acc[NAI - 1][0][3][n]; *(f32x4*)at32(zside, o + DFF) = acc[NAI - 1][1][3][n];
                    if (seqend) { const unsigned o2 = (unsigned)(((ht >> 7) * 2 + (fr - 14)) * DFF2 + c0); *(f32x4*)at32(conv_p, o2) = acc[NAI - 1][0][3][n]; *(f32x4*)at32(conv_p, o2 + DFF) = acc[NAI - 1][1][3][n]; } }
            } else if (sample && fr >= 14) {
#pragma unroll
                for (int qq = 1; qq < 4 * NAI; qq += 2) { const unsigned o2 = (unsigned)((sb2 + (qq >> 1) * 2 + (fr - 14)) * DFF2 + c0);
                    *(f32x4*)at32(conv_s, o2) = acc[qq >> 2][0][qq & 3][n]; *(f32x4*)at32(conv_s, o2 + DFF) = acc[qq >> 2][1][qq & 3][n]; }
            }
        }
        unsigned outp[4 * NAI][4];
        f32x4 nr0 = *(const f32x4*)at32(cw, (unsigned)(c8 * 8)), nr1 = *(const f32x4*)at32(cw, (unsigned)(c8 * 8 + 4)), nr2 = *(const f32x4*)at32(cw, (unsigned)(c8 * 8 + 8)), nr3 = *(const f32x4*)at32(cw, (unsigned)(c8 * 8 + 12));
#pragma unroll
        for (int n = 0; n < 2; ++n)
#pragma unroll
            for (int jp = 0; jp < 2; ++jp) {
                const int c0 = c8 + 4 * n + 2 * jp;
                const f32x4 ra = nr0, rb_ = nr1, rc_ = nr2, rd_ = nr3;
                asm volatile("" ::: "memory");
                if (n * 2 + jp < 3) { const unsigned o = (unsigned)((c0 + 2) * 8); nr0 = *(const f32x4*)at32(cw, o); nr1 = *(const f32x4*)at32(cw, o + 4); nr2 = *(const f32x4*)at32(cw, o + 8); nr3 = *(const f32x4*)at32(cw, o + 12); }
                const f32x2 w0v = {ra[0], ra[1]}, w1v = {ra[2], ra[3]}, w2v = {rb_[0], rb_[1]}, bv = {rb_[2], rb_[3]};
                const f32x2 w0g = {rc_[0], rc_[1]}, w1g = {rc_[2], rc_[3]}, w2g = {rd_[0], rd_[1]}, bg = {rd_[2], rd_[3]};
                f32x2 p1v = {0.f, 0.f}, p2v = p1v, p1g = p1v, p2g = p1v;
#pragma unroll
                for (int q = 0; q < 4 * NAI; ++q) {
                    const int ai = q >> 2, m = q & 3;
                    const f32x2 zv = {acc[ai][0][m][n][2 * jp], acc[ai][0][m][n][2 * jp + 1]}, zg = {acc[ai][1][m][n][2 * jp], acc[ai][1][m][n][2 * jp + 1]};
                    if (sample && !(q & 1)) {
                        f32x2 hv = {0.f, 0.f}, hg = hv;
                        if (fr >= 14) { const unsigned so = (unsigned)((sb2 + (q >> 1) * 2 + (fr - 14)) * DFF2 + c0); hv = *(const f32x2*)at32(state, so); hg = *(const f32x2*)at32(state, so + DFF); }
#pragma unroll
                        for (int j = 0; j < 2; ++j) { p1v[j] = dppf<DPP_ROR1>(hv[j]); p2v[j] = dppf<DPP_ROR2>(hv[j]); p1g[j] = dppf<DPP_ROR1>(hg[j]); p2g[j] = dppf<DPP_ROR2>(hg[j]); }
                    }
                    f32x2 r1v, r2v, r1g, r2g, P1v, P2v, P1g, P2g;
#pragma unroll
                    for (int j = 0; j < 2; ++j) {
                        r1v[j] = dppf<DPP_ROR1>(zv[j]); r2v[j] = dppf<DPP_ROR2>(zv[j]); r1g[j] = dppf<DPP_ROR1>(zg[j]); r2g[j] = dppf<DPP_ROR2>(zg[j]);
                        P1v[j] = fr >= 1 ? r1v[j] : p1v[j]; P2v[j] = fr >= 2 ? r2v[j] : p2v[j]; P1g[j] = fr >= 1 ? r1g[j] : p1g[j]; P2g[j] = fr >= 2 ? r2g[j] : p2g[j];
                    }
                    const f32x2 cv = __builtin_elementwise_fma(w0v, P2v, __builtin_elementwise_fma(w1v, P1v, __builtin_elementwise_fma(w2v, zv, bv)));
                    const f32x2 cg = __builtin_elementwise_fma(w0g, P2g, __builtin_elementwise_fma(w1g, P1g, __builtin_elementwise_fma(w2g, zg, bg)));
                    const f32x2 tt = cg * (f32x2){-1.4426950408889634f, -1.4426950408889634f};
                    f32x2 ee = {__builtin_amdgcn_exp2f(tt[0]), __builtin_amdgcn_exp2f(tt[1])}; ee = ee + (f32x2){1.f, 1.f};
                    const f32x2 sg = {__builtin_amdgcn_rcpf(ee[0]), __builtin_amdgcn_rcpf(ee[1])};
                    const f32x2 o = cv * cg * sg;
                    p1v = r1v; p2v = r2v; p1g = r1g; p2g = r2g;
                    outp[q][2 * n + jp] = cvt_pk_bf16(o[0], o[1]);
                }
            }
#pragma unroll
        for (int q = 0; q < 4 * NAI; ++q) {
            const bool deferred = (!sample) && q == 0 && fr < 2 && !seqstart;
            if (!deferred) { u32x4 w = {outp[q][0], outp[q][1], outp[q][2], outp[q][3]}; *(u32x4*)at32(act, (unsigned)((rowhalf + 16 * q + fr) * DFF + c8)) = w; }
        }
    }
};

struct EpiQkv {
    static constexpr bool PERM = false;
    const float* partin; const float* rope; bf16_t* qb; float* qs; bf16_t* kb; bf16_t* vb; float* out; LAS unsigned char* lds; int key;
    template <int NAI> __device__ __forceinline__ void run(Acc& acc, const Unit& u, int wr, int wc, int fr, int fq) const {
        asm volatile("" : "+v"(fr), "+v"(fq));
        const int rowhalf = u.rb + wr * 128;
        float rs[2][4]; load_rstd<32, NAI>(partin, rowhalf, fr, fq, rs, lds, wr * 4 + wc, key);
        const int which = u.pn >> 3, head = u.pn & 7;
#pragma unroll
        for (int ai = 0; ai < NAI; ++ai)
#pragma unroll
            for (int m = 0; m < 4; ++m) {
                const int r = rowhalf + 64 * ai + 16 * m + fr; const bool smp = r >= MP;
                const int pos = smp ? PAST + ((r - MP) & 31) : (r & (SEQ - 1));
                f32x4 cs = {1.f, 1.f, 1.f, 1.f}, sn = {0.f, 0.f, 0.f, 0.f};
                if (which < 2 && wc == 0) { cs = *(const f32x4*)at32(rope, (unsigned)(pos * 32 + 4 * fq)); sn = *(const f32x4*)at32(rope, (unsigned)(pos * 32 + 16 + 4 * fq)); }
#pragma unroll
                for (int bj = 0; bj < 2; ++bj) {
                    f32x4 v0 = acc[ai][bj][m][0] * rs[ai][m], v1 = acc[ai][bj][m][1] * rs[ai][m];
                    if (which < 2 && wc == 0) { const f32x4 a = v0, b = v1; v0 = a * cs - b * sn; v1 = b * cs + a * sn; }
                    const int c = head * 256 + bj * 128 + wc * 32 + 4 * fq;
                    u32x2 w0, w1; w0.x = cvt_pk_bf16(v0[0], v0[1]); w0.y = cvt_pk_bf16(v0[2], v0[3]); w1.x = cvt_pk_bf16(v1[0], v1[1]); w1.y = cvt_pk_bf16(v1[2], v1[3]);
                    if (which == 0) {
                        *(u32x2*)at32(qb, (unsigned)(r * DM + c)) = w0; *(u32x2*)at32(qb, (unsigned)(r * DM + c + 16)) = w1;
                        if (smp) { *(f32x4*)at32(qs, (unsigned)((r - MP) * DM + c)) = v0; *(f32x4*)at32(qs, (unsigned)((r - MP) * DM + c + 16)) = v1; }
                    } else {
                        float* ob = out + (smp ? (which == 1 ? O_K_S : O_V_S) : (which == 1 ? O_K_P : O_V_P)); const unsigned oo = (unsigned)((smp ? r - MP : r) * DM + c);
                        *(f32x4*)at32(ob, oo) = v0; *(f32x4*)at32(ob, oo + 16u) = v1;
                        if (!smp) { bf16_t* bp = (which == 1 ? kb : vb); *(u32x2*)at32(bp, (unsigned)(r * DM + c)) = w0; *(u32x2*)at32(bp, (unsigned)(r * DM + c + 16)) = w1; }
                    }
                }
            }
    }
};

#define XB_TMO      128
#define XB_XCNT(j)  (256  + 64 * (j))
#define XB_XSUB(j)  (1280 + 64 * (j))
#define XB_XGEN(j)  (2304 + 64 * (j))
#define XB_TOP      3328
#define XB_TOPGEN   3392
#define XCD_BAR_WORDS 3456
#define XB_SPIN_CAP (1u << 22)

__device__ __forceinline__ unsigned xb_ld(unsigned* p)              { return __hip_atomic_load(p, __ATOMIC_RELAXED, __HIP_MEMORY_SCOPE_AGENT); }
__device__ __forceinline__ unsigned xb_add(unsigned* p, unsigned v) { return __hip_atomic_fetch_add(p, v, __ATOMIC_RELAXED, __HIP_MEMORY_SCOPE_AGENT); }
__device__ __forceinline__ unsigned xb_xcc_id() { return (unsigned)__builtin_amdgcn_s_getreg((3 << 11) | 20) & 0xFu; }
#define XB_SPIN(cond, bar) do { unsigned _sp = 0; while (cond) { __builtin_amdgcn_s_sleep(1); \
    if ((++_sp & 255u) == 0u) { if (xb_ld(&(bar)[XB_TMO])) break; if (_sp > XB_SPIN_CAP) { atomicAdd(&(bar)[XB_TMO], 1u); break; } } } } while (0)

struct XcdBarrier { unsigned* bar; unsigned x; volatile LAS unsigned* st; };

__device__ __forceinline__ XcdBarrier xcd_barrier_post(unsigned* bar, volatile LAS unsigned* st) {
    XcdBarrier b; b.bar = bar; b.x = xb_xcc_id(); b.st = st;
    if (threadIdx.x == 0) (void)xb_add(&bar[XB_XCNT(b.x)], 1u);
    return b;
}
__device__ __forceinline__ void xcd_barrier_complete(unsigned* bar, unsigned x, unsigned& nloc, unsigned& nx) {
    const unsigned G = gridDim.x * gridDim.y * gridDim.z;
    unsigned sum, cnt, mine, sp = 0u;
    for (;;) {
        sum = 0u; cnt = 0u; mine = 0u;
#pragma unroll
        for (unsigned j = 0; j < 16; ++j) { const unsigned c = xb_ld(&bar[XB_XCNT(j)]); sum += c; cnt += (c > 0u) ? 1u : 0u; mine = (j == x) ? c : mine; }
        if (sum == G) break;
        __builtin_amdgcn_s_sleep(1);
        if ((++sp & 255u) == 0u) { if (xb_ld(&bar[XB_TMO])) break; if (sp > XB_SPIN_CAP) { atomicAdd(&bar[XB_TMO], 1u); break; } }
    }
    nloc = mine > 0u ? mine : 1u; nx = cnt > 0u ? cnt : 1u;
}
__device__ __forceinline__ void xcd_barrier(const XcdBarrier& b) {
    asm volatile("s_waitcnt vmcnt(0)" ::: "memory");
    __syncthreads();
    if (threadIdx.x == 0) {
        unsigned* bar = b.bar;
        __builtin_amdgcn_s_waitcnt(0);
        unsigned nloc = b.st[0], nx = b.st[1];
        if (nloc == 0u) { xcd_barrier_complete(bar, b.x, nloc, nx); b.st[0] = nloc; b.st[1] = nx; }
        const unsigned old = xb_add(&bar[XB_XSUB(b.x)], 1u);
        const unsigned gen = old / nloc;
        if (old + 1u == (gen + 1u) * nloc) {
            __builtin_amdgcn_fence(__ATOMIC_RELEASE, "agent");
            asm volatile("s_waitcnt vmcnt(0)" ::: "memory");
            const unsigned og = xb_add(&bar[XB_TOP], 1u);
            const unsigned tg = og / nx;
            if (og + 1u == (tg + 1u) * nx) xb_add(&bar[XB_TOPGEN], 1u);
            else XB_SPIN(xb_ld(&bar[XB_TOPGEN]) == tg, bar);
            __builtin_amdgcn_fence(__ATOMIC_ACQUIRE, "agent");
            xb_add(&bar[XB_XGEN(b.x)], 1u);
            asm volatile("s_waitcnt vmcnt(0)" ::: "memory");
        } else {
            XB_SPIN(xb_ld(&bar[XB_XGEN(b.x)]) == gen, bar);
            __builtin_amdgcn_fence(__ATOMIC_ACQUIRE, "agent");
            asm volatile("s_waitcnt vmcnt(0)" ::: "memory");
        }
    }
    __syncthreads();
}

namespace att {
constexpr float SCALE = 0.08838834764831845f, THR = 8.f;
constexpr int NW = 8, QBLK = 32, KVBLK = 64, QB = NW * QBLK, D = 128;
constexpr int SHM_V = KVBLK * D * 2, SHM_K = KVBLK * D * 2;
constexpr int LDS_ATT = 2 * SHM_V + 2 * SHM_K + NW * 64 * 4;
constexpr int QS = DM, KS = DM, OS = 2 * DM;
template <class A, class Bt> struct same_t { static constexpr bool v = false; };
template <class A> struct same_t<A, A> { static constexpr bool v = true; };
#define KSWZ(row, colB) ((row) * 256 + ((colB) ^ (((row) & 7) << 4)))
#define SBAR() __builtin_amdgcn_sched_barrier(0)
__device__ __forceinline__ int v_st(int k, int c) { const int kk = (k & ~0xC) | ((k & 4) << 1) | ((k & 8) >> 1); return ((kk >> 3) * 4 + (c >> 5)) * 512 + ((kk & 7) * 32 + (c & 31)) * 2; }
__device__ __forceinline__ int v_rd_base(int lane) { return ((lane & 3) << 3) | (((lane >> 2) & 3) << 6) | (((lane >> 4) & 1) << 5) | (((lane >> 5) & 1) << 8); }
constexpr int v_rd_off(int d0, int ks, int half) { return d0 * 512 + ks * 4096 + half * 2048; }
__device__ __forceinline__ int crow(int r, int hi) { return (r & 3) + 8 * (r >> 2) + 4 * hi; }
__device__ __forceinline__ unsigned cvtpk(float lo, float hi) { unsigned r; asm volatile("v_cvt_pk_bf16_f32 %0, %1, %2" : "=v"(r) : "v"(lo), "v"(hi)); return r; }
__device__ __forceinline__ bf16x8 pack8(f32x4 a, f32x4 b) { u32x4 w = {cvtpk(a[0], a[1]), cvtpk(a[2], a[3]), cvtpk(b[0], b[1]), cvtpk(b[2], b[3])}; return *reinterpret_cast<bf16x8*>(&w); }
template <class T> __device__ __forceinline__ bf16x8 load8(const T* p) {
    if constexpr (same_t<T, float>::v) { return pack8(*(const f32x4*)p, *(const f32x4*)(p + 4)); }
    else { return *reinterpret_cast<const bf16x8*>(p); }
}
__device__ __forceinline__ void partialSM(f32x16& p0, f32x16& p1, float& m_reg, float& mn, float& alpha) {
    float pmax;
    asm("v_max3_f32 %0, %1, %2, %3" : "=v"(pmax) : "v"(p0[0]), "v"(p0[1]), "v"(p0[2]));
#pragma unroll
    for (int r = 3; r < 15; r += 2) asm("v_max3_f32 %0, %0, %1, %2" : "+v"(pmax) : "v"(p0[r]), "v"(p0[r + 1]));
    asm("v_max3_f32 %0, %0, %1, %2" : "+v"(pmax) : "v"(p0[15]), "v"(p1[0]));
#pragma unroll
    for (int r = 1; r < 15; r += 2) asm("v_max3_f32 %0, %0, %1, %2" : "+v"(pmax) : "v"(p1[r]), "v"(p1[r + 1]));
    asm("v_max_f32 %0, %0, %1" : "+v"(pmax) : "v"(p1[15]));
    { auto rr = __builtin_amdgcn_permlane32_swap(__float_as_uint(pmax), __float_as_uint(pmax), false, false);
      asm("v_max_f32 %0, %1, %2" : "=v"(pmax) : "v"(__uint_as_float(rr[0])), "v"(__uint_as_float(rr[1]))); }
    constexpr float C2 = 1.4426950408889634f * SCALE;
    if (__builtin_expect(__all((pmax - m_reg) * SCALE <= THR), 1)) { mn = m_reg; alpha = 1.f; }
    else { mn = fmaxf(m_reg, pmax); alpha = __builtin_amdgcn_exp2f((m_reg - mn) * C2); m_reg = mn; }
    const float mnL = -mn * C2;
    for (int r = 0; r < 16; ++r) p0[r] = fmaf(p0[r], C2, mnL); for (int r = 0; r < 16; ++r) p1[r] = fmaf(p1[r], C2, mnL);
    for (int r = 0; r < 16; ++r) p0[r] = __builtin_amdgcn_exp2f(p0[r]);
}
__device__ __forceinline__ void partialSM2(f32x16& p0, f32x16& p1, float& mnL, float& mthr, float& alpha) {
    float pmax;
    asm("v_max3_f32 %0, %1, %2, %3" : "=v"(pmax) : "v"(p0[0]), "v"(p0[1]), "v"(p0[2]));
#pragma unroll
    for (int r = 3; r < 15; r += 2) asm("v_max3_f32 %0, %0, %1, %2" : "+v"(pmax) : "v"(p0[r]), "v"(p0[r + 1]));
    asm("v_max3_f32 %0, %0, %1, %2" : "+v"(pmax) : "v"(p0[15]), "v"(p1[0]));
#pragma unroll
    for (int r = 1; r < 15; r += 2) asm("v_max3_f32 %0, %0, %1, %2" : "+v"(pmax) : "v"(p1[r]), "v"(p1[r + 1]));
    asm("v_max_f32 %0, %0, %1" : "+v"(pmax) : "v"(p1[15]));
    { auto rr = __builtin_amdgcn_permlane32_swap(__float_as_uint(pmax), __float_as_uint(pmax), false, false);
      asm("v_max_f32 %0, %1, %2" : "=v"(pmax) : "v"(__uint_as_float(rr[0])), "v"(__uint_as_float(rr[1]))); }
    constexpr float C2 = 1.4426950408889634f * SCALE;
    if (__builtin_expect(__all(pmax <= mthr), 1)) { alpha = 1.f; }
    else { const float m_old = mnL * (-1.f / C2), mn = fmaxf(m_old, pmax); alpha = __builtin_amdgcn_exp2f((m_old - mn) * C2); mnL = -mn * C2; mthr = mn + THR / SCALE; }
    for (int r = 0; r < 16; ++r) p0[r] = fmaf(p0[r], C2, mnL); for (int r = 0; r < 16; ++r) p1[r] = fmaf(p1[r], C2, mnL);
    for (int r = 0; r < 16; ++r) p0[r] = __builtin_amdgcn_exp2f(p0[r]);
}
__device__ __forceinline__ void finishSM(f32x16& p0, f32x16& p1, float alpha, float& l_reg, bf16x8& pa0, bf16x8& pa1, bf16x8& pa2, bf16x8& pa3) {
    for (int r = 0; r < 16; ++r) p1[r] = __builtin_amdgcn_exp2f(p1[r]);
    float ps = 0; for (int r = 0; r < 16; ++r) ps += p0[r]; for (int r = 0; r < 16; ++r) ps += p1[r];
    { auto rr = __builtin_amdgcn_permlane32_swap(__float_as_uint(ps), __float_as_uint(ps), false, false);
      ps = __uint_as_float(rr[0]) + __uint_as_float(rr[1]); }
    l_reg = l_reg * alpha + ps;
#define PK4(P, B_, OUT) do { unsigned a0 = cvtpk(P[B_+0], P[B_+1]), a1 = cvtpk(P[B_+2], P[B_+3]);                          \
        unsigned b0 = cvtpk(P[B_+4], P[B_+5]), b1 = cvtpk(P[B_+6], P[B_+7]);                                             \
        auto r0 = __builtin_amdgcn_permlane32_swap(a0, b0, false, false); auto r1 = __builtin_amdgcn_permlane32_swap(a1, b1, false, false); \
        u32x4 w = {r0[0], r1[0], r0[1], r1[1]}; OUT = *reinterpret_cast<bf16x8*>(&w); } while (0)
    PK4(p0, 0, pa0); PK4(p0, 8, pa1); PK4(p1, 0, pa2); PK4(p1, 8, pa3);
#undef PK4
}
template <int KB>
__device__ __forceinline__ void qkt(f32x16& p0, f32x16& p1, const char* K_lds, int r32, int hi, const bf16x8* qr) {
    p0 = f32x16{}; p1 = f32x16{};
    const char* kb[4];
#pragma unroll
    for (int dd = 0; dd < 4; ++dd) kb[dd] = K_lds + KB * SHM_K + KSWZ(r32, (dd * 16 + hi * 8) * 2);
#pragma unroll
    for (int d0 = 0; d0 < 8; ++d0) { const char* a = kb[d0 & 3] + (d0 >> 2) * 128;
        bf16x8 b0 = *reinterpret_cast<const bf16x8*>(a);
        bf16x8 b1 = *reinterpret_cast<const bf16x8*>(a + 32 * 256);
        p0 = __builtin_amdgcn_mfma_f32_32x32x16_bf16(b0, qr[d0], p0, 0, 0, 0);
        p1 = __builtin_amdgcn_mfma_f32_32x32x16_bf16(b1, qr[d0], p1, 0, 0, 0); }
}
template <int VB>
__device__ __forceinline__ void pv_tile(f32x16* o, int vb0, bf16x8 pa0, bf16x8 pa1, bf16x8 pa2, bf16x8 pa3) {
#define TRRD(dst, off) asm volatile("ds_read_b64_tr_b16 %0, %1 offset:%2" : "=&v"(dst) : "v"(vb0), "i"(off) : "memory")
#define PV_D0(d0) do { s16x4 l0, l1, l2, l3, h0, h1, h2, h3; constexpr int b_ = VB * SHM_V + v_rd_off(d0, 0, 0); \
        TRRD(l0, b_); TRRD(h0, b_ + 2048); TRRD(l1, b_ + 4096); TRRD(h1, b_ + 6144); TRRD(l2, b_ + 8192); TRRD(h2, b_ + 10240); TRRD(l3, b_ + 12288); TRRD(h3, b_ + 14336); \
        asm volatile("s_waitcnt lgkmcnt(0)" ::: "memory"); SBAR();   \
        o[d0] = __builtin_amdgcn_mfma_f32_32x32x16_bf16(pa0, (bf16x8){l0[0], l0[1], l0[2], l0[3], h0[0], h0[1], h0[2], h0[3]}, o[d0], 0, 0, 0);   \
        o[d0] = __builtin_amdgcn_mfma_f32_32x32x16_bf16(pa1, (bf16x8){l1[0], l1[1], l1[2], l1[3], h1[0], h1[1], h1[2], h1[3]}, o[d0], 0, 0, 0);   \
        o[d0] = __builtin_amdgcn_mfma_f32_32x32x16_bf16(pa2, (bf16x8){l2[0], l2[1], l2[2], l2[3], h2[0], h2[1], h2[2], h2[3]}, o[d0], 0, 0, 0);   \
        o[d0] = __builtin_amdgcn_mfma_f32_32x32x16_bf16(pa3, (bf16x8){l3[0], l3[1], l3[2], l3[3], h3[0], h3[1], h3[2], h3[3]}, o[d0], 0, 0, 0); } while (0)
    PV_D0(0); PV_D0(1); PV_D0(2); PV_D0(3);
#undef PV_D0
#undef TRRD
}

template <class TIn> struct BlockRef { const TIn* Q; const TIn* K; const TIn* V; const TIn* Kt; const TIn* Vt; bf16_t* O; int P0, nt, nrows, pad; };
template <class TIn> struct Seam {
    bf16x8 qr[8];
    bf16x8 st_v0, st_v1, st_k0, st_k1; f32x4 sf0, sf1, sf2, sf3;
    f32x4 tq[16];
};
template <bool SMP, class TIn> __device__ __forceinline__ const TIn* kvrow(const TIn* p, const TIn* pt, int k0, int rr, int sc) {
    if (SMP && k0 >= PAST) return pt + (unsigned)((rr < DSEQ ? rr : DSEQ - 1) * KS + sc);
    return p + (unsigned)((k0 + rr) * KS + sc);
}
#define VMW() asm volatile("s_waitcnt vmcnt(0)" ::: "memory")
#define VMWN(n) asm volatile("s_waitcnt vmcnt(%0)" :: "i"(n) : "memory")
#define SLOAD_H(R_, k0) do { S.st_v0 = load8<TIn>(kvrow<SMP, TIn>((R_).V, (R_).Vt, k0, sr, sc)); S.st_v1 = load8<TIn>(kvrow<SMP, TIn>((R_).V, (R_).Vt, k0, 32 + sr, sc));              \
                             S.st_k0 = load8<TIn>(kvrow<SMP, TIn>((R_).K, (R_).Kt, k0, sr, sc)); S.st_k1 = load8<TIn>(kvrow<SMP, TIn>((R_).K, (R_).Kt, k0, 32 + sr, sc)); } while (0)
#define SWRITE_HK(bf) do { *(bf16x8*)(K_lds + (bf) * SHM_K + kws) = S.st_k0; *(bf16x8*)(K_lds + (bf) * SHM_K + kws + 32 * 256) = S.st_k1; } while (0)
#define SWRITE_HV(bf) do { *(bf16x8*)(V_lds + (bf) * SHM_V + vst0) = S.st_v0; *(bf16x8*)(V_lds + (bf) * SHM_V + vst1) = S.st_v1; } while (0)
#define SWRITE_H(bf) do { SWRITE_HV(bf); SWRITE_HK(bf); } while (0)
#define SLOAD_F(p, pt, k0) do { const float* a_ = (const float*)kvrow<SMP, TIn>(p, pt, k0, sr, sc); const float* b_ = (const float*)kvrow<SMP, TIn>(p, pt, k0, 32 + sr, sc); \
                            S.sf0 = *(const f32x4*)a_; S.sf1 = *(const f32x4*)(a_ + 4); S.sf2 = *(const f32x4*)b_; S.sf3 = *(const f32x4*)(b_ + 4); } while (0)
#define SWRITE_KF(bf) do { *(bf16x8*)(K_lds + (bf) * SHM_K + kws) = pack8(S.sf0, S.sf1); *(bf16x8*)(K_lds + (bf) * SHM_K + kws + 32 * 256) = pack8(S.sf2, S.sf3); } while (0)
#define SWRITE_VF(bf) do { *(bf16x8*)(V_lds + (bf) * SHM_V + vst0) = pack8(S.sf0, S.sf1); *(bf16x8*)(V_lds + (bf) * SHM_V + vst1) = pack8(S.sf2, S.sf3); } while (0)
template <bool SMP, class TIn>
__device__ __forceinline__ void attn_prime(const BlockRef<TIn>& cur, char* lds, Seam<TIn>& S) {
    constexpr bool F32 = same_t<TIn, float>::v;
    const int tid = threadIdx.x, wid = __builtin_amdgcn_readfirstlane(tid >> 6), lane = tid & 63, r32 = lane & 31, hi = lane >> 5;
    const int sr = tid >> 4, sc = (tid & 15) * 8, kws = KSWZ(sr, sc * 2); char* K_lds = lds + 2 * SHM_V;
    for (int d0 = 0; d0 < 8; ++d0) S.qr[d0] = load8<TIn>(cur.Q + (unsigned)((wid * QBLK + r32) * QS + d0 * 16 + hi * 8));
    if constexpr (F32) { SLOAD_F(cur.K, cur.Kt, 0); VMW(); SWRITE_KF(0); SBAR(); SLOAD_F(cur.V, cur.Vt, 0); }
    else { SLOAD_H(cur, 0); VMW(); SWRITE_HK(0); }
    __syncthreads();
}
template <bool SMP, class TIn>
__device__ __forceinline__ void attn_block(const BlockRef<TIn>& cur, const BlockRef<TIn>& nxt, char* lds, Seam<TIn>& S) {
    constexpr bool F32 = same_t<TIn, float>::v;
    const int tid = threadIdx.x, wid = __builtin_amdgcn_readfirstlane(tid >> 6), lane = tid & 63, r32 = lane & 31, hi = lane >> 5;
    const int NT = cur.nt;
    const int qlo = cur.P0 + wid * QBLK;
    char* V_lds = lds; char* K_lds = lds + 2 * SHM_V;
    float* ws = (float*)(lds + 2 * SHM_V + 2 * SHM_K) + wid * 64; float* li_l = ws, * al_l = ws + 32;
    float m_reg = -1e30f, l_reg = 0; f32x16 o[4] = {};
    const int sr = tid >> 4, sc = (tid & 15) * 8, vst0 = v_st(sr, sc), vst1 = v_st(32 + sr, sc), kws = KSWZ(sr, sc * 2);
    const int vb0 = (int)(uintptr_t)V_lds + v_rd_base(lane);
#define RESC(a) do { if (__any((a) < 1.f)) { if (hi == 0) al_l[r32] = (a); asm volatile("s_waitcnt lgkmcnt(0)" ::: "memory");              \
                     for (int d_ = 0; d_ < 4; ++d_) for (int r = 0; r < 16; ++r) o[d_][r] *= al_l[crow(r, hi)]; } } while (0)
#define KBASE(t) ((t) * KVBLK)
#define MASKT(P0_, P1_, t) do { const float NEG_ = -__builtin_inff(); \
        if constexpr (SMP) { if ((t) == NT - 1) { _Pragma("unroll") for (int r_ = 0; r_ < 16; ++r_) P1_[r_] = NEG_; } } \
        else { if (KBASE(t) > (qlo & ~63)) { _Pragma("unroll") for (int r_ = 0; r_ < 16; ++r_) { P0_[r_] = NEG_; P1_[r_] = NEG_; } } } } while (0)
    constexpr int NQL = F32 ? 16 : 8;
#define SEAM_K0() do { VMWN(NQL); if constexpr (F32) { SWRITE_KF(0); SBAR(); SLOAD_F(nxt.V, nxt.Vt, 0); } else { SWRITE_HK(0); } SBAR(); } while (0)
    f32x16 pA0, pA1, pB0, pB1; float mnA, mnB, alA, alB; bf16x8 pa0, pa1, pa2, pa3;
    if constexpr (F32) { VMW(); SWRITE_VF(0); SBAR(); } else { SWRITE_HV(0); SBAR(); }
    if (NT > 1) { if constexpr (F32) SLOAD_F(cur.K, cur.Kt, KBASE(1)); else SLOAD_H(cur, KBASE(1)); }
    SBAR(); qkt<0>(pA0, pA1, K_lds, r32, hi, S.qr);
    if constexpr (F32) { if (NT > 1) { VMW(); SWRITE_KF(1); SBAR(); SLOAD_F(cur.V, cur.Vt, KBASE(1)); } }
    MASKT(pA0, pA1, 0); partialSM(pA0, pA1, m_reg, mnA, alA);
    if (NT > 1) { VMW(); if constexpr (F32) { SWRITE_VF(1); SBAR(); if (NT > 2) SLOAD_F(cur.K, cur.Kt, KBASE(2)); } else SWRITE_H(1); }
    __syncthreads();
#define HALF_STEP(PX0, PX1, mnX, alX, PY0, PY1, alY, t, KB, VB, SB) do {                                                      \
        SBAR(); qkt<KB>(PX0, PX1, K_lds, r32, hi, S.qr);                                             \
        finishSM(PY0, PY1, alY, l_reg, pa0, pa1, pa2, pa3); SBAR();                                                           \
        if ((t) + 1 < NT) { if constexpr (F32) { VMW(); SWRITE_KF(SB); SBAR(); SLOAD_F(cur.V, cur.Vt, KBASE((t) + 1)); }  \
                            else { SLOAD_H(cur, KBASE((t) + 1)); } SBAR(); }                                               \
        pv_tile<VB>(o, vb0, pa0, pa1, pa2, pa3); MASKT(PX0, PX1, (t)); partialSM(PX0, PX1, m_reg, mnX, alX);                                        \
        __syncthreads();                                                                                                      \
        if ((t) + 1 < NT) { VMW(); if constexpr (F32) { SWRITE_VF(SB); SBAR(); if ((t) + 2 < NT) SLOAD_F(cur.K, cur.Kt, KBASE((t) + 2)); } \
                            else { SWRITE_H(SB); } }                                                                          \
        RESC(alX); __syncthreads(); } while (0)
    for (int t = 1; t + 1 < NT; t += 2) {
        HALF_STEP(pB0, pB1, mnB, alB, pA0, pA1, alA, t, 1, 0, 0);
        HALF_STEP(pA0, pA1, mnA, alA, pB0, pB1, alB, t + 1, 0, 1, 1);
    }
    const bool even = (NT & 1) == 0;
    if (even) { SBAR(); qkt<1>(pB0, pB1, K_lds, r32, hi, S.qr); SBAR(); }
#define QROW(e) (nxt.Q + (unsigned)((wid * QBLK + r32) * QS + ((e) >> 1) * 16 + hi * 8 + ((e) & 1) * 4))
    if constexpr (F32) { SLOAD_F(nxt.K, nxt.Kt, 0); SBAR();
#pragma unroll
        for (int e = 0; e < 8; ++e) S.tq[e] = *(const f32x4*)QROW(e); }
    else { SLOAD_H(nxt, 0); SBAR();
#pragma unroll
        for (int d0 = 0; d0 < 8; ++d0) S.qr[d0] = load8<TIn>(nxt.Q + (unsigned)((wid * QBLK + r32) * QS + d0 * 16 + hi * 8)); }
    SBAR();
    finishSM(pA0, pA1, alA, l_reg, pa0, pa1, pa2, pa3); SBAR();
    if constexpr (F32) {
#pragma unroll
        for (int e = 8; e < 16; ++e) S.tq[e] = *(const f32x4*)QROW(e); SBAR(); }
#undef QROW
    pv_tile<0>(o, vb0, pa0, pa1, pa2, pa3);
    if (even) { MASKT(pB0, pB1, NT - 1); partialSM(pB0, pB1, m_reg, mnB, alB); __syncthreads(); RESC(alB);
        finishSM(pB0, pB1, alB, l_reg, pa0, pa1, pa2, pa3); SBAR(); pv_tile<1>(o, vb0, pa0, pa1, pa2, pa3); }
    SBAR(); SEAM_K0();
    if (hi == 0) li_l[r32] = l_reg; asm volatile("s_waitcnt lgkmcnt(0)" ::: "memory");
    float rli[16];
#pragma unroll
    for (int r = 0; r < 16; ++r) rli[r] = __builtin_amdgcn_rcpf(li_l[crow(r, hi)]);
    bf16_t* Ow = cur.O;
    const bool st_ok = wid * QBLK < cur.nrows;
#pragma unroll
    for (int r = 0; r < 16; ++r) { const int orow = crow(r, hi);
#pragma unroll
        for (int d0 = 0; d0 < 4; ++d0) { const float v = o[d0][r] * rli[r];
            const float vn = __shfl_xor(v, 1);
            if (st_ok && (r32 & 1) == 0) *(unsigned*)(Ow + (unsigned)((wid * QBLK + orow) * OS + d0 * 32 + r32)) = cvtpk(v, vn); } }
    if constexpr (F32) {
#pragma unroll
        for (int d0 = 0; d0 < 8; ++d0) S.qr[d0] = pack8(S.tq[2 * d0], S.tq[2 * d0 + 1]); }
    __syncthreads();
#undef RESC
#undef KBASE
#undef MASKT
#undef SEAM_K0
#undef HALF_STEP
}
#undef VMW
#undef VMWN
#undef SLOAD_H
#undef SWRITE_HK
#undef SWRITE_HV
#undef SWRITE_H
#undef SLOAD_F
#undef SWRITE_KF
#undef SWRITE_VF
}

namespace datt {
using att::crow; using att::cvtpk; using att::partialSM; using att::finishSM;
constexpr int SHM_V = 64 * 256 * 2, SHM_K = 64 * 128 * 2, L_V = 0, L_K = 2 * SHM_V, L_WS = 2 * SHM_V + 2 * SHM_K;
constexpr int QS = DM, KS = DM, OS = 2 * DM;
__device__ __forceinline__ int v_st2(int k, int c) { const int kk = (k & ~0xC) | ((k & 4) << 1) | ((k & 8) >> 1); return ((kk >> 3) * 8 + (c >> 5)) * 512 + ((kk & 7) * 32 + (c & 31)) * 2; }
struct DRef { const bf16_t* Q; const bf16_t* K; const bf16_t* V; bf16_t* O; int P0, pad; };
struct DSeam { bf16x8 qr[8]; };
template <int KB>
__device__ __forceinline__ void qkt(f32x16& p0, f32x16& p1, const char* K_lds, int r32, int hi, const bf16x8* qr) {
    p0 = f32x16{}; p1 = f32x16{};
    const char* kb[4];
#pragma unroll
    for (int dd = 0; dd < 4; ++dd) kb[dd] = K_lds + KB * SHM_K + KSWZ(r32, (dd * 16 + hi * 8) * 2);
#define KRD(set, d0) do { const char* a_ = kb[(d0) & 3] + ((d0) >> 2) * 128; set[0] = *reinterpret_cast<const bf16x8*>(a_); set[1] = *reinterpret_cast<const bf16x8*>(a_ + 32 * 256); } while (0)
#define KMM(set, d0) do { p0 = __builtin_amdgcn_mfma_f32_32x32x16_bf16(set[0], qr[d0], p0, 0, 0, 0); p1 = __builtin_amdgcn_mfma_f32_32x32x16_bf16(set[1], qr[d0], p1, 0, 0, 0); } while (0)
    bf16x8 ka[2], kc[2];
    KRD(ka, 0); KRD(kc, 1); SBAR();
    KMM(ka, 0); SBAR(); KRD(ka, 2); SBAR();
    KMM(kc, 1); SBAR(); KRD(kc, 3); SBAR();
    KMM(ka, 2); SBAR(); KRD(ka, 4); SBAR();
    KMM(kc, 3); SBAR(); KRD(kc, 5); SBAR();
    KMM(ka, 4); SBAR(); KRD(ka, 6); SBAR();
    KMM(kc, 5); SBAR(); KRD(kc, 7); SBAR();
    KMM(ka, 6); SBAR();
    KMM(kc, 7); SBAR();
#undef KRD
#undef KMM
}
template <int B_> __device__ __forceinline__ bf16x8 pk4(const f32x16& P) {
    const unsigned a0 = cvtpk(P[B_ + 0], P[B_ + 1]), a1 = cvtpk(P[B_ + 2], P[B_ + 3]), b0 = cvtpk(P[B_ + 4], P[B_ + 5]), b1 = cvtpk(P[B_ + 6], P[B_ + 7]);
    auto r0 = __builtin_amdgcn_permlane32_swap(a0, b0, false, false); auto r1 = __builtin_amdgcn_permlane32_swap(a1, b1, false, false);
    u32x4 w = {r0[0], r1[0], r0[1], r1[1]}; return *reinterpret_cast<bf16x8*>(&w);
}
__device__ __forceinline__ void smA(const f32x16& p0, float& ps, bf16x8& pa0, bf16x8& pa1) {
    ps = 0.f;
#pragma unroll
    for (int r = 0; r < 16; ++r) ps += p0[r];
    pa0 = pk4<0>(p0); pa1 = pk4<8>(p0);
}
template <int VB>
__device__ __forceinline__ void pv_tile2(f32x16* o, int vb0, bf16x8 pa0, bf16x8 pa1, f32x16& p1, float& ps, float alpha, float& l_reg) {
#define TRRD(dst, off) asm volatile("ds_read_b64_tr_b16 %0, %1 offset:%2" : "=&v"(dst) : "v"(vb0), "i"(off) : "memory")
#define PV_RDA(S_, d0) do { constexpr int b_ = VB * SHM_V + (d0) * 512; TRRD(S_[0], b_); TRRD(S_[1], b_ + 4096); TRRD(S_[2], b_ + 8192); TRRD(S_[3], b_ + 12288); } while (0)
#define PV_RDB(S_, d0) do { constexpr int b_ = VB * SHM_V + (d0) * 512 + 16384; TRRD(S_[0], b_); TRRD(S_[1], b_ + 4096); TRRD(S_[2], b_ + 8192); TRRD(S_[3], b_ + 12288); } while (0)
#define PV_MM2(S_, d0, PA, PB) do { \
        o[d0] = __builtin_amdgcn_mfma_f32_32x32x16_bf16(PA, (bf16x8){S_[0][0], S_[0][1], S_[0][2], S_[0][3], S_[1][0], S_[1][1], S_[1][2], S_[1][3]}, o[d0], 0, 0, 0);   \
        o[d0] = __builtin_amdgcn_mfma_f32_32x32x16_bf16(PB, (bf16x8){S_[2][0], S_[2][1], S_[2][2], S_[2][3], S_[3][0], S_[3][1], S_[3][2], S_[3][3]}, o[d0], 0, 0, 0); } while (0)
#define PV_SL(i) do { p1[2 * (i)] = __builtin_amdgcn_exp2f(p1[2 * (i)]); p1[2 * (i) + 1] = __builtin_amdgcn_exp2f(p1[2 * (i) + 1]); ps += p1[2 * (i)] + p1[2 * (i) + 1]; } while (0)
#define PV_W4() do { asm volatile("s_waitcnt lgkmcnt(4)" ::: "memory"); SBAR(); } while (0)
#define PV_W0() do { asm volatile("s_waitcnt lgkmcnt(0)" ::: "memory"); SBAR(); } while (0)
    s16x4 sa[4], sb[4]; bf16x8 pa2, pa3;
    PV_RDA(sa, 0); PV_RDA(sb, 1); PV_W4(); PV_MM2(sa, 0, pa0, pa1); PV_SL(0); SBAR();
    PV_RDA(sa, 2); PV_W4(); PV_MM2(sb, 1, pa0, pa1); PV_SL(1); SBAR();
    PV_RDA(sb, 3); PV_W4(); PV_MM2(sa, 2, pa0, pa1); PV_SL(2); SBAR();
    PV_RDA(sa, 4); PV_W4(); PV_MM2(sb, 3, pa0, pa1); PV_SL(3); SBAR();
    PV_RDA(sb, 5); PV_W4(); PV_MM2(sa, 4, pa0, pa1); pa2 = pk4<0>(p1); PV_SL(4); SBAR();
    PV_RDA(sa, 6); PV_W4(); PV_MM2(sb, 5, pa0, pa1); PV_SL(5); SBAR();
    PV_RDA(sb, 7); PV_W4(); PV_MM2(sa, 6, pa0, pa1); PV_SL(6); SBAR();
    PV_RDB(sa, 0); PV_W4(); PV_MM2(sb, 7, pa0, pa1); PV_SL(7); SBAR();
    PV_RDB(sb, 1); PV_W4(); pa3 = pk4<8>(p1); PV_MM2(sa, 0, pa2, pa3);
    { auto rr = __builtin_amdgcn_permlane32_swap(__float_as_uint(ps), __float_as_uint(ps), false, false); ps = __uint_as_float(rr[0]) + __uint_as_float(rr[1]); l_reg = l_reg * alpha + ps; } SBAR();
    PV_RDB(sa, 2); PV_W4(); PV_MM2(sb, 1, pa2, pa3); SBAR();
    PV_RDB(sb, 3); PV_W4(); PV_MM2(sa, 2, pa2, pa3); SBAR();
    PV_RDB(sa, 4); PV_W4(); PV_MM2(sb, 3, pa2, pa3); SBAR();
    PV_RDB(sb, 5); PV_W4(); PV_MM2(sa, 4, pa2, pa3); SBAR();
    PV_RDB(sa, 6); PV_W4(); PV_MM2(sb, 5, pa2, pa3); SBAR();
    PV_RDB(sb, 7); PV_W4(); PV_MM2(sa, 6, pa2, pa3); SBAR();
    PV_W0(); PV_MM2(sb, 7, pa2, pa3); SBAR();
#undef TRRD
#undef PV_RDA
#undef PV_RDB
#undef PV_MM2
#undef PV_SL
#undef PV_W4
#undef PV_W0
}
template <int VB>
__device__ __forceinline__ void pv_tile(f32x16* o, int vb0, bf16x8 pa0, bf16x8 pa1, bf16x8 pa2, bf16x8 pa3) {
#define TRRD(dst, off) asm volatile("ds_read_b64_tr_b16 %0, %1 offset:%2" : "=&v"(dst) : "v"(vb0), "i"(off) : "memory")
#define PV_RD(S_, d0) do { constexpr int b_ = VB * SHM_V + (d0) * 512; \
        TRRD(S_[0], b_); TRRD(S_[1], b_ + 4096); TRRD(S_[2], b_ + 8192); TRRD(S_[3], b_ + 12288); TRRD(S_[4], b_ + 16384); TRRD(S_[5], b_ + 20480); TRRD(S_[6], b_ + 24576); TRRD(S_[7], b_ + 28672); } while (0)
#define PV_MM(S_, d0) do { \
        o[d0] = __builtin_amdgcn_mfma_f32_32x32x16_bf16(pa0, (bf16x8){S_[0][0], S_[0][1], S_[0][2], S_[0][3], S_[1][0], S_[1][1], S_[1][2], S_[1][3]}, o[d0], 0, 0, 0);   \
        o[d0] = __builtin_amdgcn_mfma_f32_32x32x16_bf16(pa1, (bf16x8){S_[2][0], S_[2][1], S_[2][2], S_[2][3], S_[3][0], S_[3][1], S_[3][2], S_[3][3]}, o[d0], 0, 0, 0);   \
        o[d0] = __builtin_amdgcn_mfma_f32_32x32x16_bf16(pa2, (bf16x8){S_[4][0], S_[4][1], S_[4][2], S_[4][3], S_[5][0], S_[5][1], S_[5][2], S_[5][3]}, o[d0], 0, 0, 0);   \
        o[d0] = __builtin_amdgcn_mfma_f32_32x32x16_bf16(pa3, (bf16x8){S_[6][0], S_[6][1], S_[6][2], S_[6][3], S_[7][0], S_[7][1], S_[7][2], S_[7][3]}, o[d0], 0, 0, 0); } while (0)
#define PV_W8() do { asm volatile("s_waitcnt lgkmcnt(8)" ::: "memory"); SBAR(); } while (0)
#define PV_W0() do { asm volatile("s_waitcnt lgkmcnt(0)" ::: "memory"); SBAR(); } while (0)
    s16x4 sa[8], sb[8];
    PV_RD(sa, 0); PV_RD(sb, 1); PV_W8(); PV_MM(sa, 0); SBAR();
    PV_RD(sa, 2); PV_W8(); PV_MM(sb, 1); SBAR();
    PV_RD(sb, 3); PV_W8(); PV_MM(sa, 2); SBAR();
    PV_RD(sa, 4); PV_W8(); PV_MM(sb, 3); SBAR();
    PV_RD(sb, 5); PV_W8(); PV_MM(sa, 4); SBAR();
    PV_RD(sa, 6); PV_W8(); PV_MM(sb, 5); SBAR();
    PV_RD(sb, 7); PV_W8(); PV_MM(sa, 6); SBAR();
    PV_W0(); PV_MM(sb, 7); SBAR();
#undef PV_RD
#undef PV_MM
#undef PV_W8
#undef PV_W0
#undef TRRD
}
#define DVMW() asm volatile("s_waitcnt vmcnt(0)" ::: "memory")
#define DLOADQ(R_) do { _Pragma("unroll") for (int d0_ = 0; d0_ < 8; ++d0_) S.qr[d0_] = *(const bf16x8*)((R_).Q + (unsigned)((wid * 32 + r32) * QS + d0_ * 16 + hi * 8)); } while (0)
#define DDMA(R_, k0, bf) do { \
        const __amdgpu_buffer_rsrc_t rk_ = __builtin_amdgcn_make_buffer_rsrc((void*)(R_).K, 0, 0x7ffffff0, 0x00020000), rv_ = __builtin_amdgcn_make_buffer_rsrc((void*)(R_).V, 0, 0x7ffffff0, 0x00020000); \
        _Pragma("unroll") for (int j_ = 0; j_ < 2; ++j_) __builtin_amdgcn_raw_ptr_buffer_load_lds(rk_, (LAS unsigned*)(lds + L_K + (bf) * SHM_K + (8 * j_ + wid) * 1024), 16, (int)(offK * 2u), (int)(((k0) + 32 * j_) * KS * 2), 0, 0); \
        _Pragma("unroll") for (int j_ = 0; j_ < 4; ++j_) __builtin_amdgcn_raw_ptr_buffer_load_lds(rv_, (LAS unsigned*)(lds + L_V + (bf) * SHM_V + (8 * j_ + wid) * 1024), 16, (int)(offV * 2u), (int)(((k0) + 16 * j_) * KS * 2), 0, 0); } while (0)
__device__ __forceinline__ void dattn_prime(const DRef& cur, LAS char* lds, DSeam& S) {
    const int tid = threadIdx.x, wid = __builtin_amdgcn_readfirstlane(tid >> 6), lane = tid & 63, r32 = lane & 31, hi = lane >> 5;
    const int rowK = 4 * wid + (lane >> 4); const unsigned offK = (unsigned)(rowK * KS + (((lane & 15) ^ (rowK & 7)) * 8));
    const int sub = 2 * wid + (lane >> 5), kk = (sub >> 3) * 8 + ((lane & 31) >> 2), kv = (kk & ~0xC) | ((kk & 4) << 1) | ((kk & 8) >> 1); const unsigned offV = (unsigned)(kv * KS + (sub & 7) * 32 + (lane & 3) * 8);
    DLOADQ(cur); DDMA(cur, 0, 0); DVMW();
    __syncthreads();
}
__device__ __forceinline__ void dattn_block(const DRef& cur, const DRef& nxt, LAS char* lds, DSeam& S) {
    const int tid = threadIdx.x, wid = __builtin_amdgcn_readfirstlane(tid >> 6), lane = tid & 63, r32 = lane & 31, hi = lane >> 5;
    const int NT = (cur.P0 + 255) / 64 + 1;
    const int qlo = cur.P0 + wid * 32;
    const char* K_lds = (const char*)(lds + L_K);
    float* ws = (float*)(lds + L_WS) + wid * 64; float* li_l = ws, * al_l = ws + 32;
    float mnL_reg = 1e30f * (1.4426950408889634f * att::SCALE), mthr_reg = -1e30f, l_reg = 0; f32x16 o[8] = {};
    const int rowK = 4 * wid + (lane >> 4); const unsigned offK = (unsigned)(rowK * KS + (((lane & 15) ^ (rowK & 7)) * 8));
    const int sub = 2 * wid + (lane >> 5), kk = (sub >> 3) * 8 + ((lane & 31) >> 2), kv = (kk & ~0xC) | ((kk & 4) << 1) | ((kk & 8) >> 1); const unsigned offV = (unsigned)(kv * KS + (sub & 7) * 32 + (lane & 3) * 8);
    const int vb0 = (int)(uintptr_t)(lds + L_V) + att::v_rd_base(lane);
    f32x16 p0, p1; float al, psum; bf16x8 pa0, pa1;
    if (wid >= 4) __builtin_amdgcn_s_setprio(1);
#define DSTEP(t, B, NB) do { \
        if ((t) + 1 < NT) DDMA(cur, ((t) + 1) * 64, NB); else DDMA(nxt, 0, NB); \
        SBAR(); qkt<B>(p0, p1, K_lds, r32, hi, S.qr); SBAR(); \
        if ((t) + 1 == NT) DLOADQ(nxt); \
        if (__builtin_expect((t) * 64 > (qlo & ~63), 0)) { asm volatile("" ::: "memory"); const float NEG_ = -__builtin_inff(); _Pragma("unroll") for (int r_ = 0; r_ < 16; ++r_) { p0[r_] = NEG_; p1[r_] = NEG_; } asm volatile("" : "+v"(p0), "+v"(p1)); } \
        att::partialSM2(p0, p1, mnL_reg, mthr_reg, al); smA(p0, psum, pa0, pa1); SBAR(); \
        if (__any(al < 1.f)) { if (hi == 0) al_l[r32] = al; asm volatile("s_waitcnt lgkmcnt(0)" ::: "memory"); \
            _Pragma("unroll") for (int d_ = 0; d_ < 8; ++d_) _Pragma("unroll") for (int r = 0; r < 16; ++r) o[d_][r] *= al_l[crow(r, hi)]; } \
        pv_tile2<B>(o, vb0, pa0, pa1, p1, psum, al, l_reg); SBAR(); \
        DVMW(); __syncthreads(); } while (0)
    for (int t = 0; t < NT; t += 2) { DSTEP(t, 0, 1); DSTEP(t + 1, 1, 0); }
#undef DSTEP
    __builtin_amdgcn_s_setprio(0);
    if (hi == 0) li_l[r32] = l_reg; asm volatile("s_waitcnt lgkmcnt(0)" ::: "memory");
    float rli[16];
#pragma unroll
    for (int r = 0; r < 16; ++r) rli[r] = __builtin_amdgcn_rcpf(li_l[crow(r, hi)]);
#pragma unroll
    for (int r = 0; r < 16; ++r) { const int orow = crow(r, hi);
#pragma unroll
        for (int d0 = 0; d0 < 8; ++d0) { const float v = o[d0][r] * rli[r];
            const float vn = __shfl_xor(v, 1);
            if ((r32 & 1) == 0) *(unsigned*)(cur.O + (unsigned)((wid * 32 + orow) * OS + d0 * 32 + r32)) = cvtpk(v, vn); } }
}
#undef DVMW
#undef DLOADQ
#undef DDMA
}

struct Args { const float* in[38]; float* out; unsigned char* ws; int ph_lo, ph_hi; };
typedef const float* cfp_t;
typedef const __attribute__((address_space(4))) unsigned char* KP;
__device__ __forceinline__ KP kargs() { KP p = (KP)__builtin_amdgcn_kernarg_segment_ptr(); asm volatile("" : "+s"(p)); return p; }
struct Frame {
    LAS unsigned char* lds; KP kp;
    int tid, lane, wave, G, bid;
    __device__ __forceinline__ const float* in(int i) const { return *(const __attribute__((address_space(4))) cfp_t*)(kp + 8 * i); }
    __device__ __forceinline__ float* out() const { return *(float* const __attribute__((address_space(4)))*)(kp + 304); }
    __device__ __forceinline__ unsigned char* ws() const { return *(unsigned char* const __attribute__((address_space(4)))*)(kp + 312); }
};
static_assert(sizeof(Args) == 328, "Args layout");
enum { I_XP = 0, I_XS, I_SRE, I_SIM, I_SCONV, I_CK, I_CV, I_PP, I_PS, I_NMIX, I_ARE, I_AIM, I_LDT, I_BRE, I_BIM, I_CRE, I_CIM, I_SSMD, I_WGLU, I_NKV, I_WK, I_WV, I_WQ,
       I_LQ1, I_LK1, I_LQ2, I_LK2, I_NSUB, I_WO, I_NFFN, I_WUP, I_CONVW, I_CONVB, I_WDOWN, I_NPLE, I_WGATE, I_WPROJ, I_NFIN };

__device__ __forceinline__ void transpose_item(const float* W, int K, int N, bf16_t* WT, int row_off, const float* gain, int pairhalf, LAS float* scr, int item, int lane) {
    const int nblk = N / 32, kb = item / nblk, nb = item % nblk, k0 = 64 * kb, n0 = 32 * nb;
    int c0 = n0; if (pairhalf) c0 = ((n0 >> 7) & 1) * pairhalf + (n0 >> 8) * 128 + (n0 & 127);
#pragma unroll 8
    for (int i = 0; i < 32; ++i) { const int kk = 2 * i + (lane >> 5); float v = W[(size_t)(k0 + kk) * N + c0 + (lane & 31)]; if (gain) v *= gain[k0 + kk]; scr[kk * 33 + (lane & 31)] = v; }
    asm volatile("s_waitcnt lgkmcnt(0)" ::: "memory");
    const int c = lane & 7;
#pragma unroll
    for (int j = 0; j < 4; ++j) { const int n = (lane >> 3) + 8 * j; const LAS float* s = scr + (8 * c) * 33 + n;
        u32x4 o; o.x = cvt_pk_bf16(s[0 * 33], s[1 * 33]); o.y = cvt_pk_bf16(s[2 * 33], s[3 * 33]); o.z = cvt_pk_bf16(s[4 * 33], s[5 * 33]); o.w = cvt_pk_bf16(s[6 * 33], s[7 * 33]);
        *(u32x4*)(WT + (size_t)(row_off + n0 + n) * K + k0 + 8 * c) = o; }
    asm volatile("s_waitcnt lgkmcnt(0)" ::: "memory");
}

__device__ __forceinline__ void ssm_build_group(Frame& F, int g) {
    LAS f32x2* lbp = (LAS f32x2*)F.lds;
    LAS f32x2* Bb = lbp + 17 * 64;
    LAS f32x2* Cc = Bb + 64 * 16;
    LAS float* Kd = (LAS float*)(Cc + 16 * 64);
    LAS float* Dd = Kd + 4096;
    LAS f32x2* kt = (LAS f32x2*)(Dd + 16);
    const float* are = F.in(I_ARE) + g * 64; const float* aim = F.in(I_AIM) + g * 64;
    const int tid = F.tid;
    for (int i = tid; i < 17 * 64; i += NTHR) { const int d = i >> 6, p = i & 63; const double dt = exp((double)F.in(I_LDT)[g]); const double ar = are[p], ai = aim[p];
        const double mag = exp(ar * dt * d); double sn, cs; sincos(ai * dt * d, &sn, &cs); lbp[d * 64 + p] = (f32x2){(float)(mag * cs), (float)(mag * sn)}; }
    if (tid < 64) {
        const int p = tid; const double dt = exp((double)F.in(I_LDT)[g]); const double ar = are[p], ai = aim[p];
        const double mag = exp(ar * dt); double sn, cs; sincos(ai * dt, &sn, &cs); const double lr = mag * cs, li = mag * sn, den = ar * ar + ai * ai, nr = lr - 1.0;
        kt[p] = (f32x2){(float)((nr * ar + li * ai) / den), (float)((li * ar - nr * ai) / den)};
    }
    if (tid < 16) Dd[tid] = F.in(I_SSMD)[g * 16 + tid];
    __syncthreads();
    for (int i = tid; i < 1024; i += NTHR) { const int p = i >> 4, ch = i & 15; const float br = F.in(I_BRE)[((size_t)g * 64 + p) * 16 + ch], bi = F.in(I_BIM)[((size_t)g * 64 + p) * 16 + ch]; const f32x2 k = kt[p];
        Bb[i] = (f32x2){k.x * br - k.y * bi, k.x * bi + k.y * br};
        const int co = i >> 6, pp = i & 63; Cc[i] = (f32x2){F.in(I_CRE)[((size_t)g * 16 + co) * 64 + pp], F.in(I_CIM)[((size_t)g * 16 + co) * 64 + pp]}; }
    __syncthreads();
    for (int i = tid; i < 4096; i += NTHR) { const int d = i >> 8, co = (i >> 4) & 15, ch = i & 15; float s = 0.f;
        for (int p = 0; p < 64; ++p) { const f32x2 c = Cc[co * 64 + p], l = lbp[d * 64 + p], b = Bb[p * 16 + ch];
            const float wr = c.x * l.x - c.y * l.y, wi = c.x * l.y + c.y * l.x; s += wr * b.x - wi * b.y; }
        if (d == 0 && co == ch) s += Dd[co];
        Kd[i] = s; }
    __syncthreads();
    unsigned char* base = F.ws() + WS_SSM + (size_t)g * SSM_G_BYTES;
    for (int e = tid; e < 8 * 16 * 64; e += NTHR) { const int ln = e & 63, ks = (e >> 6) & 15, Mb = e >> 10; const int row = 32 * Mb + (ln & 31), t = row >> 4, co = row & 15, s = ks; float v[8];
#pragma unroll
        for (int j = 0; j < 8; ++j) { const int ch = 8 * (ln >> 5) + j; v[j] = (t >= s) ? Kd[((t - s) * 16 + co) * 16 + ch] : 0.f; }
        u32x4 o = {cvt_pk_bf16(v[0], v[1]), cvt_pk_bf16(v[2], v[3]), cvt_pk_bf16(v[4], v[5]), cvt_pk_bf16(v[6], v[7])}; *(u32x4*)(base + (size_t)e * 16) = o; }
    for (int e = tid; e < 4 * 16 * 64; e += NTHR) { const int ln = e & 63, ks = (e >> 6) & 15, Mb = e >> 10; const int hr = 32 * Mb + (ln & 31), c = hr >> 6, p = hr & 63, s = ks; float v[8]; const f32x2 l = lbp[(15 - s) * 64 + p];
#pragma unroll
        for (int j = 0; j < 8; ++j) { const f32x2 b = Bb[p * 16 + 8 * (ln >> 5) + j]; v[j] = c == 0 ? (l.x * b.x - l.y * b.y) : (l.x * b.y + l.y * b.x); }
        u32x4 o = {cvt_pk_bf16(v[0], v[1]), cvt_pk_bf16(v[2], v[3]), cvt_pk_bf16(v[4], v[5]), cvt_pk_bf16(v[6], v[7])}; *(u32x4*)(base + 131072 + (size_t)e * 16) = o; }
    for (int e = tid; e < 8 * 8 * 64; e += NTHR) { const int ln = e & 63, ks = (e >> 6) & 7, Mb = e >> 9; const int row = 32 * Mb + (ln & 31), t = row >> 4, co = row & 15; float v[8];
#pragma unroll
        for (int j = 0; j < 8; ++j) { const int hr = 16 * ks + 8 * (ln >> 5) + j, c = hr >> 6, p = hr & 63; const f32x2 cc = Cc[co * 64 + p], l = lbp[(t + 1) * 64 + p];
            v[j] = c == 0 ? (cc.x * l.x - cc.y * l.y) : -(cc.x * l.y + cc.y * l.x); }
        u32x4 o = {cvt_pk_bf16(v[0], v[1]), cvt_pk_bf16(v[2], v[3]), cvt_pk_bf16(v[4], v[5]), cvt_pk_bf16(v[6], v[7])}; *(u32x4*)(base + 196608 + (size_t)e * 16) = o; }
    if (tid < 64) ((f32x2*)(F.ws() + WS_L16))[g * 64 + tid] = lbp[16 * 64 + tid];
    __syncthreads();
}

__device__ __forceinline__ void rms_row_to_bf16(const float* xrow, const float* g, bf16_t* orow, int lane) {
    const f32x4* xr = (const f32x4*)xrow + lane; f32x4 v[8]; float s = 0.f;
#pragma unroll
    for (int j = 0; j < 8; ++j) { v[j] = xr[64 * j]; s += (v[j][0] * v[j][0] + v[j][1] * v[j][1]) + (v[j][2] * v[j][2] + v[j][3] * v[j][3]); }
    const float rstd = rsqrtf(wave_sum(s) * (1.f / DM) + EPS);
    u32x2* o8 = (u32x2*)orow + lane;
#pragma unroll
    for (int j = 0; j < 8; ++j) { const f32x4 gg = ((const f32x4*)g)[lane + 64 * j]; const f32x4 y = v[j] * rstd * gg; u32x2 w; w.x = cvt_pk_bf16(y[0], y[1]); w.y = cvt_pk_bf16(y[2], y[3]); o8[64 * j] = w; }
}
__device__ __forceinline__ void convert_p(Frame& F, int layer) {
    const float* pp = F.in(I_PP) + (size_t)layer * MP * PLE; const float* ps = F.in(I_PS) + (size_t)layer * MS * PLE; bf16_t* pb = (bf16_t*)(F.ws() + WS_PB);
    const size_t n8 = (size_t)MT * PLE / 8;
    for (size_t i = (size_t)F.bid * NTHR + F.tid; i < n8; i += (size_t)F.G * NTHR) { const size_t e = i * 8; const float* src = e < (size_t)MP * PLE ? pp + e : ps + (e - (size_t)MP * PLE);
        const f32x4 a = *(const f32x4*)src, b = *(const f32x4*)(src + 4); u32x4 w = {cvt_pk_bf16(a[0], a[1]), cvt_pk_bf16(a[2], a[3]), cvt_pk_bf16(b[0], b[1]), cvt_pk_bf16(b[2], b[3])}; *(u32x4*)(pb + e) = w; }
}
__device__ __forceinline__ int bg_slot(Frame& F, int word) {
    const int lane = __builtin_amdgcn_mbcnt_hi(~0u, __builtin_amdgcn_mbcnt_lo(~0u, 0u));
    unsigned tk = 0u; if (lane == 0) tk = __hip_atomic_fetch_add((LAS unsigned*)(F.lds + LDS_BYTES - 256) + 16 + word, 1u, __ATOMIC_RELAXED, __HIP_MEMORY_SCOPE_WORKGROUP);
    return __builtin_amdgcn_readfirstlane((int)tk) & 7;
}
template <int LIST> __device__ __forceinline__ void bg_work(Frame& F, int busy, int slot) {
    const int rem = busy < F.G ? busy : 0; int nb = F.G, bi = F.bid;
    if (rem != 0) { if (F.bid < rem) return; nb = F.G - rem; bi = F.bid - rem; }
    const int lane = __builtin_amdgcn_mbcnt_hi(~0u, __builtin_amdgcn_mbcnt_lo(~0u, 0u));
    LAS float* scr = (LAS float*)(F.lds + slot * 16384);
    const int gw = bi * NWAVES + slot, NGW = nb * NWAVES;
    constexpr int I_UP = 32 * 352, I_DN = 88 * 64, I_GT = 32 * 64, I_PJ = 4 * 64, I_SQ = 32 * 64;
    if constexpr (LIST == 0 || LIST == 3) { constexpr int l = LIST == 0 ? 0 : 1;
        for (int it = gw; it < I_UP; it += NGW) transpose_item(F.in(I_WUP) + (size_t)l * DM * DFF2, DM, DFF2, (bf16_t*)(F.ws() + WS_WUP) + (size_t)l * DFF2 * DM, 0, F.in(I_NFFN) + l * DM, DFF, scr, it, lane);
    } else if constexpr (LIST == 1 || LIST == 4) { constexpr int l = LIST == 1 ? 0 : 1;
        for (int it = gw; it < I_DN + I_GT + I_PJ; it += NGW) { int r = it;
            if (r < I_DN) { transpose_item(F.in(I_WDOWN) + (size_t)l * DFF * DM, DFF, DM, (bf16_t*)(F.ws() + WS_WDOWN) + (size_t)l * DM * DFF, 0, nullptr, 0, scr, r, lane); continue; } r -= I_DN;
            if (r < I_GT) { transpose_item(F.in(I_WGATE) + (size_t)l * DM * DM, DM, DM, (bf16_t*)(F.ws() + WS_WGATE) + (size_t)l * DM * DM, 0, F.in(I_NPLE) + l * DM, 0, scr, r, lane); continue; } r -= I_GT;
            transpose_item(F.in(I_WPROJ) + (size_t)l * PLE * DM, PLE, DM, (bf16_t*)(F.ws() + WS_WPROJ) + (size_t)l * DM * PLE, 0, nullptr, 0, scr, r, lane); }
    } else {
        for (int it = gw; it < 4 * I_SQ; it += NGW) { int r = it;
            if (r < I_SQ) { transpose_item(F.in(I_WQ), DM, DM, (bf16_t*)(F.ws() + WS_WQKV), 0, F.in(I_NMIX) + DM, 0, scr, r, lane); continue; } r -= I_SQ;
            if (r < I_SQ) { transpose_item(F.in(I_WK), DM, DM, (bf16_t*)(F.ws() + WS_WQKV), DM, F.in(I_NKV), 0, scr, r, lane); continue; } r -= I_SQ;
            if (r < I_SQ) { transpose_item(F.in(I_WV), DM, DM, (bf16_t*)(F.ws() + WS_WQKV), 2 * DM, F.in(I_NKV), 0, scr, r, lane); continue; } r -= I_SQ;
            transpose_item(F.in(I_WO), DM, DM, (bf16_t*)(F.ws() + WS_WO), 0, nullptr, 0, scr, r, lane); }
    }
}
__device__ __forceinline__ void p0_prologue(Frame& F) {
    for (int g = F.bid; g < NG; g += F.G) ssm_build_group(F, g);
    __syncthreads();
    LAS float* scr = (LAS float*)(F.lds + F.wave * 16384);
    const int gw = F.bid * NWAVES + F.wave, NGW = F.G * NWAVES;
    for (int it = gw; it < 32 * 128; it += NGW) transpose_item(F.in(I_WGLU), DM, 2 * DM, (bf16_t*)(F.ws() + WS_WGLU), 0, nullptr, DM, scr, it, F.lane);
    { float* rope = (float*)(F.ws() + WS_ROPE);
      for (int i = F.bid * NTHR + F.tid; i < SEQ * 16; i += F.G * NTHR) { const int pos = i >> 4, k = i & 15; const double inv = exp(-(double)k * (13.122363377404328 / 16.0)); double sn, cs; sincos((double)pos * inv, &sn, &cs);
          rope[(size_t)pos * 32 + k] = (float)cs; rope[(size_t)pos * 32 + 16 + k] = (float)sn; } }
    { float* cp_ = (float*)(F.ws() + WS_CONVP);
      for (int i = F.bid * NTHR + F.tid; i < 2 * DFF; i += F.G * NTHR) { const int l = i / DFF, c = i % DFF; const float* cw = F.in(I_CONVW) + (size_t)l * 3 * DFF2; const float* cb = F.in(I_CONVB) + (size_t)l * DFF2;
          float* r = cp_ + (size_t)(i & ~1) * 8 + (c & 1);
          r[0] = cw[c]; r[2] = cw[DFF2 + c]; r[4] = cw[2 * DFF2 + c]; r[6] = cb[c]; r[8] = cw[DFF + c]; r[10] = cw[DFF2 + DFF + c]; r[12] = cw[2 * DFF2 + DFF + c]; r[14] = cb[DFF + c]; } }
    convert_p(F, 0);
    bf16_t* ub = (bf16_t*)(F.ws() + WS_UB);
    for (int m = gw; m < MT; m += NGW) rms_row_to_bf16(m < MP ? F.in(I_XP) + (size_t)m * DM : F.in(I_XS) + (size_t)(m - MP) * DM, F.in(I_NMIX), ub + (size_t)m * DM, F.lane);
}

__device__ __forceinline__ void ssm_phase(Frame& F, bf16_t* dstb) {
    constexpr int L_G = 0, L_U = 65536, L_S0 = 98304, L_S1 = 116736, L_XB = 135168;
    const int tid = F.tid, wave = F.wave, lane = F.lane, n = lane & 31, hi = lane >> 5;
    bf16_t* ub = (bf16_t*)(F.ws() + WS_UB);
    const int sn_ = tid & 31, ss_ = tid >> 5;
    for (int item = F.bid; item < NBAT * NG + NG; item += F.G) {
        const bool smp = item >= NBAT * NG;
        const int g = smp ? item - NBAT * NG : item % NG, b = smp ? 0 : item / NG;
        const int nsteps = smp ? 1 : SEQ / 512; const int row0 = smp ? MP : b * SEQ;
        const unsigned char* mats = F.ws() + WS_SSM + (size_t)g * SSM_G_BYTES;
        __syncthreads();
        for (int i = tid; i < 4096; i += NTHR) *(LAS u32x4*)(F.lds + L_G + i * 16) = *(const u32x4*)(mats + 196608 + (size_t)i * 16);
        bf16x8 Kf[16], Hf[8];
#pragma unroll
        for (int ks = 0; ks < 16; ++ks) Kf[ks] = *(const bf16x8*)(mats + ((size_t)(wave * 16 + ks) * 64 + lane) * 16);
#pragma unroll
        for (int i = 0; i < 8; ++i) Hf[i] = *(const bf16x8*)(mats + 131072 + ((size_t)((wave & 3) * 16 + (wave >> 2) * 8 + i) * 64 + lane) * 16);
        f32x2 lam = {0.f, 0.f}, X = {0.f, 0.f};
        if (wave == 0) lam = ((const f32x2*)(F.ws() + WS_L16))[g * 64 + lane];
        { const bf16_t* src = ub + (size_t)(row0 + 16 * sn_ + ss_) * DM + 16 * g; const u32x4 a = *(const u32x4*)src, c = *(const u32x4*)(src + 8);
          LAS unsigned char* d = F.lds + L_U + ss_ * 1024 + sn_ * 32; *(LAS u32x4*)d = a; *(LAS u32x4*)(d + 16) = c; }
        __syncthreads();
        for (int step = 0; step < nsteps; ++step) {
            const int rowb = row0 + step * 512;
            LAS unsigned char* Ucur = F.lds + L_U + (step & 1) * 16384;
            u32x4 na = {0u, 0u, 0u, 0u}, nc = na;
            if (step + 1 < nsteps) { const bf16_t* src = ub + (size_t)(rowb + 512 + 16 * sn_ + ss_) * DM + 16 * g; na = *(const u32x4*)src; nc = *(const u32x4*)(src + 8); }
            { f32x16 sa = {};
#pragma unroll
              for (int i = 0; i < 8; ++i) { const bf16x8 uf = *(const LAS bf16x8*)(Ucur + ((wave >> 2) * 8 + i) * 1024 + n * 32 + hi * 16); sa = __builtin_amdgcn_mfma_f32_32x32x16_bf16(Hf[i], uf, sa, 0, 0, 0); }
              LAS float* Sp = (LAS float*)(F.lds + ((wave >> 2) ? L_S1 : L_S0));
#pragma unroll
              for (int r = 0; r < 16; ++r) Sp[(32 * (wave & 3) + att::crow(r, hi)) * 36 + n] = sa[r]; }
            __syncthreads();
            if (step > 0) { const LAS unsigned char* ysrc = F.lds + L_U + ((step - 1) & 1) * 16384 + ss_ * 1024 + sn_ * 32; const u32x4 ya0 = *(const LAS u32x4*)ysrc, ya1 = *(const LAS u32x4*)(ysrc + 16);
                bf16_t* dst = dstb + (size_t)(rowb - 512 + 16 * sn_ + ss_) * DM + 16 * g; *(u32x4*)dst = ya0; *(u32x4*)(dst + 8) = ya1; }
            if (wave == 0) {
                const LAS float* S0 = (const LAS float*)(F.lds + L_S0); const LAS float* S1 = (const LAS float*)(F.lds + L_S1);
                LAS bf16_t* Xb = (LAS bf16_t*)(F.lds + L_XB);
#pragma unroll 1
                for (int cg = 0; cg < 4; ++cg) {
                    f32x4 re[2], im[2];
#pragma unroll
                    for (int i = 0; i < 2; ++i) { re[i] = *(const LAS f32x4*)(S0 + lane * 36 + 8 * cg + 4 * i) + *(const LAS f32x4*)(S1 + lane * 36 + 8 * cg + 4 * i);
                                                  im[i] = *(const LAS f32x4*)(S0 + (64 + lane) * 36 + 8 * cg + 4 * i) + *(const LAS f32x4*)(S1 + (64 + lane) * 36 + 8 * cg + 4 * i); }
#pragma unroll
                    for (int k = 0; k < 8; ++k) { const int c = 8 * cg + k;
                        if (smp && !(c & 1)) { const size_t si = ((size_t)(c >> 1) * NG + g) * 64 + lane; X = (f32x2){F.in(I_SRE)[si], F.in(I_SIM)[si]}; }
                        Xb[c * 136 + lane] = (bf16_t)(cvt_pk_bf16(X.x, 0.f) & 0xffffu); Xb[c * 136 + 64 + lane] = (bf16_t)(cvt_pk_bf16(X.y, 0.f) & 0xffffu);
                        const float sr = re[k >> 2][k & 3], si2 = im[k >> 2][k & 3];
                        const float nx = lam.x * X.x - lam.y * X.y + sr, ny = lam.x * X.y + lam.y * X.x + si2; X = (f32x2){nx, ny};
                        if (smp && (c & 1)) { const size_t so = ((size_t)(c >> 1) * NG + g) * 64 + lane; F.out()[O_SRE_S + so] = X.x; F.out()[O_SIM_S + so] = X.y; } }
                }
            }
            f32x16 ya = {};
#pragma unroll
            for (int ks = 0; ks < 16; ++ks) if (ks <= 2 * wave + 1) { const bf16x8 uf = *(const LAS bf16x8*)(Ucur + ks * 1024 + n * 32 + hi * 16); ya = __builtin_amdgcn_mfma_f32_32x32x16_bf16(Kf[ks], uf, ya, 0, 0, 0); }
            if (step + 1 < nsteps) { LAS unsigned char* d = F.lds + L_U + ((step + 1) & 1) * 16384 + ss_ * 1024 + sn_ * 32; *(LAS u32x4*)d = na; *(LAS u32x4*)(d + 16) = nc; }
            __syncthreads();
#pragma unroll
            for (int i = 0; i < 8; ++i) { const bf16x8 gf = *(const LAS bf16x8*)(F.lds + L_G + ((wave * 8 + i) * 64 + lane) * 16); const bf16x8 xf = *(const LAS bf16x8*)(F.lds + L_XB + n * 272 + (16 * i + 8 * hi) * 2);
                ya = __builtin_amdgcn_mfma_f32_32x32x16_bf16(gf, xf, ya, 0, 0, 0); }
#pragma unroll
            for (int q = 0; q < 4; ++q) { const int tl = q >> 1, co = 8 * (q & 1) + 4 * hi;
                u32x2 w; w.x = cvt_pk_bf16(gelu_tanh(ya[4 * q]), gelu_tanh(ya[4 * q + 1])); w.y = cvt_pk_bf16(gelu_tanh(ya[4 * q + 2]), gelu_tanh(ya[4 * q + 3]));
                *(LAS u32x2*)(Ucur + (2 * wave + tl) * 1024 + n * 32 + co * 2) = w; }
        }
        __syncthreads();
        { const int ls = nsteps - 1; const LAS unsigned char* ysrc = F.lds + L_U + (ls & 1) * 16384 + ss_ * 1024 + sn_ * 32; const u32x4 ya0 = *(const LAS u32x4*)ysrc, ya1 = *(const LAS u32x4*)(ysrc + 16);
          bf16_t* dst = dstb + (size_t)(row0 + ls * 512 + 16 * sn_ + ss_) * DM + 16 * g; *(u32x4*)dst = ya0; *(u32x4*)(dst + 8) = ya1; }
        if (!smp && wave == 0) { const size_t so = ((size_t)b * NG + g) * 64 + lane; F.out()[O_SRE_P + so] = X.x; F.out()[O_SIM_P + so] = X.y; }
    }
}

__device__ __forceinline__ void fixup_phase(Frame& F, int layer) {
    const float* zs = (const float*)(F.ws() + WS_ZSIDE); bf16_t* act = (bf16_t*)(F.ws() + WS_BIG);
    const float* cw = F.in(I_CONVW) + (size_t)layer * 3 * DFF2; const float* cb = F.in(I_CONVB) + (size_t)layer * DFF2;
    constexpr int NC4 = DFF / 4;
    for (int i = F.bid * NTHR + F.tid; i < 256 * NC4; i += F.G * NTHR) {
        const int ht = i / NC4, c0 = (i % NC4) * 4; if ((ht & 127) == 0) continue;
        const float* zp = zs + (size_t)(ht - 1) * 4 * DFF2; const float* zc = zs + (size_t)ht * 4 * DFF2;
        f32x4 o0, o1;
        f32x4 cv0, cv1, cg0, cg1;
        { const f32x4 L0 = *(const f32x4*)(zp + 2 * DFF2 + c0), L1 = *(const f32x4*)(zp + 3 * DFF2 + c0), f0 = *(const f32x4*)(zc + c0), f1 = *(const f32x4*)(zc + DFF2 + c0);
          const f32x4 w0 = *(const f32x4*)(cw + c0), w1 = *(const f32x4*)(cw + DFF2 + c0), w2 = *(const f32x4*)(cw + 2 * DFF2 + c0), bb = *(const f32x4*)(cb + c0);
          cv0 = bb + w2 * f0 + w1 * L1 + w0 * L0; cv1 = bb + w2 * f1 + w1 * f0 + w0 * L1; }
        { const int c1 = DFF + c0; const f32x4 L0 = *(const f32x4*)(zp + 2 * DFF2 + c1), L1 = *(const f32x4*)(zp + 3 * DFF2 + c1), f0 = *(const f32x4*)(zc + c1), f1 = *(const f32x4*)(zc + DFF2 + c1);
          const f32x4 w0 = *(const f32x4*)(cw + c1), w1 = *(const f32x4*)(cw + DFF2 + c1), w2 = *(const f32x4*)(cw + 2 * DFF2 + c1), bb = *(const f32x4*)(cb + c1);
          cg0 = bb + w2 * f0 + w1 * L1 + w0 * L0; cg1 = bb + w2 * f1 + w1 * f0 + w0 * L1; }
#pragma unroll
        for (int j = 0; j < 4; ++j) { o0[j] = cv0[j] * cg0[j] * fsigmoid(cg0[j]); o1[j] = cv1[j] * cg1[j] * fsigmoid(cg1[j]); }
        u32x2 w; w.x = cvt_pk_bf16(o0[0], o0[1]); w.y = cvt_pk_bf16(o0[2], o0[3]); *(u32x2*)(act + (size_t)(128 * ht) * DFF + c0) = w;
        w.x = cvt_pk_bf16(o1[0], o1[1]); w.y = cvt_pk_bf16(o1[2], o1[3]); *(u32x2*)(act + (size_t)(128 * ht + 1) * DFF + c0) = w;
    }
}

__device__ __forceinline__ att::BlockRef<bf16_t> attn_ref_p(Frame& F, int L, int pass) {
    const int bh = L >> 5, x = L & 31, qb = pass ? 63 - x : x, b = bh >> 5, vhp = bh & 31, vh = vhp >> 1, vhalf = vhp & 1;
    att::BlockRef<bf16_t> r; const size_t row0 = (size_t)b * SEQ;
    r.Q = (const bf16_t*)(F.ws() + WS_UB) + (row0 + (size_t)qb * 256) * DM + vh * 128;
    r.K = (const bf16_t*)(F.ws() + WS_KB) + row0 * DM + vh * 128; r.V = (const bf16_t*)(F.ws() + WS_VB) + row0 * DM + (vh >> 1) * 256 + vhalf * 128; r.Kt = r.K; r.Vt = r.V;
    r.O = (bf16_t*)(F.ws() + WS_BIG) + (row0 + (size_t)qb * 256) * (2 * DM) + vh * 256 + vhalf * 128;
    r.P0 = qb * 256; r.nt = (r.P0 + 255) / 64 + 1; r.nrows = 256; r.pad = 0; return r;
}
__device__ __forceinline__ att::BlockRef<float> attn_ref_s(Frame& F, int L) {
    const int b = L >> 5, vhp = L & 31, vh = vhp >> 1, vhalf = vhp & 1;
    att::BlockRef<float> r;
    r.Q = (const float*)(F.ws() + WS_QS) + (size_t)b * DSEQ * DM + vh * 128;
    r.K = F.in(I_CK) + (size_t)b * PAST * DM + vh * 128; r.V = F.in(I_CV) + (size_t)b * PAST * DM + (vh >> 1) * 256 + vhalf * 128;
    r.Kt = F.out() + O_K_S + (size_t)b * DSEQ * DM + vh * 128; r.Vt = F.out() + O_V_S + (size_t)b * DSEQ * DM + (vh >> 1) * 256 + vhalf * 128;
    r.O = (bf16_t*)(F.ws() + WS_BIG) + ((size_t)MP + (size_t)b * DSEQ) * (2 * DM) + vh * 256 + vhalf * 128;
    r.P0 = PAST; r.nt = PAST / 64 + 1; r.nrows = DSEQ; r.pad = 0; return r;
}
__device__ __forceinline__ datt::DRef dattn_ref(Frame& F, int L, int pass) {
    const int bh = L >> 5, x = L & 31, qb = pass ? 63 - x : x, b = bh >> 4, vh = bh & 15;
    datt::DRef r; const size_t row0 = (size_t)b * SEQ;
    r.Q = (const bf16_t*)(F.ws() + WS_UB) + (row0 + (size_t)qb * 256) * DM + vh * 128;
    r.K = (const bf16_t*)(F.ws() + WS_KB) + row0 * DM + vh * 128; r.V = (const bf16_t*)(F.ws() + WS_VB) + row0 * DM + (vh >> 1) * 256;
    r.O = (bf16_t*)(F.ws() + WS_BIG) + (row0 + (size_t)qb * 256) * (2 * DM) + vh * 256;
    r.P0 = qb * 256; r.pad = 0; return r;
}
__device__ __forceinline__ int attn_item(int bid, int i, int G) { return G == 256 ? ((8 * i + (bid & 7)) << 5) + (bid >> 3) : bid + i * G; }
__device__ __forceinline__ void attn_phase_prompt(Frame& F) {
    constexpr int total = NBAT * 16 * 32; const int G = F.G, bid = F.bid;
    const int nit = G == 256 ? total / 256 : (total - bid + G - 1) / G; if (nit <= 0) return;
    int it = 0, pass = 0; datt::DRef cur = dattn_ref(F, attn_item(bid, 0, G), 0); datt::DSeam S;
    datt::dattn_prime(cur, (LAS char*)F.lds, S);
    for (;;) {
        const bool more_pass = pass == 0, more_item = it + 1 < nit, last = !more_pass && !more_item;
        int passn = pass + 1, itn = it; if (!more_pass) { passn = 0; itn = more_item ? it + 1 : it; }
        const datt::DRef nxt = last ? cur : dattn_ref(F, attn_item(bid, itn, G), passn);
        datt::dattn_block(cur, nxt, (LAS char*)F.lds, S);
        if (last) break;
        cur = nxt; pass = passn; it = itn;
    }
    asm volatile("s_waitcnt vmcnt(0)" ::: "memory"); __syncthreads();
}
__device__ __forceinline__ int attn_item_s(int bid, int i, int G) { return G == 256 ? i * 256 + (((bid & 7) * 8 + (bid >> 5)) << 2) + ((bid >> 3) & 3) : bid + i * G; }
__device__ __forceinline__ void attn_phase_sample(Frame& F) {
    constexpr int total = DB * 32; const int G = F.G, bid = F.bid;
    const int nit = G == 256 ? total / 256 : (total - bid + G - 1) / G; if (nit <= 0) return;
    int it = 0; att::BlockRef<float> cur = attn_ref_s(F, attn_item_s(bid, 0, G)); att::Seam<float> S;
    att::attn_prime<true, float>(cur, (char*)F.lds, S);
    for (;;) {
        const bool last = it + 1 >= nit;
        const att::BlockRef<float> nxt = last ? cur : attn_ref_s(F, attn_item_s(bid, it + 1, G));
        att::attn_block<true, float>(cur, nxt, (char*)F.lds, S);
        if (last) break;
        cur = nxt; ++it;
    }
}

__device__ __forceinline__ void combine_phase(Frame& F) {
    const float l1 = wave_sum(F.in(I_LQ1)[F.lane] * F.in(I_LK1)[F.lane] + F.in(I_LQ1)[64 + F.lane] * F.in(I_LK1)[64 + F.lane]);
    const float l2 = wave_sum(F.in(I_LQ2)[F.lane] * F.in(I_LK2)[F.lane] + F.in(I_LQ2)[64 + F.lane] * F.in(I_LK2)[64 + F.lane]);
    const float lam_init = 0.8f - 0.6f * 0.7408182206817179f;
    const float lam = expf(l1) - expf(l2) + lam_init, post = 1.0f - lam_init;
    const bf16_t* O = (const bf16_t*)(F.ws() + WS_BIG); bf16_t* ab = (bf16_t*)(F.ws() + WS_HB);
    const int hh = F.lane >> 3, cb = (F.lane & 7) * 8;
    f32x4 gs[8];
#pragma unroll
    for (int i = 0; i < 8; ++i) gs[i] = *(const f32x4*)(F.in(I_NSUB) + (i >> 1) * 64 + cb + (i & 1) * 4);
    const int gw = F.bid * NWAVES + F.wave, NGW = F.G * NWAVES;
    for (int m = gw; m < MT; m += NGW) {
        const u32x4* p1 = (const u32x4*)(O + (size_t)m * (2 * DM) + hh * 512 + cb); const u32x4* p2 = (const u32x4*)(O + (size_t)m * (2 * DM) + hh * 512 + 256 + cb);
        u32x4 a[4], c[4];
#pragma unroll
        for (int i = 0; i < 4; ++i) { a[i] = p1[8 * i]; c[i] = p2[8 * i]; }
        float d[32]; float ss = 0.f;
#pragma unroll
        for (int i = 0; i < 4; ++i)
#pragma unroll
            for (int j = 0; j < 4; ++j) { const float x0 = __uint_as_float(a[i][j] << 16) - lam * __uint_as_float(c[i][j] << 16), x1 = __uint_as_float(a[i][j] & 0xffff0000u) - lam * __uint_as_float(c[i][j] & 0xffff0000u);
                d[8 * i + 2 * j] = x0; d[8 * i + 2 * j + 1] = x1; ss += x0 * x0 + x1 * x1; }
        ss += __shfl_xor(ss, 1); ss += __shfl_xor(ss, 2); ss += __shfl_xor(ss, 4);
        const float rstd = rsqrtf(ss * (1.f / VD) + SUBLN_EPS) * post;
        u32x4* op = (u32x4*)(ab + (size_t)m * DM + hh * 256 + cb);
#pragma unroll
        for (int i = 0; i < 4; ++i) { u32x4 w;
#pragma unroll
            for (int j = 0; j < 4; ++j) w[j] = cvt_pk_bf16(d[8 * i + 2 * j] * rstd * gs[2 * i + (j >> 1)][2 * (j & 1)], d[8 * i + 2 * j + 1] * rstd * gs[2 * i + (j >> 1)][2 * (j & 1) + 1]);
            op[8 * i] = w; }
    }
}

__device__ __forceinline__ void final_phase(Frame& F, const float* part, float* dst) {
    const int gw = F.bid * NWAVES + F.wave, NGW = F.G * NWAVES; const float* g = F.in(I_NFIN); const bf16_t* hb = (const bf16_t*)(F.ws() + WS_HB);
    f32x4 gg[4][2];
#pragma unroll
    for (int j = 0; j < 4; ++j) { gg[j][0] = ((const f32x4*)g)[128 * j + 2 * F.lane]; gg[j][1] = ((const f32x4*)g)[128 * j + 2 * F.lane + 1]; }
    for (int m = gw; m < MT; m += NGW) {
        const float pv = F.lane < 32 ? part[part_idx(m >> 7, F.lane, m & 15) + ((m >> 4) & 7)] : 0.f;
        const float rstd = rsqrtf(wave_sum(pv) * (1.f / DM) + EPS);
        const u32x4* row = (const u32x4*)(hb + (size_t)m * DM) + F.lane; f32x4* orow = (f32x4*)(dst + (size_t)m * DM) + 2 * F.lane;
#pragma unroll
        for (int j = 0; j < 4; ++j) { const u32x4 w = row[64 * j];
            const f32x4 a = {__uint_as_float(w[0] << 16), __uint_as_float(w[0] & 0xffff0000u), __uint_as_float(w[1] << 16), __uint_as_float(w[1] & 0xffff0000u)};
            const f32x4 b2 = {__uint_as_float(w[2] << 16), __uint_as_float(w[2] & 0xffff0000u), __uint_as_float(w[3] << 16), __uint_as_float(w[3] & 0xffff0000u)};
            orow[128 * j] = a * rstd * gg[j][0]; orow[128 * j + 1] = b2 * rstd * gg[j][1]; }
    }
}


__device__ __forceinline__ void probe_mfma(Frame& F, int nit) {
    unsigned sd = (unsigned)F.tid * 2654435761u + (unsigned)F.bid * 40503u + 12345u;
    bf16x8 a[2], b[2];
#pragma unroll
    for (int i = 0; i < 2; ++i) { u32x4 wa, wb;
#pragma unroll
        for (int j = 0; j < 4; ++j) { sd = sd * 1664525u + 1013904223u; wa[j] = (sd & 0xbfffbfffu) | 0x3c003c00u; sd = sd * 1664525u + 1013904223u; wb[j] = (sd & 0xbfffbfffu) | 0x3c003c00u; }
        a[i] = *reinterpret_cast<bf16x8*>(&wa); b[i] = *reinterpret_cast<bf16x8*>(&wb); }
    f32x16 c[4] = {};
    for (int it = 0; it < nit; ++it) {
#pragma unroll
        for (int k = 0; k < 4; ++k) { c[k] = __builtin_amdgcn_mfma_f32_32x32x16_bf16(a[k & 1], b[k >> 1], c[k], 0, 0, 0); }
#pragma unroll
        for (int k = 0; k < 4; ++k) { c[k] = __builtin_amdgcn_mfma_f32_32x32x16_bf16(a[(k + 1) & 1], b[k >> 1], c[k], 0, 0, 0); }
        asm volatile("" : "+v"(a[0]), "+v"(b[0]));
    }
    float s = 0.f;
#pragma unroll
    for (int k = 0; k < 4; ++k) for (int r = 0; r < 16; ++r) s += c[k][r];
    if (s == 1.2345e-30f) *(float*)(F.ws() + WS_CTL + 65536) = s;
}
constexpr int NPHASE = 16;
__device__ __forceinline__ Frame mkframe(LAS unsigned char* lds) {
    Frame F; F.lds = lds; F.kp = kargs();
    int t = threadIdx.x; asm volatile("" : "+v"(t));
    F.wave = __builtin_amdgcn_readfirstlane(t >> 6);
    int ln = __builtin_amdgcn_mbcnt_hi(~0u, __builtin_amdgcn_mbcnt_lo(~0u, 0u)); asm volatile("" : "+v"(ln));
    F.lane = ln; F.tid = F.wave * 64 + ln; F.G = gridDim.x; F.bid = blockIdx.x;
    return F;
}
__device__ __forceinline__ bool ph_in(const Frame& F, int k) { const int lo = *(const __attribute__((address_space(4))) int*)(F.kp + 320), hi = *(const __attribute__((address_space(4))) int*)(F.kp + 324); return lo <= k && k < hi; }
template <unsigned PMASK, int K> __device__ __forceinline__ bool phase_on(const Frame& F) { if constexpr (((PMASK >> K) & 1u) == 0u) return false; else return ph_in(F, K); }
template <unsigned PMASK, int K> __device__ __forceinline__ void seam(LAS unsigned char* lds) {
    if constexpr (K + 1 < NPHASE && ((PMASK >> K) & 1u) && ((PMASK >> (K + 1)) & 1u)) {
        Frame F = mkframe(lds);
        if (ph_in(F, K) && ph_in(F, K + 1)) { XcdBarrier bar; bar.bar = (unsigned*)(F.ws() + WS_CTL) + CW_BAR; bar.x = xb_xcc_id(); bar.st = (volatile LAS unsigned*)(lds + LDS_BYTES - 256) + 8; xcd_barrier(bar); }
    }
}
template <class Epi> __device__ __forceinline__ void gemm_both(LAS unsigned char* ring, const bf16_t* A, const bf16_t* Bt, int N, int K, const Epi& E, int G, int bid, int skip = 0) {
    if (skip > 0 && skip < G) { if (bid < skip) return; G -= skip; bid -= skip; }
    const int wid = __builtin_amdgcn_readfirstlane((int)threadIdx.x >> 6);
    asm volatile("" : "+s"(K));
    { pg8::Gemm g{A, Bt, MP, N, K}; pg8::StaticOrder S; S.init(MP, N, G, bid); pg8::gemm_phase<Epi, pg8::StaticOrder, false>(ring, g, S, E, wid); }
    { pg8::Gemm g{A, Bt, MT, N, K}; pg8::HalfOrder H; H.init(MP / 256, N, G, bid); pg8::gemm_phase<Epi, pg8::HalfOrder, true>(ring, g, H, E, wid); }
}
template <int LAYER, int STEP> __device__ __forceinline__ void ffn_phase(Frame& F) {
    LAS unsigned char* ring = F.lds;
    bf16_t* const hb = (bf16_t*)(F.ws() + (LAYER == 0 ? WS_HB : WS_PP)); bf16_t* const ppb = (bf16_t*)(F.ws() + (LAYER == 0 ? WS_PP : WS_HB));
    float* const pin = (float*)(F.ws() + (LAYER == 0 ? WS_PART0 : WS_PART1)); float* const pout = (float*)(F.ws() + (LAYER == 0 ? WS_PART1 : WS_PART0));
    if constexpr (STEP == 0) {
        const float* cw = (const float*)(F.ws() + WS_CONVP) + (size_t)LAYER * DFF * 8; const float* cb = nullptr; const float* st = F.in(I_SCONV) + (size_t)LAYER * DB * 2 * DFF2;
        float* cp = F.out() + O_CONV_P + (size_t)LAYER * NBAT * 2 * DFF2; float* cs = F.out() + O_CONV_S + (size_t)LAYER * DB * 2 * DFF2;
        constexpr int NP = LAYER == 0 ? 64 : 32;
        EpiUp<NP> E{pin, (bf16_t*)(F.ws() + WS_BIG), cw, cb, st, (float*)(F.ws() + WS_ZSIDE), cp, cs, F.lds, (LAYER == 0 ? 1 : 2) << 20};
        gemm_both(ring, hb, (const bf16_t*)(F.ws() + WS_WUP) + (size_t)LAYER * DFF2 * DM, DFF2, DM, E, F.G, F.bid);
        if constexpr (LAYER == 0) bg_work<1>(F, 4 * (DFF2 / 256), bg_slot(F, 1));
    } else if constexpr (STEP == 1) { fixup_phase(F, LAYER);
    } else if constexpr (STEP == 2) {
        EpiResid E{hb, pout};
        gemm_both(ring, (const bf16_t*)(F.ws() + WS_BIG), (const bf16_t*)(F.ws() + WS_WDOWN) + (size_t)LAYER * DM * DFF, DM, DFF, E, F.G, F.bid);
    } else if constexpr (STEP == 3) {
        EpiBf16 E{ppb, DM};
        gemm_both(ring, (const bf16_t*)(F.ws() + WS_PB), (const bf16_t*)(F.ws() + WS_WPROJ) + (size_t)LAYER * DM * PLE, DM, PLE, E, F.G, F.bid, 4 * (DM / 256));
    } else {
        if constexpr (LAYER == 0) convert_p(F, 1);
        EpiPle E{pout, hb, ppb, pin, F.lds, (LAYER == 0 ? 3 : 4) << 20};
        gemm_both(ring, hb, (const bf16_t*)(F.ws() + WS_WGATE) + (size_t)LAYER * DM * DM, DM, DM, E, F.G, F.bid);
        if constexpr (LAYER == 0) { const int sl = bg_slot(F, 3); bg_work<3>(F, 4 * (DM / 256), sl); bg_work<2>(F, 4 * (DM / 256), sl); }
    }
}
template <unsigned PMASK> __global__ void __launch_bounds__(NTHR, 2) yoco_fwd(Args args) {
    extern __shared__ __attribute__((aligned(16))) unsigned char lds_raw[];
    LAS unsigned char* const lds = (LAS unsigned char*)lds_raw;
    (void)args;
    { Frame F = mkframe(lds);
      volatile LAS unsigned* MISC = (volatile LAS unsigned*)(lds + LDS_BYTES - 256);
      if (F.tid < 64) MISC[F.tid] = 0u;
      __syncthreads();
      if (MK_N_LAUNCHES == 1) (void)xcd_barrier_post((unsigned*)(F.ws() + WS_CTL) + CW_BAR, MISC + 8); }
    if (PROBE_MFMA) { Frame F = mkframe(lds); if (phase_on<PMASK, 0>(F)) probe_mfma(F, PROBE_MFMA); }
#define PH(K, ...) { Frame F = mkframe(lds); if (phase_on<PMASK, K>(F)) { __VA_ARGS__ } } seam<PMASK, K>(lds);
    if (PROBE_P2) { Frame F = mkframe(lds); if (phase_on<PMASK, 0>(F)) { p0_prologue(F); __syncthreads(); } }
    PH(0, p0_prologue(F);)
    if (PROBE_SSM2) { Frame F = mkframe(lds); if (phase_on<PMASK, 1>(F)) { ssm_phase(F, (bf16_t*)(F.ws() + WS_PP)); __syncthreads(); } }
    PH(1, ssm_phase(F, (bf16_t*)(F.ws() + WS_UB));)
    PH(2, { EpiGlu E{F.in(I_XP), F.in(I_XS), (bf16_t*)(F.ws() + WS_HB), (float*)(F.ws() + WS_PART0)};
            gemm_both(F.lds, (const bf16_t*)(F.ws() + WS_UB), (const bf16_t*)(F.ws() + WS_WGLU), 2 * DM, DM, E, F.G, F.bid); bg_work<0>(F, 4 * (2 * DM / 256), bg_slot(F, 0)); })
    if (PROBE_UP2) { Frame F = mkframe(lds); if (phase_on<PMASK, 3>(F)) { ffn_phase<0, 0>(F); } }
    PH(3, (ffn_phase<0, 0>(F));)
    if (PROBE_FF2) { Frame F = mkframe(lds); if (phase_on<PMASK, 4>(F)) { ffn_phase<0, 1>(F); } }
    PH(4, (ffn_phase<0, 1>(F));)
    { Frame F = mkframe(lds); if (phase_on<PMASK, 5>(F)) { ffn_phase<0, 2>(F); } }
    PH(5, (ffn_phase<0, 3>(F));)
    PH(6, (ffn_phase<0, 4>(F));)
    PH(7, { EpiQkv E{(const float*)(F.ws() + WS_PART0), (const float*)(F.ws() + WS_ROPE), (bf16_t*)(F.ws() + WS_UB), (float*)(F.ws() + WS_QS), (bf16_t*)(F.ws() + WS_KB), (bf16_t*)(F.ws() + WS_VB), F.out(), F.lds, 5 << 20};
            gemm_both(F.lds, (const bf16_t*)(F.ws() + WS_PP), (const bf16_t*)(F.ws() + WS_WQKV), 3 * DM, DM, E, F.G, F.bid); bg_work<4>(F, 4 * (3 * DM / 256), bg_slot(F, 4)); })
    { Frame F = mkframe(lds); if (phase_on<PMASK, 8>(F) && ((F.bid >> 5) & 1)) { attn_phase_sample(F); asm volatile("s_waitcnt vmcnt(0)" ::: "memory"); __syncthreads(); } }
    { Frame F = mkframe(lds); if (phase_on<PMASK, 8>(F)) { attn_phase_prompt(F); } }
    { Frame F = mkframe(lds); if (phase_on<PMASK, 8>(F) && !((F.bid >> 5) & 1)) { attn_phase_sample(F); } }
    seam<PMASK, 8>(lds);
    if (PROBE_S2) { Frame F = mkframe(lds); if (phase_on<PMASK, 9>(F)) { combine_phase(F); } }
    PH(9, combine_phase(F);)
    PH(10, { EpiResid E{(bf16_t*)(F.ws() + WS_PP), (float*)(F.ws() + WS_PART1)};
             gemm_both(F.lds, (const bf16_t*)(F.ws() + WS_HB), (const bf16_t*)(F.ws() + WS_WO), DM, DM, E, F.G, F.bid); })
    if (PROBE_UP2) { Frame F = mkframe(lds); if (phase_on<PMASK, 11>(F)) { ffn_phase<1, 0>(F); } }
    PH(11, (ffn_phase<1, 0>(F));)
    if (PROBE_FF2) { Frame F = mkframe(lds); if (phase_on<PMASK, 12>(F)) { ffn_phase<1, 1>(F); } }
    PH(12, (ffn_phase<1, 1>(F));)
    { Frame F = mkframe(lds); if (phase_on<PMASK, 13>(F)) { ffn_phase<1, 2>(F); } }
    PH(13, (ffn_phase<1, 3>(F));)
    PH(14, (ffn_phase<1, 4>(F));)
    if (PROBE_FF2) { Frame F = mkframe(lds); if (phase_on<PMASK, 15>(F)) { final_phase(F, (const float*)(F.ws() + WS_PART1), (float*)(F.ws() + WS_UB)); } }
    PH(15, final_phase(F, (const float*)(F.ws() + WS_PART1), F.out());)
#undef PH
}

#ifndef PHASE_MASK
#define PHASE_MASK 0xFFFFu
#endif
template <unsigned PMASK> static bool prep_kernel() {
    if (hipFuncSetAttribute((const void*)yoco_fwd<PMASK>, hipFuncAttributeMaxDynamicSharedMemorySize, LDS_BYTES) != hipSuccess) { fprintf(stderr, "kernel_launch: hipFuncSetAttribute failed\n"); return false; }
    return true;
}
template <int P> static void launch_phases(int grid, Args& a, hipStream_t stream) {
    if constexpr (P < NPHASE) {
        if ((PHASE_MASK >> P) & 1u) { a.ph_lo = P; a.ph_hi = P + 1; hipLaunchKernelGGL(yoco_fwd<(1u << P)>, dim3(grid), dim3(NTHR), LDS_BYTES, stream, a); }
        launch_phases<P + 1>(grid, a, stream);
    }
}
template <int P> static bool prep_phases() { if constexpr (P < NPHASE) { return prep_kernel<(1u << P)>() && prep_phases<P + 1>(); } else return true; }
extern "C" void kernel_launch(void* const* d_in, const int* in_sizes, int n_in, void* d_out, int out_size, void* d_ws, size_t ws_size, hipStream_t stream) {
    static int grid = 0;
    if (grid == 0) {
        if (n_in != 38 || out_size != (int)O_END || ws_size < WS_END) { fprintf(stderr, "kernel_launch: unexpected shapes (n_in %d, out %d, ws %zu)\n", n_in, out_size, ws_size); grid = -1; return; }
        int dev = 0, cus = 0;
        if (hipGetDevice(&dev) != hipSuccess || hipDeviceGetAttribute(&cus, hipDeviceAttributeMultiprocessorCount, dev) != hipSuccess) { grid = -1; return; }
        bool ok;
        if constexpr (MK_N_LAUNCHES == 1) ok = prep_kernel<0xFFFFu>(); else ok = prep_phases<0>();
        if (!ok) { grid = -1; return; }
        (void)hipGetLastError();
        grid = cus;
    }
    if (grid < 0) return;
    (void)hipMemsetAsync((char*)d_ws + WS_CTL, 0, CTL_ZERO_BYTES, stream);
    Args a{};
    for (int i = 0; i < 38; ++i) a.in[i] = (const float*)d_in[i];
    a.out = (float*)d_out; a.ws = (unsigned char*)d_ws;
    if constexpr (MK_N_LAUNCHES == 1) { a.ph_lo = 0; a.ph_hi = NPHASE; hipLaunchKernelGGL(yoco_fwd<0xFFFFu>, dim3(grid), dim3(NTHR), LDS_BYTES, stream, a); }
    else launch_phases<0>(grid, a, stream);
}
```

```cpp
#include <hip/hip_runtime.h>
#include <cstdio>
#include <cstdint>

#ifndef MK_N_LAUNCHES
#define MK_N_LAUNCHES 1
#endif

#ifndef PROBE_ATT2
#define PROBE_ATT2 0
#endif
#ifndef PROBE_UP2
#define PROBE_UP2 0
#endif
#ifndef PROBE_G2
#define PROBE_G2 0
#endif
#ifndef PROBE_SSM2
#define PROBE_SSM2 0
#endif
#ifndef PROBE_MFMA
#define PROBE_MFMA 0
#endif
#ifndef PROBE_FF2
#define PROBE_FF2 0
#endif
#ifndef PROBE_PO2
#define PROBE_PO2 0
#endif
#ifndef PROBE_DOWN2
#define PROBE_DOWN2 0
#endif
#ifndef PROBE_P2
#define PROBE_P2 0
#endif
#ifndef PROBE_S2
#define PROBE_S2 0
#endif
#define LAS __attribute__((address_space(3)))
typedef unsigned short bf16_t;
typedef short bf16x8 __attribute__((ext_vector_type(8)));
typedef short s16x4 __attribute__((ext_vector_type(4)));
typedef float f32x4 __attribute__((ext_vector_type(4)));
typedef float f32x2 __attribute__((ext_vector_type(2)));
typedef float f32x16 __attribute__((ext_vector_type(16)));
typedef unsigned u32x4 __attribute__((ext_vector_type(4)));
typedef unsigned u32x2 __attribute__((ext_vector_type(2)));

constexpr int DM = 2048, SEQ = 16384, NBAT = 2, MP = NBAT * SEQ, DB = 16, DSEQ = 32, MS = DB * DSEQ, MT = MP + MS;
constexpr int NTILE = MT / 256;
constexpr int DFF = 5632, DFF2 = 2 * DFF, PLE = 256, PAST = 2048;
constexpr int NG = 128, NST = 64, NH = 8, HD = 128, VD = 256;
constexpr float EPS = 1e-6f, SUBLN_EPS = 1e-5f;
constexpr int NWAVES = 8, NTHR = 512;

constexpr size_t O_Y = 0, O_YS = 67108864, O_SRE_P = 68157440, O_SIM_P = 68173824, O_CONV_P = 68190208, O_K_P = 68280320, O_V_P = 135389184,
                 O_SRE_S = 202498048, O_SIM_S = 202629120, O_CONV_S = 202760192, O_K_S = 203481088, O_V_S = 204529664, O_END = 205578240;

constexpr size_t MiB = 1u << 20;
constexpr size_t WS_CTL = 0, CTL_ZERO_BYTES = 1 * MiB;
constexpr size_t WS_WGLU = 1 * MiB;
constexpr size_t WS_WUP = 17 * MiB;
constexpr size_t WS_WDOWN = 105 * MiB;
constexpr size_t WS_WGATE = 149 * MiB;
constexpr size_t WS_WPROJ = 165 * MiB;
constexpr size_t WS_WQKV = 167 * MiB;
constexpr size_t WS_WO = 191 * MiB;
constexpr size_t WS_ROPE = 199 * MiB;
constexpr size_t WS_L16 = 202 * MiB;
constexpr size_t WS_CONVP = 202 * MiB + 131072;
constexpr size_t WS_QS = 203 * MiB;
constexpr size_t WS_PB = 209 * MiB;
constexpr size_t WS_PART0 = 226 * MiB, WS_PART1 = 235 * MiB;
constexpr size_t WS_HB = 244 * MiB;
constexpr size_t WS_UB = 374 * MiB;
constexpr size_t WS_PP = 504 * MiB;
constexpr size_t WS_BIG = 634 * MiB;
constexpr size_t WS_KB = 894 * MiB;
constexpr size_t WS_VB = 1022 * MiB;
constexpr size_t WS_END = 1150 * MiB;
constexpr size_t WS_SSM = WS_KB;
constexpr size_t SSM_G_BYTES = 262144;
constexpr size_t WS_ZSIDE = WS_VB;

constexpr int CW_BAR = 4096;

constexpr int RING_BYTES = 131072, LDSCTL_OFF = RING_BYTES, LDS_BYTES = 147456;

__device__ __forceinline__ unsigned cvt_pk_bf16(float lo, float hi) { unsigned r; asm volatile("v_cvt_pk_bf16_f32 %0, %1, %2" : "=v"(r) : "v"(lo), "v"(hi)); return r; }
__device__ __forceinline__ float bf2f(unsigned short b) { return __uint_as_float(((unsigned)b) << 16); }
__device__ __forceinline__ float fsigmoid(float x) { return __builtin_amdgcn_rcpf(1.f + __expf(-x)); }
__device__ __forceinline__ float gelu_tanh(float x) { const float t = 1.5957691216f * (x + 0.044715f * x * x * x); return x * fsigmoid(t); }
__device__ __forceinline__ float wave_sum(float v) {
#pragma unroll
    for (int o = 1; o < 64; o <<= 1) v += __shfl_xor(v, o);
    return v;
}
template <class T> __device__ __forceinline__ T* at32(T* base, unsigned elem) { return (T*)((char*)base + elem * (unsigned)sizeof(T)); }
template <class T> __device__ __forceinline__ const T* at32(const T* base, unsigned elem) { return (const T*)((const char*)base + elem * (unsigned)sizeof(T)); }
template <int CTRL> __device__ __forceinline__ float dppf(float v) { return __int_as_float(__builtin_amdgcn_mov_dpp(__float_as_int(v), CTRL, 0xf, 0xf, false)); }
#define DPP_ROR1 0x121
#define DPP_ROR2 0x122

namespace pg8 {
constexpr int BM = 256, BK = 64, HALF = 128, HTB = HALF * BK * 2, STAGE_BYTES = 8 * HTB, NXCD = 8, WGM = 4;
__host__ __device__ __forceinline__ int lds_byte(int r, int c) { const int st = (r >> 4) * 2 + (c >> 5), rr = r & 15, cc = c & 31, ob = rr * 64 + cc * 2; return st * 1024 + (ob ^ (((ob >> 9) & 1) << 5)); }
__host__ __device__ __forceinline__ void stage_rc(int b, int& R, int& C) { const int st = b / 1024, sb = b % 1024, swz = sb ^ (((sb >> 9) & 1) << 5); R = (st >> 1) * 16 + swz / 64; C = (st & 1) * 32 + (swz % 64) / 2; }
__host__ __device__ __forceinline__ int perm32(int rho) { const int n = rho >> 4, i = rho & 15; return 8 * (i >> 2) + 4 * n + (i & 3); }

struct Unit { int pm, pn, rb, aih; };
struct Gemm { const bf16_t* A; const bf16_t* Bt; int M, N, K; };

struct StaticOrder {
    int nM, nN, nwg, G, c;
    __host__ __device__ void init(int M, int N, int G_, int c_) { nM = M / BM; nN = N / BM; nwg = nM * nN; G = G_; c = c_; }
    __host__ __device__ bool next(int i, Unit& u) const {
        const long L = (long)i * G + c; if (L >= nwg) return false;
        int wgid = (int)L; { const int q = nwg / NXCD, r = nwg % NXCD, xcd = wgid % NXCD, off = wgid / NXCD; wgid = (xcd < r ? xcd * (q + 1) : r * (q + 1) + (xcd - r) * q) + off; }
        const int nig = WGM * nN, gid = wgid / nig, fm = gid * WGM, gsz = (nM - fm) < WGM ? (nM - fm) : WGM;
        u.pm = fm + ((wgid % nig) % gsz); u.pn = (wgid % nig) / gsz; u.rb = u.pm * BM; u.aih = 0; return true;
    }
    __device__ __forceinline__ void a_ready(const Unit&) const {}
    __device__ __forceinline__ void done(const Unit&) const {}
};
struct HalfOrder {
    int nN, nwg, G, c, pm0;
    __host__ __device__ void init(int pm0_, int N, int G_, int c_) { pm0 = pm0_; nN = N / BM; nwg = 4 * nN; G = G_; c = c_; }
    __host__ __device__ bool next(int i, Unit& u) const {
        const long L = (long)i * G + c; if (L >= nwg) return false;
        const int idx = (int)L, sub = idx & 3; u.pn = idx >> 2; u.pm = pm0 + (sub >> 1); u.aih = sub & 1; u.rb = u.pm * BM + 64 * u.aih; return true;
    }
    __device__ __forceinline__ void a_ready(const Unit&) const {}
    __device__ __forceinline__ void done(const Unit&) const {}
};

#ifndef PG8_SP2
#define PG8_SP2 true
#endif
#ifndef PG8_ALIGN
#define PG8_ALIGN true
#endif
template <class Epi, class Sched, bool HALFM = false, bool ALIGN_EPI = PG8_ALIGN, bool SP2 = PG8_SP2>
__device__ __forceinline__ void gemm_phase(LAS unsigned char* lds, const Gemm g, const Sched& S, const Epi& E, const int wid  ) {
    int lane_ = __builtin_amdgcn_mbcnt_hi(~0u, __builtin_amdgcn_mbcnt_lo(~0u, 0u)); asm volatile("" : "+v"(lane_));
    const int lane = lane_, tid = wid * 64 + lane, wr = wid >> 2, wc = wid & 3, fr = lane & 15, fq = lane >> 4;
    const int K = g.K, nt = K / BK;
    unsigned voffA[2], voffB[2];
#pragma unroll
    for (int i = 0; i < 2; ++i) { int R, C; stage_rc(tid * 16 + i * 8192, R, C); const int Rb = Epi::PERM ? ((R & ~31) + perm32(R & 31)) : R;
        const int Ra = (R >> 6) * 128 + (R & 63);
        voffA[i] = (unsigned)(Ra * K + C) * 2u; voffB[i] = (unsigned)(Rb * K + C) * 2u; }
    const __amdgpu_buffer_rsrc_t rsA_ = __builtin_amdgcn_make_buffer_rsrc((void*)g.A, 0, 0x7ffffff0, 0x00020000), rsB_ = __builtin_amdgcn_make_buffer_rsrc((void*)g.Bt, 0, 0x7ffffff0, 0x00020000);
    const size_t kstep = (size_t)(BK * 2);
    const size_t hstepB = (size_t)HALF * K * 2, hstepA = (size_t)64 * K * 2;
    const size_t tstep = (size_t)BM * K * 2;
    const unsigned ldsw = (unsigned)wid * 1024u;
    const int aoff = lds_byte(wr * 64 + fr, fq * 8), boff = lds_byte(wc * 32 + fr, fq * 8);
#define PG8_SA(b, h) (((b) * 2 + (h)) * HTB)
#define PG8_SB(b, h) ((4 + (b) * 2 + (h)) * HTB)
#define PG8_STAGE(bufoff, gbase, voff) do { const int so_ = (int)(unsigned)((const char*)(gbase) - PG8_BASE_##voff); _Pragma("unroll") for (int _i = 0; _i < 2; ++_i) \
        __builtin_amdgcn_raw_ptr_buffer_load_lds(PG8_RS_##voff, (LAS unsigned*)(lds + (bufoff) + ldsw + _i * 8192), 16, (int)(voff)[_i], so_, 0, 0); } while (0)
#define PG8_BASE_voffA ((const char*)g.A)
#define PG8_BASE_voffB ((const char*)g.Bt)
#define PG8_RS_voffA rsA_
#define PG8_RS_voffB rsB_
#define PG8_LDA(dst, b, h) do { _Pragma("unroll") for (int m = 0; m < 4; ++m) _Pragma("unroll") for (int k = 0; k < 2; ++k) dst[m][k] = *(const LAS bf16x8*)(lds + PG8_SA(b, h) + aoff + m * 2048 + k * 1024); } while (0)
#define PG8_LDB(dst, b, h) do { _Pragma("unroll") for (int n = 0; n < 2; ++n) _Pragma("unroll") for (int k = 0; k < 2; ++k) dst[n][k] = *(const LAS bf16x8*)(lds + PG8_SB(b, h) + boff + n * 2048 + k * 1024); } while (0)
#define PG8_MMA(ai, bj, At, Bt) do { __builtin_amdgcn_s_setprio(1); _Pragma("unroll") for (int m = 0; m < 4; ++m) _Pragma("unroll") for (int n = 0; n < 2; ++n) _Pragma("unroll") for (int k = 0; k < 2; ++k) \
        acc[ai][bj][m][n] = __builtin_amdgcn_mfma_f32_16x16x32_bf16(Bt[n][k], At[m][k], acc[ai][bj][m][n], 0, 0, 0); __builtin_amdgcn_s_setprio(0); } while (0)
#define PG8_WAIT_V(n) asm volatile("s_waitcnt vmcnt(" #n ")" ::: "memory")
#define PG8_WAIT_L(n) asm volatile("s_waitcnt lgkmcnt(" #n ")" ::: "memory")
#define PG8_BAR __builtin_amdgcn_s_barrier()
#define PG8_SCHED __builtin_amdgcn_sched_barrier(0)
    Unit cur, nxt; int ui = 0;
    if (!S.next(0, cur)) return;
    f32x4 acc[2][2][4][2];
#pragma unroll
    for (int a = 0; a < 2; ++a)
#pragma unroll
        for (int b = 0; b < 2; ++b)
#pragma unroll
            for (int m = 0; m < 4; ++m)
#pragma unroll
                for (int n = 0; n < 2; ++n) acc[a][b][m][n] = (f32x4){0.f, 0.f, 0.f, 0.f};
    bf16x8 At[4][2], B0[2][2], B1[2][2];
    static_assert(SP2 || !HALFM, "half-M units: SP2 loop only");
    const char* cA = (const char*)g.A + (size_t)cur.pm * tstep + (size_t)cur.aih * hstepA; const char* cB = (const char*)g.Bt + (size_t)cur.pn * tstep;
    S.a_ready(cur);
    if constexpr (SP2) {
        PG8_STAGE(PG8_SB(0, 0), cB, voffB); PG8_STAGE(PG8_SB(0, 1), cB + hstepB, voffB); PG8_STAGE(PG8_SA(0, 0), cA, voffA); if constexpr (!HALFM) PG8_STAGE(PG8_SA(0, 1), cA + hstepA, voffA);
        if (wr == 1) PG8_BAR;
        if constexpr (HALFM) PG8_WAIT_V(0); else PG8_WAIT_V(2);
        PG8_BAR;
        PG8_STAGE(PG8_SB(1, 0), cB + kstep, voffB); PG8_STAGE(PG8_SA(1, 0), cA + kstep, voffA); PG8_STAGE(PG8_SB(1, 1), cB + hstepB + kstep, voffB);
        PG8_WAIT_V(6); PG8_BAR;
    } else {
    PG8_STAGE(PG8_SB(0, 0), cB, voffB); PG8_STAGE(PG8_SA(0, 0), cA, voffA); PG8_STAGE(PG8_SB(0, 1), cB + hstepB, voffB); PG8_STAGE(PG8_SA(0, 1), cA + hstepA, voffA);
    if (wr == 1) PG8_BAR;
    PG8_WAIT_V(4); PG8_BAR;
    PG8_STAGE(PG8_SB(1, 0), cB + kstep, voffB); PG8_STAGE(PG8_SA(1, 0), cA + kstep, voffA); PG8_STAGE(PG8_SB(1, 1), cB + hstepB + kstep, voffB);
    PG8_WAIT_V(6); PG8_BAR;
    }
    for (;;) {
        const bool has_next = S.next(ui + 1, nxt);
        const char* nA = has_next ? (const char*)g.A + (size_t)nxt.pm * tstep + (size_t)nxt.aih * hstepA : cA; const char* nB = has_next ? (const char*)g.Bt + (size_t)nxt.pn * tstep : cB;
        for (int t = 0; t < nt; t += 2) {
            const bool last = (t == nt - 2);
            const char* a1 = cA + (size_t)(t + 1) * kstep;
            const char* a2 = last ? nA : cA + (size_t)(t + 2) * kstep; const char* b2 = last ? nB : cB + (size_t)(t + 2) * kstep;
            const char* a3 = a2 + kstep; const char* b3 = b2 + kstep;
            if (last && has_next) S.a_ready(nxt);
            if constexpr (SP2) {
#define PG8_WAIT_VH() do { if constexpr (HALFM) PG8_WAIT_V(6); else PG8_WAIT_V(8); } while (0)
            PG8_LDB(B0, 0, 0); PG8_LDB(B1, 0, 1); PG8_SCHED; PG8_LDA(At, 0, 0); if constexpr (!HALFM) PG8_STAGE(PG8_SA(1, 1), a1 + hstepA, voffA);
            PG8_WAIT_VH(); PG8_WAIT_L(0); PG8_BAR; PG8_MMA(0, 0, At, B0); PG8_MMA(0, 1, At, B1); PG8_BAR; PG8_SCHED;
            if constexpr (!HALFM) PG8_LDA(At, 0, 1); PG8_STAGE(PG8_SB(0, 0), b2, voffB); PG8_STAGE(PG8_SB(0, 1), b2 + hstepB, voffB); PG8_STAGE(PG8_SA(0, 0), a2, voffA);
            PG8_WAIT_VH(); PG8_WAIT_L(0); PG8_BAR; if constexpr (!HALFM) { PG8_MMA(1, 0, At, B0); PG8_MMA(1, 1, At, B1); } PG8_BAR; PG8_SCHED;
            PG8_LDB(B0, 1, 0); PG8_LDB(B1, 1, 1); PG8_SCHED; PG8_LDA(At, 1, 0); if constexpr (!HALFM) PG8_STAGE(PG8_SA(0, 1), a2 + hstepA, voffA);
            PG8_WAIT_VH(); PG8_WAIT_L(0); PG8_BAR; PG8_MMA(0, 0, At, B0); PG8_MMA(0, 1, At, B1); PG8_BAR; PG8_SCHED;
            if constexpr (!HALFM) PG8_LDA(At, 1, 1); PG8_STAGE(PG8_SB(1, 0), b3, voffB); PG8_STAGE(PG8_SB(1, 1), b3 + hstepB, voffB); PG8_STAGE(PG8_SA(1, 0), a3, voffA);
            PG8_WAIT_VH(); PG8_WAIT_L(0); PG8_BAR; if constexpr (!HALFM) { PG8_MMA(1, 0, At, B0); PG8_MMA(1, 1, At, B1); } PG8_BAR; PG8_SCHED;
#undef PG8_WAIT_VH
            } else {
            PG8_LDB(B0, 0, 0); PG8_SCHED; PG8_LDA(At, 0, 0); PG8_STAGE(PG8_SA(1, 1), a1 + hstepA, voffA);
            PG8_WAIT_L(8); PG8_BAR; PG8_WAIT_L(0); PG8_MMA(0, 0, At, B0); PG8_BAR; PG8_SCHED;
            PG8_LDB(B1, 0, 1); PG8_STAGE(PG8_SB(0, 0), b2, voffB);
            PG8_BAR; PG8_WAIT_L(0); PG8_MMA(0, 1, At, B1); PG8_BAR;
            PG8_LDA(At, 0, 1); PG8_STAGE(PG8_SA(0, 0), a2, voffA);
            PG8_BAR; PG8_WAIT_L(0); PG8_MMA(1, 0, At, B0); PG8_BAR; PG8_SCHED;
            PG8_STAGE(PG8_SB(0, 1), b2 + hstepB, voffB);
            PG8_WAIT_V(6); PG8_BAR; PG8_MMA(1, 1, At, B1); PG8_BAR;
            PG8_LDB(B0, 1, 0); PG8_SCHED; PG8_LDA(At, 1, 0); PG8_STAGE(PG8_SA(0, 1), a2 + hstepA, voffA);
            PG8_WAIT_L(8); PG8_BAR; PG8_WAIT_L(0); PG8_MMA(0, 0, At, B0); PG8_BAR; PG8_SCHED;
            PG8_LDB(B1, 1, 1); PG8_STAGE(PG8_SB(1, 0), b3, voffB);
            PG8_BAR; PG8_WAIT_L(0); PG8_MMA(0, 1, At, B1); PG8_BAR;
            PG8_LDA(At, 1, 1); PG8_STAGE(PG8_SA(1, 0), a3, voffA);
            PG8_BAR; PG8_WAIT_L(0); PG8_MMA(1, 0, At, B0); PG8_BAR; PG8_SCHED;
            PG8_STAGE(PG8_SB(1, 1), b3 + hstepB, voffB);
            PG8_WAIT_V(6); PG8_BAR; PG8_MMA(1, 1, At, B1); PG8_BAR;
            }
        }
        if constexpr (ALIGN_EPI) { if (wr == 0) PG8_BAR; }
        E.template run<HALFM ? 1 : 2>(acc, cur, wr, wc, fr, fq); S.done(cur);
        if (!has_next) break;
#pragma unroll
        for (int a = 0; a < 2; ++a)
#pragma unroll
            for (int b = 0; b < 2; ++b)
#pragma unroll
                for (int m = 0; m < 4; ++m)
#pragma unroll
                    for (int n = 0; n < 2; ++n) acc[a][b][m][n] = (f32x4){0.f, 0.f, 0.f, 0.f};
        cur = nxt; cA = nA; cB = nB; ++ui;
        if constexpr (ALIGN_EPI) { if (wr == 1) PG8_BAR; }
    }
    PG8_WAIT_V(0);
    if constexpr (!ALIGN_EPI) { if (wr == 0) PG8_BAR; }
    PG8_BAR;
#undef PG8_SA
#undef PG8_SB
#undef PG8_STAGE
#undef PG8_BASE_voffA
#undef PG8_BASE_voffB
#undef PG8_RS_voffA
#undef PG8_RS_voffB
#undef PG8_LDA
#undef PG8_LDB
#undef PG8_MMA
#undef PG8_WAIT_V
#undef PG8_WAIT_L
#undef PG8_BAR
#undef PG8_SCHED
}
}
using pg8::Unit;

typedef f32x4 Acc[2][2][4][2];

__device__ __forceinline__ unsigned part_idx(int ph, int slot, int fr) { return (unsigned)(((ph * 64 + slot) * 16 + fr) * 8); }
constexpr int RSTD_LDS = RING_BYTES;
template <int NP, int NAI> __device__ __forceinline__ void load_rstd(const float* part, int rowbase, int fr, int fq, float (&rs)[2][4], LAS unsigned char* lds, int wid, int key) {
    LAS float* rc = (LAS float*)(lds + RSTD_LDS) + wid * 128; LAS int* tagp = (LAS int*)(lds + LDS_BYTES - 256) + 32 + wid;
    const int want = key | rowbase;
    if (__builtin_amdgcn_readfirstlane(*tagp) == want) {
#pragma unroll
        for (int ai = 0; ai < NAI; ++ai)
#pragma unroll
            for (int m = 0; m < 4; ++m) rs[ai][m] = rc[64 * ai + 16 * m + fr];
        return;
    }
    { const int ph = rowbase >> 7, q0 = (rowbase >> 4) & 7;
      f32x4 sacc[2] = {{0.f, 0.f, 0.f, 0.f}, {0.f, 0.f, 0.f, 0.f}};
#pragma unroll
      for (int i = 0; i < NP / 4; ++i) { const unsigned o_ = part_idx(ph, fq * (NP / 4) + i, fr) + q0;
#pragma unroll
          for (int ai = 0; ai < NAI; ++ai) sacc[ai] += *(const f32x4*)at32(part, o_ + 4 * ai);
          if ((i & 3) == 3) asm volatile("" : "+v"(sacc[0]), "+v"(sacc[1]));     }
#pragma unroll
      for (int ai = 0; ai < NAI; ++ai)
#pragma unroll
        for (int m = 0; m < 4; ++m) { float sv = sacc[ai][m]; sv += __shfl_xor(sv, 16); sv += __shfl_xor(sv, 32);
            rs[ai][m] = rsqrtf(sv * (1.0f / DM) + EPS);
            if (NAI == 2 && fq == 0) rc[64 * ai + 16 * m + fr] = rs[ai][m]; } }
    if (NAI == 2) { if (fr == 0 && fq == 0) *tagp = want; }
    asm volatile("s_waitcnt lgkmcnt(0)" ::: "memory");
}

template <int NAI> __device__ __forceinline__ void store_part4(float* part, const Unit& u, int wr, int slot, int fr, int fq, int ai, const f32x4 v) {
    if (fq == 0) *(f32x4*)at32(part, part_idx(u.pm * 2 + wr, slot, fr) + 4u * (unsigned)(NAI == 1 ? u.aih : ai)) = v;
}
struct EpiGlu {
    static constexpr bool PERM = true;
    const float* xp; const float* xs; bf16_t* hb; float* part;
    template <int NAI> __device__ __forceinline__ void run(Acc& acc, const Unit& u, int wr, int wc, int fr, int fq) const {
        asm volatile("" : "+v"(fr), "+v"(fq));
        const int rowbase = u.rb + wr * 128 + fr, col0 = u.pn * 128 + wc * 32 + 8 * fq;
        const bool smp = u.pm >= MP / 256; const float* xb = smp ? xs : xp; const int rsub = smp ? MP : 0;
#pragma unroll
        for (int ai = 0; ai < NAI; ++ai) {
            f32x4 xv[4][2]; f32x4 ssv;
#pragma unroll
            for (int m = 0; m < 4; ++m)
#pragma unroll
                for (int n = 0; n < 2; ++n) xv[m][n] = *(const f32x4*)at32(xb, (unsigned)((rowbase + 64 * ai + 16 * m - rsub) * DM + col0 + 4 * n));
#pragma unroll
            for (int m = 0; m < 4; ++m) {
                const int r = rowbase + 64 * ai + 16 * m; float ss = 0.f; u32x4 w;
#pragma unroll
                for (int n = 0; n < 2; ++n) {
                    const f32x4 a = acc[ai][0][m][n], b = acc[ai][1][m][n]; f32x4 o;
#pragma unroll
                    for (int j = 0; j < 4; ++j) { o[j] = xv[m][n][j] + a[j] * fsigmoid(b[j]); ss += o[j] * o[j]; }
                    w[2 * n] = cvt_pk_bf16(o[0], o[1]); w[2 * n + 1] = cvt_pk_bf16(o[2], o[3]);
                }
                *(u32x4*)at32(hb, (unsigned)(r * DM + col0)) = w;
                ss += __shfl_xor(ss, 16); ss += __shfl_xor(ss, 32);
                ssv[m] = ss;
            }
            store_part4<NAI>(part, u, wr, u.pn * 4 + wc, fr, fq, ai, ssv);
        }
    }
};

struct EpiResid {
    static constexpr bool PERM = true;
    bf16_t* hb; float* part;
    template <int NAI> __device__ __forceinline__ void run(Acc& acc, const Unit& u, int wr, int wc, int fr, int fq) const {
        asm volatile("" : "+v"(fr), "+v"(fq));
        const int rowbase = u.rb + wr * 128 + fr, col0 = u.pn * 256 + wc * 32 + 8 * fq;
#pragma unroll
        for (int ai = 0; ai < NAI; ++ai) {
            u32x4 hv[4][2]; f32x4 ssv;
#pragma unroll
            for (int m = 0; m < 4; ++m)
#pragma unroll
                for (int bj = 0; bj < 2; ++bj) hv[m][bj] = *(const u32x4*)at32((const bf16_t*)hb, (unsigned)((rowbase + 64 * ai + 16 * m) * DM + col0 + 128 * bj));
#pragma unroll
            for (int m = 0; m < 4; ++m) {
                const int r = rowbase + 64 * ai + 16 * m; float ss = 0.f;
#pragma unroll
                for (int bj = 0; bj < 2; ++bj) { u32x4 w;
#pragma unroll
                    for (int n = 0; n < 2; ++n) {
                        const unsigned h0 = hv[m][bj][2 * n], h1 = hv[m][bj][2 * n + 1]; const f32x4 a = acc[ai][bj][m][n];
                        const f32x4 o = {__uint_as_float(h0 << 16) + a[0], __uint_as_float(h0 & 0xffff0000u) + a[1], __uint_as_float(h1 << 16) + a[2], __uint_as_float(h1 & 0xffff0000u) + a[3]};
                        ss += (o[0] * o[0] + o[1] * o[1]) + (o[2] * o[2] + o[3] * o[3]);
                        w[2 * n] = cvt_pk_bf16(o[0], o[1]); w[2 * n + 1] = cvt_pk_bf16(o[2], o[3]);
                    }
                    *(u32x4*)at32(hb, (unsigned)(r * DM + col0 + 128 * bj)) = w; }
                ss += __shfl_xor(ss, 16); ss += __shfl_xor(ss, 32);
                ssv[m] = ss;
            }
            store_part4<NAI>(part, u, wr, u.pn * 4 + wc, fr, fq, ai, ssv);
        }
    }
};

struct EpiBf16 {
    static constexpr bool PERM = true;
    bf16_t* O; int ldc;
    template <int NAI> __device__ __forceinline__ void run(Acc& acc, const Unit& u, int wr, int wc, int fr, int fq) const {
        asm volatile("" : "+v"(fr), "+v"(fq));
        const int rowbase = u.rb + wr * 128 + fr, col0 = u.pn * 256 + wc * 32 + 8 * fq;
#pragma unroll
        for (int ai = 0; ai < NAI; ++ai)
#pragma unroll
            for (int m = 0; m < 4; ++m) { const unsigned ro = (unsigned)((rowbase + 64 * ai + 16 * m) * ldc + col0);
#pragma unroll
                for (int bj = 0; bj < 2; ++bj) { const f32x4 v0 = acc[ai][bj][m][0], v1 = acc[ai][bj][m][1];
                    u32x4 w = {cvt_pk_bf16(v0[0], v0[1]), cvt_pk_bf16(v0[2], v0[3]), cvt_pk_bf16(v1[0], v1[1]), cvt_pk_bf16(v1[2], v1[3])}; *(u32x4*)at32(O, ro + (unsigned)(bj * 128)) = w; } }
    }
};

struct EpiPle {
    static constexpr bool PERM = true;
    const float* partin; const bf16_t* hsrc; bf16_t* ppio; float* part; LAS unsigned char* lds; int key;
    template <int NAI> __device__ __forceinline__ void run(Acc& acc, const Unit& u, int wr, int wc, int fr, int fq) const {
        asm volatile("" : "+v"(fr), "+v"(fq));
        const int rowbase = u.rb + wr * 128 + fr, col0 = u.pn * 256 + wc * 32 + 8 * fq;
        float rs[2][4]; load_rstd<32, NAI>(partin, u.rb + wr * 128, fr, fq, rs, lds, wr * 4 + wc, key); f32x4 ssv = {0.f, 0.f, 0.f, 0.f};
#pragma unroll
        for (int q2 = 0; q2 < 2 * NAI; ++q2) {
            const int ai = q2 >> 1, m0 = (q2 & 1) * 2;
            u32x4 hv[2][2], pv[2][2];
#pragma unroll
            for (int mm = 0; mm < 2; ++mm)
#pragma unroll
                for (int bj = 0; bj < 2; ++bj) { const unsigned o_ = (unsigned)((rowbase + 64 * ai + 16 * (m0 + mm)) * DM + col0 + 128 * bj);
                    hv[mm][bj] = *(const u32x4*)at32(hsrc, o_); pv[mm][bj] = *(const u32x4*)at32((const bf16_t*)ppio, o_); }
#pragma unroll
            for (int mm = 0; mm < 2; ++mm) {
                const int m = m0 + mm, r = rowbase + 64 * ai + 16 * m; float ss = 0.f;
#pragma unroll
                for (int bj = 0; bj < 2; ++bj) { u32x4 w;
#pragma unroll
                    for (int n = 0; n < 2; ++n) {
                        const unsigned pw0 = pv[mm][bj][2 * n], pw1 = pv[mm][bj][2 * n + 1], h0 = hv[mm][bj][2 * n], h1 = hv[mm][bj][2 * n + 1];
                        const f32x4 a = acc[ai][bj][m][n] * rs[ai][m]; f32x4 o;
                        o[0] = __uint_as_float(h0 << 16) + __uint_as_float(pw0 << 16) * fsigmoid(a[0]); o[1] = __uint_as_float(h0 & 0xffff0000u) + __uint_as_float(pw0 & 0xffff0000u) * fsigmoid(a[1]);
                        o[2] = __uint_as_float(h1 << 16) + __uint_as_float(pw1 << 16) * fsigmoid(a[2]); o[3] = __uint_as_float(h1 & 0xffff0000u) + __uint_as_float(pw1 & 0xffff0000u) * fsigmoid(a[3]);
                        ss += (o[0] * o[0] + o[1] * o[1]) + (o[2] * o[2] + o[3] * o[3]);
                        w[2 * n] = cvt_pk_bf16(o[0], o[1]); w[2 * n + 1] = cvt_pk_bf16(o[2], o[3]);
                    }
                    *(u32x4*)at32(ppio, (unsigned)(r * DM + col0 + 128 * bj)) = w; }
                ss += __shfl_xor(ss, 16); ss += __shfl_xor(ss, 32);
                ssv[m] = ss;
            }
            if (q2 & 1) store_part4<NAI>(part, u, wr, u.pn * 4 + wc, fr, fq, ai, ssv);
        }
    }
};

template <int NP> struct EpiUp {
    static constexpr bool PERM = true;
    const float* partin; bf16_t* act; const float* cw; const float* cb; const float* state; float* zside; float* conv_p; float* conv_s; LAS unsigned char* lds; int key;
    template <int NAI> __device__ __forceinline__ void run(Acc& acc, const Unit& u, int wr, int wc, int fr, int fq) const {
        asm volatile("" : "+v"(fr), "+v"(fq));
        const bool sample = u.pm >= MP / 256;
        const int rowhalf = u.rb + wr * 128;
        { float rs[2][4]; load_rstd<NP, NAI>(partin, rowhalf, fr, fq, rs, lds, wr * 4 + wc, key);
#pragma unroll
          for (int ai = 0; ai < NAI; ++ai)
#pragma unroll
            for (int bj = 0; bj < 2; ++bj)
#pragma unroll
                for (int m = 0; m < 4; ++m)
#pragma unroll
                    for (int n = 0; n < 2; ++n) acc[ai][bj][m][n] = acc[ai][bj][m][n] * rs[ai][m]; }
        const int ht = u.pm * 2 + wr;
        const bool seqstart = (!sample) && ((ht & 127) == 0);
        const bool seqend = (!sample) && ((ht & 127) == 127);
        const int sb2 = ((rowhalf - MP) >> 5) * 2;
        const int c8 = u.pn * 128 + wc * 32 + 8 * fq;
#pragma unroll
        for (int n = 0; n < 2; ++n) {
            const int c0 = c8 + 4 * n;
            if (NAI == 2 && !sample) {
                if (fr < 2) { const unsigned o = (unsigned)((ht * 4 + fr) * DFF2 + c0); *(f32x4*)at32(zside, o) = acc[0][0][0][n]; *(f32x4*)at32(zside, o + DFF) = acc[0][1][0][n]; }
                if (fr >= 14) { const unsigned o = (unsigned)((ht * 4 + 2 + (fr - 14)) * DFF2 + c0); *(f32x4*)at32(zside, o) = acc[NAI - 1][0][3][n]; *(f32x4*)at32(zside, o + DFF) = acc[NAI - 1][1][3][n];
                    if (seqend) { const unsigned o2 = (unsigned)(((ht >> 7) * 2 + (fr - 14)) * DFF2 + c0); *(f32x4*)at32(conv_p, o2) = acc[NAI - 1][0][3][n]; *(f32x4*)at32(conv_p, o2 + DFF) = acc[NAI - 1][1][3][n]; } }
            } else if (sample && fr >= 14) {
#pragma unroll
                for (int qq = 1; qq < 4 * NAI; qq += 2) { const unsigned o2 = (unsigned)((sb2 + (qq >> 1) * 2 + (fr - 14)) * DFF2 + c0);
                    *(f32x4*)at32(conv_s, o2) = acc[qq >> 2][0][qq & 3][n]; *(f32x4*)at32(conv_s, o2 + DFF) = acc[qq >> 2][1][qq & 3][n]; }
            }
        }
        unsigned outp[4 * NAI][4];
        f32x4 nr0 = *(const f32x4*)at32(cw, (unsigned)(c8 * 8)), nr1 = *(const f32x4*)at32(cw, (unsigned)(c8 * 8 + 4)), nr2 = *(const f32x4*)at32(cw, (unsigned)(c8 * 8 + 8)), nr3 = *(const f32x4*)at32(cw, (unsigned)(c8 * 8 + 12));
#pragma unroll
        for (int n = 0; n < 2; ++n)
#pragma unroll
            for (int jp = 0; jp < 2; ++jp) {
                const int c0 = c8 + 4 * n + 2 * jp;
                const f32x4 ra = nr0, rb_ = nr1, rc_ = nr2, rd_ = nr3;
                asm volatile("" ::: "memory");
                if (n * 2 + jp < 3) { const unsigned o = (unsigned)((c0 + 2) * 8); nr0 = *(const f32x4*)at32(cw, o); nr1 = *(const f32x4*)at32(cw, o + 4); nr2 = *(const f32x4*)at32(cw, o + 8); nr3 = *(const f32x4*)at32(cw, o + 12); }
                const f32x2 w0v = {ra[0], ra[1]}, w1v = {ra[2], ra[3]}, w2v = {rb_[0], rb_[1]}, bv = {rb_[2], rb_[3]};
                const f32x2 w0g = {rc_[0], rc_[1]}, w1g = {rc_[2], rc_[3]}, w2g = {rd_[0], rd_[1]}, bg = {rd_[2], rd_[3]};
                f32x2 p1v = {0.f, 0.f}, p2v = p1v, p1g = p1v, p2g = p1v;
#pragma unroll
                for (int q = 0; q < 4 * NAI; ++q) {
                    const int ai = q >> 2, m = q & 3;
                    const f32x2 zv = {acc[ai][0][m][n][2 * jp], acc[ai][0][m][n][2 * jp + 1]}, zg = {acc[ai][1][m][n][2 * jp], acc[ai][1][m][n][2 * jp + 1]};
                    if (sample && !(q & 1)) {
                        f32x2 hv = {0.f, 0.f}, hg = hv;
                        if (fr >= 14) { const unsigned so = (unsigned)((sb2 + (q >> 1) * 2 + (fr - 14)) * DFF2 + c0); hv = *(const f32x2*)at32(state, so); hg = *(const f32x2*)at32(state, so + DFF); }
#pragma unroll
                        for (int j = 0; j < 2; ++j) { p1v[j] = dppf<DPP_ROR1>(hv[j]); p2v[j] = dppf<DPP_ROR2>(hv[j]); p1g[j] = dppf<DPP_ROR1>(hg[j]); p2g[j] = dppf<DPP_ROR2>(hg[j]); }
                    }
                    f32x2 r1v, r2v, r1g, r2g, P1v, P2v, P1g, P2g;
#pragma unroll
                    for (int j = 0; j < 2; ++j) {
                        r1v[j] = dppf<DPP_ROR1>(zv[j]); r2v[j] = dppf<DPP_ROR2>(zv[j]); r1g[j] = dppf<DPP_ROR1>(zg[j]); r2g[j] = dppf<DPP_ROR2>(zg[j]);
                        P1v[j] = fr >= 1 ? r1v[j] : p1v[j]; P2v[j] = fr >= 2 ? r2v[j] : p2v[j]; P1g[j] = fr >= 1 ? r1g[j] : p1g[j]; P2g[j] = fr >= 2 ? r2g[j] : p2g[j];
                    }
                    const f32x2 cv = __builtin_elementwise_fma(w0v, P2v, __builtin_elementwise_fma(w1v, P1v, __builtin_elementwise_fma(w2v, zv, bv)));
                    const f32x2 cg = __builtin_elementwise_fma(w0g, P2g, __builtin_elementwise_fma(w1g, P1g, __builtin_elementwise_fma(w2g, zg, bg)));
                    const f32x2 tt = cg * (f32x2){-1.4426950408889634f, -1.4426950408889634f};
                    f32x2 ee = {__builtin_amdgcn_exp2f(tt[0]), __builtin_amdgcn_exp2f(tt[1])}; ee = ee + (f32x2){1.f, 1.f};
                    const f32x2 sg = {__builtin_amdgcn_rcpf(ee[0]), __builtin_amdgcn_rcpf(ee[1])};
                    const f32x2 o = cv * cg * sg;
                    p1v = r1v; p2v = r2v; p1g = r1g; p2g = r2g;
                    outp[q][2 * n + jp] = cvt_pk_bf16(o[0], o[1]);
                }
            }
#pragma unroll
        for (int q = 0; q < 4 * NAI; ++q) {
            const bool deferred = (!sample) && q == 0 && fr < 2 && !seqstart;
            if (!deferred) { u32x4 w = {outp[q][0], outp[q][1], outp[q][2], outp[q][3]}; *(u32x4*)at32(act, (unsigned)((rowhalf + 16 * q + fr) * DFF + c8)) = w; }
        }
    }
};

struct EpiQkv {
    static constexpr bool PERM = false;
    const float* partin; const float* rope; bf16_t* qb; float* qs; bf16_t* kb; bf16_t* vb; float* out; LAS unsigned char* lds; int key;
    template <int NAI> __device__ __forceinline__ void run(Acc& acc, const Unit& u, int wr, int wc, int fr, int fq) const {
        asm volatile("" : "+v"(fr), "+v"(fq));
        const int rowhalf = u.rb + wr * 128;
        float rs[2][4]; load_rstd<32, NAI>(partin, rowhalf, fr, fq, rs, lds, wr * 4 + wc, key);
        const int which = u.pn >> 3, head = u.pn & 7;
#pragma unroll
        for (int ai = 0; ai < NAI; ++ai)
#pragma unroll
            for (int m = 0; m < 4; ++m) {
                const int r = rowhalf + 64 * ai + 16 * m + fr; const bool smp = r >= MP;
                const int pos = smp ? PAST + ((r - MP) & 31) : (r & (SEQ - 1));
                f32x4 cs = {1.f, 1.f, 1.f, 1.f}, sn = {0.f, 0.f, 0.f, 0.f};
                if (which < 2 && wc == 0) { cs = *(const f32x4*)at32(rope, (unsigned)(pos * 32 + 4 * fq)); sn = *(const f32x4*)at32(rope, (unsigned)(pos * 32 + 16 + 4 * fq)); }
#pragma unroll
                for (int bj = 0; bj < 2; ++bj) {
                    f32x4 v0 = acc[ai][bj][m][0] * rs[ai][m], v1 = acc[ai][bj][m][1] * rs[ai][m];
                    if (which < 2 && wc == 0) { const f32x4 a = v0, b = v1; v0 = a * cs - b * sn; v1 = b * cs + a * sn; }
                    const int c = head * 256 + bj * 128 + wc * 32 + 4 * fq;
                    u32x2 w0, w1; w0.x = cvt_pk_bf16(v0[0], v0[1]); w0.y = cvt_pk_bf16(v0[2], v0[3]); w1.x = cvt_pk_bf16(v1[0], v1[1]); w1.y = cvt_pk_bf16(v1[2], v1[3]);
                    if (which == 0) {
                        *(u32x2*)at32(qb, (unsigned)(r * DM + c)) = w0; *(u32x2*)at32(qb, (unsigned)(r * DM + c + 16)) = w1;
                        if (smp) { *(f32x4*)at32(qs, (unsigned)((r - MP) * DM + c)) = v0; *(f32x4*)at32(qs, (unsigned)((r - MP) * DM + c + 16)) = v1; }
                    } else {
                        float* ob = out + (smp ? (which == 1 ? O_K_S : O_V_S) : (which == 1 ? O_K_P : O_V_P)); const unsigned oo = (unsigned)((smp ? r - MP : r) * DM + c);
                        *(f32x4*)at32(ob, oo) = v0; *(f32x4*)at32(ob, oo + 16u) = v1;
                        if (!smp) { bf16_t* bp = (which == 1 ? kb : vb); *(u32x2*)at32(bp, (unsigned)(r * DM + c)) = w0; *(u32x2*)at32(bp, (unsigned)(r * DM + c + 16)) = w1; }
                    }
                }
            }
    }
};

#define XB_TMO      128
#define XB_XCNT(j)  (256  + 64 * (j))
#define XB_XSUB(j)  (1280 + 64 * (j))
#define XB_XGEN(j)  (2304 + 64 * (j))
#define XB_TOP      3328
#define XB_TOPGEN   3392
#define XCD_BAR_WORDS 3456
#define XB_SPIN_CAP (1u << 22)

__device__ __forceinline__ unsigned xb_ld(unsigned* p)              { return __hip_atomic_load(p, __ATOMIC_RELAXED, __HIP_MEMORY_SCOPE_AGENT); }
__device__ __forceinline__ unsigned xb_add(unsigned* p, unsigned v) { return __hip_atomic_fetch_add(p, v, __ATOMIC_RELAXED, __HIP_MEMORY_SCOPE_AGENT); }
__device__ __forceinline__ unsigned xb_xcc_id() { return (unsigned)__builtin_amdgcn_s_getreg((3 << 11) | 20) & 0xFu; }
#define XB_SPIN(cond, bar) do { unsigned _sp = 0; while (cond) { __builtin_amdgcn_s_sleep(1); \
    if ((++_sp & 255u) == 0u) { if (xb_ld(&(bar)[XB_TMO])) break; if (_sp > XB_SPIN_CAP) { atomicAdd(&(bar)[XB_TMO], 1u); break; } } } } while (0)

struct XcdBarrier { unsigned* bar; unsigned x; volatile LAS unsigned* st; };

__device__ __forceinline__ XcdBarrier xcd_barrier_post(unsigned* bar, volatile LAS unsigned* st) {
    XcdBarrier b; b.bar = bar; b.x = xb_xcc_id(); b.st = st;
    if (threadIdx.x == 0) (void)xb_add(&bar[XB_XCNT(b.x)], 1u);
    return b;
}
__device__ __forceinline__ void xcd_barrier_complete(unsigned* bar, unsigned x, unsigned& nloc, unsigned& nx) {
    const unsigned G = gridDim.x * gridDim.y * gridDim.z;
    unsigned sum, cnt, mine, sp = 0u;
    for (;;) {
        sum = 0u; cnt = 0u; mine = 0u;
#pragma unroll
        for (unsigned j = 0; j < 16; ++j) { const unsigned c = xb_ld(&bar[XB_XCNT(j)]); sum += c; cnt += (c > 0u) ? 1u : 0u; mine = (j == x) ? c : mine; }
        if (sum == G) break;
        __builtin_amdgcn_s_sleep(1);
        if ((++sp & 255u) == 0u) { if (xb_ld(&bar[XB_TMO])) break; if (sp > XB_SPIN_CAP) { atomicAdd(&bar[XB_TMO], 1u); break; } }
    }
    nloc = mine > 0u ? mine : 1u; nx = cnt > 0u ? cnt : 1u;
}
__device__ __forceinline__ void xcd_barrier(const XcdBarrier& b) {
    asm volatile("s_waitcnt vmcnt(0)" ::: "memory");
    __syncthreads();
    if (threadIdx.x == 0) {
        unsigned* bar = b.bar;
        __builtin_amdgcn_s_waitcnt(0);
        unsigned nloc = b.st[0], nx = b.st[1];
        if (nloc == 0u) { xcd_barrier_complete(bar, b.x, nloc, nx); b.st[0] = nloc; b.st[1] = nx; }
        const unsigned old = xb_add(&bar[XB_XSUB(b.x)], 1u);
        const unsigned gen = old / nloc;
        if (old + 1u == (gen + 1u) * nloc) {
            __builtin_amdgcn_fence(__ATOMIC_RELEASE, "agent");
            asm volatile("s_waitcnt vmcnt(0)" ::: "memory");
            const unsigned og = xb_add(&bar[XB_TOP], 1u);
            const unsigned tg = og / nx;
            if (og + 1u == (tg + 1u) * nx) xb_add(&bar[XB_TOPGEN], 1u);
            else XB_SPIN(xb_ld(&bar[XB_TOPGEN]) == tg, bar);
            __builtin_amdgcn_fence(__ATOMIC_ACQUIRE, "agent");
            xb_add(&bar[XB_XGEN(b.x)], 1u);
            asm volatile("s_waitcnt vmcnt(0)" ::: "memory");
        } else {
            XB_SPIN(xb_ld(&bar[XB_XGEN(b.x)]) == gen, bar);
            __builtin_amdgcn_fence(__ATOMIC_ACQUIRE, "agent");
            asm volatile("s_waitcnt vmcnt(0)" ::: "memory");
        }
    }
    __syncthreads();
}

namespace att {
constexpr float SCALE = 0.08838834764831845f, THR = 8.f;
constexpr int NW = 8, QBLK = 32, KVBLK = 64, QB = NW * QBLK, D = 128;
constexpr int SHM_V = KVBLK * D * 2, SHM_K = KVBLK * D * 2;
constexpr int LDS_ATT = 2 * SHM_V + 2 * SHM_K + NW * 64 * 4;
constexpr int QS = DM, KS = DM, OS = 2 * DM;
template <class A, class Bt> struct same_t { static constexpr bool v = false; };
template <class A> struct same_t<A, A> { static constexpr bool v = true; };
#define KSWZ(row, colB) ((row) * 256 + ((colB) ^ (((row) & 7) << 4)))
#define SBAR() __builtin_amdgcn_sched_barrier(0)
__device__ __forceinline__ int v_st(int k, int c) { const int kk = (k & ~0xC) | ((k & 4) << 1) | ((k & 8) >> 1); return ((kk >> 3) * 4 + (c >> 5)) * 512 + ((kk & 7) * 32 + (c & 31)) * 2; }
__device__ __forceinline__ int v_rd_base(int lane) { return ((lane & 3) << 3) | (((lane >> 2) & 3) << 6) | (((lane >> 4) & 1) << 5) | (((lane >> 5) & 1) << 8); }
constexpr int v_rd_off(int d0, int ks, int half) { return d0 * 512 + ks * 4096 + half * 2048; }
__device__ __forceinline__ int crow(int r, int hi) { return (r & 3) + 8 * (r >> 2) + 4 * hi; }
__device__ __forceinline__ unsigned cvtpk(float lo, float hi) { unsigned r; asm volatile("v_cvt_pk_bf16_f32 %0, %1, %2" : "=v"(r) : "v"(lo), "v"(hi)); return r; }
__device__ __forceinline__ bf16x8 pack8(f32x4 a, f32x4 b) { u32x4 w = {cvtpk(a[0], a[1]), cvtpk(a[2], a[3]), cvtpk(b[0], b[1]), cvtpk(b[2], b[3])}; return *reinterpret_cast<bf16x8*>(&w); }
template <class T> __device__ __forceinline__ bf16x8 load8(const T* p) {
    if constexpr (same_t<T, float>::v) { return pack8(*(const f32x4*)p, *(const f32x4*)(p + 4)); }
    else { return *reinterpret_cast<const bf16x8*>(p); }
}
__device__ __forceinline__ void partialSM(f32x16& p0, f32x16& p1, float& m_reg, float& mn, float& alpha) {
    float pmax;
    asm("v_max3_f32 %0, %1, %2, %3" : "=v"(pmax) : "v"(p0[0]), "v"(p0[1]), "v"(p0[2]));
#pragma unroll
    for (int r = 3; r < 15; r += 2) asm("v_max3_f32 %0, %0, %1, %2" : "+v"(pmax) : "v"(p0[r]), "v"(p0[r + 1]));
    asm("v_max3_f32 %0, %0, %1, %2" : "+v"(pmax) : "v"(p0[15]), "v"(p1[0]));
#pragma unroll
    for (int r = 1; r < 15; r += 2) asm("v_max3_f32 %0, %0, %1, %2" : "+v"(pmax) : "v"(p1[r]), "v"(p1[r + 1]));
    asm("v_max_f32 %0, %0, %1" : "+v"(pmax) : "v"(p1[15]));
    { auto rr = __builtin_amdgcn_permlane32_swap(__float_as_uint(pmax), __float_as_uint(pmax), false, false);
      asm("v_max_f32 %0, %1, %2" : "=v"(pmax) : "v"(__uint_as_float(rr[0])), "v"(__uint_as_float(rr[1]))); }
    constexpr float C2 = 1.4426950408889634f * SCALE;
    if (__builtin_expect(__all((pmax - m_reg) * SCALE <= THR), 1)) { mn = m_reg; alpha = 1.f; }
    else { mn = fmaxf(m_reg, pmax); alpha = __builtin_amdgcn_exp2f((m_reg - mn) * C2); m_reg = mn; }
    const float mnL = -mn * C2;
    for (int r = 0; r < 16; ++r) p0[r] = fmaf(p0[r], C2, mnL); for (int r = 0; r < 16; ++r) p1[r] = fmaf(p1[r], C2, mnL);
    for (int r = 0; r < 16; ++r) p0[r] = __builtin_amdgcn_exp2f(p0[r]);
}
__device__ __forceinline__ void partialSM2(f32x16& p0, f32x16& p1, float& mnL, float& mthr, float& alpha) {
    float pmax;
    asm("v_max3_f32 %0, %1, %2, %3" : "=v"(pmax) : "v"(p0[0]), "v"(p0[1]), "v"(p0[2]));
#pragma unroll
    for (int r = 3; r < 15; r += 2) asm("v_max3_f32 %0, %0, %1, %2" : "+v"(pmax) : "v"(p0[r]), "v"(p0[r + 1]));
    asm("v_max3_f32 %0, %0, %1, %2" : "+v"(pmax) : "v"(p0[15]), "v"(p1[0]));
#pragma unroll
    for (int r = 1; r < 15; r += 2) asm("v_max3_f32 %0, %0, %1, %2" : "+v"(pmax) : "v"(p1[r]), "v"(p1[r + 1]));
    asm("v_max_f32 %0, %0, %1" : "+v"(pmax) : "v"(p1[15]));
    { auto rr = __builtin_amdgcn_permlane32_swap(__float_as_uint(pmax), __float_as_uint(pmax), false, false);
      asm("v_max_f32 %0, %1, %2" : "=v"(pmax) : "v"(__uint_as_float(rr[0])), "v"(__uint_as_float(rr[1]))); }
    constexpr float C2 = 1.4426950408889634f * SCALE;
    if (__builtin_expect(__all(pmax <= mthr), 1)) { alpha = 1.f; }
    else { const float m_old = mnL * (-1.f / C2), mn = fmaxf(m_old, pmax); alpha = __builtin_amdgcn_exp2f((m_old - mn) * C2); mnL = -mn * C2; mthr = mn + THR / SCALE; }
    for (int r = 0; r < 16; ++r) p0[r] = fmaf(p0[r], C2, mnL); for (int r = 0; r < 16; ++r) p1[r] = fmaf(p1[r], C2, mnL);
    for (int r = 0; r < 16; ++r) p0[r] = __builtin_amdgcn_exp2f(p0[r]);
}
__device__ __forceinline__ void finishSM(f32x16& p0, f32x16& p1, float alpha, float& l_reg, bf16x8& pa0, bf16x8& pa1, bf16x8& pa2, bf16x8& pa3) {
    for (int r = 0; r < 16; ++r) p1[r] = __builtin_amdgcn_exp2f(p1[r]);
    float ps = 0; for (int r = 0; r < 16; ++r) ps += p0[r]; for (int r = 0; r < 16; ++r) ps += p1[r];
    { auto rr = __builtin_amdgcn_permlane32_swap(__float_as_uint(ps), __float_as_uint(ps), false, false);
      ps = __uint_as_float(rr[0]) + __uint_as_float(rr[1]); }
    l_reg = l_reg * alpha + ps;
#define PK4(P, B_, OUT) do { unsigned a0 = cvtpk(P[B_+0], P[B_+1]), a1 = cvtpk(P[B_+2], P[B_+3]);                          \
        unsigned b0 = cvtpk(P[B_+4], P[B_+5]), b1 = cvtpk(P[B_+6], P[B_+7]);                                             \
        auto r0 = __builtin_amdgcn_permlane32_swap(a0, b0, false, false); auto r1 = __builtin_amdgcn_permlane32_swap(a1, b1, false, false); \
        u32x4 w = {r0[0], r1[0], r0[1], r1[1]}; OUT = *reinterpret_cast<bf16x8*>(&w); } while (0)
    PK4(p0, 0, pa0); PK4(p0, 8, pa1); PK4(p1, 0, pa2); PK4(p1, 8, pa3);
#undef PK4
}
template <int KB>
__device__ __forceinline__ void qkt(f32x16& p0, f32x16& p1, const char* K_lds, int r32, int hi, const bf16x8* qr) {
    p0 = f32x16{}; p1 = f32x16{};
    const char* kb[4];
#pragma unroll
    for (int dd = 0; dd < 4; ++dd) kb[dd] = K_lds + KB * SHM_K + KSWZ(r32, (dd * 16 + hi * 8) * 2);
#pragma unroll
    for (int d0 = 0; d0 < 8; ++d0) { const char* a = kb[d0 & 3] + (d0 >> 2) * 128;
        bf16x8 b0 = *reinterpret_cast<const bf16x8*>(a);
        bf16x8 b1 = *reinterpret_cast<const bf16x8*>(a + 32 * 256);
        p0 = __builtin_amdgcn_mfma_f32_32x32x16_bf16(b0, qr[d0], p0, 0, 0, 0);
        p1 = __builtin_amdgcn_mfma_f32_32x32x16_bf16(b1, qr[d0], p1, 0, 0, 0); }
}
template <int VB>
__device__ __forceinline__ void pv_tile(f32x16* o, int vb0, bf16x8 pa0, bf16x8 pa1, bf16x8 pa2, bf16x8 pa3) {
#define TRRD(dst, off) asm volatile("ds_read_b64_tr_b16 %0, %1 offset:%2" : "=&v"(dst) : "v"(vb0), "i"(off) : "memory")
#define PV_D0(d0) do { s16x4 l0, l1, l2, l3, h0, h1, h2, h3; constexpr int b_ = VB * SHM_V + v_rd_off(d0, 0, 0); \
        TRRD(l0, b_); TRRD(h0, b_ + 2048); TRRD(l1, b_ + 4096); TRRD(h1, b_ + 6144); TRRD(l2, b_ + 8192); TRRD(h2, b_ + 10240); TRRD(l3, b_ + 12288); TRRD(h3, b_ + 14336); \
        asm volatile("s_waitcnt lgkmcnt(0)" ::: "memory"); SBAR();   \
        o[d0] = __builtin_amdgcn_mfma_f32_32x32x16_bf16(pa0, (bf16x8){l0[0], l0[1], l0[2], l0[3], h0[0], h0[1], h0[2], h0[3]}, o[d0], 0, 0, 0);   \
        o[d0] = __builtin_amdgcn_mfma_f32_32x32x16_bf16(pa1, (bf16x8){l1[0], l1[1], l1[2], l1[3], h1[0], h1[1], h1[2], h1[3]}, o[d0], 0, 0, 0);   \
        o[d0] = __builtin_amdgcn_mfma_f32_32x32x16_bf16(pa2, (bf16x8){l2[0], l2[1], l2[2], l2[3], h2[0], h2[1], h2[2], h2[3]}, o[d0], 0, 0, 0);   \
        o[d0] = __builtin_amdgcn_mfma_f32_32x32x16_bf16(pa3, (bf16x8){l3[0], l3[1], l3[2], l3[3], h3[0], h3[1], h3[2], h3[3]}, o[d0], 0, 0, 0); } while (0)
    PV_D0(0); PV_D0(1); PV_D0(2); PV_D0(3);
#undef PV_D0
#undef TRRD
}

template <class TIn> struct BlockRef { const TIn* Q; const TIn* K; const TIn* V; const TIn* Kt; const TIn* Vt; bf16_t* O; int P0, nt, nrows, pad; };
template <class TIn> struct Seam {
    bf16x8 qr[8];
    bf16x8 st_v0, st_v1, st_k0, st_k1; f32x4 sf0, sf1, sf2, sf3;
    f32x4 tq[16];
};
template <bool SMP, class TIn> __device__ __forceinline__ const TIn* kvrow(const TIn* p, const TIn* pt, int k0, int rr, int sc) {
    if (SMP && k0 >= PAST) return pt + (unsigned)((rr < DSEQ ? rr : DSEQ - 1) * KS + sc);
    return p + (unsigned)((k0 + rr) * KS + sc);
}
#define VMW() asm volatile("s_waitcnt vmcnt(0)" ::: "memory")
#define VMWN(n) asm volatile("s_waitcnt vmcnt(%0)" :: "i"(n) : "memory")
#define SLOAD_H(R_, k0) do { S.st_v0 = load8<TIn>(kvrow<SMP, TIn>((R_).V, (R_).Vt, k0, sr, sc)); S.st_v1 = load8<TIn>(kvrow<SMP, TIn>((R_).V, (R_).Vt, k0, 32 + sr, sc));              \
                             S.st_k0 = load8<TIn>(kvrow<SMP, TIn>((R_).K, (R_).Kt, k0, sr, sc)); S.st_k1 = load8<TIn>(kvrow<SMP, TIn>((R_).K, (R_).Kt, k0, 32 + sr, sc)); } while (0)
#define SWRITE_HK(bf) do { *(bf16x8*)(K_lds + (bf) * SHM_K + kws) = S.st_k0; *(bf16x8*)(K_lds + (bf) * SHM_K + kws + 32 * 256) = S.st_k1; } while (0)
#define SWRITE_HV(bf) do { *(bf16x8*)(V_lds + (bf) * SHM_V + vst0) = S.st_v0; *(bf16x8*)(V_lds + (bf) * SHM_V + vst1) = S.st_v1; } while (0)
#define SWRITE_H(bf) do { SWRITE_HV(bf); SWRITE_HK(bf); } while (0)
#define SLOAD_F(p, pt, k0) do { const float* a_ = (const float*)kvrow<SMP, TIn>(p, pt, k0, sr, sc); const float* b_ = (const float*)kvrow<SMP, TIn>(p, pt, k0, 32 + sr, sc); \
                            S.sf0 = *(const f32x4*)a_; S.sf1 = *(const f32x4*)(a_ + 4); S.sf2 = *(const f32x4*)b_; S.sf3 = *(const f32x4*)(b_ + 4); } while (0)
#define SWRITE_KF(bf) do { *(bf16x8*)(K_lds + (bf) * SHM_K + kws) = pack8(S.sf0, S.sf1); *(bf16x8*)(K_lds + (bf) * SHM_K + kws + 32 * 256) = pack8(S.sf2, S.sf3); } while (0)
#define SWRITE_VF(bf) do { *(bf16x8*)(V_lds + (bf) * SHM_V + vst0) = pack8(S.sf0, S.sf1); *(bf16x8*)(V_lds + (bf) * SHM_V + vst1) = pack8(S.sf2, S.sf3); } while (0)
template <bool SMP, class TIn>
__device__ __forceinline__ void attn_prime(const BlockRef<TIn>& cur, char* lds, Seam<TIn>& S) {
    constexpr bool F32 = same_t<TIn, float>::v;
    const int tid = threadIdx.x, wid = __builtin_amdgcn_readfirstlane(tid >> 6), lane = tid & 63, r32 = lane & 31, hi = lane >> 5;
    const int sr = tid >> 4, sc = (tid & 15) * 8, kws = KSWZ(sr, sc * 2); char* K_lds = lds + 2 * SHM_V;
    for (int d0 = 0; d0 < 8; ++d0) S.qr[d0] = load8<TIn>(cur.Q + (unsigned)((wid * QBLK + r32) * QS + d0 * 16 + hi * 8));
    if constexpr (F32) { SLOAD_F(cur.K, cur.Kt, 0); VMW(); SWRITE_KF(0); SBAR(); SLOAD_F(cur.V, cur.Vt, 0); }
    else { SLOAD_H(cur, 0); VMW(); SWRITE_HK(0); }
    __syncthreads();
}
template <bool SMP, class TIn>
__device__ __forceinline__ void attn_block(const BlockRef<TIn>& cur, const BlockRef<TIn>& nxt, char* lds, Seam<TIn>& S) {
    constexpr bool F32 = same_t<TIn, float>::v;
    const int tid = threadIdx.x, wid = __builtin_amdgcn_readfirstlane(tid >> 6), lane = tid & 63, r32 = lane & 31, hi = lane >> 5;
    const int NT = cur.nt;
    const int qlo = cur.P0 + wid * QBLK;
    char* V_lds = lds; char* K_lds = lds + 2 * SHM_V;
    float* ws = (float*)(lds + 2 * SHM_V + 2 * SHM_K) + wid * 64; float* li_l = ws, * al_l = ws + 32;
    float m_reg = -1e30f, l_reg = 0; f32x16 o[4] = {};
    const int sr = tid >> 4, sc = (tid & 15) * 8, vst0 = v_st(sr, sc), vst1 = v_st(32 + sr, sc), kws = KSWZ(sr, sc * 2);
    const int vb0 = (int)(uintptr_t)V_lds + v_rd_base(lane);
#define RESC(a) do { if (__any((a) < 1.f)) { if (hi == 0) al_l[r32] = (a); asm volatile("s_waitcnt lgkmcnt(0)" ::: "memory");              \
                     for (int d_ = 0; d_ < 4; ++d_) for (int r = 0; r < 16; ++r) o[d_][r] *= al_l[crow(r, hi)]; } } while (0)
#define KBASE(t) ((t) * KVBLK)
#define MASKT(P0_, P1_, t) do { const float NEG_ = -__builtin_inff(); \
        if constexpr (SMP) { if ((t) == NT - 1) { _Pragma("unroll") for (int r_ = 0; r_ < 16; ++r_) P1_[r_] = NEG_; } } \
        else { if (KBASE(t) > (qlo & ~63)) { _Pragma("unroll") for (int r_ = 0; r_ < 16; ++r_) { P0_[r_] = NEG_; P1_[r_] = NEG_; } } } } while (0)
    constexpr int NQL = F32 ? 16 : 8;
#define SEAM_K0() do { VMWN(NQL); if constexpr (F32) { SWRITE_KF(0); SBAR(); SLOAD_F(nxt.V, nxt.Vt, 0); } else { SWRITE_HK(0); } SBAR(); } while (0)
    f32x16 pA0, pA1, pB0, pB1; float mnA, mnB, alA, alB; bf16x8 pa0, pa1, pa2, pa3;
    if constexpr (F32) { VMW(); SWRITE_VF(0); SBAR(); } else { SWRITE_HV(0); SBAR(); }
    if (NT > 1) { if constexpr (F32) SLOAD_F(cur.K, cur.Kt, KBASE(1)); else SLOAD_H(cur, KBASE(1)); }
    SBAR(); qkt<0>(pA0, pA1, K_lds, r32, hi, S.qr);
    if constexpr (F32) { if (NT > 1) { VMW(); SWRITE_KF(1); SBAR(); SLOAD_F(cur.V, cur.Vt, KBASE(1)); } }
    MASKT(pA0, pA1, 0); partialSM(pA0, pA1, m_reg, mnA, alA);
    if (NT > 1) { VMW(); if constexpr (F32) { SWRITE_VF(1); SBAR(); if (NT > 2) SLOAD_F(cur.K, cur.Kt, KBASE(2)); } else SWRITE_H(1); }
    __syncthreads();
#define HALF_STEP(PX0, PX1, mnX, alX, PY0, PY1, alY, t, KB, VB, SB) do {                                                      \
        SBAR(); qkt<KB>(PX0, PX1, K_lds, r32, hi, S.qr);                                             \
        finishSM(PY0, PY1, alY, l_reg, pa0, pa1, pa2, pa3); SBAR();                                                           \
        if ((t) + 1 < NT) { if constexpr (F32) { VMW(); SWRITE_KF(SB); SBAR(); SLOAD_F(cur.V, cur.Vt, KBASE((t) + 1)); }  \
                            else { SLOAD_H(cur, KBASE((t) + 1)); } SBAR(); }                                               \
        pv_tile<VB>(o, vb0, pa0, pa1, pa2, pa3); MASKT(PX0, PX1, (t)); partialSM(PX0, PX1, m_reg, mnX, alX);                                        \
        __syncthreads();                                                                                                      \
        if ((t) + 1 < NT) { VMW(); if constexpr (F32) { SWRITE_VF(SB); SBAR(); if ((t) + 2 < NT) SLOAD_F(cur.K, cur.Kt, KBASE((t) + 2)); } \
                            else { SWRITE_H(SB); } }                                                                          \
        RESC(alX); __syncthreads(); } while (0)
    for (int t = 1; t + 1 < NT; t += 2) {
        HALF_STEP(pB0, pB1, mnB, alB, pA0, pA1, alA, t, 1, 0, 0);
        HALF_STEP(pA0, pA1, mnA, alA, pB0, pB1, alB, t + 1, 0, 1, 1);
    }
    const bool even = (NT & 1) == 0;
    if (even) { SBAR(); qkt<1>(pB0, pB1, K_lds, r32, hi, S.qr); SBAR(); }
#define QROW(e) (nxt.Q + (unsigned)((wid * QBLK + r32) * QS + ((e) >> 1) * 16 + hi * 8 + ((e) & 1) * 4))
    if constexpr (F32) { SLOAD_F(nxt.K, nxt.Kt, 0); SBAR();
#pragma unroll
        for (int e = 0; e < 8; ++e) S.tq[e] = *(const f32x4*)QROW(e); }
    else { SLOAD_H(nxt, 0); SBAR();
#pragma unroll
        for (int d0 = 0; d0 < 8; ++d0) S.qr[d0] = load8<TIn>(nxt.Q + (unsigned)((wid * QBLK + r32) * QS + d0 * 16 + hi * 8)); }
    SBAR();
    finishSM(pA0, pA1, alA, l_reg, pa0, pa1, pa2, pa3); SBAR();
    if constexpr (F32) {
#pragma unroll
        for (int e = 8; e < 16; ++e) S.tq[e] = *(const f32x4*)QROW(e); SBAR(); }
#undef QROW
    pv_tile<0>(o, vb0, pa0, pa1, pa2, pa3);
    if (even) { MASKT(pB0, pB1, NT - 1); partialSM(pB0, pB1, m_reg, mnB, alB); __syncthreads(); RESC(alB);
        finishSM(pB0, pB1, alB, l_reg, pa0, pa1, pa2, pa3); SBAR(); pv_tile<1>(o, vb0, pa0, pa1, pa2, pa3); }
    SBAR(); SEAM_K0();
    if (hi == 0) li_l[r32] = l_reg; asm volatile("s_waitcnt lgkmcnt(0)" ::: "memory");
    float rli[16];
#pragma unroll
    for (int r = 0; r < 16; ++r) rli[r] = __builtin_amdgcn_rcpf(li_l[crow(r, hi)]);
    bf16_t* Ow = cur.O;
    const bool st_ok = wid * QBLK < cur.nrows;
#pragma unroll
    for (int r = 0; r < 16; ++r) { const int orow = crow(r, hi);
#pragma unroll
        for (int d0 = 0; d0 < 4; ++d0) { const float v = o[d0][r] * rli[r];
            const float vn = __shfl_xor(v, 1);
            if (st_ok && (r32 & 1) == 0) *(unsigned*)(Ow + (unsigned)((wid * QBLK + orow) * OS + d0 * 32 + r32)) = cvtpk(v, vn); } }
    if constexpr (F32) {
#pragma unroll
        for (int d0 = 0; d0 < 8; ++d0) S.qr[d0] = pack8(S.tq[2 * d0], S.tq[2 * d0 + 1]); }
    __syncthreads();
#undef RESC
#undef KBASE
#undef MASKT
#undef SEAM_K0
#undef HALF_STEP
}
#undef VMW
#undef VMWN
#undef SLOAD_H
#undef SWRITE_HK
#undef SWRITE_HV
#undef SWRITE_H
#undef SLOAD_F
#undef SWRITE_KF
#undef SWRITE_VF
}

namespace datt {
using att::crow; using att::cvtpk; using att::partialSM; using att::finishSM;
constexpr int SHM_V = 64 * 256 * 2, SHM_K = 64 * 128 * 2, L_V = 0, L_K = 2 * SHM_V, L_WS = 2 * SHM_V + 2 * SHM_K;
constexpr int QS = DM, KS = DM, OS = 2 * DM;
__device__ __forceinline__ int v_st2(int k, int c) { const int kk = (k & ~0xC) | ((k & 4) << 1) | ((k & 8) >> 1); return ((kk >> 3) * 8 + (c >> 5)) * 512 + ((kk & 7) * 32 + (c & 31)) * 2; }
struct DRef { const bf16_t* Q; const bf16_t* K; const bf16_t* V; bf16_t* O; int P0, pad; };
struct DSeam { bf16x8 qr[8]; };
template <int KB>
__device__ __forceinline__ void qkt(f32x16& p0, f32x16& p1, const char* K_lds, int r32, int hi, const bf16x8* qr) {
    p0 = f32x16{}; p1 = f32x16{};
    const char* kb[4];
#pragma unroll
    for (int dd = 0; dd < 4; ++dd) kb[dd] = K_lds + KB * SHM_K + KSWZ(r32, (dd * 16 + hi * 8) * 2);
#define KRD(set, d0) do { const char* a_ = kb[(d0) & 3] + ((d0) >> 2) * 128; set[0] = *reinterpret_cast<const bf16x8*>(a_); set[1] = *reinterpret_cast<const bf16x8*>(a_ + 32 * 256); } while (0)
#define KMM(set, d0) do { p0 = __builtin_amdgcn_mfma_f32_32x32x16_bf16(set[0], qr[d0], p0, 0, 0, 0); p1 = __builtin_amdgcn_mfma_f32_32x32x16_bf16(set[1], qr[d0], p1, 0, 0, 0); } while (0)
    bf16x8 ka[2], kc[2];
    KRD(ka, 0); KRD(kc, 1); SBAR();
    KMM(ka, 0); SBAR(); KRD(ka, 2); SBAR();
    KMM(kc, 1); SBAR(); KRD(kc, 3); SBAR();
    KMM(ka, 2); SBAR(); KRD(ka, 4); SBAR();
    KMM(kc, 3); SBAR(); KRD(kc, 5); SBAR();
    KMM(ka, 4); SBAR(); KRD(ka, 6); SBAR();
    KMM(kc, 5); SBAR(); KRD(kc, 7); SBAR();
    KMM(ka, 6); SBAR();
    KMM(kc, 7); SBAR();
#undef KRD
#undef KMM
}
struct DmaSrc { const bf16_t* K; const bf16_t* V; int so; };
template <int KB, int NB>
__device__ __forceinline__ void qkt_dma(f32x16& p0, f32x16& p1, const char* K_lds, int r32, int hi, const bf16x8* qr, const DmaSrc d, LAS char* lds, int wid, unsigned offK, unsigned offV) {
    p0 = f32x16{}; p1 = f32x16{};
    const __amdgpu_buffer_rsrc_t rk_ = __builtin_amdgcn_make_buffer_rsrc((void*)d.K, 0, 0x7ffffff0, 0x00020000), rv_ = __builtin_amdgcn_make_buffer_rsrc((void*)d.V, 0, 0x7ffffff0, 0x00020000);
    const char* kb[4];
#pragma unroll
    for (int dd = 0; dd < 4; ++dd) kb[dd] = K_lds + KB * SHM_K + KSWZ(r32, (dd * 16 + hi * 8) * 2);
#define KRD(set, d0) do { const char* a_ = kb[(d0) & 3] + ((d0) >> 2) * 128; set[0] = *reinterpret_cast<const bf16x8*>(a_); set[1] = *reinterpret_cast<const bf16x8*>(a_ + 32 * 256); } while (0)
#define KMM(set, d0) do { p0 = __builtin_amdgcn_mfma_f32_32x32x16_bf16(set[0], qr[d0], p0, 0, 0, 0); p1 = __builtin_amdgcn_mfma_f32_32x32x16_bf16(set[1], qr[d0], p1, 0, 0, 0); } while (0)
#define DK(j_) __builtin_amdgcn_raw_ptr_buffer_load_lds(rk_, (LAS unsigned*)(lds + L_K + NB * SHM_K + (8 * (j_) + wid) * 1024), 16, (int)(offK * 2u), d.so + 32 * (j_) * KS * 2, 0, 0)
#define DV(j_) __builtin_amdgcn_raw_ptr_buffer_load_lds(rv_, (LAS unsigned*)(lds + L_V + NB * SHM_V + (8 * (j_) + wid) * 1024), 16, (int)(offV * 2u), d.so + 16 * (j_) * KS * 2, 0, 0)
    bf16x8 ka[2], kc[2];
    KRD(ka, 0); KRD(kc, 1); SBAR();
    KMM(ka, 0); DK(0); SBAR(); KRD(ka, 2); SBAR();
    KMM(kc, 1); DK(1); SBAR(); KRD(kc, 3); SBAR();
    KMM(ka, 2); DV(0); SBAR(); KRD(ka, 4); SBAR();
    KMM(kc, 3); DV(1); SBAR(); KRD(kc, 5); SBAR();
    KMM(ka, 4); DV(2); SBAR(); KRD(ka, 6); SBAR();
    KMM(kc, 5); DV(3); SBAR(); KRD(kc, 7); SBAR();
    KMM(ka, 6); SBAR();
    KMM(kc, 7); SBAR();
#undef KRD
#undef KMM
#undef DK
#undef DV
}
template <int B_> __device__ __forceinline__ bf16x8 pk4(const f32x16& P) {
    const unsigned a0 = cvtpk(P[B_ + 0], P[B_ + 1]), a1 = cvtpk(P[B_ + 2], P[B_ + 3]), b0 = cvtpk(P[B_ + 4], P[B_ + 5]), b1 = cvtpk(P[B_ + 6], P[B_ + 7]);
    auto r0 = __builtin_amdgcn_permlane32_swap(a0, b0, false, false); auto r1 = __builtin_amdgcn_permlane32_swap(a1, b1, false, false);
    u32x4 w = {r0[0], r1[0], r0[1], r1[1]}; return *reinterpret_cast<bf16x8*>(&w);
}
__device__ __forceinline__ void smA(const f32x16& p0, float& ps, bf16x8& pa0, bf16x8& pa1) {
    ps = 0.f;
#pragma unroll
    for (int r = 0; r < 16; ++r) ps += p0[r];
    pa0 = pk4<0>(p0); pa1 = pk4<8>(p0);
}
template <int VB>
__device__ __forceinline__ void pv_tile2(f32x16* o, int vb0, bf16x8 pa0, bf16x8 pa1, f32x16& p1, float& ps, float alpha, float& l_reg) {
#define TRRD(dst, off) asm volatile("ds_read_b64_tr_b16 %0, %1 offset:%2" : "=&v"(dst) : "v"(vb0), "i"(off) : "memory")
#define PV_RDA(S_, d0) do { constexpr int b_ = VB * SHM_V + (d0) * 512; TRRD(S_[0], b_); TRRD(S_[1], b_ + 4096); TRRD(S_[2], b_ + 8192); TRRD(S_[3], b_ + 12288); } while (0)
#define PV_RDB(S_, d0) do { constexpr int b_ = VB * SHM_V + (d0) * 512 + 16384; TRRD(S_[0], b_); TRRD(S_[1], b_ + 4096); TRRD(S_[2], b_ + 8192); TRRD(S_[3], b_ + 12288); } while (0)
#define PV_MM2(S_, d0, PA, PB) do { \
        o[d0] = __builtin_amdgcn_mfma_f32_32x32x16_bf16(PA, (bf16x8){S_[0][0], S_[0][1], S_[0][2], S_[0][3], S_[1][0], S_[1][1], S_[1][2], S_[1][3]}, o[d0], 0, 0, 0);   \
        o[d0] = __builtin_amdgcn_mfma_f32_32x32x16_bf16(PB, (bf16x8){S_[2][0], S_[2][1], S_[2][2], S_[2][3], S_[3][0], S_[3][1], S_[3][2], S_[3][3]}, o[d0], 0, 0, 0); } while (0)
#define PV_SL(i) do { p1[2 * (i)] = __builtin_amdgcn_exp2f(p1[2 * (i)]); p1[2 * (i) + 1] = __builtin_amdgcn_exp2f(p1[2 * (i) + 1]); ps += p1[2 * (i)] + p1[2 * (i) + 1]; } while (0)
#define PV_W4() do { asm volatile("s_waitcnt lgkmcnt(4)" ::: "memory"); SBAR(); } while (0)
#define PV_W0() do { asm volatile("s_waitcnt lgkmcnt(0)" ::: "memory"); SBAR(); } while (0)
    s16x4 sa[4], sb[4]; bf16x8 pa2, pa3;
    PV_RDA(sa, 0); PV_RDA(sb, 1); PV_W4(); PV_MM2(sa, 0, pa0, pa1); PV_SL(0); SBAR();
    PV_RDA(sa, 2); PV_W4(); PV_MM2(sb, 1, pa0, pa1); PV_SL(1); SBAR();
    PV_RDA(sb, 3); PV_W4(); PV_MM2(sa, 2, pa0, pa1); PV_SL(2); SBAR();
    PV_RDA(sa, 4); PV_W4(); PV_MM2(sb, 3, pa0, pa1); PV_SL(3); SBAR();
    PV_RDA(sb, 5); PV_W4(); PV_MM2(sa, 4, pa0, pa1); pa2 = pk4<0>(p1); PV_SL(4); SBAR();
    PV_RDA(sa, 6); PV_W4(); PV_MM2(sb, 5, pa0, pa1); PV_SL(5); SBAR();
    PV_RDA(sb, 7); PV_W4(); PV_MM2(sa, 6, pa0, pa1); PV_SL(6); SBAR();
    PV_RDB(sa, 0); PV_W4(); PV_MM2(sb, 7, pa0, pa1); PV_SL(7); SBAR();
    PV_RDB(sb, 1); PV_W4(); pa3 = pk4<8>(p1); PV_MM2(sa, 0, pa2, pa3);
    { auto rr = __builtin_amdgcn_permlane32_swap(__float_as_uint(ps), __float_as_uint(ps), false, false); ps = __uint_as_float(rr[0]) + __uint_as_float(rr[1]); l_reg = l_reg * alpha + ps; } SBAR();
    PV_RDB(sa, 2); PV_W4(); PV_MM2(sb, 1, pa2, pa3); SBAR();
    PV_RDB(sb, 3); PV_W4(); PV_MM2(sa, 2, pa2, pa3); SBAR();
    PV_RDB(sa, 4); PV_W4(); PV_MM2(sb, 3, pa2, pa3); SBAR();
    PV_RDB(sb, 5); PV_W4(); PV_MM2(sa, 4, pa2, pa3); SBAR();
    PV_RDB(sa, 6); PV_W4(); PV_MM2(sb, 5, pa2, pa3); SBAR();
    PV_RDB(sb, 7); PV_W4(); PV_MM2(sa, 6, pa2, pa3); SBAR();
    PV_W0(); PV_MM2(sb, 7, pa2, pa3); SBAR();
#undef TRRD
#undef PV_RDA
#undef PV_RDB
#undef PV_MM2
#undef PV_SL
#undef PV_W4
#undef PV_W0
}
template <int VB>
__device__ __forceinline__ void pv_tile(f32x16* o, int vb0, bf16x8 pa0, bf16x8 pa1, bf16x8 pa2, bf16x8 pa3) {
#define TRRD(dst, off) asm volatile("ds_read_b64_tr_b16 %0, %1 offset:%2" : "=&v"(dst) : "v"(vb0), "i"(off) : "memory")
#define PV_RD(S_, d0) do { constexpr int b_ = VB * SHM_V + (d0) * 512; \
        TRRD(S_[0], b_); TRRD(S_[1], b_ + 4096); TRRD(S_[2], b_ + 8192); TRRD(S_[3], b_ + 12288); TRRD(S_[4], b_ + 16384); TRRD(S_[5], b_ + 20480); TRRD(S_[6], b_ + 24576); TRRD(S_[7], b_ + 28672); } while (0)
#define PV_MM(S_, d0) do { \
        o[d0] = __builtin_amdgcn_mfma_f32_32x32x16_bf16(pa0, (bf16x8){S_[0][0], S_[0][1], S_[0][2], S_[0][3], S_[1][0], S_[1][1], S_[1][2], S_[1][3]}, o[d0], 0, 0, 0);   \
        o[d0] = __builtin_amdgcn_mfma_f32_32x32x16_bf16(pa1, (bf16x8){S_[2][0], S_[2][1], S_[2][2], S_[2][3], S_[3][0], S_[3][1], S_[3][2], S_[3][3]}, o[d0], 0, 0, 0);   \
        o[d0] = __builtin_amdgcn_mfma_f32_32x32x16_bf16(pa2, (bf16x8){S_[4][0], S_[4][1], S_[4][2], S_[4][3], S_[5][0], S_[5][1], S_[5][2], S_[5][3]}, o[d0], 0, 0, 0);   \
        o[d0] = __builtin_amdgcn_mfma_f32_32x32x16_bf16(pa3, (bf16x8){S_[6][0], S_[6][1], S_[6][2], S_[6][3], S_[7][0], S_[7][1], S_[7][2], S_[7][3]}, o[d0], 0, 0, 0); } while (0)
#define PV_W8() do { asm volatile("s_waitcnt lgkmcnt(8)" ::: "memory"); SBAR(); } while (0)
#define PV_W0() do { asm volatile("s_waitcnt lgkmcnt(0)" ::: "memory"); SBAR(); } while (0)
    s16x4 sa[8], sb[8];
    PV_RD(sa, 0); PV_RD(sb, 1); PV_W8(); PV_MM(sa, 0); SBAR();
    PV_RD(sa, 2); PV_W8(); PV_MM(sb, 1); SBAR();
    PV_RD(sb, 3); PV_W8(); PV_MM(sa, 2); SBAR();
    PV_RD(sa, 4); PV_W8(); PV_MM(sb, 3); SBAR();
    PV_RD(sb, 5); PV_W8(); PV_MM(sa, 4); SBAR();
    PV_RD(sa, 6); PV_W8(); PV_MM(sb, 5); SBAR();
    PV_RD(sb, 7); PV_W8(); PV_MM(sa, 6); SBAR();
    PV_W0(); PV_MM(sb, 7); SBAR();
#undef PV_RD
#undef PV_MM
#undef PV_W8
#undef PV_W0
#undef TRRD
}
#define DVMW() asm volatile("s_waitcnt vmcnt(0)" ::: "memory")
#define DLOADQ(R_) do { _Pragma("unroll") for (int d0_ = 0; d0_ < 8; ++d0_) S.qr[d0_] = *(const bf16x8*)((R_).Q + (unsigned)((wid * 32 + r32) * QS + d0_ * 16 + hi * 8)); } while (0)
#define DDMA(R_, k0, bf) do { \
        const __amdgpu_buffer_rsrc_t rk_ = __builtin_amdgcn_make_buffer_rsrc((void*)(R_).K, 0, 0x7ffffff0, 0x00020000), rv_ = __builtin_amdgcn_make_buffer_rsrc((void*)(R_).V, 0, 0x7ffffff0, 0x00020000); \
        _Pragma("unroll") for (int j_ = 0; j_ < 2; ++j_) __builtin_amdgcn_raw_ptr_buffer_load_lds(rk_, (LAS unsigned*)(lds + L_K + (bf) * SHM_K + (8 * j_ + wid) * 1024), 16, (int)(offK * 2u), (int)(((k0) + 32 * j_) * KS * 2), 0, 0); \
        _Pragma("unroll") for (int j_ = 0; j_ < 4; ++j_) __builtin_amdgcn_raw_ptr_buffer_load_lds(rv_, (LAS unsigned*)(lds + L_V + (bf) * SHM_V + (8 * j_ + wid) * 1024), 16, (int)(offV * 2u), (int)(((k0) + 16 * j_) * KS * 2), 0, 0); } while (0)
__device__ __forceinline__ void dattn_prime(const DRef& cur, LAS char* lds, DSeam& S) {
    const int tid = threadIdx.x, wid = __builtin_amdgcn_readfirstlane(tid >> 6), lane = tid & 63, r32 = lane & 31, hi = lane >> 5;
    const int rowK = 4 * wid + (lane >> 4); const unsigned offK = (unsigned)(rowK * KS + (((lane & 15) ^ (rowK & 7)) * 8));
    const int sub = 2 * wid + (lane >> 5), kk = (sub >> 3) * 8 + ((lane & 31) >> 2), kv = (kk & ~0xC) | ((kk & 4) << 1) | ((kk & 8) >> 1); const unsigned offV = (unsigned)(kv * KS + (sub & 7) * 32 + (lane & 3) * 8);
    DLOADQ(cur); DDMA(cur, 0, 0); DVMW();
    __syncthreads();
}
__device__ __forceinline__ void dattn_block(const DRef& cur, const DRef& nxt, LAS char* lds, DSeam& S) {
    const int tid = threadIdx.x, wid = __builtin_amdgcn_readfirstlane(tid >> 6), lane = tid & 63, r32 = lane & 31, hi = lane >> 5;
    const int NT = (cur.P0 + 255) / 64 + 1;
    const int qlo = cur.P0 + wid * 32;
    const char* K_lds = (const char*)(lds + L_K);
    float* ws = (float*)(lds + L_WS) + wid * 64; float* li_l = ws, * al_l = ws + 32;
    float mnL_reg = 1e30f * (1.4426950408889634f * att::SCALE), mthr_reg = -1e30f, l_reg = 0; f32x16 o[8] = {};
    const int rowK = 4 * wid + (lane >> 4); const unsigned offK = (unsigned)(rowK * KS + (((lane & 15) ^ (rowK & 7)) * 8));
    const int sub = 2 * wid + (lane >> 5), kk = (sub >> 3) * 8 + ((lane & 31) >> 2), kv = (kk & ~0xC) | ((kk & 4) << 1) | ((kk & 8) >> 1); const unsigned offV = (unsigned)(kv * KS + (sub & 7) * 32 + (lane & 3) * 8);
    const int vb0 = (int)(uintptr_t)(lds + L_V) + att::v_rd_base(lane);
    f32x16 p0, p1; float al, psum; bf16x8 pa0, pa1;
    if (wid >= 4) __builtin_amdgcn_s_setprio(1);
#define DSTEP(t, B, NB) do { \
        { const bool more_ = (t) + 1 < NT; const DmaSrc ds_ = {more_ ? cur.K : nxt.K, more_ ? cur.V : nxt.V, more_ ? ((t) + 1) * 64 * KS * 2 : 0}; \
          SBAR(); qkt_dma<B, NB>(p0, p1, K_lds, r32, hi, S.qr, ds_, lds, wid, offK, offV); SBAR(); } \
        if ((t) + 1 == NT) DLOADQ(nxt); \
        if (__builtin_expect((t) * 64 > (qlo & ~63), 0)) { asm volatile("" ::: "memory"); const float NEG_ = -__builtin_inff(); _Pragma("unroll") for (int r_ = 0; r_ < 16; ++r_) { p0[r_] = NEG_; p1[r_] = NEG_; } asm volatile("" : "+v"(p0), "+v"(p1)); } \
        att::partialSM2(p0, p1, mnL_reg, mthr_reg, al); smA(p0, psum, pa0, pa1); SBAR(); \
        if (__any(al < 1.f)) { if (hi == 0) al_l[r32] = al; asm volatile("s_waitcnt lgkmcnt(0)" ::: "memory"); \
            _Pragma("unroll") for (int d_ = 0; d_ < 8; ++d_) _Pragma("unroll") for (int r = 0; r < 16; ++r) o[d_][r] *= al_l[crow(r, hi)]; } \
        pv_tile2<B>(o, vb0, pa0, pa1, p1, psum, al, l_reg); SBAR(); \
        DVMW(); __syncthreads(); } while (0)
    for (int t = 0; t < NT; t += 2) { DSTEP(t, 0, 1); DSTEP(t + 1, 1, 0); }
#undef DSTEP
    __builtin_amdgcn_s_setprio(0);
    if (hi == 0) li_l[r32] = l_reg; asm volatile("s_waitcnt lgkmcnt(0)" ::: "memory");
    float rli[16];
#pragma unroll
    for (int r = 0; r < 16; ++r) rli[r] = __builtin_amdgcn_rcpf(li_l[crow(r, hi)]);
#pragma unroll
    for (int r = 0; r < 16; ++r) { const int orow = crow(r, hi);
#pragma unroll
        for (int d0 = 0; d0 < 8; ++d0) { const float v = o[d0][r] * rli[r];
            const float vn = __shfl_xor(v, 1);
            if ((r32 & 1) == 0) *(unsigned*)(cur.O + (unsigned)((wid * 32 + orow) * OS + d0 * 32 + r32)) = cvtpk(v, vn); } }
}
#undef DVMW
#undef DLOADQ
#undef DDMA
}

struct Args { const float* in[38]; float* out; unsigned char* ws; int ph_lo, ph_hi; };
typedef const float* cfp_t;
typedef const __attribute__((address_space(4))) unsigned char* KP;
__device__ __forceinline__ KP kargs() { KP p = (KP)__builtin_amdgcn_kernarg_segment_ptr(); asm volatile("" : "+s"(p)); return p; }
struct Frame {
    LAS unsigned char* lds; KP kp;
    int tid, lane, wave, G, bid;
    __device__ __forceinline__ const float* in(int i) const { return *(const __attribute__((address_space(4))) cfp_t*)(kp + 8 * i); }
    __device__ __forceinline__ float* out() const { return *(float* const __attribute__((address_space(4)))*)(kp + 304); }
    __device__ __forceinline__ unsigned char* ws() const { return *(unsigned char* const __attribute__((address_space(4)))*)(kp + 312); }
};
static_assert(sizeof(Args) == 328, "Args layout");
enum { I_XP = 0, I_XS, I_SRE, I_SIM, I_SCONV, I_CK, I_CV, I_PP, I_PS, I_NMIX, I_ARE, I_AIM, I_LDT, I_BRE, I_BIM, I_CRE, I_CIM, I_SSMD, I_WGLU, I_NKV, I_WK, I_WV, I_WQ,
       I_LQ1, I_LK1, I_LQ2, I_LK2, I_NSUB, I_WO, I_NFFN, I_WUP, I_CONVW, I_CONVB, I_WDOWN, I_NPLE, I_WGATE, I_WPROJ, I_NFIN };

__device__ __forceinline__ void transpose_item(const float* W, int K, int N, bf16_t* WT, int row_off, const float* gain, int pairhalf, LAS float* scr, int item, int lane) {
    const int nblk = N / 32, kb = item / nblk, nb = item % nblk, k0 = 64 * kb, n0 = 32 * nb;
    int c0 = n0; if (pairhalf) c0 = ((n0 >> 7) & 1) * pairhalf + (n0 >> 8) * 128 + (n0 & 127);
#pragma unroll 8
    for (int i = 0; i < 32; ++i) { const int kk = 2 * i + (lane >> 5); float v = W[(size_t)(k0 + kk) * N + c0 + (lane & 31)]; if (gain) v *= gain[k0 + kk]; scr[kk * 33 + (lane & 31)] = v; }
    asm volatile("s_waitcnt lgkmcnt(0)" ::: "memory");
    const int c = lane & 7;
#pragma unroll
    for (int j = 0; j < 4; ++j) { const int n = (lane >> 3) + 8 * j; const LAS float* s = scr + (8 * c) * 33 + n;
        u32x4 o; o.x = cvt_pk_bf16(s[0 * 33], s[1 * 33]); o.y = cvt_pk_bf16(s[2 * 33], s[3 * 33]); o.z = cvt_pk_bf16(s[4 * 33], s[5 * 33]); o.w = cvt_pk_bf16(s[6 * 33], s[7 * 33]);
        *(u32x4*)(WT + (size_t)(row_off + n0 + n) * K + k0 + 8 * c) = o; }
    asm volatile("s_waitcnt lgkmcnt(0)" ::: "memory");
}

__device__ __forceinline__ void ssm_build_group(Frame& F, int g) {
    LAS f32x2* lbp = (LAS f32x2*)F.lds;
    LAS f32x2* Bb = lbp + 17 * 64;
    LAS f32x2* Cc = Bb + 64 * 16;
    LAS float* Kd = (LAS float*)(Cc + 16 * 64);
    LAS float* Dd = Kd + 4096;
    LAS f32x2* kt = (LAS f32x2*)(Dd + 16);
    const float* are = F.in(I_ARE) + g * 64; const float* aim = F.in(I_AIM) + g * 64;
    const int tid = F.tid;
    for (int i = tid; i < 17 * 64; i += NTHR) { const int d = i >> 6, p = i & 63; const double dt = exp((double)F.in(I_LDT)[g]); const double ar = are[p], ai = aim[p];
        const double mag = exp(ar * dt * d); double sn, cs; sincos(ai * dt * d, &sn, &cs); lbp[d * 64 + p] = (f32x2){(float)(mag * cs), (float)(mag * sn)}; }
    if (tid < 64) {
        const int p = tid; const double dt = exp((double)F.in(I_LDT)[g]); const double ar = are[p], ai = aim[p];
        const double mag = exp(ar * dt); double sn, cs; sincos(ai * dt, &sn, &cs); const double lr = mag * cs, li = mag * sn, den = ar * ar + ai * ai, nr = lr - 1.0;
        kt[p] = (f32x2){(float)((nr * ar + li * ai) / den), (float)((li * ar - nr * ai) / den)};
    }
    if (tid < 16) Dd[tid] = F.in(I_SSMD)[g * 16 + tid];
    __syncthreads();
    for (int i = tid; i < 1024; i += NTHR) { const int p = i >> 4, ch = i & 15; const float br = F.in(I_BRE)[((size_t)g * 64 + p) * 16 + ch], bi = F.in(I_BIM)[((size_t)g * 64 + p) * 16 + ch]; const f32x2 k = kt[p];
        Bb[i] = (f32x2){k.x * br - k.y * bi, k.x * bi + k.y * br};
        const int co = i >> 6, pp = i & 63; Cc[i] = (f32x2){F.in(I_CRE)[((size_t)g * 16 + co) * 64 + pp], F.in(I_CIM)[((size_t)g * 16 + co) * 64 + pp]}; }
    __syncthreads();
    for (int i = tid; i < 4096; i += NTHR) { const int d = i >> 8, co = (i >> 4) & 15, ch = i & 15; float s = 0.f;
        for (int p = 0; p < 64; ++p) { const f32x2 c = Cc[co * 64 + p], l = lbp[d * 64 + p], b = Bb[p * 16 + ch];
            const float wr = c.x * l.x - c.y * l.y, wi = c.x * l.y + c.y * l.x; s += wr * b.x - wi * b.y; }
        if (d == 0 && co == ch) s += Dd[co];
        Kd[i] = s; }
    __syncthreads();
    unsigned char* base = F.ws() + WS_SSM + (size_t)g * SSM_G_BYTES;
    for (int e = tid; e < 8 * 16 * 64; e += NTHR) { const int ln = e & 63, ks = (e >> 6) & 15, Mb = e >> 10; const int row = 32 * Mb + (ln & 31), t = row >> 4, co = row & 15, s = ks; float v[8];
#pragma unroll
        for (int j = 0; j < 8; ++j) { const int ch = 8 * (ln >> 5) + j; v[j] = (t >= s) ? Kd[((t - s) * 16 + co) * 16 + ch] : 0.f; }
        u32x4 o = {cvt_pk_bf16(v[0], v[1]), cvt_pk_bf16(v[2], v[3]), cvt_pk_bf16(v[4], v[5]), cvt_pk_bf16(v[6], v[7])}; *(u32x4*)(base + (size_t)e * 16) = o; }
    for (int e = tid; e < 4 * 16 * 64; e += NTHR) { const int ln = e & 63, ks = (e >> 6) & 15, Mb = e >> 10; const int hr = 32 * Mb + (ln & 31), c = hr >> 6, p = hr & 63, s = ks; float v[8]; const f32x2 l = lbp[(15 - s) * 64 + p];
#pragma unroll
        for (int j = 0; j < 8; ++j) { const f32x2 b = Bb[p * 16 + 8 * (ln >> 5) + j]; v[j] = c == 0 ? (l.x * b.x - l.y * b.y) : (l.x * b.y + l.y * b.x); }
        u32x4 o = {cvt_pk_bf16(v[0], v[1]), cvt_pk_bf16(v[2], v[3]), cvt_pk_bf16(v[4], v[5]), cvt_pk_bf16(v[6], v[7])}; *(u32x4*)(base + 131072 + (size_t)e * 16) = o; }
    for (int e = tid; e < 8 * 8 * 64; e += NTHR) { const int ln = e & 63, ks = (e >> 6) & 7, Mb = e >> 9; const int row = 32 * Mb + (ln & 31), t = row >> 4, co = row & 15; float v[8];
#pragma unroll
        for (int j = 0; j < 8; ++j) { const int hr = 16 * ks + 8 * (ln >> 5) + j, c = hr >> 6, p = hr & 63; const f32x2 cc = Cc[co * 64 + p], l = lbp[(t + 1) * 64 + p];
            v[j] = c == 0 ? (cc.x * l.x - cc.y * l.y) : -(cc.x * l.y + cc.y * l.x); }
        u32x4 o = {cvt_pk_bf16(v[0], v[1]), cvt_pk_bf16(v[2], v[3]), cvt_pk_bf16(v[4], v[5]), cvt_pk_bf16(v[6], v[7])}; *(u32x4*)(base + 196608 + (size_t)e * 16) = o; }
    if (tid < 64) ((f32x2*)(F.ws() + WS_L16))[g * 64 + tid] = lbp[16 * 64 + tid];
    __syncthreads();
}

__device__ __forceinline__ void rms_row_to_bf16(const float* xrow, const float* g, bf16_t* orow, int lane) {
    const f32x4* xr = (const f32x4*)xrow + lane; f32x4 v[8]; float s = 0.f;
#pragma unroll
    for (int j = 0; j < 8; ++j) { v[j] = xr[64 * j]; s += (v[j][0] * v[j][0] + v[j][1] * v[j][1]) + (v[j][2] * v[j][2] + v[j][3] * v[j][3]); }
    const float rstd = rsqrtf(wave_sum(s) * (1.f / DM) + EPS);
    u32x2* o8 = (u32x2*)orow + lane;
#pragma unroll
    for (int j = 0; j < 8; ++j) { const f32x4 gg = ((const f32x4*)g)[lane + 64 * j]; const f32x4 y = v[j] * rstd * gg; u32x2 w; w.x = cvt_pk_bf16(y[0], y[1]); w.y = cvt_pk_bf16(y[2], y[3]); o8[64 * j] = w; }
}
__device__ __forceinline__ void convert_p(Frame& F, int layer) {
    const float* pp = F.in(I_PP) + (size_t)layer * MP * PLE; const float* ps = F.in(I_PS) + (size_t)layer * MS * PLE; bf16_t* pb = (bf16_t*)(F.ws() + WS_PB);
    const size_t n8 = (size_t)MT * PLE / 8;
    for (size_t i = (size_t)F.bid * NTHR + F.tid; i < n8; i += (size_t)F.G * NTHR) { const size_t e = i * 8; const float* src = e < (size_t)MP * PLE ? pp + e : ps + (e - (size_t)MP * PLE);
        const f32x4 a = *(const f32x4*)src, b = *(const f32x4*)(src + 4); u32x4 w = {cvt_pk_bf16(a[0], a[1]), cvt_pk_bf16(a[2], a[3]), cvt_pk_bf16(b[0], b[1]), cvt_pk_bf16(b[2], b[3])}; *(u32x4*)(pb + e) = w; }
}
__device__ __forceinline__ int bg_slot(Frame& F, int word) {
    const int lane = __builtin_amdgcn_mbcnt_hi(~0u, __builtin_amdgcn_mbcnt_lo(~0u, 0u));
    unsigned tk = 0u; if (lane == 0) tk = __hip_atomic_fetch_add((LAS unsigned*)(F.lds + LDS_BYTES - 256) + 16 + word, 1u, __ATOMIC_RELAXED, __HIP_MEMORY_SCOPE_WORKGROUP);
    return __builtin_amdgcn_readfirstlane((int)tk) & 7;
}
template <int LIST> __device__ __forceinline__ void bg_work(Frame& F, int busy, int slot) {
    const int rem = busy < F.G ? busy : 0; int nb = F.G, bi = F.bid;
    if (rem != 0) { if (F.bid < rem) return; nb = F.G - rem; bi = F.bid - rem; }
    const int lane = __builtin_amdgcn_mbcnt_hi(~0u, __builtin_amdgcn_mbcnt_lo(~0u, 0u));
    LAS float* scr = (LAS float*)(F.lds + slot * 16384);
    const int gw = bi * NWAVES + slot, NGW = nb * NWAVES;
    constexpr int I_UP = 32 * 352, I_DN = 88 * 64, I_GT = 32 * 64, I_PJ = 4 * 64, I_SQ = 32 * 64;
    if constexpr (LIST == 0 || LIST == 3) { constexpr int l = LIST == 0 ? 0 : 1;
        for (int it = gw; it < I_UP; it += NGW) transpose_item(F.in(I_WUP) + (size_t)l * DM * DFF2, DM, DFF2, (bf16_t*)(F.ws() + WS_WUP) + (size_t)l * DFF2 * DM, 0, F.in(I_NFFN) + l * DM, DFF, scr, it, lane);
    } else if constexpr (LIST == 1 || LIST == 4) { constexpr int l = LIST == 1 ? 0 : 1;
        for (int it = gw; it < I_DN + I_GT + I_PJ; it += NGW) { int r = it;
            if (r < I_DN) { transpose_item(F.in(I_WDOWN) + (size_t)l * DFF * DM, DFF, DM, (bf16_t*)(F.ws() + WS_WDOWN) + (size_t)l * DM * DFF, 0, nullptr, 0, scr, r, lane); continue; } r -= I_DN;
            if (r < I_GT) { transpose_item(F.in(I_WGATE) + (size_t)l * DM * DM, DM, DM, (bf16_t*)(F.ws() + WS_WGATE) + (size_t)l * DM * DM, 0, F.in(I_NPLE) + l * DM, 0, scr, r, lane); continue; } r -= I_GT;
            transpose_item(F.in(I_WPROJ) + (size_t)l * PLE * DM, PLE, DM, (bf16_t*)(F.ws() + WS_WPROJ) + (size_t)l * DM * PLE, 0, nullptr, 0, scr, r, lane); }
    } else {
        for (int it = gw; it < 4 * I_SQ; it += NGW) { int r = it;
            if (r < I_SQ) { transpose_item(F.in(I_WQ), DM, DM, (bf16_t*)(F.ws() + WS_WQKV), 0, F.in(I_NMIX) + DM, 0, scr, r, lane); continue; } r -= I_SQ;
            if (r < I_SQ) { transpose_item(F.in(I_WK), DM, DM, (bf16_t*)(F.ws() + WS_WQKV), DM, F.in(I_NKV), 0, scr, r, lane); continue; } r -= I_SQ;
            if (r < I_SQ) { transpose_item(F.in(I_WV), DM, DM, (bf16_t*)(F.ws() + WS_WQKV), 2 * DM, F.in(I_NKV), 0, scr, r, lane); continue; } r -= I_SQ;
            transpose_item(F.in(I_WO), DM, DM, (bf16_t*)(F.ws() + WS_WO), 0, nullptr, 0, scr, r, lane); }
    }
}
__device__ __forceinline__ void p0_prologue(Frame& F) {
    for (int g = F.bid; g < NG; g += F.G) ssm_build_group(F, g);
    __syncthreads();
    LAS float* scr = (LAS float*)(F.lds + F.wave * 16384);
    const int gw = F.bid * NWAVES + F.wave, NGW = F.G * NWAVES;
    for (int it = gw; it < 32 * 128; it += NGW) transpose_item(F.in(I_WGLU), DM, 2 * DM, (bf16_t*)(F.ws() + WS_WGLU), 0, nullptr, DM, scr, it, F.lane);
    { float* rope = (float*)(F.ws() + WS_ROPE);
      for (int i = F.bid * NTHR + F.tid; i < SEQ * 16; i += F.G * NTHR) { const int pos = i >> 4, k = i & 15; const double inv = exp(-(double)k * (13.122363377404328 / 16.0)); double sn, cs; sincos((double)pos * inv, &sn, &cs);
          rope[(size_t)pos * 32 + k] = (float)cs; rope[(size_t)pos * 32 + 16 + k] = (float)sn; } }
    { float* cp_ = (float*)(F.ws() + WS_CONVP);
      for (int i = F.bid * NTHR + F.tid; i < 2 * DFF; i += F.G * NTHR) { const int l = i / DFF, c = i % DFF; const float* cw = F.in(I_CONVW) + (size_t)l * 3 * DFF2; const float* cb = F.in(I_CONVB) + (size_t)l * DFF2;
          float* r = cp_ + (size_t)(i & ~1) * 8 + (c & 1);
          r[0] = cw[c]; r[2] = cw[DFF2 + c]; r[4] = cw[2 * DFF2 + c]; r[6] = cb[c]; r[8] = cw[DFF + c]; r[10] = cw[DFF2 + DFF + c]; r[12] = cw[2 * DFF2 + DFF + c]; r[14] = cb[DFF + c]; } }
    convert_p(F, 0);
    bf16_t* ub = (bf16_t*)(F.ws() + WS_UB);
    for (int m = gw; m < MT; m += NGW) rms_row_to_bf16(m < MP ? F.in(I_XP) + (size_t)m * DM : F.in(I_XS) + (size_t)(m - MP) * DM, F.in(I_NMIX), ub + (size_t)m * DM, F.lane);
}

__device__ __forceinline__ void ssm_phase(Frame& F, bf16_t* dstb) {
    constexpr int L_G = 0, L_U = 65536, L_S0 = 98304, L_S1 = 116736, L_XB = 135168;
    const int tid = F.tid, wave = F.wave, lane = F.lane, n = lane & 31, hi = lane >> 5;
    bf16_t* ub = (bf16_t*)(F.ws() + WS_UB);
    const int sn_ = tid & 31, ss_ = tid >> 5;
    for (int item = F.bid; item < NBAT * NG + NG; item += F.G) {
        const bool smp = item >= NBAT * NG;
        const int g = smp ? item - NBAT * NG : item % NG, b = smp ? 0 : item / NG;
        const int nsteps = smp ? 1 : SEQ / 512; const int row0 = smp ? MP : b * SEQ;
        const unsigned char* mats = F.ws() + WS_SSM + (size_t)g * SSM_G_BYTES;
        __syncthreads();
        for (int i = tid; i < 4096; i += NTHR) *(LAS u32x4*)(F.lds + L_G + i * 16) = *(const u32x4*)(mats + 196608 + (size_t)i * 16);
        bf16x8 Kf[16], Hf[8];
#pragma unroll
        for (int ks = 0; ks < 16; ++ks) Kf[ks] = *(const bf16x8*)(mats + ((size_t)(wave * 16 + ks) * 64 + lane) * 16);
#pragma unroll
        for (int i = 0; i < 8; ++i) Hf[i] = *(const bf16x8*)(mats + 131072 + ((size_t)((wave & 3) * 16 + (wave >> 2) * 8 + i) * 64 + lane) * 16);
        f32x2 lam = {0.f, 0.f}, X = {0.f, 0.f};
        if (wave == 0) lam = ((const f32x2*)(F.ws() + WS_L16))[g * 64 + lane];
        { const bf16_t* src = ub + (size_t)(row0 + 16 * sn_ + ss_) * DM + 16 * g; const u32x4 a = *(const u32x4*)src, c = *(const u32x4*)(src + 8);
          LAS unsigned char* d = F.lds + L_U + ss_ * 1024 + sn_ * 32; *(LAS u32x4*)d = a; *(LAS u32x4*)(d + 16) = c; }
        __syncthreads();
        for (int step = 0; step < nsteps; ++step) {
            const int rowb = row0 + step * 512;
            LAS unsigned char* Ucur = F.lds + L_U + (step & 1) * 16384;
            u32x4 na = {0u, 0u, 0u, 0u}, nc = na;
            if (step + 1 < nsteps) { const bf16_t* src = ub + (size_t)(rowb + 512 + 16 * sn_ + ss_) * DM + 16 * g; na = *(const u32x4*)src; nc = *(const u32x4*)(src + 8); }
            { f32x16 sa = {};
#pragma unroll
              for (int i = 0; i < 8; ++i) { const bf16x8 uf = *(const LAS bf16x8*)(Ucur + ((wave >> 2) * 8 + i) * 1024 + n * 32 + hi * 16); sa = __builtin_amdgcn_mfma_f32_32x32x16_bf16(Hf[i], uf, sa, 0, 0, 0); }
              LAS float* Sp = (LAS float*)(F.lds + ((wave >> 2) ? L_S1 : L_S0));
#pragma unroll
              for (int r = 0; r < 16; ++r) Sp[(32 * (wave & 3) + att::crow(r, hi)) * 36 + n] = sa[r]; }
            __syncthreads();
            if (step > 0) { const LAS unsigned char* ysrc = F.lds + L_U + ((step - 1) & 1) * 16384 + ss_ * 1024 + sn_ * 32; const u32x4 ya0 = *(const LAS u32x4*)ysrc, ya1 = *(const LAS u32x4*)(ysrc + 16);
                bf16_t* dst = dstb + (size_t)(rowb - 512 + 16 * sn_ + ss_) * DM + 16 * g; *(u32x4*)dst = ya0; *(u32x4*)(dst + 8) = ya1; }
            if (wave == 0) {
                const LAS float* S0 = (const LAS float*)(F.lds + L_S0); const LAS float* S1 = (const LAS float*)(F.lds + L_S1);
                LAS bf16_t* Xb = (LAS bf16_t*)(F.lds + L_XB);
#pragma unroll 1
                for (int cg = 0; cg < 4; ++cg) {
                    f32x4 re[2], im[2];
#pragma unroll
                    for (int i = 0; i < 2; ++i) { re[i] = *(const LAS f32x4*)(S0 + lane * 36 + 8 * cg + 4 * i) + *(const LAS f32x4*)(S1 + lane * 36 + 8 * cg + 4 * i);
                                                  im[i] = *(const LAS f32x4*)(S0 + (64 + lane) * 36 + 8 * cg + 4 * i) + *(const LAS f32x4*)(S1 + (64 + lane) * 36 + 8 * cg + 4 * i); }
#pragma unroll
                    for (int k = 0; k < 8; ++k) { const int c = 8 * cg + k;
                        if (smp && !(c & 1)) { const size_t si = ((size_t)(c >> 1) * NG + g) * 64 + lane; X = (f32x2){F.in(I_SRE)[si], F.in(I_SIM)[si]}; }
                        Xb[c * 136 + lane] = (bf16_t)(cvt_pk_bf16(X.x, 0.f) & 0xffffu); Xb[c * 136 + 64 + lane] = (bf16_t)(cvt_pk_bf16(X.y, 0.f) & 0xffffu);
                        const float sr = re[k >> 2][k & 3], si2 = im[k >> 2][k & 3];
                        const float nx = lam.x * X.x - lam.y * X.y + sr, ny = lam.x * X.y + lam.y * X.x + si2; X = (f32x2){nx, ny};
                        if (smp && (c & 1)) { const size_t so = ((size_t)(c >> 1) * NG + g) * 64 + lane; F.out()[O_SRE_S + so] = X.x; F.out()[O_SIM_S + so] = X.y; } }
                }
            }
            f32x16 ya = {};
#pragma unroll
            for (int ks = 0; ks < 16; ++ks) if (ks <= 2 * wave + 1) { const bf16x8 uf = *(const LAS bf16x8*)(Ucur + ks * 1024 + n * 32 + hi * 16); ya = __builtin_amdgcn_mfma_f32_32x32x16_bf16(Kf[ks], uf, ya, 0, 0, 0); }
            if (step + 1 < nsteps) { LAS unsigned char* d = F.lds + L_U + ((step + 1) & 1) * 16384 + ss_ * 1024 + sn_ * 32; *(LAS u32x4*)d = na; *(LAS u32x4*)(d + 16) = nc; }
            __syncthreads();
#pragma unroll
            for (int i = 0; i < 8; ++i) { const bf16x8 gf = *(const LAS bf16x8*)(F.lds + L_G + ((wave * 8 + i) * 64 + lane) * 16); const bf16x8 xf = *(const LAS bf16x8*)(F.lds + L_XB + n * 272 + (16 * i + 8 * hi) * 2);
                ya = __builtin_amdgcn_mfma_f32_32x32x16_bf16(gf, xf, ya, 0, 0, 0); }
#pragma unroll
            for (int q = 0; q < 4; ++q) { const int tl = q >> 1, co = 8 * (q & 1) + 4 * hi;
                u32x2 w; w.x = cvt_pk_bf16(gelu_tanh(ya[4 * q]), gelu_tanh(ya[4 * q + 1])); w.y = cvt_pk_bf16(gelu_tanh(ya[4 * q + 2]), gelu_tanh(ya[4 * q + 3]));
                *(LAS u32x2*)(Ucur + (2 * wave + tl) * 1024 + n * 32 + co * 2) = w; }
        }
        __syncthreads();
        { const int ls = nsteps - 1; const LAS unsigned char* ysrc = F.lds + L_U + (ls & 1) * 16384 + ss_ * 1024 + sn_ * 32; const u32x4 ya0 = *(const LAS u32x4*)ysrc, ya1 = *(const LAS u32x4*)(ysrc + 16);
          bf16_t* dst = dstb + (size_t)(row0 + ls * 512 + 16 * sn_ + ss_) * DM + 16 * g; *(u32x4*)dst = ya0; *(u32x4*)(dst + 8) = ya1; }
        if (!smp && wave == 0) { const size_t so = ((size_t)b * NG + g) * 64 + lane; F.out()[O_SRE_P + so] = X.x; F.out()[O_SIM_P + so] = X.y; }
    }
}

__device__ __forceinline__ void fixup_phase(Frame& F, int layer) {
    const float* zs = (const float*)(F.ws() + WS_ZSIDE); bf16_t* act = (bf16_t*)(F.ws() + WS_BIG);
    const float* cw = F.in(I_CONVW) + (size_t)layer * 3 * DFF2; const float* cb = F.in(I_CONVB) + (size_t)layer * DFF2;
    constexpr int NC4 = DFF / 4;
    for (int i = F.bid * NTHR + F.tid; i < 256 * NC4; i += F.G * NTHR) {
        const int ht = i / NC4, c0 = (i % NC4) * 4; if ((ht & 127) == 0) continue;
        const float* zp = zs + (size_t)(ht - 1) * 4 * DFF2; const float* zc = zs + (size_t)ht * 4 * DFF2;
        f32x4 o0, o1;
        f32x4 cv0, cv1, cg0, cg1;
        { const f32x4 L0 = *(const f32x4*)(zp + 2 * DFF2 + c0), L1 = *(const f32x4*)(zp + 3 * DFF2 + c0), f0 = *(const f32x4*)(zc + c0), f1 = *(const f32x4*)(zc + DFF2 + c0);
          const f32x4 w0 = *(const f32x4*)(cw + c0), w1 = *(const f32x4*)(cw + DFF2 + c0), w2 = *(const f32x4*)(cw + 2 * DFF2 + c0), bb = *(const f32x4*)(cb + c0);
          cv0 = bb + w2 * f0 + w1 * L1 + w0 * L0; cv1 = bb + w2 * f1 + w1 * f0 + w0 * L1; }
        { const int c1 = DFF + c0; const f32x4 L0 = *(const f32x4*)(zp + 2 * DFF2 + c1), L1 = *(const f32x4*)(zp + 3 * DFF2 + c1), f0 = *(const f32x4*)(zc + c1), f1 = *(const f32x4*)(zc + DFF2 + c1);
          const f32x4 w0 = *(const f32x4*)(cw + c1), w1 = *(const f32x4*)(cw + DFF2 + c1), w2 = *(const f32x4*)(cw + 2 * DFF2 + c1), bb = *(const f32x4*)(cb + c1);
          cg0 = bb + w2 * f0 + w1 * L1 + w0 * L0; cg1 = bb + w2 * f1 + w1 * f0 + w0 * L1; }
#pragma unroll
        for (int j = 0; j < 4; ++j) { o0[j] = cv0[j] * cg0[j] * fsigmoid(cg0[j]); o1[j] = cv1[j] * cg1[j] * fsigmoid(cg1[j]); }
        u32x2 w; w.x = cvt_pk_bf16(o0[0], o0[1]); w.y = cvt_pk_bf16(o0[2], o0[3]); *(u32x2*)(act + (size_t)(128 * ht) * DFF + c0) = w;
        w.x = cvt_pk_bf16(o1[0], o1[1]); w.y = cvt_pk_bf16(o1[2], o1[3]); *(u32x2*)(act + (size_t)(128 * ht + 1) * DFF + c0) = w;
    }
}

__device__ __forceinline__ att::BlockRef<bf16_t> attn_ref_p(Frame& F, int L, int pass) {
    const int bh = L >> 5, x = L & 31, qb = pass ? 63 - x : x, b = bh >> 5, vhp = bh & 31, vh = vhp >> 1, vhalf = vhp & 1;
    att::BlockRef<bf16_t> r; const size_t row0 = (size_t)b * SEQ;
    r.Q = (const bf16_t*)(F.ws() + WS_UB) + (row0 + (size_t)qb * 256) * DM + vh * 128;
    r.K = (const bf16_t*)(F.ws() + WS_KB) + row0 * DM + vh * 128; r.V = (const bf16_t*)(F.ws() + WS_VB) + row0 * DM + (vh >> 1) * 256 + vhalf * 128; r.Kt = r.K; r.Vt = r.V;
    r.O = (bf16_t*)(F.ws() + WS_BIG) + (row0 + (size_t)qb * 256) * (2 * DM) + vh * 256 + vhalf * 128;
    r.P0 = qb * 256; r.nt = (r.P0 + 255) / 64 + 1; r.nrows = 256; r.pad = 0; return r;
}
__device__ __forceinline__ att::BlockRef<float> attn_ref_s(Frame& F, int L) {
    const int b = L >> 5, vhp = L & 31, vh = vhp >> 1, vhalf = vhp & 1;
    att::BlockRef<float> r;
    r.Q = (const float*)(F.ws() + WS_QS) + (size_t)b * DSEQ * DM + vh * 128;
    r.K = F.in(I_CK) + (size_t)b * PAST * DM + vh * 128; r.V = F.in(I_CV) + (size_t)b * PAST * DM + (vh >> 1) * 256 + vhalf * 128;
    r.Kt = F.out() + O_K_S + (size_t)b * DSEQ * DM + vh * 128; r.Vt = F.out() + O_V_S + (size_t)b * DSEQ * DM + (vh >> 1) * 256 + vhalf * 128;
    r.O = (bf16_t*)(F.ws() + WS_BIG) + ((size_t)MP + (size_t)b * DSEQ) * (2 * DM) + vh * 256 + vhalf * 128;
    r.P0 = PAST; r.nt = PAST / 64 + 1; r.nrows = DSEQ; r.pad = 0; return r;
}
__device__ __forceinline__ datt::DRef dattn_ref(Frame& F, int L, int pass) {
    const int bh = L >> 5, x = L & 31, qb = pass ? 63 - x : x, b = bh >> 4, vh = bh & 15;
    datt::DRef r; const size_t row0 = (size_t)b * SEQ;
    r.Q = (const bf16_t*)(F.ws() + WS_UB) + (row0 + (size_t)qb * 256) * DM + vh * 128;
    r.K = (const bf16_t*)(F.ws() + WS_KB) + row0 * DM + vh * 128; r.V = (const bf16_t*)(F.ws() + WS_VB) + row0 * DM + (vh >> 1) * 256;
    r.O = (bf16_t*)(F.ws() + WS_BIG) + (row0 + (size_t)qb * 256) * (2 * DM) + vh * 256;
    r.P0 = qb * 256; r.pad = 0; return r;
}
__device__ __forceinline__ int attn_item(int bid, int i, int G) { return G == 256 ? ((8 * i + (bid & 7)) << 5) + (bid >> 3) : bid + i * G; }
__device__ __forceinline__ void attn_phase_prompt(Frame& F) {
    constexpr int total = NBAT * 16 * 32; const int G = F.G, bid = F.bid;
    const int nit = G == 256 ? total / 256 : (total - bid + G - 1) / G; if (nit <= 0) return;
    int it = 0, pass = 0; datt::DRef cur = dattn_ref(F, attn_item(bid, 0, G), 0); datt::DSeam S;
    datt::dattn_prime(cur, (LAS char*)F.lds, S);
    for (;;) {
        const bool more_pass = pass == 0, more_item = it + 1 < nit, last = !more_pass && !more_item;
        int passn = pass + 1, itn = it; if (!more_pass) { passn = 0; itn = more_item ? it + 1 : it; }
        const datt::DRef nxt = last ? cur : dattn_ref(F, attn_item(bid, itn, G), passn);
        datt::dattn_block(cur, nxt, (LAS char*)F.lds, S);
        if (last) break;
        cur = nxt; pass = passn; it = itn;
    }
    asm volatile("s_waitcnt vmcnt(0)" ::: "memory"); __syncthreads();
}
__device__ __forceinline__ int attn_item_s(int bid, int i, int G) { return G == 256 ? i * 256 + (((bid & 7) * 8 + (bid >> 5)) << 2) + ((bid >> 3) & 3) : bid + i * G; }
__device__ __forceinline__ void attn_phase_sample(Frame& F) {
    constexpr int total = DB * 32; const int G = F.G, bid = F.bid;
    const int nit = G == 256 ? total / 256 : (total - bid + G - 1) / G; if (nit <= 0) return;
    int it = 0; att::BlockRef<float> cur = attn_ref_s(F, attn_item_s(bid, 0, G)); att::Seam<float> S;
    att::attn_prime<true, float>(cur, (char*)F.lds, S);
    for (;;) {
        const bool last = it + 1 >= nit;
        const att::BlockRef<float> nxt = last ? cur : attn_ref_s(F, attn_item_s(bid, it + 1, G));
        att::attn_block<true, float>(cur, nxt, (char*)F.lds, S);
        if (last) break;
        cur = nxt; ++it;
    }
}

__device__ __forceinline__ void combine_phase(Frame& F) {
    const float l1 = wave_sum(F.in(I_LQ1)[F.lane] * F.in(I_LK1)[F.lane] + F.in(I_LQ1)[64 + F.lane] * F.in(I_LK1)[64 + F.lane]);
    const float l2 = wave_sum(F.in(I_LQ2)[F.lane] * F.in(I_LK2)[F.lane] + F.in(I_LQ2)[64 + F.lane] * F.in(I_LK2)[64 + F.lane]);
    const float lam_init = 0.8f - 0.6f * 0.7408182206817179f;
    const float lam = expf(l1) - expf(l2) + lam_init, post = 1.0f - lam_init;
    const bf16_t* O = (const bf16_t*)(F.ws() + WS_BIG); bf16_t* ab = (bf16_t*)(F.ws() + WS_HB);
    const int hh = F.lane >> 3, cb = (F.lane & 7) * 8;
    f32x4 gs[8];
#pragma unroll
    for (int i = 0; i < 8; ++i) gs[i] = *(const f32x4*)(F.in(I_NSUB) + (i >> 1) * 64 + cb + (i & 1) * 4);
    const int gw = F.bid * NWAVES + F.wave, NGW = F.G * NWAVES;
    for (int m = gw; m < MT; m += NGW) {
        const u32x4* p1 = (const u32x4*)(O + (size_t)m * (2 * DM) + hh * 512 + cb); const u32x4* p2 = (const u32x4*)(O + (size_t)m * (2 * DM) + hh * 512 + 256 + cb);
        u32x4 a[4], c[4];
#pragma unroll
        for (int i = 0; i < 4; ++i) { a[i] = p1[8 * i]; c[i] = p2[8 * i]; }
        float d[32]; float ss = 0.f;
#pragma unroll
        for (int i = 0; i < 4; ++i)
#pragma unroll
            for (int j = 0; j < 4; ++j) { const float x0 = __uint_as_float(a[i][j] << 16) - lam * __uint_as_float(c[i][j] << 16), x1 = __uint_as_float(a[i][j] & 0xffff0000u) - lam * __uint_as_float(c[i][j] & 0xffff0000u);
                d[8 * i + 2 * j] = x0; d[8 * i + 2 * j + 1] = x1; ss += x0 * x0 + x1 * x1; }
        ss += __shfl_xor(ss, 1); ss += __shfl_xor(ss, 2); ss += __shfl_xor(ss, 4);
        const float rstd = rsqrtf(ss * (1.f / VD) + SUBLN_EPS) * post;
        u32x4* op = (u32x4*)(ab + (size_t)m * DM + hh * 256 + cb);
#pragma unroll
        for (int i = 0; i < 4; ++i) { u32x4 w;
#pragma unroll
            for (int j = 0; j < 4; ++j) w[j] = cvt_pk_bf16(d[8 * i + 2 * j] * rstd * gs[2 * i + (j >> 1)][2 * (j & 1)], d[8 * i + 2 * j + 1] * rstd * gs[2 * i + (j >> 1)][2 * (j & 1) + 1]);
            op[8 * i] = w; }
    }
}

__device__ __forceinline__ void final_phase(Frame& F, const float* part, float* dst) {
    const int gw = F.bid * NWAVES + F.wave, NGW = F.G * NWAVES; const float* g = F.in(I_NFIN); const bf16_t* hb = (const bf16_t*)(F.ws() + WS_HB);
    f32x4 gg[4][2];
#pragma unroll
    for (int j = 0; j < 4; ++j) { gg[j][0] = ((const f32x4*)g)[128 * j + 2 * F.lane]; gg[j][1] = ((const f32x4*)g)[128 * j + 2 * F.lane + 1]; }
    for (int m = gw; m < MT; m += NGW) {
        const float pv = F.lane < 32 ? part[part_idx(m >> 7, F.lane, m & 15) + ((m >> 4) & 7)] : 0.f;
        const float rstd = rsqrtf(wave_sum(pv) * (1.f / DM) + EPS);
        const u32x4* row = (const u32x4*)(hb + (size_t)m * DM) + F.lane; f32x4* orow = (f32x4*)(dst + (size_t)m * DM) + 2 * F.lane;
#pragma unroll
        for (int j = 0; j < 4; ++j) { const u32x4 w = row[64 * j];
            const f32x4 a = {__uint_as_float(w[0] << 16), __uint_as_float(w[0] & 0xffff0000u), __uint_as_float(w[1] << 16), __uint_as_float(w[1] & 0xffff0000u)};
            const f32x4 b2 = {__uint_as_float(w[2] << 16), __uint_as_float(w[2] & 0xffff0000u), __uint_as_float(w[3] << 16), __uint_as_float(w[3] & 0xffff0000u)};
            orow[128 * j] = a * rstd * gg[j][0]; orow[128 * j + 1] = b2 * rstd * gg[j][1]; }
    }
}


__device__ __forceinline__ void probe_mfma(Frame& F, int nit) {
    unsigned sd = (unsigned)F.tid * 2654435761u + (unsigned)F.bid * 40503u + 12345u;
    bf16x8 a[2], b[2];
#pragma unroll
    for (int i = 0; i < 2; ++i) { u32x4 wa, wb;
#pragma unroll
        for (int j = 0; j < 4; ++j) { sd = sd * 1664525u + 1013904223u; wa[j] = (sd & 0xbfffbfffu) | 0x3c003c00u; sd = sd * 1664525u + 1013904223u; wb[j] = (sd & 0xbfffbfffu) | 0x3c003c00u; }
        a[i] = *reinterpret_cast<bf16x8*>(&wa); b[i] = *reinterpret_cast<bf16x8*>(&wb); }
    f32x16 c[4] = {};
    for (int it = 0; it < nit; ++it) {
#pragma unroll
        for (int k = 0; k < 4; ++k) { c[k] = __builtin_amdgcn_mfma_f32_32x32x16_bf16(a[k & 1], b[k >> 1], c[k], 0, 0, 0); }
#pragma unroll
        for (int k = 0; k < 4; ++k) { c[k] = __builtin_amdgcn_mfma_f32_32x32x16_bf16(a[(k + 1) & 1], b[k >> 1], c[k], 0, 0, 0); }
        asm volatile("" : "+v"(a[0]), "+v"(b[0]));
    }
    float s = 0.f;
#pragma unroll
    for (int k = 0; k < 4; ++k) for (int r = 0; r < 16; ++r) s += c[k][r];
    if (s == 1.2345e-30f) *(float*)(F.ws() + WS_CTL + 65536) = s;
}
constexpr int NPHASE = 16;
__device__ __forceinline__ Frame mkframe(LAS unsigned char* lds) {
    Frame F; F.lds = lds; F.kp = kargs();
    int t = threadIdx.x; asm volatile("" : "+v"(t));
    F.wave = __builtin_amdgcn_readfirstlane(t >> 6);
    int ln = __builtin_amdgcn_mbcnt_hi(~0u, __builtin_amdgcn_mbcnt_lo(~0u, 0u)); asm volatile("" : "+v"(ln));
    F.lane = ln; F.tid = F.wave * 64 + ln; F.G = gridDim.x; F.bid = blockIdx.x;
    return F;
}
__device__ __forceinline__ bool ph_in(const Frame& F, int k) { const int lo = *(const __attribute__((address_space(4))) int*)(F.kp + 320), hi = *(const __attribute__((address_space(4))) int*)(F.kp + 324); return lo <= k && k < hi; }
template <unsigned PMASK, int K> __device__ __forceinline__ bool phase_on(const Frame& F) { if constexpr (((PMASK >> K) & 1u) == 0u) return false; else return ph_in(F, K); }
template <unsigned PMASK, int K> __device__ __forceinline__ void seam(LAS unsigned char* lds) {
    if constexpr (K + 1 < NPHASE && ((PMASK >> K) & 1u) && ((PMASK >> (K + 1)) & 1u)) {
        Frame F = mkframe(lds);
        if (ph_in(F, K) && ph_in(F, K + 1)) { XcdBarrier bar; bar.bar = (unsigned*)(F.ws() + WS_CTL) + CW_BAR; bar.x = xb_xcc_id(); bar.st = (volatile LAS unsigned*)(lds + LDS_BYTES - 256) + 8; xcd_barrier(bar); }
    }
}
template <class Epi> __device__ __forceinline__ void gemm_both(LAS unsigned char* ring, const bf16_t* A, const bf16_t* Bt, int N, int K, const Epi& E, int G, int bid, int skip = 0) {
    if (skip > 0 && skip < G) { if (bid < skip) return; G -= skip; bid -= skip; }
    const int wid = __builtin_amdgcn_readfirstlane((int)threadIdx.x >> 6);
    asm volatile("" : "+s"(K));
    { pg8::Gemm g{A, Bt, MP, N, K}; pg8::StaticOrder S; S.init(MP, N, G, bid); pg8::gemm_phase<Epi, pg8::StaticOrder, false>(ring, g, S, E, wid); }
    { pg8::Gemm g{A, Bt, MT, N, K}; pg8::HalfOrder H; H.init(MP / 256, N, G, bid); pg8::gemm_phase<Epi, pg8::HalfOrder, true>(ring, g, H, E, wid); }
}
template <int LAYER, int STEP> __device__ __forceinline__ void ffn_phase(Frame& F) {
    LAS unsigned char* ring = F.lds;
    bf16_t* const hb = (bf16_t*)(F.ws() + (LAYER == 0 ? WS_HB : WS_PP)); bf16_t* const ppb = (bf16_t*)(F.ws() + (LAYER == 0 ? WS_PP : WS_HB));
    float* const pin = (float*)(F.ws() + (LAYER == 0 ? WS_PART0 : WS_PART1)); float* const pout = (float*)(F.ws() + (LAYER == 0 ? WS_PART1 : WS_PART0));
    if constexpr (STEP == 0) {
        const float* cw = (const float*)(F.ws() + WS_CONVP) + (size_t)LAYER * DFF * 8; const float* cb = nullptr; const float* st = F.in(I_SCONV) + (size_t)LAYER * DB * 2 * DFF2;
        float* cp = F.out() + O_CONV_P + (size_t)LAYER * NBAT * 2 * DFF2; float* cs = F.out() + O_CONV_S + (size_t)LAYER * DB * 2 * DFF2;
        constexpr int NP = LAYER == 0 ? 64 : 32;
        EpiUp<NP> E{pin, (bf16_t*)(F.ws() + WS_BIG), cw, cb, st, (float*)(F.ws() + WS_ZSIDE), cp, cs, F.lds, (LAYER == 0 ? 1 : 2) << 20};
        gemm_both(ring, hb, (const bf16_t*)(F.ws() + WS_WUP) + (size_t)LAYER * DFF2 * DM, DFF2, DM, E, F.G, F.bid);
        if constexpr (LAYER == 0) bg_work<1>(F, 4 * (DFF2 / 256), bg_slot(F, 1));
    } else if constexpr (STEP == 1) { fixup_phase(F, LAYER);
    } else if constexpr (STEP == 2) {
        EpiResid E{hb, pout};
        gemm_both(ring, (const bf16_t*)(F.ws() + WS_BIG), (const bf16_t*)(F.ws() + WS_WDOWN) + (size_t)LAYER * DM * DFF, DM, DFF, E, F.G, F.bid);
    } else if constexpr (STEP == 3) {
        EpiBf16 E{ppb, DM};
        gemm_both(ring, (const bf16_t*)(F.ws() + WS_PB), (const bf16_t*)(F.ws() + WS_WPROJ) + (size_t)LAYER * DM * PLE, DM, PLE, E, F.G, F.bid, 4 * (DM / 256));
    } else {
        if constexpr (LAYER == 0) convert_p(F, 1);
        EpiPle E{pout, hb, ppb, pin, F.lds, (LAYER == 0 ? 3 : 4) << 20};
        gemm_both(ring, hb, (const bf16_t*)(F.ws() + WS_WGATE) + (size_t)LAYER * DM * DM, DM, DM, E, F.G, F.bid);
        if constexpr (LAYER == 0) { const int sl = bg_slot(F, 3); bg_work<3>(F, 4 * (DM / 256), sl); bg_work<2>(F, 4 * (DM / 256), sl); }
    }
}
template <unsigned PMASK> __global__ void __launch_bounds__(NTHR, 2) yoco_fwd(Args args) {
    extern __shared__ __attribute__((aligned(16))) unsigned char lds_raw[];
    LAS unsigned char* const lds = (LAS unsigned char*)lds_raw;
    (void)args;
    { Frame F = mkframe(lds);
      volatile LAS unsigned* MISC = (volatile LAS unsigned*)(lds + LDS_BYTES - 256);
      if (F.tid < 64) MISC[F.tid] = 0u;
      __syncthreads();
      if (MK_N_LAUNCHES == 1) (void)xcd_barrier_post((unsigned*)(F.ws() + WS_CTL) + CW_BAR, MISC + 8); }
    if (PROBE_MFMA) { Frame F = mkframe(lds); if (phase_on<PMASK, 0>(F)) probe_mfma(F, PROBE_MFMA); }
#define PH(K, ...) { Frame F = mkframe(lds); if (phase_on<PMASK, K>(F)) { __VA_ARGS__ } } seam<PMASK, K>(lds);
    if (PROBE_P2) { Frame F = mkframe(lds); if (phase_on<PMASK, 0>(F)) { p0_prologue(F); __syncthreads(); } }
    PH(0, p0_prologue(F);)
    if (PROBE_SSM2) { Frame F = mkframe(lds); if (phase_on<PMASK, 1>(F)) { ssm_phase(F, (bf16_t*)(F.ws() + WS_PP)); __syncthreads(); } }
    PH(1, ssm_phase(F, (bf16_t*)(F.ws() + WS_UB));)
    PH(2, { EpiGlu E{F.in(I_XP), F.in(I_XS), (bf16_t*)(F.ws() + WS_HB), (float*)(F.ws() + WS_PART0)};
            gemm_both(F.lds, (const bf16_t*)(F.ws() + WS_UB), (const bf16_t*)(F.ws() + WS_WGLU), 2 * DM, DM, E, F.G, F.bid); bg_work<0>(F, 4 * (2 * DM / 256), bg_slot(F, 0)); })
    if (PROBE_UP2) { Frame F = mkframe(lds); if (phase_on<PMASK, 3>(F)) { ffn_phase<0, 0>(F); } }
    PH(3, (ffn_phase<0, 0>(F));)
    if (PROBE_FF2) { Frame F = mkframe(lds); if (phase_on<PMASK, 4>(F)) { ffn_phase<0, 1>(F); } }
    PH(4, (ffn_phase<0, 1>(F));)
    { Frame F = mkframe(lds); if (phase_on<PMASK, 5>(F)) { ffn_phase<0, 2>(F); } }
    PH(5, (ffn_phase<0, 3>(F));)
    PH(6, (ffn_phase<0, 4>(F));)
    PH(7, { EpiQkv E{(const float*)(F.ws() + WS_PART0), (const float*)(F.ws() + WS_ROPE), (bf16_t*)(F.ws() + WS_UB), (float*)(F.ws() + WS_QS), (bf16_t*)(F.ws() + WS_KB), (bf16_t*)(F.ws() + WS_VB), F.out(), F.lds, 5 << 20};
            gemm_both(F.lds, (const bf16_t*)(F.ws() + WS_PP), (const bf16_t*)(F.ws() + WS_WQKV), 3 * DM, DM, E, F.G, F.bid); bg_work<4>(F, 4 * (3 * DM / 256), bg_slot(F, 4)); })
    { Frame F = mkframe(lds); if (phase_on<PMASK, 8>(F) && ((F.bid >> 5) & 1)) { attn_phase_sample(F); asm volatile("s_waitcnt vmcnt(0)" ::: "memory"); __syncthreads(); } }
    { Frame F = mkframe(lds); if (phase_on<PMASK, 8>(F)) { attn_phase_prompt(F); } }
    { Frame F = mkframe(lds); if (phase_on<PMASK, 8>(F) && !((F.bid >> 5) & 1)) { attn_phase_sample(F); } }
    seam<PMASK, 8>(lds);
    if (PROBE_S2) { Frame F = mkframe(lds); if (phase_on<PMASK, 9>(F)) { combine_phase(F); } }
    PH(9, combine_phase(F);)
    PH(10, { EpiResid E{(bf16_t*)(F.ws() + WS_PP), (float*)(F.ws() + WS_PART1)};
             gemm_both(F.lds, (const bf16_t*)(F.ws() + WS_HB), (const bf16_t*)(F.ws() + WS_WO), DM, DM, E, F.G, F.bid); })
    if (PROBE_UP2) { Frame F = mkframe(lds); if (phase_on<PMASK, 11>(F)) { ffn_phase<1, 0>(F); } }
    PH(11, (ffn_phase<1, 0>(F));)
    if (PROBE_FF2) { Frame F = mkframe(lds); if (phase_on<PMASK, 12>(F)) { ffn_phase<1, 1>(F); } }
    PH(12, (ffn_phase<1, 1>(F));)
    { Frame F = mkframe(lds); if (phase_on<PMASK, 13>(F)) { ffn_phase<1, 2>(F); } }
    PH(13, (ffn_phase<1, 3>(F));)
    PH(14, (ffn_phase<1, 4>(F));)
    if (PROBE_FF2) { Frame F = mkframe(lds); if (phase_on<PMASK, 15>(F)) { final_phase(F, (const float*)(F.ws() + WS_PART1), (float*)(F.ws() + WS_UB)); } }
    PH(15, final_phase(F, (const float*)(F.ws() + WS_PART1), F.out());)
#undef PH
}

#ifndef PHASE_MASK
#define PHASE_MASK 0xFFFFu
#endif
template <unsigned PMASK> static bool prep_kernel() {
    if (hipFuncSetAttribute((const void*)yoco_fwd<PMASK>, hipFuncAttributeMaxDynamicSharedMemorySize, LDS_BYTES) != hipSuccess) { fprintf(stderr, "kernel_launch: hipFuncSetAttribute failed\n"); return false; }
    return true;
}
template <int P> static void launch_phases(int grid, Args& a, hipStream_t stream) {
    if constexpr (P < NPHASE) {
        if ((PHASE_MASK >> P) & 1u) { a.ph_lo = P; a.ph_hi = P + 1; hipLaunchKernelGGL(yoco_fwd<(1u << P)>, dim3(grid), dim3(NTHR), LDS_BYTES, stream, a); }
        launch_phases<P + 1>(grid, a, stream);
    }
}
template <int P> static bool prep_phases() { if constexpr (P < NPHASE) { return prep_kernel<(1u << P)>() && prep_phases<P + 1>(); } else return true; }
extern "C" void kernel_launch(void* const* d_in, const int* in_sizes, int n_in, void* d_out, int out_size, void* d_ws, size_t ws_size, hipStream_t stream) {
    static int grid = 0;
    if (grid == 0) {
        if (n_in != 38 || out_size != (int)O_END || ws_size < WS_END) { fprintf(stderr, "kernel_launch: unexpected shapes (n_in %d, out %d, ws %zu)\n", n_in, out_size, ws_size); grid = -1; return; }
        int dev = 0, cus = 0;
        if (hipGetDevice(&dev) != hipSuccess || hipDeviceGetAttribute(&cus, hipDeviceAttributeMultiprocessorCount, dev) != hipSuccess) { grid = -1; return; }
        bool ok;
        if constexpr (MK_N_LAUNCHES == 1) ok = prep_kernel<0xFFFFu>(); else ok = prep_phases<0>();
        if (!ok) { grid = -1; return; }
        (void)hipGetLastError();
        grid = cus;
    }
    if (grid < 0) return;
    (void)hipMemsetAsync((char*)d_ws + WS_CTL, 0, CTL_ZERO_BYTES, stream);
    Args a{};
    for (int i = 0; i < 38; ++i) a.in[i] = (const float*)d_in[i];
    a.out = (float*)d_out; a.ws = (unsigned char*)d_ws;
    if constexpr (MK_N_LAUNCHES == 1) { a.ph_lo = 0; a.ph_hi = NPHASE; hipLaunchKernelGGL(yoco_fwd<0xFFFFu>, dim3(grid), dim3(NTHR), LDS_BYTES, stream, a); }
    else launch_phases<0>(grid, a, stream);
}
```
